# Optimizing an MI355X kernel written in HIP

```python
import math
import jax, jax.numpy as jnp
from jax import lax
import numpy as np

D_MODEL = 1024
BATCH = 2
SEQ = 8192
DEPTH = 1

N_META = 16
BLOCK = 128
HEAD_DIM = 64
ROT_DIM = HEAD_DIM // 4
ROPE_THETA = 500000.0
DSA_HEADS = 8
KV_RANK = 256
IDX_HEADS = 8
IDX_DIM = 64
TOPK_MAX = 256
FOX_HEADS = 8
DSA_W = DSA_HEADS * HEAD_DIM
FOX_W = FOX_HEADS * HEAD_DIM
N_GROUPS = 4
EXPERTS_PER_GROUP = 8
N_EXPERTS = N_GROUPS * EXPERTS_PER_GROUP
TOPK_IN_GROUP = 2
D_EXPERT = 256
MOE_BLOCK = 128
DN_ALPHA = (2.0 * DEPTH) ** 0.25
DN_BETA = (8.0 * DEPTH) ** -0.25
LN_EPS = 1e-5
RMS_EPS = 1e-6
NEG = -1e30
IN_SPLITS = (DSA_W, KV_RANK, IDX_HEADS * IDX_DIM, IDX_DIM, IDX_HEADS, FOX_W, FOX_W, FOX_W, FOX_HEADS, D_MODEL, D_MODEL)
IN_WIDTH = sum(IN_SPLITS)

kernel_name = "hybrid_dsa_fox_gated_hmoe_deepnorm"


def layer_norm(x, g, b):
    xf = x.astype(jnp.float32)
    mu = xf.mean(-1, keepdims=True)
    var = jnp.square(xf - mu).mean(-1, keepdims=True)
    return ((xf - mu) * lax.rsqrt(var + LN_EPS)).astype(x.dtype) * g + b


def rms_norm(x, g):
    xf = x.astype(jnp.float32)
    return (xf * lax.rsqrt(jnp.square(xf).mean(-1, keepdims=True) + RMS_EPS)).astype(x.dtype) * g


def partial_rope(x, pos):
    half = ROT_DIM // 2
    inv = ROPE_THETA ** (-jnp.arange(half, dtype=jnp.float32) / half)
    ang = pos.astype(jnp.float32)[:, None] * inv[None, :]
    cos = jnp.cos(ang)[None, :, None, :]
    sin = jnp.sin(ang)[None, :, None, :]
    xr = x[..., :ROT_DIM].astype(jnp.float32)
    x1, x2 = xr[..., :half], xr[..., half:]
    rot = jnp.concatenate([x1 * cos - x2 * sin, x2 * cos + x1 * sin], axis=-1).astype(x.dtype)
    return jnp.concatenate([rot, x[..., ROT_DIM:]], axis=-1)


def to_blocks(a):
    B, Lp = a.shape[0], a.shape[1]
    return jnp.moveaxis(a.reshape((B, Lp // BLOCK, BLOCK) + a.shape[2:]), 1, 0)


def from_blocks(a):
    nb, B = a.shape[0], a.shape[1]
    return jnp.moveaxis(a, 0, 1).reshape((B, nb * BLOCK) + a.shape[3:])


def dsa_attention(q, k, v, qi, ki, wi, n_keys):
    Lp = q.shape[1]
    dh = q.shape[-1]
    pad = Lp - n_keys
    topk = min(TOPK_MAX, n_keys // 4)
    kpos = jnp.arange(Lp)
    ki32 = ki.astype(jnp.float32)

    def blk(args):
        qb, qib, wib, b0 = args
        qpos = b0 * BLOCK + jnp.arange(BLOCK)
        valid = (kpos[None, :] <= qpos[:, None]) & (kpos[None, :] >= pad)
        s_idx = jnp.einsum('bqhd,bkd->bqhk', qib.astype(jnp.float32), ki32) * (IDX_DIM ** -0.5)
        s_idx = jnp.einsum('bqhk,bqh->bqk', jax.nn.relu(s_idx), wib.astype(jnp.float32))
        s_idx = jnp.where(valid[None], s_idx, NEG)
        _, sel = lax.top_k(s_idx, topk)
        sel_valid = (sel <= qpos[None, :, None]) & (sel >= pad)
        ks = jax.vmap(lambda kk, ii: kk[ii])(k, sel)
        vs = jax.vmap(lambda vv, ii: vv[ii])(v, sel)
        s = jnp.einsum('bqhd,bqkhd->bhqk', qb.astype(jnp.float32), ks.astype(jnp.float32)) * (dh ** -0.5)
        s = jnp.where(sel_valid[:, None], s, NEG)
        p = jax.nn.softmax(s, axis=-1)
        o = jnp.einsum('bhqk,bqkhd->bqhd', p, vs.astype(jnp.float32))
        return o.astype(q.dtype)

    nb = Lp // BLOCK
    out = lax.map(blk, (to_blocks(q), to_blocks(qi), to_blocks(wi), jnp.arange(nb)))
    return from_blocks(out)


def fox_attention(q, k, v, log_f, n_keys):
    Lp = q.shape[1]
    dh = q.shape[-1]
    pad = Lp - n_keys
    kpos = jnp.arange(Lp)
    c = jnp.cumsum(log_f, axis=1)
    c_k = jnp.transpose(c, (0, 2, 1))
    k32 = k.astype(jnp.float32)
    v32 = v.astype(jnp.float32)

    def blk(args):
        qb, cqb, b0 = args
        qpos = b0 * BLOCK + jnp.arange(BLOCK)
        valid = (kpos[None, :] <= qpos[:, None]) & (kpos[None, :] >= pad)
        s = jnp.einsum('bqhd,bkhd->bhqk', qb.astype(jnp.float32), k32) * (dh ** -0.5)
        s = s + jnp.transpose(cqb, (0, 2, 1))[..., None] - c_k[:, :, None, :]
        s = jnp.where(valid[None, None], s, NEG)
        p = jax.nn.softmax(s, axis=-1)
        o = jnp.einsum('bhqk,bkhd->bqhd', p, v32)
        return o.astype(q.dtype)

    nb = Lp // BLOCK
    out = lax.map(blk, (to_blocks(q), to_blocks(c), jnp.arange(nb)))
    return from_blocks(out)


def token_mixer(h, pos, w_in, b_forget, kv_norm_g, w_kv_up, w_branch_dsa, w_branch_fox, w_out):
    B, T, _ = h.shape
    pad = (-N_META) % BLOCK
    proj = h @ w_in
    offs = np.cumsum(IN_SPLITS)[:-1].tolist()
    (q_a, c_kv, q_i, k_i, w_i, q_f, k_f, v_f, f_lg, g_a, g_f) = jnp.split(proj, offs, axis=-1)

    def heads(t, n):
        return t.reshape(B, T, n, -1)

    q_a = partial_rope(heads(q_a, DSA_HEADS), pos)
    kv = rms_norm(c_kv, kv_norm_g) @ w_kv_up
    k_a, v_a = jnp.split(kv, 2, axis=-1)
    k_a = partial_rope(heads(k_a, DSA_HEADS), pos)
    v_a = heads(v_a, DSA_HEADS)
    q_i = partial_rope(heads(q_i, IDX_HEADS), pos)
    k_i = partial_rope(k_i[:, :, None, :], pos)[:, :, 0]
    w_i = w_i * (IDX_HEADS ** -0.5)
    q_f, k_f, v_f = heads(q_f, FOX_HEADS), heads(k_f, FOX_HEADS), heads(v_f, FOX_HEADS)
    log_f = jax.nn.log_sigmoid((f_lg + b_forget).astype(jnp.float32))

    def pf(t):
        return jnp.pad(t, [(0, 0), (pad, 0)] + [(0, 0)] * (t.ndim - 2))

    y_a = dsa_attention(pf(q_a), pf(k_a), pf(v_a), pf(q_i), pf(k_i), pf(w_i), T)[:, pad:].reshape(B, T, DSA_W)
    y_f = fox_attention(pf(q_f), pf(k_f), pf(v_f), pf(log_f), T)[:, pad:].reshape(B, T, FOX_W)
    merged = jax.nn.sigmoid(g_a) * (y_a @ w_branch_dsa) + jax.nn.sigmoid(g_f) * (y_f @ w_branch_fox)
    return merged @ w_out


def hierarchical_moe(h, w_rg, b_rg, w_re, b_re, w_gate, w_up, w_down):
    B, T, D = h.shape
    xf = h.reshape(-1, D)
    N = xf.shape[0]
    g_logits = (xf @ w_rg).astype(jnp.float32) + b_rg
    g_prob = jax.nn.softmax(g_logits, axis=-1)
    g_sel = jnp.argmax(g_logits, axis=-1)
    rows = jnp.arange(N)
    p_group = g_prob[rows, g_sel][:, None]
    e_logits = ((xf @ w_re).astype(jnp.float32) + b_re).reshape(N, N_GROUPS, EXPERTS_PER_GROUP)
    e_logits = e_logits[rows, g_sel]
    top_l, top_i = lax.top_k(e_logits, TOPK_IN_GROUP)
    gate = p_group * jax.nn.softmax(top_l, axis=-1)
    eid = (g_sel[:, None] * EXPERTS_PER_GROUP + top_i).reshape(-1)
    tok = jnp.repeat(rows, TOPK_IN_GROUP)
    gw = gate.reshape(-1)
    A = N * TOPK_IN_GROUP
    order = jnp.argsort(eid)
    eid_s, tok_s, gw_s = eid[order], tok[order], gw[order]
    counts = jnp.zeros((N_EXPERTS,), jnp.int32).at[eid].add(1)
    start = jnp.cumsum(counts) - counts
    pcounts = (counts + MOE_BLOCK - 1) // MOE_BLOCK * MOE_BLOCK
    pend = jnp.cumsum(pcounts)
    pstart = pend - pcounts
    dest = pstart[eid_s] + jnp.arange(A) - start[eid_s]
    n_blocks = (A + N_EXPERTS * (MOE_BLOCK - 1) + MOE_BLOCK - 1) // MOE_BLOCK
    R = n_blocks * MOE_BLOCK
    buf_x = jnp.zeros((R, D), h.dtype).at[dest].set(xf[tok_s])
    buf_w = jnp.zeros((R,), jnp.float32).at[dest].set(gw_s.astype(jnp.float32))
    buf_tok = jnp.zeros((R,), jnp.int32).at[dest].set(tok_s)
    blk_e = jnp.minimum(jnp.searchsorted(pend, jnp.arange(n_blocks) * MOE_BLOCK, side='right'), N_EXPERTS - 1)

    def expert_block(args):
        xb, e = args
        return (jax.nn.silu(xb @ w_gate[e]) * (xb @ w_up[e])) @ w_down[e]

    y = lax.map(expert_block, (buf_x.reshape(n_blocks, MOE_BLOCK, D), blk_e)).reshape(R, D)
    out = jnp.zeros((N, D), jnp.float32).at[buf_tok].add(y.astype(jnp.float32) * buf_w[:, None])
    return out.astype(h.dtype).reshape(B, T, D)


def setup_inputs(seed: int = 0) -> dict:
    key = jax.random.key(seed)
    ks = jax.random.split(key, 24)
    n = jax.random.normal
    f32 = jnp.float32
    L = DEPTH
    return {
        "x": n(ks[0], (BATCH, SEQ, D_MODEL), f32),
        "meta_tokens": n(ks[1], (N_META, D_MODEL), f32),
        "emb_ln_g": 1.0 + 0.02 * n(ks[2], (D_MODEL,), f32),
        "emb_ln_b": 0.02 * n(ks[3], (D_MODEL,), f32),
        "w_in": n(ks[4], (L, D_MODEL, IN_WIDTH), f32) * D_MODEL ** -0.5,
        "b_forget": 3.0 + 0.5 * n(ks[5], (L, FOX_HEADS), f32),
        "kv_norm_g": 1.0 + 0.02 * n(ks[6], (L, KV_RANK), f32),
        "w_kv_up": n(ks[7], (L, KV_RANK, 2 * DSA_W), f32) * KV_RANK ** -0.5,
        "w_branch_dsa": n(ks[8], (L, DSA_W, D_MODEL), f32) * DSA_W ** -0.5,
        "w_branch_fox": n(ks[9], (L, FOX_W, D_MODEL), f32) * FOX_W ** -0.5,
        "w_out": n(ks[10], (L, D_MODEL, D_MODEL), f32) * (D_MODEL ** -0.5 * DN_BETA),
        "ln1_g": 1.0 + 0.02 * n(ks[11], (L, D_MODEL), f32),
        "ln1_b": 0.02 * n(ks[12], (L, D_MODEL), f32),
        "w_router_group": n(ks[13], (L, D_MODEL, N_GROUPS), f32) * D_MODEL ** -0.5,
        "b_router_group": 0.01 * n(ks[14], (L, N_GROUPS), f32),
        "w_router_expert": n(ks[15], (L, D_MODEL, N_EXPERTS), f32) * D_MODEL ** -0.5,
        "b_router_expert": 0.01 * n(ks[16], (L, N_EXPERTS), f32),
        "w_gate": n(ks[17], (L, N_EXPERTS, D_MODEL, D_EXPERT), f32) * D_MODEL ** -0.5,
        "w_up": n(ks[18], (L, N_EXPERTS, D_MODEL, D_EXPERT), f32) * D_MODEL ** -0.5,
        "w_down": n(ks[19], (L, N_EXPERTS, D_EXPERT, D_MODEL), f32) * (D_EXPERT ** -0.5 * DN_BETA),
        "ln2_g": 1.0 + 0.02 * n(ks[20], (L, D_MODEL), f32),
        "ln2_b": 0.02 * n(ks[21], (L, D_MODEL), f32),
    }


def reference(x, meta_tokens, emb_ln_g, emb_ln_b, w_in, b_forget, kv_norm_g, w_kv_up, w_branch_dsa,
              w_branch_fox, w_out, ln1_g, ln1_b, w_router_group, b_router_group, w_router_expert,
              b_router_expert, w_gate, w_up, w_down, ln2_g, ln2_b):
    B = x.shape[0]
    meta = jnp.broadcast_to(meta_tokens.astype(x.dtype)[None], (B, N_META, x.shape[-1]))
    h = layer_norm(jnp.concatenate([meta, x], axis=1), emb_ln_g, emb_ln_b)
    pos = jnp.arange(h.shape[1])
    for l in range(DEPTH):
        mix = token_mixer(h, pos, w_in[l], b_forget[l], kv_norm_g[l], w_kv_up[l],
                          w_branch_dsa[l], w_branch_fox[l], w_out[l])
        h = layer_norm(DN_ALPHA * h + mix, ln1_g[l], ln1_b[l])
        ffn = hierarchical_moe(h, w_router_group[l], b_router_group[l], w_router_expert[l],
                               b_router_expert[l], w_gate[l], w_up[l], w_down[l])
        h = layer_norm(DN_ALPHA * h + ffn, ln2_g[l], ln2_b[l])
    return h[:, N_META:]
```

```cpp
#include <hip/hip_runtime.h>
#include <hip/hip_cooperative_groups.h>
#include <hip/hip_bf16.h>
#include <stdint.h>
#include <stdio.h>
namespace cg = cooperative_groups;

#ifndef ONLY_PHASE
#define ONLY_PHASE -1
#endif
#ifndef PH_MASK
#define PH_MASK 0x7ff
#endif
#define PH(k) ((ONLY_PHASE < 0 || ONLY_PHASE == (k)) && ((PH_MASK >> (k)) & 1))
#ifndef REPEAT_PH
#define REPEAT_PH -1
#endif
#ifndef IDX_REP_MFMA
#define IDX_REP_MFMA 1
#endif
#ifndef P7_REP
#define P7_REP 1
#endif
#ifndef P10_REP
#define P10_REP 1
#endif
#ifndef ATT_PROBE
#define ATT_PROBE 0
#endif
#ifndef IDX_PROBE
#define IDX_PROBE 0
#endif
#ifndef IDX_REP_SEL
#define IDX_REP_SEL 1
#endif
#ifndef IDX_REP
#define IDX_REP 1
#endif
#ifndef EXTRA_SYNCS
#define EXTRA_SYNCS 0
#endif
#ifndef N_LAUNCH_MODE
#define N_LAUNCH_MODE 0
#endif

typedef unsigned short bf16_t;
typedef short bf16x8 __attribute__((ext_vector_type(8)));
typedef float f32x4 __attribute__((ext_vector_type(4)));
typedef float f32x16 __attribute__((ext_vector_type(16)));

constexpr int NB = 2, SEQ = 8192, DM = 1024, NMETA = 16;
constexpr int T = SEQ + NMETA;
constexpr int TP = 8448;
constexpr int R = NB * TP;
constexpr int NTOK = NB * SEQ;
constexpr int NP = 5120;
constexpr int MW = TP / 64;
constexpr float LN_EPS = 1e-5f, RMS_EPS = 1e-6f;
constexpr float ALPHA = 1.189207115002721f;
constexpr float LOG2E = 1.4426950408889634f;
constexpr float QSCALE = 0.125f * LOG2E;
constexpr int NTHREADS = 512;
constexpr int NPHASES = 11;

constexpr size_t al256(size_t x) { return (x + 255) & ~size_t(255); }
constexpr size_t OFF_CTL = 0;
constexpr size_t OFF_ROPE = 65536;
constexpr size_t OFF_STAT0 = OFF_ROPE + al256((size_t)TP * 16 * 4);
constexpr size_t OFF_WRT = OFF_STAT0 + al256((size_t)R * 8);
constexpr size_t OFF_WIN = OFF_WRT + (size_t)2 * 48 * 1024 * 2;
constexpr size_t OFF_WKV = OFF_WIN + (size_t)NP * 1024 * 2;
constexpr size_t OFF_WA = OFF_WKV + (size_t)1024 * 256 * 2;
constexpr size_t OFF_WF = OFF_WA + (size_t)1024 * 512 * 2;
constexpr size_t OFF_WO = OFF_WF + (size_t)1024 * 512 * 2;
constexpr size_t OFF_HB = OFF_WO + (size_t)1024 * 1024 * 2;
constexpr size_t OFF_HBM = OFF_HB + (size_t)NTOK * 1024 * 2;
constexpr size_t OFF_QI = OFF_HB + (size_t)R * 1024 * 2;
constexpr size_t OFF_QA = OFF_QI + (size_t)R * 512 * 2;
constexpr size_t OFF_QF = OFF_QA + (size_t)R * 512 * 2;
constexpr size_t OFF_KF = OFF_QF + (size_t)R * 512 * 2;
constexpr size_t OFF_VF = OFF_KF + (size_t)R * 512 * 2;
constexpr size_t OFF_KA = OFF_VF + (size_t)R * 512 * 2;
constexpr size_t OFF_VA = OFF_KA + (size_t)R * 512 * 2;
constexpr size_t OFF_KI = OFF_VA + (size_t)R * 512 * 2;
constexpr size_t OFF_WI = OFF_KI + (size_t)R * 64 * 2;
constexpr size_t OFF_LOGF = OFF_WI + (size_t)R * 8 * 4;
constexpr size_t OFF_CUM = OFF_LOGF + (size_t)R * 8 * 4;
constexpr size_t OFF_CUMT = OFF_CUM + (size_t)R * 8 * 4;
constexpr size_t OFF_KNORM = OFF_CUMT + (size_t)R * 8 * 4;
constexpr size_t OFF_CKV = OFF_KNORM + al256((size_t)NB * 8 * MW * 4);
constexpr size_t OFF_MASK = OFF_CKV + (size_t)R * 256 * 2;
constexpr size_t OFF_TOKL = OFF_MASK + (size_t)R * MW * 8;
constexpr size_t OFF_GW = OFF_TOKL + (size_t)32 * 32768 * 4;
constexpr int HID_ROWS = 32768 + 32 * 256;
constexpr size_t OFF_MCKV = OFF_GW + (size_t)NTOK * 2 * 4;
constexpr size_t OFF_ST1 = OFF_MCKV + 16 * 256 * 4;
constexpr size_t OFF_HID = OFF_ST1 + (size_t)NTOK * 2 * 4;
constexpr size_t OFF_YA = OFF_HID + (size_t)HID_ROWS * 256 * 2;
constexpr size_t OFF_YF = OFF_YA + (size_t)NTOK * 512 * 2;
constexpr size_t WS_END = OFF_YF + (size_t)NTOK * 512 * 2;
constexpr size_t OFF_WGU = OFF_HB;
constexpr size_t OFF_WD = OFF_WGU + (size_t)32 * 512 * 1024 * 2;
constexpr size_t OFF_MERGED = OFF_KF;
constexpr size_t OFF_H1B = OFF_YA;
constexpr size_t OFF_SLOT = OFF_QA;
static_assert(OFF_WD + (size_t)32 * 1024 * 256 * 2 <= OFF_QA, "moe weights fit in HB+QI");
static_assert(OFF_MERGED + (size_t)NTOK * 1024 * 2 <= OFF_KA, "merged fits");
static_assert(OFF_H1B + (size_t)NTOK * 1024 * 2 <= WS_END, "h1b fits");
static_assert(OFF_SLOT + (size_t)NTOK * 2 * 1024 * 2 <= OFF_KA, "slot fits");
static_assert(WS_END <= (size_t)256 * 1024 * 1024, "workspace");

constexpr int CW_Q3 = 0, CW_Q4 = 64, CW_ECNT = 128, CW_BAR = 4096;

constexpr int SCP = TP + 16;
constexpr int HP = 264;
constexpr int LDS_IDX = 8 * SCP * 2 + 8 * HP * 4;
constexpr int LDS_ROUTER = 36 * 1024 * 4;
constexpr int LDS_GEMM = 2 * (256 * 64 + 128 * 64) * 2 + 1024;
constexpr int LDS_BYTES = 150528;

struct Params {
    const float* in[22];
    float* out;
    unsigned char* ws;
    int ph_lo, ph_hi;
};

typedef const __attribute__((address_space(4))) Params* KParams;
__device__ __forceinline__ f32x4 zero4() { float z = 0.f; asm volatile("" : "+v"(z)); return (f32x4){z, z, z, z}; }
__device__ __forceinline__ uint4 zero4u() { unsigned z = 0u; asm volatile("" : "+v"(z)); return make_uint4(z, z, z, z); }
__device__ __forceinline__ int ltid() { int t = threadIdx.x; asm volatile("" : "+v"(t)); return t; }
__device__ __forceinline__ unsigned f2bf(float f) { unsigned u = __float_as_uint(f); return (u + 0x7fffu + ((u >> 16) & 1u)) >> 16; }
typedef __bf16 bf16x2_t __attribute__((ext_vector_type(2)));
typedef float f32x2 __attribute__((ext_vector_type(2)));
__device__ __forceinline__ unsigned pk2(float lo, float hi) { f32x2 v = {lo, hi}; bf16x2_t b = __builtin_convertvector(v, bf16x2_t); return __builtin_bit_cast(unsigned, b); }
__device__ __forceinline__ float bf2f(unsigned h) { return __uint_as_float(h << 16); }
template <int CTRL> __device__ __forceinline__ float dppf(float v) { return __uint_as_float((unsigned)__builtin_amdgcn_update_dpp(0, (int)__float_as_uint(v), CTRL, 0xf, 0xf, true)); }
__device__ __forceinline__ float wave_sum(float v) {
    v += dppf<0xB1>(v);
    v += dppf<0x4E>(v);
    v += dppf<0x124>(v);
    v += dppf<0x128>(v);
    const float a = __uint_as_float((unsigned)__builtin_amdgcn_readlane((int)__float_as_uint(v), 0)), b = __uint_as_float((unsigned)__builtin_amdgcn_readlane((int)__float_as_uint(v), 16));
    const float c = __uint_as_float((unsigned)__builtin_amdgcn_readlane((int)__float_as_uint(v), 32)), d = __uint_as_float((unsigned)__builtin_amdgcn_readlane((int)__float_as_uint(v), 48));
    return (a + b) + (c + d);
}
__device__ __forceinline__ float sigmoidf_(float v) { return 1.0f / (1.0f + __expf(-v)); }

__device__ __forceinline__ int win_oldcol(int n) {
    if (n < 1344) return n;
    if (n < 2880) return n + 8;
    if (n < 4928) return n + 16;
    if (n < 4936) return 1344 + (n - 4928);
    if (n < 4944) return 2888 + (n - 4936);
    return -1;
}

template <class ColMap>
__device__ __forceinline__ void xpose64(const float* __restrict__ src, int src_ld, bf16_t* __restrict__ dst, int dst_ld, int k0, int n0, ColMap cm,
                                        const float* __restrict__ kscale, float* tile) {
    const int tid = ltid();
    {
        const int nn = tid & 63; const int sc = cm(n0 + nn);
#pragma unroll
        for (int i = 0; i < 8; ++i) {
            const int kk = (tid >> 6) + 8 * i;
            float v = 0.f;
            if (sc >= 0) { v = src[(size_t)(k0 + kk) * src_ld + sc]; if (kscale) v *= kscale[k0 + kk]; }
            tile[kk * 65 + nn] = v;
        }
    }
    __syncthreads();
    {
        const int kp = tid & 31;
#pragma unroll
        for (int i = 0; i < 4; ++i) {
            const int nn = (tid >> 5) + 16 * i;
            const unsigned u = pk2(tile[(2 * kp) * 65 + nn], tile[(2 * kp + 1) * 65 + nn]);
            *(unsigned*)(dst + (size_t)(n0 + nn) * dst_ld + k0 + 2 * kp) = u;
        }
    }
    __syncthreads();
}


struct XTile { const float* src; bf16_t* dst; const float* kscale; int src_ld, dst_ld, k0, j0, rb, s16, winmap; };
template <class Decode>
__device__ __forceinline__ void xpose_group(int g4, int ntiles, Decode dec, float* tiles  ) {
    const int tid = ltid();
    const int nn = tid & 63, kr = tid >> 6;
    float v[4][8];
    XTile xt[4];
#pragma unroll
    for (int q = 0; q < 4; ++q) {
        const int it = g4 * 4 + q;
        if (it < ntiles) {
            xt[q] = dec(it);
            const int sc = xt[q].winmap ? win_oldcol(xt[q].j0 + nn) : (xt[q].j0 + nn);
#pragma unroll
            for (int i = 0; i < 8; ++i) {
                const int kk = kr + 8 * i;
                float x = 0.f;
                if (sc >= 0) x = xt[q].src[(size_t)(xt[q].k0 + kk) * xt[q].src_ld + sc];
                v[q][i] = x;
            }
        }
    }
#pragma unroll
    for (int q = 0; q < 4; ++q)
        if (g4 * 4 + q < ntiles) {
#pragma unroll
            for (int i = 0; i < 8; ++i) {
                const int kk = kr + 8 * i;
                float x = v[q][i];
                if (xt[q].kscale) x *= xt[q].kscale[xt[q].k0 + kk];
                tiles[q * 4160 + kk * 65 + nn] = x;
            }
        }
    __syncthreads();
    {
        const int kp = tid & 31;
#pragma unroll
        for (int q = 0; q < 4; ++q)
            if (g4 * 4 + q < ntiles) {
#pragma unroll
                for (int i = 0; i < 4; ++i) {
                    const int vr = (tid >> 5) + 16 * i;
                    const int row = xt[q].rb + (vr >> 4) * xt[q].s16 + (vr & 15);
                    *(unsigned*)(xt[q].dst + (size_t)row * xt[q].dst_ld + xt[q].k0 + 2 * kp) = pk2(tiles[q * 4160 + (2 * kp) * 65 + vr], tiles[q * 4160 + (2 * kp + 1) * 65 + vr]);
                }
            }
    }
    __syncthreads();
}
template <class Decode>
__device__ __forceinline__ void xpose_many(int ntiles, int G, int bid, Decode dec, float* tiles) {
    for (int g4 = bid; g4 * 4 < ntiles; g4 += G) xpose_group(g4, ntiles, dec, tiles);
}
__device__ __forceinline__ XTile moe_tile(KParams kq, unsigned char* wsq, int it) {
    XTile x; x.kscale = nullptr; x.winmap = 0;
    const int which = it / 2048, rem = it % 2048, e = rem / 64, i = rem % 64;
    if (which < 2) {
        x.src = kq->in[which == 0 ? 17 : 18] + (size_t)e * 1024 * 256; x.src_ld = 256;
        x.dst = (bf16_t*)(wsq + OFF_WGU) + (size_t)e * 512 * 1024; x.dst_ld = 1024;
        x.k0 = (i % 16) * 64; x.j0 = (i / 16) * 64; x.rb = (x.j0 >> 4) * 32 + which * 16; x.s16 = 32;
    } else {
        x.src = kq->in[19] + (size_t)e * 256 * 1024; x.src_ld = 1024;
        x.dst = (bf16_t*)(wsq + OFF_WD) + (size_t)e * 1024 * 256; x.dst_ld = 256;
        x.k0 = (i % 4) * 64; x.j0 = (i / 4) * 64; x.rb = x.j0; x.s16 = 16;
    }
    return x;
}

constexpr int GEMM_BUF = 256 * 64 + 128 * 64;
__device__ __forceinline__ void gemm_core(const bf16_t* const (&ap)[4], const bf16_t* const (&bp)[2], int K, bf16_t* sm, f32x4 (&acc)[4][4]) {
    const int tid = ltid(), lane = tid & 63, wave = __builtin_amdgcn_readfirstlane(tid >> 6);
    const int wm = wave >> 1, wn = wave & 1;
    const int swz = ((tid & 7) ^ ((tid >> 4) & 7)) * 8;
    const int woff = (tid >> 3) * 64 + swz;
    uint4 ra[4], rb[2];
#pragma unroll
    for (int i = 0; i < 4; ++i) ra[i] = *(const uint4*)(ap[i]);
#pragma unroll
    for (int i = 0; i < 2; ++i) rb[i] = *(const uint4*)(bp[i]);
#pragma unroll
    for (int i = 0; i < 4; ++i) *(uint4*)(sm + woff + 4096 * i) = ra[i];
#pragma unroll
    for (int i = 0; i < 2; ++i) *(uint4*)(sm + 16384 + woff + 4096 * i) = rb[i];
    __syncthreads();
    const int nk = K >> 6;
    const int rsw = (lane >> 1) & 7;
    for (int kt = 0; kt < nk; ++kt) {
        const int cur = kt & 1;
        if (kt + 1 < nk) {
#pragma unroll
            for (int i = 0; i < 4; ++i) ra[i] = *(const uint4*)(ap[i] + (kt + 1) * 64);
#pragma unroll
            for (int i = 0; i < 2; ++i) rb[i] = *(const uint4*)(bp[i] + (kt + 1) * 64);
        }
        const bf16_t* sa = sm + cur * GEMM_BUF;
        const bf16_t* sb = sa + 16384;
#pragma unroll
        for (int ks = 0; ks < 2; ++ks) {
            const int coff = ((ks * 4 + (lane >> 4)) ^ rsw) * 8;
            bf16x8 af[4], bfr[4];
#pragma unroll
            for (int mi = 0; mi < 4; ++mi) af[mi] = *(const bf16x8*)(sa + (wm * 64 + mi * 16 + (lane & 15)) * 64 + coff);
#pragma unroll
            for (int ni = 0; ni < 4; ++ni) bfr[ni] = *(const bf16x8*)(sb + (wn * 64 + ni * 16 + (lane & 15)) * 64 + coff);
#pragma unroll
            for (int mi = 0; mi < 4; ++mi)
#pragma unroll
                for (int ni = 0; ni < 4; ++ni) acc[mi][ni] = __builtin_amdgcn_mfma_f32_16x16x32_bf16(bfr[ni], af[mi], acc[mi][ni], 0, 0, 0);
        }
        if (kt + 1 < nk) {
            bf16_t* dn = sm + (cur ^ 1) * GEMM_BUF;
#pragma unroll
            for (int i = 0; i < 4; ++i) *(uint4*)(dn + woff + 4096 * i) = ra[i];
#pragma unroll
            for (int i = 0; i < 2; ++i) *(uint4*)(dn + 16384 + woff + 4096 * i) = rb[i];
        }
        __syncthreads();
    }
}
__device__ __forceinline__ void zero_acc(f32x4 (&acc)[4][4]) {
#pragma unroll
    for (int i = 0; i < 4; ++i)
#pragma unroll
        for (int j = 0; j < 4; ++j) acc[i][j] = zero4();
}
__device__ __forceinline__ void dense_ptrs(const bf16_t* A, int lda, int row0, const bf16_t* Bt, int ldb, int col0, const bf16_t* (&ap)[4], const bf16_t* (&bp)[2]) {
    const int tid = ltid();
#pragma unroll
    for (int i = 0; i < 4; ++i) ap[i] = A + (size_t)(row0 + (tid >> 3) + 64 * i) * lda + (tid & 7) * 8;
#pragma unroll
    for (int i = 0; i < 2; ++i) bp[i] = Bt + (size_t)(col0 + (tid >> 3) + 64 * i) * ldb + (tid & 7) * 8;
}

__device__ __forceinline__ void rope_tile(f32x4& v, const float* __restrict__ rope, int t, int lane) {
    const int ib = ((lane >> 4) & 1) * 4;
    const float* rp = rope + (size_t)t * 16 + ib * 2;
#pragma unroll
    for (int j = 0; j < 4; ++j) {
        const float x = v[j];
        const float pr = __shfl_xor(x, 32);
        const float c = rp[2 * j], s = rp[2 * j + 1];
        v[j] = (lane < 32) ? (x * c - pr * s) : (x * c + pr * s);
    }
}
__device__ __forceinline__ void store4bf(bf16_t* dst, const f32x4& v) {
    uint2 u; u.x = pk2(v[0], v[1]); u.y = pk2(v[2], v[3]);
    *(uint2*)dst = u;
}

namespace pg8 {
#define PG8_LAS __attribute__((address_space(3)))
constexpr int BM = 256, BK = 64, HALF = 128, HTB = HALF * BK * 2  , STAGE_BYTES = 8 * HTB, NXCD = 8, WGM = 8;

__host__ __device__ __forceinline__ int lds_byte(int r, int c) { const int st = (r >> 4) * 2 + (c >> 5), rr = r & 15, cc = c & 31, ob = rr * 64 + cc * 2; return st * 1024 + (ob ^ (((ob >> 9) & 1) << 5)); }
__host__ __device__ __forceinline__ void stage_rc(int b, int& R, int& C) { const int st = b / 1024, sb = b % 1024, swz = sb ^ (((sb >> 9) & 1) << 5); R = (st >> 1) * 16 + swz / 64; C = (st & 1) * 32 + (swz % 64) / 2; }
__host__ __device__ __forceinline__ int perm32(int rho) { const int n = rho >> 4, i = rho & 15; return 8 * (i >> 2) + 4 * n + (i & 3); }

struct Unit { int pm, pn; };
struct Gemm { const bf16_t* A; const bf16_t* Bt; int M, N, K; };

struct StaticOrder {
    int nM, nN, nwg, G, c;
    const PG8_LAS int* tab;
    __host__ __device__ void init(int M, int N, int G_, int c_) { nM = M / BM; nN = N / BM; nwg = nM * nN; G = G_; c = c_; tab = nullptr; }
    __device__ void init_moe(const PG8_LAS int* tab_, int G_, int c_) { nM = nN = nwg = 0; G = G_; c = c_; tab = tab_; }
    __device__ bool next(int i, Unit& u) const {
        if (tab) {
            const int L = i * G + c; if (L >= tab[96] * 4) return false;
            const int ch = L >> 2; int e = 0;
#pragma unroll 1
            for (int k = 1; k < 32; ++k) if (tab[32 + k] <= ch) e = k;
            u.pm = (tab[64 + e] >> 8) + (ch - tab[32 + e]); u.pn = e * 4 + (L & 3); return true;
        }
        const long L = (long)i * G + c; if (L >= nwg) return false;
        int wgid = (int)L; { const int q = nwg / NXCD, r = nwg % NXCD, xcd = wgid % NXCD, off = wgid / NXCD; wgid = (xcd < r ? xcd * (q + 1) : r * (q + 1) + (xcd - r) * q) + off; }
        const int nig = WGM * nN, gid = wgid / nig, fm = gid * WGM, gsz = (nM - fm) < WGM ? (nM - fm) : WGM;
        u.pm = fm + ((wgid % nig) % gsz); u.pn = (wgid % nig) / gsz; return true;
    }
    __device__ __forceinline__ void a_ready(const Unit&) const {}
    __device__ __forceinline__ void done(const Unit&) const {}
};

template <class Epi, class Sched, bool ALIGN_EPI = false, bool SP2 = false>
__device__ __forceinline__ void gemm_phase(PG8_LAS unsigned char* lds, const Gemm g, const Sched& S, const Epi& E) {
    const int tid = ltid(), wid = __builtin_amdgcn_readfirstlane(tid >> 6), lane = tid & 63, wr = wid >> 2, wc = wid & 3, fr = lane & 15, fq = lane >> 4;
    const int K = g.K, nt = K / BK;
    unsigned voffA[2], voffB[2];
#pragma unroll
    for (int i = 0; i < 2; ++i) { int R, C; stage_rc(tid * 16 + i * 8192, R, C); const int Rb = Epi::PERM ? ((R & ~31) + perm32(R & 31)) : R;
        voffA[i] = (unsigned)(R * K + C) * 2u; voffB[i] = (unsigned)(Rb * K + C) * 2u; }
    const size_t kstep = (size_t)(BK * 2);
    const size_t hstep = (size_t)HALF * K * 2;
    const size_t tstep = 2 * hstep;
    const unsigned ldsw = (unsigned)wid * 1024u;
    const int aoff = lds_byte(wr * 64 + fr, fq * 8), boff = lds_byte(wc * 32 + fr, fq * 8);
#define PG8_SA(b, h) (((b) * 2 + (h)) * HTB)
#define PG8_SB(b, h) ((4 + (b) * 2 + (h)) * HTB)
#define PG8_STAGE(bufoff, gbase, voff) do { _Pragma("unroll") for (int _i = 0; _i < 2; ++_i) \
        __builtin_amdgcn_global_load_lds((const unsigned*)((const char*)(gbase) + (voff)[_i]), (PG8_LAS unsigned*)(lds + (bufoff) + ldsw + _i * 8192), 16, 0, 0); } while (0)
#define PG8_LDA(dst, b, h) do { _Pragma("unroll") for (int m = 0; m < 4; ++m) _Pragma("unroll") for (int k = 0; k < 2; ++k) dst[m][k] = *(const PG8_LAS bf16x8*)(lds + PG8_SA(b, h) + aoff + m * 2048 + k * 1024); } while (0)
#define PG8_LDB(dst, b, h) do { _Pragma("unroll") for (int n = 0; n < 2; ++n) _Pragma("unroll") for (int k = 0; k < 2; ++k) dst[n][k] = *(const PG8_LAS bf16x8*)(lds + PG8_SB(b, h) + boff + n * 2048 + k * 1024); } while (0)
#define PG8_MMA(ai, bj, At, Bt) do { __builtin_amdgcn_s_setprio(1); _Pragma("unroll") for (int m = 0; m < 4; ++m) _Pragma("unroll") for (int n = 0; n < 2; ++n) _Pragma("unroll") for (int k = 0; k < 2; ++k) \
        acc[ai][bj][m][n] = __builtin_amdgcn_mfma_f32_16x16x32_bf16(Bt[n][k], At[m][k], acc[ai][bj][m][n], 0, 0, 0); __builtin_amdgcn_s_setprio(0); } while (0)
#define PG8_WAIT_V(n) asm volatile("s_waitcnt vmcnt(" #n ")" ::: "memory")
#define PG8_WAIT_L(n) asm volatile("s_waitcnt lgkmcnt(" #n ")" ::: "memory")
#define PG8_BAR __builtin_amdgcn_s_barrier()
#define PG8_SCHED __builtin_amdgcn_sched_barrier(0)
    Unit cur, nxt; int ui = 0;
    if (!S.next(0, cur)) return;
    f32x4 acc[2][2][4][2];
#pragma unroll
    for (int a = 0; a < 2; ++a)
#pragma unroll
        for (int b = 0; b < 2; ++b)
#pragma unroll
            for (int m = 0; m < 4; ++m)
#pragma unroll
                for (int n = 0; n < 2; ++n) acc[a][b][m][n] = zero4();
    bf16x8 At[4][2], B0[2][2], B1[2][2];
    const char* cA = (const char*)g.A + (size_t)cur.pm * tstep; const char* cB = (const char*)g.Bt + (size_t)cur.pn * tstep;
    S.a_ready(cur);
    if constexpr (SP2) {
        PG8_STAGE(PG8_SB(0, 0), cB, voffB); PG8_STAGE(PG8_SB(0, 1), cB + hstep, voffB); PG8_STAGE(PG8_SA(0, 0), cA, voffA); PG8_STAGE(PG8_SA(0, 1), cA + hstep, voffA);
        if (wr == 1) PG8_BAR;
        PG8_WAIT_V(2); PG8_BAR;
        PG8_STAGE(PG8_SB(1, 0), cB + kstep, voffB); PG8_STAGE(PG8_SA(1, 0), cA + kstep, voffA); PG8_STAGE(PG8_SB(1, 1), cB + hstep + kstep, voffB);
        PG8_WAIT_V(6); PG8_BAR;
    } else {
        PG8_STAGE(PG8_SB(0, 0), cB, voffB); PG8_STAGE(PG8_SA(0, 0), cA, voffA); PG8_STAGE(PG8_SB(0, 1), cB + hstep, voffB); PG8_STAGE(PG8_SA(0, 1), cA + hstep, voffA);
        if (wr == 1) PG8_BAR;
        PG8_WAIT_V(4); PG8_BAR;
        PG8_STAGE(PG8_SB(1, 0), cB + kstep, voffB); PG8_STAGE(PG8_SA(1, 0), cA + kstep, voffA); PG8_STAGE(PG8_SB(1, 1), cB + hstep + kstep, voffB);
        PG8_WAIT_V(6); PG8_BAR;
    }
    for (;;) {
        const bool has_next = S.next(ui + 1, nxt);
        const char* nA = has_next ? (const char*)g.A + (size_t)nxt.pm * tstep : cA; const char* nB = has_next ? (const char*)g.Bt + (size_t)nxt.pn * tstep : cB;
        for (int t = 0; t < nt; t += 2) {
            const bool last = (t == nt - 2);
            const char* a1 = cA + (size_t)(t + 1) * kstep;
            const char* a2 = last ? nA : cA + (size_t)(t + 2) * kstep; const char* b2 = last ? nB : cB + (size_t)(t + 2) * kstep;
            const char* a3 = a2 + kstep; const char* b3 = b2 + kstep;
            if (last && has_next) S.a_ready(nxt);
            if constexpr (SP2) {
            PG8_LDB(B0, 0, 0); PG8_LDB(B1, 0, 1); PG8_SCHED; PG8_LDA(At, 0, 0); PG8_STAGE(PG8_SA(1, 1), a1 + hstep, voffA);
            PG8_WAIT_V(8); PG8_WAIT_L(0); PG8_BAR; PG8_MMA(0, 0, At, B0); PG8_MMA(0, 1, At, B1); PG8_BAR; PG8_SCHED;
            PG8_LDA(At, 0, 1); PG8_STAGE(PG8_SB(0, 0), b2, voffB); PG8_STAGE(PG8_SB(0, 1), b2 + hstep, voffB); PG8_STAGE(PG8_SA(0, 0), a2, voffA);
            PG8_WAIT_V(8); PG8_WAIT_L(0); PG8_BAR; PG8_MMA(1, 0, At, B0); PG8_MMA(1, 1, At, B1); PG8_BAR; PG8_SCHED;
            PG8_LDB(B0, 1, 0); PG8_LDB(B1, 1, 1); PG8_SCHED; PG8_LDA(At, 1, 0); PG8_STAGE(PG8_SA(0, 1), a2 + hstep, voffA);
            PG8_WAIT_V(8); PG8_WAIT_L(0); PG8_BAR; PG8_MMA(0, 0, At, B0); PG8_MMA(0, 1, At, B1); PG8_BAR; PG8_SCHED;
            PG8_LDA(At, 1, 1); PG8_STAGE(PG8_SB(1, 0), b3, voffB); PG8_STAGE(PG8_SB(1, 1), b3 + hstep, voffB); PG8_STAGE(PG8_SA(1, 0), a3, voffA);
            PG8_WAIT_V(8); PG8_WAIT_L(0); PG8_BAR; PG8_MMA(1, 0, At, B0); PG8_MMA(1, 1, At, B1); PG8_BAR; PG8_SCHED;
            } else {
            PG8_LDB(B0, 0, 0); PG8_SCHED; PG8_LDA(At, 0, 0); PG8_STAGE(PG8_SA(1, 1), a1 + hstep, voffA);
            PG8_WAIT_L(8); PG8_BAR; PG8_WAIT_L(0); PG8_MMA(0, 0, At, B0); PG8_BAR; PG8_SCHED;
            PG8_LDB(B1, 0, 1); PG8_STAGE(PG8_SB(0, 0), b2, voffB);
            PG8_BAR; PG8_WAIT_L(0); PG8_MMA(0, 1, At, B1); PG8_BAR;
            PG8_LDA(At, 0, 1); PG8_STAGE(PG8_SA(0, 0), a2, voffA);
            PG8_BAR; PG8_WAIT_L(0); PG8_MMA(1, 0, At, B0); PG8_BAR; PG8_SCHED;
            PG8_STAGE(PG8_SB(0, 1), b2 + hstep, voffB);
            PG8_WAIT_V(6); PG8_BAR; PG8_MMA(1, 1, At, B1); PG8_BAR;
            PG8_LDB(B0, 1, 0); PG8_SCHED; PG8_LDA(At, 1, 0); PG8_STAGE(PG8_SA(0, 1), a2 + hstep, voffA);
            PG8_WAIT_L(8); PG8_BAR; PG8_WAIT_L(0); PG8_MMA(0, 0, At, B0); PG8_BAR; PG8_SCHED;
            PG8_LDB(B1, 1, 1); PG8_STAGE(PG8_SB(1, 0), b3, voffB);
            PG8_BAR; PG8_WAIT_L(0); PG8_MMA(0, 1, At, B1); PG8_BAR;
            PG8_LDA(At, 1, 1); PG8_STAGE(PG8_SA(1, 0), a3, voffA);
            PG8_BAR; PG8_WAIT_L(0); PG8_MMA(1, 0, At, B0); PG8_BAR; PG8_SCHED;
            PG8_STAGE(PG8_SB(1, 1), b3 + hstep, voffB);
            PG8_WAIT_V(6); PG8_BAR; PG8_MMA(1, 1, At, B1); PG8_BAR;
            }
        }
        if constexpr (ALIGN_EPI) { if (wr == 0) PG8_BAR; }
        if constexpr (!Epi::AFTER_DRAIN) { E(acc, cur, wr, wc, fr, fq); S.done(cur); }
        if (!has_next) break;
#pragma unroll
        for (int a = 0; a < 2; ++a)
#pragma unroll
            for (int b = 0; b < 2; ++b)
#pragma unroll
                for (int m = 0; m < 4; ++m)
#pragma unroll
                    for (int n = 0; n < 2; ++n) acc[a][b][m][n] = zero4();
        cur = nxt; cA = nA; cB = nB; ++ui;
        if constexpr (ALIGN_EPI) { if (wr == 1) PG8_BAR; }
    }
    PG8_WAIT_V(0);
    if constexpr (!ALIGN_EPI) { if (wr == 0) PG8_BAR; }
    PG8_BAR;
    if constexpr (Epi::AFTER_DRAIN) { E.fused(acc, cur, wr, wc, fr, fq, lds, wid, lane); S.done(cur); }
#undef PG8_SA
#undef PG8_SB
#undef PG8_STAGE
#undef PG8_LDA
#undef PG8_LDB
#undef PG8_MMA
#undef PG8_WAIT_V
#undef PG8_WAIT_L
#undef PG8_BAR
#undef PG8_SCHED
}
}

__device__ __forceinline__ int opaque(int v) { asm volatile("" : "+s"(v)); return v; }
__device__ __forceinline__ size_t kimg_off(int b, int h, int t, int d) { return ((((size_t)(b * 8 + h) * MW + (t >> 6)) * 8 + (d >> 3)) * 64 + (t & 63)) * 8 + (d & 7); }
__device__ __forceinline__ size_t vimg_off(int b, int h, int t, int d) { return ((((size_t)(b * 8 + h) * MW + (t >> 6)) * 2 + (d >> 5)) * 64 + (t & 63)) * 32 + (d & 31); }
__device__ __forceinline__ void store8bf(bf16_t* dst, const f32x4& a, const f32x4& b) {
    uint4 w; w.x = pk2(a[0], a[1]); w.y = pk2(a[2], a[3]); w.z = pk2(b[0], b[1]); w.w = pk2(b[2], b[3]);
    *(uint4*)dst = w;
}
__device__ __forceinline__ void rope8(f32x4& v0, f32x4& v1, const float* __restrict__ rope, int t, int fq) {
    const float* rp = rope + (size_t)t * 16;
#pragma unroll
    for (int j = 0; j < 4; ++j) {
        { const float x = v0[j]; const float pr = __shfl_xor(x, 16); const float c = rp[2 * j], sn = rp[2 * j + 1];
          v0[j] = (fq == 0) ? (x * c - pr * sn) : ((fq == 1) ? (x * c + pr * sn) : x); }
        { const float x = v1[j]; const float pr = __shfl_xor(x, 16); const float c = rp[2 * (4 + j)], sn = rp[2 * (4 + j) + 1];
          v1[j] = (fq == 0) ? (x * c - pr * sn) : ((fq == 1) ? (x * c + pr * sn) : x); }
    }
}
struct EpiInProj {
    static constexpr bool PERM = true, AFTER_DRAIN = false;
    template <int BJ> __device__ __forceinline__ void part(const f32x4 (&acc)[2][2][4][2], const pg8::Unit& u, int wr, int wc, int fr, int fq) const {
        KParams kpe = (KParams)__builtin_amdgcn_kernarg_segment_ptr(); asm volatile("" : "+s"(kpe));
        unsigned char* ws = kpe->ws; const float* rope = (const float*)(ws + OFF_ROPE);
        const int cb = 256 * u.pn + 128 * BJ + 32 * wc;
        const int cg64 = cb >> 6, hf = wc & 1;
        const int cig = hf * 32 + 8 * fq;
        if (cg64 >= 78) return;
        if (cg64 < 45) {
            size_t off; int pitch = 512, hd = 0; float scl = 1.0f; bool rp = false;
            if (cg64 < 8) { off = OFF_QA; hd = cg64; scl = QSCALE; rp = true; }
            else if (cg64 < 12) { off = OFF_CKV; pitch = 256; hd = cg64 - 8; }
            else if (cg64 < 20) { off = OFF_QI; hd = cg64 - 12; scl = 0.125f; rp = true; }
            else if (cg64 == 20) { off = OFF_KI; pitch = 64; rp = true; }
            else if (cg64 < 29) { off = OFF_QF; hd = cg64 - 21; scl = QSCALE; }
            else if (cg64 < 37) { off = OFF_KF; hd = cg64 - 29; }
            else { off = OFF_VF; hd = cg64 - 37; }
            bf16_t* base = (bf16_t*)(ws + off) + hd * 64 + cig;
            rp = rp && (hf == 0);
#pragma unroll
            for (int ai = 0; ai < 2; ++ai)
#pragma unroll
                for (int m = 0; m < 4; ++m) {
                    const int n = 256 * u.pm + 128 * ai + 64 * wr + 16 * m + fr;
                    const int b = n / SEQ, t = NMETA + n % SEQ, r = b * TP + t;
                    f32x4 v0 = acc[ai][BJ][m][0], v1 = acc[ai][BJ][m][1];
                    if (rp) rope8(v0, v1, rope, t, fq);
                    if (cg64 == 20) {
                        store8bf((bf16_t*)(ws + OFF_KI) + ((size_t)((b * (TP / 16) + (t >> 4)) * 2 + hf) * 64 + fq * 16 + (t & 15)) * 8, v0, v1);
                    } else
                    store8bf(base + (size_t)((cg64 >= 8 && cg64 < 12) ? n : r) * pitch, v0 * scl, v1 * scl);
                    asm volatile("" ::: "memory");
                }
        } else if (cg64 < 77) {
            bf16_t* gates = (bf16_t*)kpe->out + (cg64 - 45) * 64 + cig;
#pragma unroll
            for (int ai = 0; ai < 2; ++ai)
#pragma unroll
                for (int m = 0; m < 4; ++m) {
                    const int n = 256 * u.pm + 128 * ai + 64 * wr + 16 * m + fr;
                    {
                        f32x4 v0 = acc[ai][BJ][m][0], v1 = acc[ai][BJ][m][1];
#pragma unroll
                        for (int j = 0; j < 4; ++j) { v0[j] = sigmoidf_(v0[j]); v1[j] = sigmoidf_(v1[j]); }
                        store8bf(gates + (size_t)n * 2048, v0, v1);
                    }
                }
        } else if (hf == 0 && fq < 2) {
            float* WIo = (float*)(ws + OFF_WI); float* LOGF = (float*)(ws + OFF_LOGF); const float* bfg = kpe->in[5];
#pragma unroll
            for (int ai = 0; ai < 2; ++ai)
#pragma unroll
                for (int m = 0; m < 4; ++m) {
                    const int n = 256 * u.pm + 128 * ai + 64 * wr + 16 * m + fr;
                    const int r = (n / SEQ) * TP + NMETA + n % SEQ;
                    const f32x4 v0 = acc[ai][BJ][m][0], v1 = acc[ai][BJ][m][1];
                    if (fq == 0) {
                        *(f32x4*)(WIo + (size_t)r * 8) = v0 * 0.3535533905932738f; *(f32x4*)(WIo + (size_t)r * 8 + 4) = v1 * 0.3535533905932738f;
                    } else {
                        f32x4 o0, o1;
#pragma unroll
                        for (int j = 0; j < 4; ++j) {
                            const float z0 = v0[j] + bfg[j], z1 = v1[j] + bfg[4 + j];
                            o0[j] = fminf(z0, 0.f) - log1pf(__expf(-fabsf(z0)));
                            o1[j] = fminf(z1, 0.f) - log1pf(__expf(-fabsf(z1)));
                        }
                        *(f32x4*)(LOGF + (size_t)r * 8) = o0; *(f32x4*)(LOGF + (size_t)r * 8 + 4) = o1;
                    }
                }
        }
    }
    __device__ __forceinline__ void operator()(const f32x4 (&acc)[2][2][4][2], const pg8::Unit& u, int wr, int wc, int fr, int fq) const {
        asm volatile("" : "+v"(fr), "+v"(fq));
        part<0>(acc, u, wr, wc, fr, fq); part<1>(acc, u, wr, wc, fr, fq);
    }
};
struct EpiKvUp {
    static constexpr bool PERM = true, AFTER_DRAIN = false;
    const PG8_LAS float* rs; const PG8_LAS int* tag;
    template <int BJ> __device__ __forceinline__ void part(const f32x4 (&acc)[2][2][4][2], const pg8::Unit& u, const PG8_LAS float* rsu, int wr, int wc, int fr, int fq) const {
        KParams kpe = (KParams)__builtin_amdgcn_kernarg_segment_ptr(); asm volatile("" : "+s"(kpe));
        unsigned char* ws = kpe->ws; const float* rope = (const float*)(ws + OFF_ROPE);
        const int cb = 256 * u.pn + 128 * BJ + 32 * wc;
        const int cg64 = cb >> 6, hf = wc & 1, cig = hf * 32 + 8 * fq;
        const bool isk = cg64 < 8, rp = isk && (hf == 0);
        bf16_t* base = (bf16_t*)(ws + (isk ? OFF_KA : OFF_VA)) + (isk ? cg64 : cg64 - 8) * 64 + cig;
#pragma unroll
        for (int ai = 0; ai < 2; ++ai)
#pragma unroll
            for (int m = 0; m < 4; ++m) {
                const int rl = 128 * ai + 64 * wr + 16 * m + fr;
                const int n = 256 * u.pm + rl, t = NMETA + n % SEQ, r = (n / SEQ) * TP + t;
                const float rstd = rsu[rl];
                f32x4 v0 = acc[ai][BJ][m][0] * rstd, v1 = acc[ai][BJ][m][1] * rstd;
                if (rp) rope8(v0, v1, rope, t, fq);
                store8bf((bf16_t*)(ws + (isk ? OFF_KA : OFF_VA)) + (isk ? kimg_off(n / SEQ, cg64, t, cig) : vimg_off(n / SEQ, cg64 - 8, t, cig)), v0, v1);
                asm volatile("" ::: "memory");
            }
    }
    __device__ __forceinline__ void operator()(const f32x4 (&acc)[2][2][4][2], const pg8::Unit& u, int wr, int wc, int fr, int fq) const {
        asm volatile("" : "+v"(fr), "+v"(fq));
        const PG8_LAS float* rsu = (tag[0] == u.pm) ? rs : rs + 256;
        part<0>(acc, u, rsu, wr, wc, fr, fq); part<1>(acc, u, rsu, wr, wc, fr, fq);
    }
};
template <int PASS> struct EpiMerge {
    static constexpr bool PERM = true, AFTER_DRAIN = false;
    __device__ __forceinline__ void operator()(const f32x4 (&acc)[2][2][4][2], const pg8::Unit& u, int wr, int wc, int fr, int fq) const {
        asm volatile("" : "+v"(fr), "+v"(fq));
        KParams kpe = (KParams)__builtin_amdgcn_kernarg_segment_ptr(); asm volatile("" : "+s"(kpe));
        bf16_t* merged = (bf16_t*)(kpe->ws + OFF_MERGED); const bf16_t* gates = (const bf16_t*)kpe->out;
#pragma unroll
        for (int bj = 0; bj < 2; ++bj) {
            const int c = 256 * u.pn + 128 * bj + 32 * wc + 8 * fq;
#pragma unroll
            for (int ai = 0; ai < 2; ++ai)
#pragma unroll
                for (int m = 0; m < 4; ++m) {
                    const size_t n = (size_t)(256 * u.pm + 128 * ai + 64 * wr + 16 * m + fr);
                    const uint4 g = *(const uint4*)(gates + n * 2048 + PASS * 1024 + c);
                    f32x4 v0 = acc[ai][bj][m][0], v1 = acc[ai][bj][m][1];
                    v0 = v0 * (f32x4){bf2f(g.x & 0xffffu), bf2f(g.x >> 16), bf2f(g.y & 0xffffu), bf2f(g.y >> 16)};
                    v1 = v1 * (f32x4){bf2f(g.z & 0xffffu), bf2f(g.z >> 16), bf2f(g.w & 0xffffu), bf2f(g.w >> 16)};
                    bf16_t* dst = merged + n * 1024 + c;
                    if (PASS == 1) {
                        const uint4 o = *(const uint4*)dst;
                        v0 = v0 + (f32x4){bf2f(o.x & 0xffffu), bf2f(o.x >> 16), bf2f(o.y & 0xffffu), bf2f(o.y >> 16)};
                        v1 = v1 + (f32x4){bf2f(o.z & 0xffffu), bf2f(o.z >> 16), bf2f(o.w & 0xffffu), bf2f(o.w >> 16)};
                    }
                    store8bf(dst, v0, v1);
                }
        }
    }
};
struct EpiOutProj {
    static constexpr bool PERM = true, AFTER_DRAIN = false;
    __device__ __forceinline__ void operator()(const f32x4 (&acc)[2][2][4][2], const pg8::Unit& u, int wr, int wc, int fr, int fq) const {
        asm volatile("" : "+v"(fr), "+v"(fq));
        KParams kpe = (KParams)__builtin_amdgcn_kernarg_segment_ptr(); asm volatile("" : "+s"(kpe));
        const float* x = kpe->in[0]; const float* g0 = kpe->in[2]; const float* b0 = kpe->in[3]; float* out = kpe->out;
        const float* stat0 = (const float*)(kpe->ws + OFF_STAT0);
#pragma unroll
        for (int ai = 0; ai < 2; ++ai)
#pragma unroll
            for (int m = 0; m < 4; ++m) {
                const int n = 256 * u.pm + 128 * ai + 64 * wr + 16 * m + fr;
                const int b = n / SEQ, sq = n % SEQ;
                const int r = b * TP + NMETA + sq;
                const float mu = stat0[2 * r], rstd = stat0[2 * r + 1];
#pragma unroll
                for (int bj = 0; bj < 2; ++bj)
#pragma unroll
                    for (int nn = 0; nn < 2; ++nn) {
                        const int c = 256 * u.pn + 128 * bj + 32 * wc + 8 * fq + 4 * nn;
                        const f32x4 xv = *(const f32x4*)(x + (size_t)n * 1024 + c);
                        const f32x4 gg = *(const f32x4*)(g0 + c), bb = *(const f32x4*)(b0 + c);
                        const f32x4 hv = (xv - mu) * rstd * gg + bb;
                        *(f32x4*)(out + (size_t)n * 1024 + c) = hv * ALPHA + acc[ai][bj][m][nn];
                    }
                if (m == 3) asm volatile("" ::: "memory");
            }
    }
};
struct EpiMoeDown {
    static constexpr bool PERM = true, AFTER_DRAIN = false;
    const PG8_LAS int* tab;
    __device__ __forceinline__ void operator()(const f32x4 (&acc)[2][2][4][2], const pg8::Unit& u, int wr, int wc, int fr, int fq) const {
        asm volatile("" : "+v"(fr), "+v"(fq));
        KParams kpe = (KParams)__builtin_amdgcn_kernarg_segment_ptr(); asm volatile("" : "+s"(kpe));
        unsigned char* ws = kpe->ws;
        const int* TOKL = (const int*)(ws + OFF_TOKL); const float* GW = (const float*)(ws + OFF_GW); bf16_t* SLOT = (bf16_t*)(ws + OFF_SLOT);
        const int e = u.pn >> 2, cnt = tab[e], pos0 = (u.pm - (tab[64 + e] >> 8)) * 256;
        const int cb = 256 * (u.pn & 3) + 32 * wc + 8 * fq;
        int aid[8]; float gw[8];
#pragma unroll
        for (int i = 0; i < 8; ++i) { const int pos = pos0 + 128 * (i >> 2) + 64 * wr + 16 * (i & 3) + fr; aid[i] = TOKL[e * 32768 + (pos < cnt ? pos : cnt - 1)]; }
#pragma unroll
        for (int i = 0; i < 8; ++i) gw[i] = GW[aid[i]];
#pragma unroll
        for (int ai = 0; ai < 2; ++ai)
#pragma unroll
            for (int m = 0; m < 4; ++m) {
                const int pos = pos0 + 128 * ai + 64 * wr + 16 * m + fr;
                if (pos < cnt) {
                    const float g = gw[ai * 4 + m];
                    bf16_t* dst = SLOT + (size_t)aid[ai * 4 + m] * 1024 + cb;
                    store8bf(dst, acc[ai][0][m][0] * g, acc[ai][0][m][1] * g);
                    store8bf(dst + 128, acc[ai][1][m][0] * g, acc[ai][1][m][1] * g);
                }
            }
    }
};
struct EpiAny {
    static constexpr bool PERM = true, AFTER_DRAIN = false;
    int kind; const PG8_LAS float* rs; const PG8_LAS int* tag;
    __device__ __forceinline__ void operator()(const f32x4 (&acc)[2][2][4][2], const pg8::Unit& u, int wr, int wc, int fr, int fq) const {
        if (kind == 0) { EpiInProj e{}; e(acc, u, wr, wc, fr, fq); }
        else if (kind == 1) { EpiKvUp e{rs, tag}; e(acc, u, wr, wc, fr, fq); }
        else if (kind == 2) { EpiMerge<0> e{}; e(acc, u, wr, wc, fr, fq); }
        else if (kind == 3) { EpiMerge<1> e{}; e(acc, u, wr, wc, fr, fq); }
        else if (kind == 4) { EpiOutProj e{}; e(acc, u, wr, wc, fr, fq); }
        else { EpiMoeDown e{tag}; e(acc, u, wr, wc, fr, fq); }
    }
};

template <int POS> __device__ __forceinline__ unsigned bitmask1(int m) { int r; asm("v_bfe_i32 %0, %1, %2, 1" : "=v"(r) : "v"(m), "n"(POS)); return (unsigned)r; }
typedef short s16x4 __attribute__((ext_vector_type(4)));
__device__ __forceinline__ s16x4 vtr16(const unsigned char* p) {
    return __builtin_bit_cast(s16x4, __builtin_amdgcn_ds_read_tr16_b64_v4i16((__attribute__((address_space(3))) s16x4*)p));
}
constexpr int AT_VP = 192;
constexpr int AT_K = 0, AT_V = 8192, AT_C = 8192 + 64 * AT_VP, AT_BUF = 8192 + 64 * AT_VP + 256;
template <bool FOX>
__device__ void attn_item(unsigned char* ws, int b, int h, int qb, unsigned char* smem) {
    constexpr int mode = 0;
    const bf16_t* Q = (const bf16_t*)(ws + (FOX ? OFF_QF : OFF_QA));
    bf16_t* Y = (bf16_t*)(ws + (FOX ? OFF_YF : OFF_YA));
    const bf16_t* Kg = (const bf16_t*)(ws + (FOX ? OFF_KF : OFF_KA));
    const bf16_t* Vt = (const bf16_t*)(ws + (FOX ? OFF_VF : OFF_VA));
    const float* cum = (const float*)(ws + OFF_CUM);
    const unsigned long long* mask = (const unsigned long long*)(ws + OFF_MASK);
    const int tid = ltid(), lane = tid & 63, wave = __builtin_amdgcn_readfirstlane(tid >> 6), hlf = lane >> 5;
    const int q0w = qb * 256 + wave * 32;
    const int qrow = q0w + (lane & 31);
    const size_t grow = (size_t)b * TP + qrow;
    const bool wave_on = q0w < T;
    bf16x8 qf[4];
#pragma unroll
    for (int ks = 0; ks < 4; ++ks) qf[ks] = *(const bf16x8*)(Q + grow * 512 + h * 64 + ks * 16 + hlf * 8);
    const int nkt = qb * 4 + 4;
    int kt0 = 0;
    if (FOX) {
        const float* knorm = (const float*)(ws + OFF_KNORM) + (size_t)(b * 8 + h) * MW;
        float* red = (float*)(smem + 2 * AT_BUF);
        float qq = 0.f;
#pragma unroll
        for (int ks = 0; ks < 4; ++ks)
#pragma unroll
            for (int e = 0; e < 8; ++e) { const float v = bf2f((unsigned)(unsigned short)qf[ks][e]); qq = fmaf(v, v, qq); }
        qq += __shfl_xor(qq, 32);
#pragma unroll
        for (int o = 1; o < 32; o <<= 1) qq = fmaxf(qq, __shfl_xor(qq, o));
        if (lane == 0) red[wave] = qq;
        __syncthreads();
        if (wave == 0) {
            float qm = red[0];
#pragma unroll
            for (int w = 1; w < 8; ++w) qm = fmaxf(qm, red[w]);
            const float Qn = sqrtf(qm) * 1.0001f;
            const float Kd = fmaxf(fmaxf(knorm[qb * 4], knorm[qb * 4 + 1]), fmaxf(knorm[qb * 4 + 2], knorm[qb * 4 + 3])) * 1.0001f;
            const float cfirst = cum[((size_t)b * TP + qb * 256) * 8 + h];
            bool keep0 = true, keep1 = true;
            if (lane < qb * 4) { const float bnd = Qn * (knorm[lane] * 1.0001f + Kd) + cfirst - cum[((size_t)b * TP + lane * 64 + 63) * 8 + h]; keep0 = !(bnd < -40.0f); }
            if (lane + 64 < qb * 4) { const float bnd = Qn * (knorm[lane + 64] * 1.0001f + Kd) + cfirst - cum[((size_t)b * TP + (lane + 64) * 64 + 63) * 8 + h]; keep1 = !(bnd < -40.0f); }
            const unsigned long long b0 = __ballot(keep0), b1 = __ballot(keep1);
            const int first = b0 ? (int)__builtin_ctzll(b0) : (b1 ? 64 + (int)__builtin_ctzll(b1) : 128);
            if (lane == 0) ((int*)red)[8] = first < qb * 4 ? first : qb * 4;
        }
        __syncthreads();
        kt0 = ((const int*)red)[8];
    }
    const int my_last = qb * 4 + (wave >> 1);
    f32x16 o0, o1;
#pragma unroll
    for (int i = 0; i < 16; ++i) { o0[i] = 0.f; o1[i] = 0.f; }
    float m_run = -1e30f, l_run = 0.f;
    const int skey = tid >> 3, sc = tid & 7;
    const bf16_t* kp = Kg + ((size_t)b * TP + skey) * 512 + h * 64 + sc * 8;
    const bf16_t* vp = Vt + ((size_t)b * TP + skey) * 512 + h * 64 + sc * 8;
    const int kw_off = skey * 128 + ((sc ^ ((skey >> 1) & 7)) * 16);
    const int vw_off = skey * AT_VP + sc * 16;
    uint4 rk = *(const uint4*)(kp + (size_t)kt0 * 64 * 512), rv = *(const uint4*)(vp + (size_t)kt0 * 64 * 512);
    float rc = 0.f;
    if (FOX && tid < 64) rc = cum[((size_t)b * TP + kt0 * 64 + tid) * 8 + h];
    unsigned long long mw = 0ull, mw_next = 0ull;
    if (!FOX) mw_next = mask[grow * MW + 0];
    for (int kt = kt0; kt < nkt; ++kt) {
        unsigned char* sb = smem + (kt & 1) * AT_BUF;
        if (mode != 3) {
        *(uint4*)(sb + AT_K + kw_off) = rk;
        *(uint4*)(sb + AT_V + vw_off) = rv;
        if (FOX && tid < 64) *(float*)(sb + AT_C + tid * 4) = rc;
        }
        mw = mw_next;
        if (mode != 3) __syncthreads();
        if (kt + 1 < nkt) {
            rk = *(const uint4*)(kp + (size_t)(kt + 1) * 64 * 512);
            rv = *(const uint4*)(vp + (size_t)(kt + 1) * 64 * 512);
            if (FOX && tid < 64) rc = cum[((size_t)b * TP + (kt + 1) * 64 + tid) * 8 + h];
            if (!FOX) mw_next = mask[grow * MW + kt + 1];
        }
        if (wave_on && kt <= my_last) {
            const bf16_t* Ks = (const bf16_t*)(sb + AT_K);
            const unsigned char* Vs = sb + AT_V;
            const float* Cs = (const float*)(sb + AT_C);
            f32x16 st[2];
#pragma unroll
            for (int sub = 0; sub < 2; ++sub) {
#pragma unroll
                for (int i = 0; i < 16; ++i) st[sub][i] = 0.f;
                const int krow = sub * 32 + (lane & 31);
                if (mode != 4)
#pragma unroll
                for (int ks = 0; ks < 4; ++ks) {
                    const bf16x8 kf = *(const bf16x8*)(Ks + krow * 64 + (((ks * 2 + hlf) ^ ((krow >> 1) & 7)) * 8));
                    st[sub] = __builtin_amdgcn_mfma_f32_32x32x16_bf16(kf, qf[ks], st[sub], 0, 0, 0);
                }
            }
            const bool diag = (kt == my_last);
            const int kbase = kt * 64 + 4 * hlf;
            float mx = -3.0e38f;
            if (FOX) {
#pragma unroll
                for (int sub = 0; sub < 2; ++sub)
#pragma unroll
                    for (int g = 0; g < 4; ++g) {
                        const f32x4 ck4 = *(const f32x4*)(Cs + sub * 32 + 8 * g + 4 * hlf);
#pragma unroll
                        for (int j = 0; j < 4; ++j) st[sub][g * 4 + j] -= ck4[j];
                    }
                if (diag) {
#pragma unroll
                    for (int sub = 0; sub < 2; ++sub)
#pragma unroll
                        for (int g = 0; g < 4; ++g)
#pragma unroll
                            for (int j = 0; j < 4; ++j) { const int key = kbase + sub * 32 + 8 * g + j; st[sub][g * 4 + j] = (key <= qrow) ? st[sub][g * 4 + j] : -3.0e38f; }
                }
            }
#pragma unroll
            for (int sub = 0; sub < 2; ++sub)
#pragma unroll
                for (int i = 0; i < 16; ++i) mx = fmaxf(mx, st[sub][i]);
            mx = fmaxf(mx, __shfl_xor(mx, 32));
            const float m_new = fmaxf(m_run, mx);
            const float alpha = __builtin_amdgcn_exp2f(m_run - m_new);
            m_run = m_new;
            float ls = 0.f;
            bf16x8 pf[2][2];
            {
                const int mb0 = (int)(unsigned)(mw >> (4 * hlf)), mb1 = (int)(unsigned)(mw >> (32 + 4 * hlf));
                unsigned pw[2][2][4];
#define ATT_PAIR(SUB, S2, J, MB) do { constexpr int r0_ = 8 * (S2) + (J), r1_ = r0_ + 1; \
                    float p0 = st[SUB][r0_], p1 = st[SUB][r1_]; \
                    if (mode != 5) { p0 = __builtin_amdgcn_exp2f(p0 - m_new); p1 = __builtin_amdgcn_exp2f(p1 - m_new); } \
                    if (!FOX && mode != 5) { p0 = __uint_as_float(__float_as_uint(p0) & bitmask1<8 * (r0_ >> 2) + (r0_ & 3)>(MB)); \
                                             p1 = __uint_as_float(__float_as_uint(p1) & bitmask1<8 * (r1_ >> 2) + (r1_ & 3)>(MB)); } \
                    ls += p0 + p1; pw[SUB][S2][(J) >> 1] = pk2(p0, p1); } while (0)
#define ATT_QUAD(SUB, S2, MB) ATT_PAIR(SUB, S2, 0, MB); ATT_PAIR(SUB, S2, 2, MB); ATT_PAIR(SUB, S2, 4, MB); ATT_PAIR(SUB, S2, 6, MB)
                ATT_QUAD(0, 0, mb0); ATT_QUAD(0, 1, mb0); ATT_QUAD(1, 0, mb1); ATT_QUAD(1, 1, mb1);
#undef ATT_QUAD
#undef ATT_PAIR
#pragma unroll
                for (int sub = 0; sub < 2; ++sub)
#pragma unroll
                    for (int s2 = 0; s2 < 2; ++s2) { uint4 t4 = make_uint4(pw[sub][s2][0], pw[sub][s2][1], pw[sub][s2][2], pw[sub][s2][3]); pf[sub][s2] = *(bf16x8*)&t4; }
            }
            l_run = l_run * alpha + ls;
            if (mode == 2) { asm volatile("" :: "v"(pf[0][0]), "v"(pf[0][1]), "v"(pf[1][0]), "v"(pf[1][1])); }
            else {
#pragma unroll
            for (int i = 0; i < 16; ++i) { o0[i] *= alpha; o1[i] *= alpha; }
#pragma unroll
            for (int sub = 0; sub < 2; ++sub)
#pragma unroll
                for (int s2 = 0; s2 < 2; ++s2) {
                    const int key0 = sub * 32 + 16 * s2 + 4 * hlf;
                    const unsigned char* vr = Vs + (key0 + ((lane & 15) >> 2)) * AT_VP + (16 * ((lane >> 4) & 1) + 4 * (lane & 3)) * 2;
                    {
                        const s16x4 a = vtr16(vr), c = vtr16(vr + 8 * AT_VP);
                        const bf16x8 vf = (bf16x8){a[0], a[1], a[2], a[3], c[0], c[1], c[2], c[3]};
                        o0 = __builtin_amdgcn_mfma_f32_32x32x16_bf16(vf, pf[sub][s2], o0, 0, 0, 0);
                    }
                    {
                        const s16x4 a = vtr16(vr + 64), c = vtr16(vr + 64 + 8 * AT_VP);
                        const bf16x8 vf = (bf16x8){a[0], a[1], a[2], a[3], c[0], c[1], c[2], c[3]};
                        o1 = __builtin_amdgcn_mfma_f32_32x32x16_bf16(vf, pf[sub][s2], o1, 0, 0, 0);
                    }
                }
            }
        }
    }
    __syncthreads();
    if (wave_on) {
        const float lt = l_run + __shfl_xor(l_run, 32);
        const float inv = 1.0f / lt;
        if (qrow >= NMETA && qrow < T && mode == 0) {
            bf16_t* yo = Y + ((size_t)b * SEQ + (qrow - NMETA)) * 512 + h * 64;
#pragma unroll
            for (int g = 0; g < 4; ++g) {
                const int d = 8 * g + 4 * hlf;
                store4bf(yo + d, (f32x4){o0[4 * g] * inv, o0[4 * g + 1] * inv, o0[4 * g + 2] * inv, o0[4 * g + 3] * inv});
                store4bf(yo + 32 + d, (f32x4){o1[4 * g] * inv, o1[4 * g + 1] * inv, o1[4 * g + 2] * inv, o1[4 * g + 3] * inv});
            }
        }
    }
}

namespace ab {
using bf16=__hip_bfloat16;
using bf16x8=__attribute__((ext_vector_type(8)))short;
using s16x4=__attribute__((ext_vector_type(4)))short;
using f32x16=__attribute__((ext_vector_type(16)))float;
using u32x4=__attribute__((ext_vector_type(4)))unsigned;
constexpr int BATCH=2,NHEAD=8,SEQ=8448  ,D=64,DM=NHEAD*D;
constexpr int NW=8,QBLK=32,QB=QBLK*NW,KVBLK=64,NQB=SEQ/QB;
constexpr int ATTN_PITCH=DM, ATTN_UNIT_ROWS=QB;
__device__ __forceinline__ int crow(int r,int hi){return (r&3)+8*(r>>2)+4*hi;}
#define SBAR() __builtin_amdgcn_sched_barrier(0)
__device__ __forceinline__ void cmask(f32x16&p0,f32x16&p1,int jb,int qrel,int hi){
  const float NEG=-INFINITY; int kb=64*jb+4*hi;
  #pragma unroll
  for(int r=0;r<16;++r){int kv=kb+(r&3)+8*(r>>2); if(kv>qrel)p0[r]=NEG; if(kv+32>qrel)p1[r]=NEG;}
}

constexpr int NSLOT=3, SLOTB=8192;
constexpr int LDS_K=0, LDS_V=NSLOT*SLOTB, LDS_WS=2*NSLOT*SLOTB, LDS_OST=LDS_WS+NW*64*4, LDS_BYTES=LDS_OST+NW*4096;
constexpr float C2=0.125f*1.4426950408889634f;
__device__ __forceinline__ void glds16(const void*gsrc,unsigned lds_dst){unsigned keep;
  asm volatile("s_mov_b32 %0, m0\n\ts_mov_b32 m0, %2\n\ts_nop 0\n\tglobal_load_lds_dwordx4 %1, off\n\ts_mov_b32 m0, %0":"=&s"(keep):"v"(gsrc),"s"(lds_dst):"memory");}
__device__ __forceinline__ float max3f(float a,float b,float c){float r;asm("v_max3_f32 %0, %1, %2, %3":"=v"(r):"v"(a),"v"(b),"v"(c));return r;}
__device__ __forceinline__ float max2f(float a,float b){float r;asm("v_max_f32_e32 %0, %1, %2":"=v"(r):"v"(a),"v"(b));return r;}
__device__ __forceinline__ float fadd_s(float a,float b){float r;asm("v_add_f32_e32 %0, %1, %2":"=v"(r):"v"(a),"v"(b));return r;}
__device__ __forceinline__ float fsub_s(float a,float b){float r;asm("v_sub_f32_e32 %0, %1, %2":"=v"(r):"v"(a),"v"(b));return r;}
typedef float f32x2_t __attribute__((ext_vector_type(2))); typedef __bf16 bf16x2_t __attribute__((ext_vector_type(2)));
__device__ __forceinline__ unsigned cvtpk_s(float lo,float hi){f32x2_t v={lo,hi};bf16x2_t b=__builtin_convertvector(v,bf16x2_t);return __builtin_bit_cast(unsigned,b);}
#define WAIT_BAR(N) asm volatile("s_waitcnt vmcnt(" #N ") lgkmcnt(0)\n\ts_barrier":::"memory")

__device__ __forceinline__ void qkt(f32x16&p0,f32x16&p1,const char*Kslot,const bf16x8*qr,const f32x16&negm,int r32,int hi){
  const char*kb=Kslot+hi*1024+r32*16;
  #pragma unroll
  for(int d0=0;d0<4;++d0){
    const bf16x8 b0=*reinterpret_cast<const bf16x8*>(kb+d0*2048);
    const bf16x8 b1=*reinterpret_cast<const bf16x8*>(kb+d0*2048+512);
    if(d0==0){p0=__builtin_amdgcn_mfma_f32_32x32x16_bf16(b0,qr[0],negm,0,0,0);p1=__builtin_amdgcn_mfma_f32_32x32x16_bf16(b1,qr[0],negm,0,0,0);}
    else{p0=__builtin_amdgcn_mfma_f32_32x32x16_bf16(b0,qr[d0],p0,0,0,0);p1=__builtin_amdgcn_mfma_f32_32x32x16_bf16(b1,qr[d0],p1,0,0,0);}}
}
typedef __attribute__((address_space(3))) const char* lds_cptr;
typedef short v4i16_t __attribute__((ext_vector_type(4)));
__device__ __forceinline__ void kload8(bf16x8*kf,lds_cptr kp){
  kf[0]=*(const __attribute__((address_space(3))) bf16x8*)(kp);      kf[1]=*(const __attribute__((address_space(3))) bf16x8*)(kp+512);
  kf[2]=*(const __attribute__((address_space(3))) bf16x8*)(kp+2048); kf[3]=*(const __attribute__((address_space(3))) bf16x8*)(kp+2560);
  kf[4]=*(const __attribute__((address_space(3))) bf16x8*)(kp+4096); kf[5]=*(const __attribute__((address_space(3))) bf16x8*)(kp+4608);
  kf[6]=*(const __attribute__((address_space(3))) bf16x8*)(kp+6144); kf[7]=*(const __attribute__((address_space(3))) bf16x8*)(kp+6656);
}
__device__ __forceinline__ void kload2(bf16x8*kf,lds_cptr kp,int j){ kf[2*j]=*(const __attribute__((address_space(3))) bf16x8*)(kp+j*2048); kf[2*j+1]=*(const __attribute__((address_space(3))) bf16x8*)(kp+j*2048+512); }
__device__ __forceinline__ s16x4 vtr(lds_cptr p){ return __builtin_bit_cast(s16x4,__builtin_amdgcn_ds_read_tr16_b64_v4i16((__attribute__((address_space(3))) v4i16_t*)p)); }
__device__ __forceinline__ float rowmax(const f32x16&p0,const f32x16&p1){
  float a=max3f(p0[0],p0[1],p1[0]),b=max3f(p0[2],p0[3],p1[1]);a=max3f(a,p1[2],p1[3]);
  #pragma unroll
  for(int r=4;r<16;r+=4){a=max3f(a,p0[r],p0[r+1]);b=max3f(b,p0[r+2],p0[r+3]);a=max3f(a,p1[r],p1[r+1]);b=max3f(b,p1[r+2],p1[r+3]);}
  const float m=max2f(a,b);
  auto rr=__builtin_amdgcn_permlane32_swap(__float_as_uint(m),__float_as_uint(m),false,false);
  return max2f(__uint_as_float(rr[0]),__uint_as_float(rr[1]));
}
__device__ __forceinline__ void pv(f32x16*o,int vb,bf16x8 pa0,bf16x8 pa1,bf16x8 pa2,bf16x8 pa3){
  #pragma unroll
  for(int d0=0;d0<2;++d0){s16x4 lo[4],hi[4];
    #pragma unroll
    for(int ks=0;ks<4;++ks){
      asm volatile("ds_read_b64_tr_b16 %0,%1 offset:%c2":"=&v"(lo[ks]):"v"(vb),"i"(d0*4096+ks*1024):"memory");
      asm volatile("ds_read_b64_tr_b16 %0,%1 offset:%c2":"=&v"(hi[ks]):"v"(vb),"i"(d0*4096+ks*1024+512):"memory");}
    asm volatile("s_waitcnt lgkmcnt(0)":::"memory");SBAR();
    #define PK(k) (bf16x8){lo[k][0],lo[k][1],lo[k][2],lo[k][3],hi[k][0],hi[k][1],hi[k][2],hi[k][3]}
    o[d0]=__builtin_amdgcn_mfma_f32_32x32x16_bf16(pa0,PK(0),o[d0],0,0,0);
    o[d0]=__builtin_amdgcn_mfma_f32_32x32x16_bf16(pa1,PK(1),o[d0],0,0,0);
    o[d0]=__builtin_amdgcn_mfma_f32_32x32x16_bf16(pa2,PK(2),o[d0],0,0,0);
    o[d0]=__builtin_amdgcn_mfma_f32_32x32x16_bf16(pa3,PK(3),o[d0],0,0,0);
    #undef PK
  }
}

#ifndef ATTN_STORE16
#define ATTN_STORE16(p,v) (*(u32x4*)(p)=(v))
#endif

template<int POS> __device__ __forceinline__ unsigned mbit(int m){int r;asm("v_bfe_i32 %0, %1, %2, 1":"=v"(r):"v"(m),"n"(POS));return (unsigned)r;}
#define AB_M1(P,R,MB) do{ if(!FOXB) P[R]=__uint_as_float(__float_as_uint(P[R])&mbit<8*((R)>>2)+((R)&3)>(MB)); }while(0)
#define AB_MASK16(P,MB) do{AB_M1(P,0,MB);AB_M1(P,1,MB);AB_M1(P,2,MB);AB_M1(P,3,MB);AB_M1(P,4,MB);AB_M1(P,5,MB);AB_M1(P,6,MB);AB_M1(P,7,MB);AB_M1(P,8,MB);AB_M1(P,9,MB);AB_M1(P,10,MB);AB_M1(P,11,MB);AB_M1(P,12,MB);AB_M1(P,13,MB);AB_M1(P,14,MB);AB_M1(P,15,MB);}while(0)
template<int THRL,bool FOXB> __device__ __forceinline__ void attn_unit(int b,int h,int qb,const bf16*Q,const bf16*__restrict__ K,const bf16*__restrict__ V,bf16*O,const unsigned long long*__restrict__ MK,const float*__restrict__ CK,int kt0,char*shm){
  const int tid=ltid(),lane=tid&63,r32=lane&31,hi=lane>>5; const int wid=__builtin_amdgcn_readfirstlane(tid>>6);
  const long rowbase=(long)b*SEQ; const int q0=qb*QB;
  const bf16*Qw=Q+(rowbase+q0+wid*QBLK)*DM+h*D;
  const long tstep=FOXB?(long)KVBLK*DM:4096;
  const bf16*Kh=FOXB?K+(rowbase+(long)kt0*KVBLK)*DM+h*D:K+(long)(b*NHEAD+h)*(SEQ/KVBLK)*4096,*Vh=FOXB?V+(rowbase+(long)kt0*KVBLK)*DM+h*D:V+(long)(b*NHEAD+h)*(SEQ/KVBLK)*4096;
  const unsigned lds0=(unsigned)(uintptr_t)shm;
  float*wsf=(float*)(shm+LDS_WS)+wid*64;
  const bf16*ksrc=FOXB?Kh+(long)lane*DM+wid*8:Kh+(wid*64+lane)*8;
  const bf16*vsrc=FOXB?Vh+(long)(16*(wid&3)+(lane>>2))*DM+(wid>>2)*32+(lane&3)*8:Vh+((wid>>2)*64+16*(wid&3))*32+lane*8;
  const unsigned kdst=lds0+LDS_K+wid*1024, vdst=lds0+LDS_V+wid*1024;
  #define DMA_K(t,slot) glds16(ksrc+(long)(t)*tstep,(unsigned)__builtin_amdgcn_readfirstlane(kdst+(slot)))
  #define DMA_V(t,slot) glds16(vsrc+(long)(t)*tstep,(unsigned)__builtin_amdgcn_readfirstlane(vdst+(slot)))
  const char*Kbase=shm+LDS_K; bf16x8 kf[8];
  const lds_cptr shm3=(lds_cptr)shm; const lds_cptr kp0=shm3+LDS_K+hi*1024+r32*16; const lds_cptr vp0=shm3+LDS_V+((lane>>4)&1)*32+(lane&3)*8+(4*hi+((lane&15)>>2))*64;
  const int NT=(q0+QB)/KVBLK-kt0;
  DMA_K(0,0);DMA_V(0,0);DMA_K(1,SLOTB);
  bf16x8 qr[4];
  #pragma unroll
  for(int d0=0;d0<4;++d0)qr[d0]=*reinterpret_cast<const bf16x8*>(&Qw[(long)r32*DM+d0*16+hi*8]);
  const lds_cptr qp0=shm3+LDS_OST+wid*4096+lane*16;
  #pragma unroll
  for(int d0=0;d0<4;++d0)*(__attribute__((address_space(3))) bf16x8*)(qp0+d0*1024)=qr[d0];
  #define QR(d) (*(const __attribute__((address_space(3))) bf16x8*)(qp0+(d)*1024))
  float mhat=0.f,l_reg=0.f;f32x16 o[2];o[0]=f32x16{};o[1]=f32x16{};f32x16 negm=f32x16{};asm volatile("":"+v"(negm));
  const int qrel=wid*QBLK+r32;
  const unsigned mrow_off=(unsigned)((rowbase+q0+qrel)*(SEQ/64));
  unsigned long long mw_cur=0ull; if(!FOXB) mw_cur=MK[mrow_off];
  float*ckring=(float*)(shm+LDS_BYTES); const unsigned ckoff=(unsigned)((b*NHEAD+h)*SEQ+kt0*KVBLK+lane); float ckreg=0.f;
  if(FOXB&&wid==0){ ckring[lane]=CK[ckoff]; ckring[64+lane]=CK[ckoff+64]; ckreg=CK[ckoff+128]; }
  #define CKBIAS(C0,C1,t) do{ if(FOXB){ const float*cks_=ckring+((t)%3)*64+4*hi; \
      _Pragma("unroll") for(int g_=0;g_<4;++g_){ const f32x4 ca_=*(const f32x4*)(cks_+8*g_), cb_=*(const f32x4*)(cks_+32+8*g_); \
        _Pragma("unroll") for(int j_=0;j_<4;++j_){ C0[4*g_+j_]-=ca_[j_]; C1[4*g_+j_]-=cb_[j_]; } } } }while(0)
  #define CMASK(P0,P1,t) do{int jb_=(t)-(NT-4); if(jb_>=0)cmask(P0,P1,jb_,qrel,hi);}while(0)
  bool resc=false;
  #define START(P0,P1) do{ const float rm=rowmax(P0,P1); resc=false; \
    { const float dl=rm; mhat=fadd_s(mhat,dl); \
      _Pragma("unroll") for(int r=0;r<16;++r){P0[r]=fsub_s(P0[r],dl);P1[r]=fsub_s(P1[r],dl);} \
      _Pragma("unroll") for(int r=0;r<16;++r)negm[r]=-mhat; asm volatile("":"+v"(negm)); } \
    _Pragma("unroll") for(int r=0;r<16;++r)P0[r]=__builtin_amdgcn_exp2f(P0[r]); }while(0)
  #define RESC() do{ if(resc){ asm volatile("s_waitcnt lgkmcnt(0)":::"memory"); \
      _Pragma("unroll") for(int d_=0;d_<2;++d_) _Pragma("unroll") for(int r=0;r<16;++r)o[d_][r]*=wsf[crow(r,hi)]; } }while(0)
  f32x16 pA0,pA1,pB0,pB1;
  int sl_prev=0,sl_cur=0,sl_next=SLOTB;
  #define ROT() do{sl_prev=sl_cur;sl_cur=sl_next;sl_next=(sl_next==(NSLOT-1)*SLOTB)?0:sl_next+SLOTB;}while(0)
  DMA_K(2,2*SLOTB);
  WAIT_BAR(3);
  qkt(pA0,pA1,Kbase,qr,negm,r32,hi);asm volatile("s_nop 15\n\ts_nop 7":"+v"(pA0),"+v"(pA1));CKBIAS(pA0,pA1,0);CMASK(pA0,pA1,0);
  START(pA0,pA1);
  _Pragma("unroll") for(int r=0;r<16;++r)pA1[r]=__builtin_amdgcn_exp2f(pA1[r]);
  WAIT_BAR(0);
  DMA_K(3,0);DMA_V(1,SLOTB);
  ROT();
  kload8(kf,kp0+sl_cur);
  WAIT_BAR(2);
  s16x4 vlo[8],vhi[8]; u32x4 pw0,pw1,pw2,pw3;
  #define PKW(P,B) cvtpk_s(P[B],P[B+1])
  #define PAF(k) __builtin_bit_cast(bf16x8,pw##k)
  #define VFR(i) (bf16x8){vlo[i][0],vlo[i][1],vlo[i][2],vlo[i][3],vhi[i][0],vhi[i][1],vhi[i][2],vhi[i][3]}
  #define PIN(x) asm volatile("":"+v"(x))
  #define MX3(a,b,c) __builtin_fmaxf(__builtin_fmaxf((a),(b)),(c))
  #define GAPA(MK_,MF,A0,A1,A2,A3,W0,W1,PW) do{ MF; MK_; sacc+=A0; sacc+=A1; sacc+=A2; sacc+=A3; PIN(sacc); W0; W1; PIN(PW); SBAR(); }while(0)
  #define MK4(P,R0,R1,R2,R3,MB) do{AB_M1(P,R0,MB);AB_M1(P,R1,MB);AB_M1(P,R2,MB);AB_M1(P,R3,MB);}while(0)
  #define EX(v) __builtin_amdgcn_exp2f(v)
  #define GAPB(MF,X,B) do{ MF; X[B]=EX(X[B]); X[B+1]=EX(X[B+1]); X[B+2]=EX(X[B+2]); X[B+3]=EX(X[B+3]); PIN(X); SBAR(); }while(0)
  #define VRD(i) do{ vlo[i]=vtr(vp_+(((i)>>2)*4096+((i)&3)*1024)); vhi[i]=vtr(vp_+(((i)>>2)*4096+((i)&3)*1024+512)); }while(0)
  #define KRD(G,j) do{ if(G){ kload2(kf,kp0+sl_next,j); SBAR(); } }while(0)
  #define STEP(C0,C1,P0,P1,t,GK,GV,GL) do{ SBAR(); \
    if(FOXB&&wid==0){ ckring[(((t)+1)%3)*64+lane]=ckreg; if((t)+2<NT) ckreg=CK[ckoff+((t)+2)*64]; } \
    const int mb0_=(int)(unsigned)(mw_cur>>(4*hi)), mb1_=(int)(unsigned)(mw_cur>>(32+4*hi)); AB_M1(P0,0,mb0_); AB_M1(P0,1,mb0_); \
    const lds_cptr vp_=vp0+sl_prev; \
    VRD(0); SBAR(); float sacc=(P0[0]+P0[1]); \
    GAPA(MK4(P0,2,3,4,5,mb0_), C0=__builtin_amdgcn_mfma_f32_32x32x16_bf16(kf[0],QR(0),negm,0,0,0), P0[2],P0[3],P0[4],P0[5],     pw0[0]=PKW(P0,0), pw0[1]=PKW(P0,2), pw0); \
    VRD(4); SBAR(); GAPA(MK4(P0,6,7,8,9,mb0_), C1=__builtin_amdgcn_mfma_f32_32x32x16_bf16(kf[1],QR(0),negm,0,0,0), P0[6],P0[7],P0[8],P0[9],     pw0[2]=PKW(P0,4), pw0[3]=PKW(P0,6), pw0); \
    VRD(1); SBAR(); GAPA(MK4(P0,10,11,12,13,mb0_), C0=__builtin_amdgcn_mfma_f32_32x32x16_bf16(kf[2],QR(1),C0,0,0,0),   P0[10],P0[11],P0[12],P0[13], pw1[0]=PKW(P0,8), pw1[1]=PKW(P0,10), pw1); \
    VRD(5); SBAR(); GAPA(do{AB_M1(P0,14,mb0_);AB_M1(P0,15,mb0_);AB_M1(P1,0,mb1_);AB_M1(P1,1,mb1_);}while(0), C1=__builtin_amdgcn_mfma_f32_32x32x16_bf16(kf[3],QR(1),C1,0,0,0),   P0[14],P0[15],P1[0],P1[1],   pw1[2]=PKW(P0,12),pw1[3]=PKW(P0,14), pw1); \
    VRD(2); SBAR(); GAPA(MK4(P1,2,3,4,5,mb1_), C0=__builtin_amdgcn_mfma_f32_32x32x16_bf16(kf[4],QR(2),C0,0,0,0),   P1[2],P1[3],P1[4],P1[5],     pw2[0]=PKW(P1,0), pw2[1]=PKW(P1,2), pw2); \
    VRD(6); SBAR(); GAPA(MK4(P1,6,7,8,9,mb1_), C1=__builtin_amdgcn_mfma_f32_32x32x16_bf16(kf[5],QR(2),C1,0,0,0),   P1[6],P1[7],P1[8],P1[9],     pw2[2]=PKW(P1,4), pw2[3]=PKW(P1,6), pw2); \
    VRD(3); SBAR(); GAPA(MK4(P1,10,11,12,13,mb1_), C0=__builtin_amdgcn_mfma_f32_32x32x16_bf16(kf[6],QR(3),C0,0,0,0),   P1[10],P1[11],P1[12],P1[13], pw3[0]=PKW(P1,8), pw3[1]=PKW(P1,10), pw3); \
    VRD(7); SBAR(); GAPA(do{AB_M1(P1,14,mb1_);AB_M1(P1,15,mb1_);}while(0), C1=__builtin_amdgcn_mfma_f32_32x32x16_bf16(kf[7],QR(3),C1,0,0,0),   P1[14],P1[15],0.f,0.f,       pw3[2]=PKW(P1,12),pw3[3]=PKW(P1,14), pw3); \
    l_reg+=sacc; if(!FOXB) mw_cur=MK[mrow_off+(t)]; \
    if(GK){DMA_K((t)+3,sl_cur);} if(GV){DMA_V((t)+1,sl_next);} \
    CKBIAS(C0,C1,t); CMASK(C0,C1,t); \
    { float a=MX3(C0[0],C0[1],C1[0]),b=MX3(C0[2],C0[3],C1[1]); a=MX3(a,C1[2],C1[3]); \
      _Pragma("unroll") for(int r=4;r<16;r+=4){a=MX3(a,C0[r],C0[r+1]);b=MX3(b,C0[r+2],C0[r+3]);a=MX3(a,C1[r],C1[r+1]);b=MX3(b,C1[r+2],C1[r+3]);} \
      float rm=__builtin_fmaxf(a,b); { auto rr=__builtin_amdgcn_permlane32_swap(__float_as_uint(rm),__float_as_uint(rm),false,false); rm=__builtin_fmaxf(__uint_as_float(rr[0]),__uint_as_float(rr[1])); } \
      resc=false; \
      if(__builtin_expect(__any(rm>(float)THRL),0)){ const float dl=__builtin_fmaxf(rm,0.f); mhat+=dl; \
        _Pragma("unroll") for(int r=0;r<16;++r){C0[r]-=dl;C1[r]-=dl;} \
        _Pragma("unroll") for(int r=0;r<16;++r)negm[r]=-mhat; asm volatile("":"+v"(negm)); \
        const float f=__builtin_amdgcn_exp2f(-dl); l_reg*=f; { int ri_=r32; asm volatile("":"+v"(ri_)); if(hi==0)wsf[ri_]=f; } resc=true; } } \
    SBAR(); \
    GAPB(o[0]=__builtin_amdgcn_mfma_f32_32x32x16_bf16(PAF(0),VFR(0),o[0],0,0,0), C0,0); \
    GAPB(o[1]=__builtin_amdgcn_mfma_f32_32x32x16_bf16(PAF(0),VFR(4),o[1],0,0,0), C0,4); \
    KRD(GL,0); GAPB(o[0]=__builtin_amdgcn_mfma_f32_32x32x16_bf16(PAF(1),VFR(1),o[0],0,0,0), C0,8); \
    KRD(GL,1); GAPB(o[1]=__builtin_amdgcn_mfma_f32_32x32x16_bf16(PAF(1),VFR(5),o[1],0,0,0), C0,12); \
    KRD(GL,2); GAPB(o[0]=__builtin_amdgcn_mfma_f32_32x32x16_bf16(PAF(2),VFR(2),o[0],0,0,0), C1,0); \
    KRD(GL,3); GAPB(o[1]=__builtin_amdgcn_mfma_f32_32x32x16_bf16(PAF(2),VFR(6),o[1],0,0,0), C1,4); \
    GAPB(o[0]=__builtin_amdgcn_mfma_f32_32x32x16_bf16(PAF(3),VFR(3),o[0],0,0,0), C1,8); \
    GAPB(o[1]=__builtin_amdgcn_mfma_f32_32x32x16_bf16(PAF(3),VFR(7),o[1],0,0,0), C1,12); \
    }while(0)
  int t=1;
  #undef CMASK
  #define CMASK(P0,P1,t) do{}while(0)
  for(;t+5<NT;t+=2){
    STEP(pB0,pB1,pA0,pA1,t,true,true,true);     WAIT_BAR(2); RESC(); ROT();
    STEP(pA0,pA1,pB0,pB1,t+1,true,true,true);   WAIT_BAR(2); RESC(); ROT();
  }
  #undef CMASK
  #define CMASK(P0,P1,t) do{int jb_=(t)-(NT-4); if(jb_>=0)cmask(P0,P1,jb_,qrel,hi);}while(0)
  #define ENDW(tt) do{ if((tt)+3<NT){WAIT_BAR(2);} else if((tt)+2<NT){WAIT_BAR(1);} else {WAIT_BAR(0);} }while(0)
  for(;t+1<NT;t+=2){
    STEP(pB0,pB1,pA0,pA1,t,(t+3<NT),(t+1<NT),(t+1<NT));       ENDW(t);   RESC(); ROT();
    STEP(pA0,pA1,pB0,pB1,t+1,(t+4<NT),(t+2<NT),(t+2<NT));     ENDW(t+1); RESC(); ROT();
  }
  STEP(pB0,pB1,pA0,pA1,NT-1,false,false,false); RESC();
  { const int mb0_=(int)(unsigned)(mw_cur>>(4*hi)), mb1_=(int)(unsigned)(mw_cur>>(32+4*hi)); AB_MASK16(pB0,mb0_); AB_MASK16(pB1,mb1_); }
  { float sacc=pB0[0]+pB0[1]; _Pragma("unroll") for(int r=2;r<16;++r)sacc+=pB0[r]; _Pragma("unroll") for(int r=0;r<16;++r)sacc+=pB1[r]; l_reg+=sacc;
    pw0=(u32x4){PKW(pB0,0),PKW(pB0,2),PKW(pB0,4),PKW(pB0,6)};pw1=(u32x4){PKW(pB0,8),PKW(pB0,10),PKW(pB0,12),PKW(pB0,14)};pw2=(u32x4){PKW(pB1,0),PKW(pB1,2),PKW(pB1,4),PKW(pB1,6)};pw3=(u32x4){PKW(pB1,8),PKW(pB1,10),PKW(pB1,12),PKW(pB1,14)};
    SBAR(); { int ln_=lane; asm volatile("":"+v"(ln_)); const int vb0=(int)(lds0+LDS_V)+((ln_>>4)&1)*32+(ln_&3)*8+(4*(ln_>>5)+((ln_&15)>>2))*64;
      pv(o,vb0+sl_cur,PAF(0),PAF(1),PAF(2),PAF(3)); } }
  #undef PKW
  #undef PAF
  #undef VFR
  #undef PIN
  #undef MX3
  #undef GAPA
  #undef MK4
  #undef GAPB
  #undef EX
  #undef VRD
  #undef KRD
  #undef STEP
  #undef ENDW
  {auto rr=__builtin_amdgcn_permlane32_swap(__float_as_uint(l_reg),__float_as_uint(l_reg),false,false);l_reg=__uint_as_float(rr[0])+__uint_as_float(rr[1]);}
  if(hi==0)wsf[32+r32]=l_reg;asm volatile("s_waitcnt lgkmcnt(0)":::"memory");
  float rli[16];
  #pragma unroll
  for(int r=0;r<16;++r)rli[r]=__builtin_amdgcn_rcpf(wsf[32+crow(r,hi)]);
  { bf16*stg=(bf16*)(shm+LDS_OST)+wid*2048;
    #pragma unroll
    for(int r=0;r<16;++r){const int orow=crow(r,hi);
      #pragma unroll
      for(int d0=0;d0<2;++d0)stg[orow*64+d0*32+r32]=__float2bfloat16(o[d0][r]*rli[r]);}
    asm volatile("s_waitcnt lgkmcnt(0)":::"memory");
    #pragma unroll
    for(int i=0;i<4;++i){const int row=i*8+(lane>>3),ch=lane&7; const u32x4 v=*(const u32x4*)(stg+row*64+ch*8); const int trow=q0+wid*QBLK+row;
      if(trow>=16&&trow<8208) ATTN_STORE16(O+((long)b*8192+(trow-16))*DM+h*D+ch*8,v);} }
  asm volatile("s_waitcnt lgkmcnt(0)\n\ts_barrier":::"memory");
  #undef DMA_K
  #undef DMA_V
  #undef CMASK
  #undef START
  #undef RESC
  #undef ROT
  #undef CKBIAS
  #undef QR
}
constexpr int ATTN_LDS_BYTES=LDS_BYTES;
#undef SBAR
#undef WAIT_BAR
}

__device__ __forceinline__ unsigned ordkey16(float s) {
    const _Float16 hf = (_Float16)(s + 0.0f);
    const unsigned bits = (unsigned)__builtin_bit_cast(unsigned short, hf);
    return (bits & 0x8000u) ? (~bits & 0xffffu) : (bits | 0x8000u);
}
template <int CTRL, int ROWMASK> __device__ __forceinline__ int dppi(int v) { return __builtin_amdgcn_update_dpp(0, v, CTRL, ROWMASK, 0xf, true); }
__device__ __forceinline__ int wave_incl_scan(int v) {
    v += dppi<0x111, 0xf>(v);
    v += dppi<0x112, 0xf>(v);
    v += dppi<0x114, 0xf>(v);
    v += dppi<0x118, 0xf>(v);
    v += dppi<0x142, 0xa>(v);
    v += dppi<0x143, 0xc>(v);
    return v;
}
__device__ __forceinline__ void hist_find(const unsigned* hist, int need, int lane, int& bin, int& above) {
    const uint4 c4 = *(const uint4*)(hist + 252 - 4 * lane);
    const int c0 = (int)c4.w, c1 = (int)c4.z, c2 = (int)c4.y, c3 = (int)c4.x;
    const int tot = c0 + c1 + c2 + c3;
    const int incl = wave_incl_scan(tot);
    const unsigned long long bal = __ballot(incl >= need);
    const int L = bal ? (int)__builtin_ctzll(bal) : 63;
    int mybin, myabove;
    {
        int cum = incl - tot;
        if (cum + c0 >= need) { mybin = 255 - 4 * lane; myabove = cum; }
        else { cum += c0;
            if (cum + c1 >= need) { mybin = 254 - 4 * lane; myabove = cum; }
            else { cum += c1;
                if (cum + c2 >= need) { mybin = 253 - 4 * lane; myabove = cum; }
                else { cum += c2; mybin = 252 - 4 * lane; myabove = cum; } } }
    }
    bin = __builtin_amdgcn_readlane(mybin, L); above = __builtin_amdgcn_readlane(myabove, L);
}
__device__ __forceinline__ unsigned fixkey16(float s) {
    const int v = (int)(__float_as_uint(fmaf(s, 2048.0f, 12582912.0f + 32768.0f)) - 0x4B400000u);
    return (unsigned)min(max(v, 1), 65535);
}
__device__ void indexer_item(unsigned char* ws, int b, int qg, unsigned char* smem) {
    const bf16_t* QI = (const bf16_t*)(ws + OFF_QI);
    const bf16_t* KI = (const bf16_t*)(ws + OFF_KI);
    const float* WI = (const float*)(ws + OFF_WI);
    unsigned long long* mask = (unsigned long long*)(ws + OFF_MASK);
    unsigned short* sc = (unsigned short*)smem;
    unsigned* hist_all = (unsigned*)(smem + 8 * SCP * 2);
    const int tid = ltid(), lane = tid & 63, wave = __builtin_amdgcn_readfirstlane(tid >> 6);
    const int t0 = qg * 8;
    const int g = lane >> 4, kc = lane & 15;
    for (int i = tid * 4; i < 8 * HP; i += NTHREADS * 4) *(uint4*)(hist_all + i) = zero4u();
    bf16x8 af[4][2];
#pragma unroll
    for (int mi = 0; mi < 4; ++mi) {
        const int q = (mi >> 1) * 4 + (kc >> 2), hh = (mi & 1) * 4 + (kc & 3);
#pragma unroll
        for (int ks = 0; ks < 2; ++ks) af[mi][ks] = *(const bf16x8*)(QI + ((size_t)b * TP + t0 + q) * 512 + hh * 64 + ks * 32 + g * 8);
    }
    float wq[2][8];
#pragma unroll
    for (int a = 0; a < 2; ++a)
#pragma unroll
        for (int hh = 0; hh < 8; ++hh) wq[a][hh] = WI[((size_t)b * TP + t0 + a * 4 + g) * 8 + hh];
    __syncthreads();
    const int ntile = (t0 + 8 + 15) >> 4;
    const bf16_t* kbase = KI + ((size_t)b * (TP / 16) * 2 * 64 + lane) * 8;
    for (int rep_ = 0; rep_ < IDX_REP_MFMA; ++rep_) {
    constexpr int U = 4;
    const f32x4 z4 = zero4();
    const int nfull = (t0 >= 15) ? ((t0 - 15) >> 4) + 1 : 0;
    unsigned short* scw0 = sc + g * SCP + kc;
    unsigned* hw0 = hist_all + g * HP;
    bf16x8 c0[U], c1[U];
#pragma unroll
    for (int u = 0; u < U; ++u) { const int kt = wave + 8 * u; if (kt < ntile) { const bf16_t* kr = kbase + (size_t)kt * 1024; c0[u] = *(const bf16x8*)kr; c1[u] = *(const bf16x8*)(kr + 512); } }
    for (int base = wave; base < ntile; base += 8 * U) {
        bf16x8 n0[U], n1[U];
#pragma unroll
        for (int u = 0; u < U; ++u) { const int kt = base + 8 * (U + u); n0[u] = c0[u]; n1[u] = c1[u]; if (kt < ntile && !(IDX_PROBE == 3 && rep_ > 0)) { const bf16_t* kr = kbase + (size_t)kt * 1024; n0[u] = *(const bf16x8*)kr; n1[u] = *(const bf16x8*)(kr + 512); } }
#pragma unroll
        for (int u = 0; u < U; ++u) {
            const int kt = base + 8 * u;
            if (kt < ntile) {
                f32x4 acc[4];
#pragma unroll
                for (int mi = 0; mi < 4; ++mi) {
                    acc[mi] = __builtin_amdgcn_mfma_f32_16x16x32_bf16(af[mi][0], c0[u], z4, 0, 0, 0);
                    acc[mi] = __builtin_amdgcn_mfma_f32_16x16x32_bf16(af[mi][1], c1[u], acc[mi], 0, 0, 0);
                }
                float s0 = 0.f, s1 = 0.f;
#pragma unroll
                for (int c = 0; c < 2; ++c)
#pragma unroll
                    for (int j = 0; j < 4; ++j) {
                        s0 = fmaf(wq[0][c * 4 + j], __builtin_amdgcn_fmed3f(acc[c][j], 0.f, 3.0e38f), s0);
                        s1 = fmaf(wq[1][c * 4 + j], __builtin_amdgcn_fmed3f(acc[2 + c][j], 0.f, 3.0e38f), s1);
                    }
                unsigned k0 = fixkey16(s0), k1 = fixkey16(s1);
                if ((IDX_PROBE == 1 || IDX_PROBE == 3) && rep_ > 0) { asm volatile("" :: "v"(k0), "v"(k1)); }
                else if (kt < nfull) {
                    scw0[kt * 16] = (unsigned short)k0; scw0[4 * SCP + kt * 16] = (unsigned short)k1;
                    if (rep_ == 0) { atomicAdd(&hw0[k0 >> 8], 1u); atomicAdd(&hw0[4 * HP + (k1 >> 8)], 1u); }
                } else {
                    const int key = kt * 16 + kc;
                    const bool ok0 = key <= t0 + g, ok1 = key <= t0 + 4 + g;
                    k0 = ok0 ? k0 : 0u; k1 = ok1 ? k1 : 0u;
                    scw0[kt * 16] = (unsigned short)k0; scw0[4 * SCP + kt * 16] = (unsigned short)k1;
                    if (rep_ == 0) { if (ok0) atomicAdd(&hw0[k0 >> 8], 1u); if (ok1) atomicAdd(&hw0[4 * HP + (k1 >> 8)], 1u); }
                }
            }
        }
#pragma unroll
        for (int u = 0; u < U; ++u) { c0[u] = n0[u]; c1[u] = n1[u]; }
    }
    }
    __syncthreads();
    for (int rep2_ = 0; rep2_ < IDX_REP_SEL; ++rep2_)
    {
        const int t = t0 + wave;
        const int n = t + 1;
        const unsigned short* row = sc + wave * SCP;
        unsigned* hist = hist_all + wave * HP;
        unsigned char* mrow = (unsigned char*)(mask + ((size_t)b * TP + t) * MW);
        const int nbytes = ((t >> 8) + 1) * 32;
        const int nit3 = (nbytes + 63) >> 6;
        unsigned Tkey = 0u; int rem = 0;
        if (n > 256) {
            const int nit = (n + 511) >> 9;
            int B1, above1;
            hist_find(hist, 256, lane, B1, above1);
            const int need2 = 256 - above1;
            __threadfence_block();
            *(uint4*)(hist + lane * 4) = zero4u();
            __threadfence_block();
            for (int it = 0; it < nit; ++it) {
                const int e0 = (it * 64 + lane) * 8;
                const uint4 v = *(const uint4*)(row + e0);
                const unsigned ww[4] = {v.x, v.y, v.z, v.w};
#pragma unroll
                for (int e = 0; e < 8; ++e) {
                    const unsigned k = (ww[e >> 1] >> ((e & 1) * 16)) & 0xffffu;
                    if (e0 + e < n && (int)(k >> 8) == B1) atomicAdd(&hist[k & 255u], 1u);
                }
            }
            __threadfence_block();
            int B2, above2;
            hist_find(hist, need2, lane, B2, above2);
            Tkey = ((unsigned)B1 << 8) | (unsigned)B2;
            rem = 256 - above1 - above2;
        }
        for (int it = 0; it < nit3; ++it) {
            const int e0 = (it * 64 + lane) * 8;
            const uint4 v = *(const uint4*)(row + e0);
            const unsigned ww[4] = {v.x, v.y, v.z, v.w};
            unsigned gtb = 0u, eqb = 0u;
#pragma unroll
            for (int e = 0; e < 8; ++e) {
                const unsigned k = (ww[e >> 1] >> ((e & 1) * 16)) & 0xffffu;
                const bool valid = (e0 + e) < n;
                gtb |= (valid && k > Tkey) ? (1u << e) : 0u;
                eqb |= (valid && k == Tkey) ? (1u << e) : 0u;
            }
            if (__ballot(eqb != 0u) != 0ull) {
                const int c = __popc(eqb);
                int incl = c;
#pragma unroll
                for (int d = 1; d < 64; d <<= 1) { const int vv = __shfl_up(incl, d); if (lane >= d) incl += vv; }
                int r = incl - c;
                unsigned tk = 0u;
#pragma unroll
                for (int e = 0; e < 8; ++e) if ((eqb >> e) & 1u) { if (r < rem) tk |= (1u << e); ++r; }
                rem -= __shfl(incl, 63) < rem ? __shfl(incl, 63) : rem;
                gtb |= tk;
            }
            const int bi = it * 64 + lane;
            if (bi < nbytes) mrow[bi] = (unsigned char)gtb;
        }
    }
    __syncthreads();
}

__device__ int fox_prune(unsigned char* ws, int b, int h, int qb, unsigned char* smem) {
    const int tid = ltid(), lane = tid & 63, wave = __builtin_amdgcn_readfirstlane(tid >> 6), hlf = lane >> 5;
    const bf16_t* Q = (const bf16_t*)(ws + OFF_QF);
    const float* cumt = (const float*)(ws + OFF_CUMT) + (size_t)(b * 8 + h) * TP;
    const float* knorm = (const float*)(ws + OFF_KNORM) + (size_t)(b * 8 + h) * MW;
    float* red = (float*)(smem + 90112);
    const size_t grow = (size_t)b * TP + qb * 256 + wave * 32 + (lane & 31);
    float qq = 0.f;
#pragma unroll
    for (int ks = 0; ks < 4; ++ks) {
        const bf16x8 qv = *(const bf16x8*)(Q + grow * 512 + h * 64 + ks * 16 + hlf * 8);
#pragma unroll
        for (int e = 0; e < 8; ++e) { const float v = bf2f((unsigned)(unsigned short)qv[e]); qq = fmaf(v, v, qq); }
    }
    qq += __shfl_xor(qq, 32);
#pragma unroll
    for (int o = 1; o < 32; o <<= 1) qq = fmaxf(qq, __shfl_xor(qq, o));
    if (lane == 0) red[wave] = qq;
    __syncthreads();
    if (wave == 0) {
        float qm = red[0];
#pragma unroll
        for (int w = 1; w < 8; ++w) qm = fmaxf(qm, red[w]);
        const float Qn = sqrtf(qm) * 1.0001f;
        const float Kd = fmaxf(fmaxf(knorm[qb * 4], knorm[qb * 4 + 1]), fmaxf(knorm[qb * 4 + 2], knorm[qb * 4 + 3])) * 1.0001f;
        const float cfirst = cumt[qb * 256];
        bool keep0 = true, keep1 = true;
        if (lane < qb * 4) { const float bnd = Qn * (knorm[lane] * 1.0001f + Kd) + cfirst - cumt[lane * 64 + 63]; keep0 = !(bnd < -40.0f); }
        if (lane + 64 < qb * 4) { const float bnd = Qn * (knorm[lane + 64] * 1.0001f + Kd) + cfirst - cumt[(lane + 64) * 64 + 63]; keep1 = !(bnd < -40.0f); }
        const unsigned long long b0 = __ballot(keep0), b1 = __ballot(keep1);
        const int first = b0 ? (int)__builtin_ctzll(b0) : (b1 ? 64 + (int)__builtin_ctzll(b1) : 128);
        if (lane == 0) ((int*)red)[8] = (first < qb * 4 ? first : qb * 4) & ~1;
    }
    __syncthreads();
    return ((const int*)red)[8];
}

#define LAS __attribute__((address_space(3)))
#define XB_TMO      128
#define XB_XCNT(j)  (256  + 64 * (j))
#define XB_XSUB(j)  (1280 + 64 * (j))
#define XB_XGEN(j)  (2304 + 64 * (j))
#define XB_TOP      3328
#define XB_TOPGEN   3392
#define XCD_BAR_WORDS 3456
#define XB_SPIN_CAP (1u << 18)
__device__ __forceinline__ unsigned xb_ld(unsigned* p)              { return __hip_atomic_load(p, __ATOMIC_RELAXED, __HIP_MEMORY_SCOPE_AGENT); }
__device__ __forceinline__ unsigned xb_add(unsigned* p, unsigned v) { return __hip_atomic_fetch_add(p, v, __ATOMIC_RELAXED, __HIP_MEMORY_SCOPE_AGENT); }
__device__ __forceinline__ unsigned xb_xcc_id() { return (unsigned)__builtin_amdgcn_s_getreg((3 << 11) | 20) & 0xFu; }
#define XB_SPIN(cond, bar) do { unsigned _sp = 0; while (cond) { __builtin_amdgcn_s_sleep(1); \
    if ((++_sp & 255u) == 0u) { if (xb_ld(&(bar)[XB_TMO])) break; if (_sp > XB_SPIN_CAP) { atomicAdd(&(bar)[XB_TMO], 1u); break; } } } } while (0)
struct XcdBarrier { unsigned* bar; unsigned x; volatile LAS unsigned* st; };
__device__ __forceinline__ XcdBarrier xcd_barrier_post(unsigned* bar, volatile LAS unsigned* st) {
    XcdBarrier b; b.bar = bar; b.x = xb_xcc_id(); b.st = st;
    if (threadIdx.x == 0) (void)xb_add(&bar[XB_XCNT(b.x)], 1u);
    return b;
}
__device__ __forceinline__ void xcd_barrier_complete(unsigned* bar, unsigned x, unsigned& nloc, unsigned& nx) {
    const unsigned G = gridDim.x * gridDim.y * gridDim.z;
    unsigned sum, cnt, mine, sp = 0u;
    for (;;) {
        sum = 0u; cnt = 0u; mine = 0u;
#pragma unroll
        for (unsigned j = 0; j < 16; ++j) { const unsigned c = xb_ld(&bar[XB_XCNT(j)]); sum += c; cnt += (c > 0u) ? 1u : 0u; mine = (j == x) ? c : mine; }
        if (sum == G) break;
        __builtin_amdgcn_s_sleep(1);
        if ((++sp & 255u) == 0u) { if (xb_ld(&bar[XB_TMO])) break; if (sp > XB_SPIN_CAP) { atomicAdd(&bar[XB_TMO], 1u); break; } }
    }
    nloc = mine > 0u ? mine : 1u; nx = cnt > 0u ? cnt : 1u;
}
__device__ __forceinline__ void xcd_barrier(const XcdBarrier& b) {
    asm volatile("s_waitcnt vmcnt(0)" ::: "memory");
    __syncthreads();
    if (threadIdx.x == 0) {
        unsigned* bar = b.bar;
        __builtin_amdgcn_s_waitcnt(0);
        unsigned nloc = b.st[0], nx = b.st[1];
        if (nloc == 0u) { xcd_barrier_complete(bar, b.x, nloc, nx); b.st[0] = nloc; b.st[1] = nx; }
        const unsigned old = xb_add(&bar[XB_XSUB(b.x)], 1u);
        const unsigned gen = old / nloc;
        if (old + 1u == (gen + 1u) * nloc) {
            __builtin_amdgcn_fence(__ATOMIC_RELEASE, "agent");
            asm volatile("s_waitcnt vmcnt(0)" ::: "memory");
            const unsigned og = xb_add(&bar[XB_TOP], 1u);
            const unsigned tg = og / nx;
            if (og + 1u == (tg + 1u) * nx) xb_add(&bar[XB_TOPGEN], 1u);
            else XB_SPIN(xb_ld(&bar[XB_TOPGEN]) == tg, bar);
            __builtin_amdgcn_fence(__ATOMIC_ACQUIRE, "agent");
            xb_add(&bar[XB_XGEN(b.x)], 1u);
            asm volatile("s_waitcnt vmcnt(0)" ::: "memory");
        } else {
            XB_SPIN(xb_ld(&bar[XB_XGEN(b.x)]) == gen, bar);
            __builtin_amdgcn_fence(__ATOMIC_ACQUIRE, "agent");
            asm volatile("s_waitcnt vmcnt(0)" ::: "memory");
        }
    }
    __syncthreads();
}

__global__ void __launch_bounds__(NTHREADS, 2) mega(Params p) {
    __shared__ __attribute__((aligned(16))) unsigned char smem[LDS_BYTES];
    volatile LAS unsigned* bst = (volatile LAS unsigned*)(smem + LDS_BYTES - 64);
    if (threadIdx.x < 2) bst[threadIdx.x] = 0u;
    __syncthreads();
    (void)xcd_barrier_post((unsigned*)(p.ws + OFF_CTL) + CW_BAR, bst);

#pragma unroll 1
    for (int step = p.ph_lo; step < p.ph_hi; ++step) {
        if (step > p.ph_lo) {
            KParams kpb = (KParams)__builtin_amdgcn_kernarg_segment_ptr(); asm volatile("" : "+s"(kpb));
            XcdBarrier gb; gb.bar = (unsigned*)(kpb->ws + OFF_CTL) + CW_BAR; gb.x = xb_xcc_id(); gb.st = (volatile LAS unsigned*)(smem + LDS_BYTES - 64);
            xcd_barrier(gb);
        }
        const int ph = (REPEAT_PH >= 0 && step > REPEAT_PH) ? step - 1 : step;
        KParams kp = (KParams)__builtin_amdgcn_kernarg_segment_ptr(); asm volatile("" : "+s"(kp));
        unsigned char* ws = kp->ws;
        const int G = gridDim.x, bid = blockIdx.x;
        unsigned* ctl = (unsigned*)(ws + OFF_CTL);
        const float* rope = (const float*)(ws + OFF_ROPE);
        float* stat0 = (float*)(ws + OFF_STAT0);
        const float* x = kp->in[0];
        if (PH(0) && ph == 0) {
            const int tid = ltid(), lane = tid & 63, wave = __builtin_amdgcn_readfirstlane(tid >> 6); (void)lane; (void)wave;
            {
                bf16_t* HB = (bf16_t*)(ws + OFF_HB); bf16_t* HBM = (bf16_t*)(ws + OFF_HBM);
                const float* g0 = kp->in[2]; const float* b0 = kp->in[3];
                for (int i = bid * 8 + wave; i < NTOK + NMETA; i += G * 8) {
                    const bool ismeta = i >= NTOK;
                    const int n = i, bb_ = n / SEQ, sq = n % SEQ;
                    const int r = bb_ * TP + NMETA + sq;
                    const float* src = ismeta ? (kp->in[1] + (size_t)(i - NTOK) * 1024) : (x + (size_t)n * 1024);
                    bf16_t* dst = ismeta ? (HBM + (size_t)(i - NTOK) * 1024) : (HB + (size_t)n * 1024);
                    f32x4 v[4]; float s = 0.f;
#pragma unroll
                    for (int j = 0; j < 4; ++j) { v[j] = *(const f32x4*)(src + lane * 4 + 256 * j); s += (v[j][0] + v[j][1]) + (v[j][2] + v[j][3]); }
                    const float mu = wave_sum(s) * (1.0f / 1024.0f);
                    float q = 0.f;
#pragma unroll
                    for (int j = 0; j < 4; ++j) { const f32x4 d = v[j] - mu; q += (d[0] * d[0] + d[1] * d[1]) + (d[2] * d[2] + d[3] * d[3]); }
                    const float rstd = rsqrtf(wave_sum(q) * (1.0f / 1024.0f) + LN_EPS);
#pragma unroll
                    for (int j = 0; j < 4; ++j) {
                        const f32x4 gg = *(const f32x4*)(g0 + lane * 4 + 256 * j), bb = *(const f32x4*)(b0 + lane * 4 + 256 * j);
                        const f32x4 y = (v[j] - mu) * rstd * gg + bb;
                        store4bf(dst + lane * 4 + 256 * j, y);
                    }
                    if (lane == 0 && !ismeta) { stat0[2 * r] = mu; stat0[2 * r + 1] = rstd; }
                }
            }
            {
                float* ropew = (float*)(ws + OFF_ROPE);
                for (int i = bid * NTHREADS + tid; i < TP * 8; i += G * NTHREADS) {
                    const int t = i >> 3, k = i & 7;
                    const float invf[8] = {1.0f, 0.1939227432012558f, 0.03760603070259094f, 0.007292664609849453f, 0.0014142135623842478f,
                                           0.00027424818836152554f, 5.3182957344688475e-05f, 1.0313385246263351e-05f};
                    float iv = invf[0];
#pragma unroll
                    for (int kk = 1; kk < 8; ++kk) iv = (k == kk) ? invf[kk] : iv;
                    const float ang = (float)t * iv;
                    ropew[2 * i] = cosf(ang); ropew[2 * i + 1] = sinf(ang);
                }
            }
            {
                bf16_t* wrt = (bf16_t*)(ws + OFF_WRT);
                const float* wrg = kp->in[13]; const float* wre = kp->in[15];
                for (int i = bid * NTHREADS + tid; i < 48 * 1024; i += G * NTHREADS) {
                    const int e = i >> 10, k = i & 1023;
                    const float w = (e < 4) ? wrg[k * 4 + e] : ((e < 36) ? wre[k * 32 + (e - 4)] : 0.f);
                    const unsigned hi = f2bf(w);
                    wrt[i] = (bf16_t)hi; wrt[48 * 1024 + i] = (bf16_t)f2bf(w - bf2f(hi));
                }
            }
            {
                KParams kq = kp;
                unsigned char* wsq = ws;
                constexpr int N_WIN = 16 * 80, N_KV = 4 * 16, N_A = 8 * 16, N_F = 8 * 16, N_O = 16 * 16;
                constexpr int NT = N_WIN + N_KV + N_A + N_F + N_O;
                auto dec = [kq, wsq](int it) -> XTile {
                    XTile x; x.kscale = nullptr; x.winmap = 0; x.s16 = 16;
                    int i = it;
                    if (i < N_WIN) { x.src = kq->in[4]; x.src_ld = 4944; x.dst = (bf16_t*)(wsq + OFF_WIN); x.dst_ld = 1024; x.k0 = (i % 16) * 64; x.j0 = (i / 16) * 64; x.winmap = 1; }
                    else if ((i -= N_WIN) < N_KV) { x.src = kq->in[7]; x.src_ld = 1024; x.dst = (bf16_t*)(wsq + OFF_WKV); x.dst_ld = 256; x.k0 = (i % 4) * 64; x.j0 = (i / 4) * 64; x.kscale = kq->in[6]; }
                    else if ((i -= N_KV) < N_A) { x.src = kq->in[8]; x.src_ld = 1024; x.dst = (bf16_t*)(wsq + OFF_WA); x.dst_ld = 512; x.k0 = (i % 8) * 64; x.j0 = (i / 8) * 64; }
                    else if ((i -= N_A) < N_F) { x.src = kq->in[9]; x.src_ld = 1024; x.dst = (bf16_t*)(wsq + OFF_WF); x.dst_ld = 512; x.k0 = (i % 8) * 64; x.j0 = (i / 8) * 64; }
                    else { i -= N_F; x.src = kq->in[10]; x.src_ld = 1024; x.dst = (bf16_t*)(wsq + OFF_WO); x.dst_ld = 1024; x.k0 = (i % 16) * 64; x.j0 = (i / 16) * 64; }
                    x.rb = x.j0;
                    return x;
                };
                xpose_many(NT, G, bid, dec, (float*)smem);
            }
        }
        if ((PH(1) && ph == 1) || (PH(2) && ph == 2) || (PH(5) && ph == 5) || (PH(6) && ph == 6) || (PH(9) && ph == 9)) {
            {
            }
            float* rs = (float*)(smem + pg8::STAGE_BYTES);
            int* tag = (int*)(smem + pg8::STAGE_BYTES + 2048);
            if (ph == 2) {
                const int tid = ltid();
                const bf16_t* CKV = (const bf16_t*)(ws + OFF_CKV);
                pg8::StaticOrder S; S.init(NTOK, 1024, G, bid);
                pg8::Unit u;
                for (int i = 0; i < 2; ++i) {
                    if (!S.next(i, u)) { if (tid == 0) tag[i] = -1; continue; }
                    if (tid == 0) tag[i] = u.pm;
                    const bf16_t* rp = CKV + (size_t)(u.pm * 256 + (tid >> 1)) * 256 + (tid & 1) * 128;
                    float ss = 0.f;
#pragma unroll
                    for (int c = 0; c < 16; ++c) {
                        const uint4 uu = *(const uint4*)(rp + c * 8);
                        const unsigned ww[4] = {uu.x, uu.y, uu.z, uu.w};
#pragma unroll
                        for (int e = 0; e < 4; ++e) { const float a0 = bf2f(ww[e] & 0xffffu), a1 = bf2f(ww[e] >> 16); ss = fmaf(a0, a0, fmaf(a1, a1, ss)); }
                    }
                    ss += __shfl_xor(ss, 1);
                    if ((tid & 1) == 0) rs[i * 256 + (tid >> 1)] = rsqrtf(ss * (1.0f / 256.0f) + RMS_EPS);
                }
                __syncthreads();
            }
            if (ph == 9) {
                const int tid = ltid();
                if (tid < 32) tag[tid] = (int)ctl[CW_ECNT + tid];
                __syncthreads();
                if (tid == 0) { int cp = 0, rb = 0; for (int e = 0; e < 32; ++e) { tag[32 + e] = cp; tag[64 + e] = rb; const int nc = (tag[e] + 255) >> 8; cp += nc; rb += nc * 256; } tag[96] = cp; }
                __syncthreads();
            }
            const int njobs = (ph == 5) ? 2 : 1;
#pragma unroll 1
            for (int job = 0; job < njobs; ++job) {
                pg8::Gemm g; int kind;
                if (ph == 1) { g = pg8::Gemm{(const bf16_t*)(ws + OFF_HB), (const bf16_t*)(ws + OFF_WIN), NTOK, NP, 1024}; kind = 0; }
                else if (ph == 2) { g = pg8::Gemm{(const bf16_t*)(ws + OFF_CKV), (const bf16_t*)(ws + OFF_WKV), NTOK, 1024, 256}; kind = 1; }
                else if (ph == 5) { g = (job == 0) ? pg8::Gemm{(const bf16_t*)(ws + OFF_YA), (const bf16_t*)(ws + OFF_WA), NTOK, 1024, 512}
                                                   : pg8::Gemm{(const bf16_t*)(ws + OFF_YF), (const bf16_t*)(ws + OFF_WF), NTOK, 1024, 512}; kind = 2 + job; }
                else if (ph == 6) { g = pg8::Gemm{(const bf16_t*)(ws + OFF_MERGED), (const bf16_t*)(ws + OFF_WO), NTOK, 1024, 1024}; kind = 4; }
                else { g = pg8::Gemm{(const bf16_t*)(ws + OFF_HID), (const bf16_t*)(ws + OFF_WD), HID_ROWS, 32 * 1024, 256}; kind = 5; }
                pg8::StaticOrder S; S.init(g.M, g.N, G, bid);
                if (ph == 9) S.init_moe((const PG8_LAS int*)tag, G, bid);
                EpiAny E{kind, (const PG8_LAS float*)rs, (const PG8_LAS int*)tag};
                pg8::gemm_phase<EpiAny, pg8::StaticOrder, true, true>((PG8_LAS unsigned char*)smem, g, S, E);
            }
            if (ph == 1) {
                const int tid = ltid(), lane = tid & 63, wave = __builtin_amdgcn_readfirstlane(tid >> 6);
                const int gw = (wave == 0) ? bid : 1 << 20;
                if (gw <= 180) {
                    const bf16_t* HBM = (const bf16_t*)(ws + OFF_HBM); const bf16_t* WIN = (const bf16_t*)(ws + OFF_WIN);
                    const int c0 = (gw < 180) ? gw * 16 : 4928;
                    f32x4 acc = zero4();
                    const bf16_t* ap_ = HBM + (size_t)(lane & 15) * 1024 + (lane >> 4) * 8;
                    const bf16_t* bp_ = WIN + (size_t)(c0 + (lane & 15)) * 1024 + (lane >> 4) * 8;
#pragma unroll 16
                    for (int kk = 0; kk < 32; ++kk) acc = __builtin_amdgcn_mfma_f32_16x16x32_bf16(*(const bf16x8*)(ap_ + kk * 32), *(const bf16x8*)(bp_ + kk * 32), acc, 0, 0, 0);
                    const int cg64 = c0 >> 6, d = (c0 & 63) + (lane & 15);
                    const bool ropeseg = (cg64 < 8 || (cg64 >= 12 && cg64 <= 20)) && ((c0 & 63) == 0);
                    const float* bfg = kp->in[5];
#pragma unroll
                    for (int j = 0; j < 4; ++j) {
                        const int t = (lane >> 4) * 4 + j;
                        float v = acc[j];
                        if (ropeseg) {
                            const float pr = __shfl_xor(v, 8);
                            const float cs = rope[t * 16 + 2 * (d & 7)], sn = rope[t * 16 + 2 * (d & 7) + 1];
                            v = (d & 8) ? (v * cs + pr * sn) : (v * cs - pr * sn);
                        }
#pragma unroll
                        for (int b = 0; b < 2; ++b) {
                            const size_t r = (size_t)b * TP + t;
                            if (cg64 < 8) ((bf16_t*)(ws + OFF_QA))[r * 512 + cg64 * 64 + d] = (bf16_t)f2bf(v * QSCALE);
                            else if (cg64 < 12) { if (b == 0) ((float*)(ws + OFF_MCKV))[t * 256 + (cg64 - 8) * 64 + d] = v; }
                            else if (cg64 < 20) ((bf16_t*)(ws + OFF_QI))[r * 512 + (cg64 - 12) * 64 + d] = (bf16_t)f2bf(v * 0.125f);
                            else if (cg64 == 20) ((bf16_t*)(ws + OFF_KI))[((size_t)((b * (TP / 16) + (t >> 4)) * 2 + (d >> 5)) * 64 + ((d & 31) >> 3) * 16 + (t & 15)) * 8 + (d & 7)] = (bf16_t)f2bf(v);
                            else if (cg64 < 29) ((bf16_t*)(ws + OFF_QF))[r * 512 + (cg64 - 21) * 64 + d] = (bf16_t)f2bf(v * QSCALE);
                            else if (cg64 < 37) ((bf16_t*)(ws + OFF_KF))[r * 512 + (cg64 - 29) * 64 + d] = (bf16_t)f2bf(v);
                            else if (cg64 < 45) ((bf16_t*)(ws + OFF_VF))[r * 512 + (cg64 - 37) * 64 + d] = (bf16_t)f2bf(v);
                            else if (d < 8) ((float*)(ws + OFF_WI))[r * 8 + d] = v * 0.3535533905932738f;
                            else { const float z = v + bfg[d - 8]; ((float*)(ws + OFF_LOGF))[r * 8 + (d - 8)] = fminf(z, 0.f) - log1pf(__expf(-fabsf(z))); }
                        }
                    }
                }
            }
            if (ph == 2) {
                const int tid = ltid(), lane = tid & 63, wave = __builtin_amdgcn_readfirstlane(tid >> 6);
                const int gw = (wave == 0) ? bid : 1 << 20;
                if (gw < 64) {
                    const float* MC = (const float*)(ws + OFF_MCKV); const bf16_t* WKV = (const bf16_t*)(ws + OFF_WKV);
                    const int c0 = gw * 16;
                    f32x4 acc = zero4(); float ss = 0.f;
                    const float* ap_ = MC + (lane & 15) * 256 + (lane >> 4) * 8;
                    const bf16_t* bp_ = WKV + (size_t)(c0 + (lane & 15)) * 256 + (lane >> 4) * 8;
#pragma unroll
                    for (int kk = 0; kk < 8; ++kk) {
                        const f32x4 a0 = *(const f32x4*)(ap_ + kk * 32), a1 = *(const f32x4*)(ap_ + kk * 32 + 4);
                        uint4 au; au.x = pk2(a0[0], a0[1]); au.y = pk2(a0[2], a0[3]); au.z = pk2(a1[0], a1[1]); au.w = pk2(a1[2], a1[3]);
                        const unsigned aw[4] = {au.x, au.y, au.z, au.w};
#pragma unroll
                        for (int e = 0; e < 4; ++e) { const float x0 = bf2f(aw[e] & 0xffffu), x1 = bf2f(aw[e] >> 16); ss = fmaf(x0, x0, fmaf(x1, x1, ss)); }
                        acc = __builtin_amdgcn_mfma_f32_16x16x32_bf16(*(bf16x8*)&au, *(const bf16x8*)(bp_ + kk * 32), acc, 0, 0, 0);
                    }
                    ss += __shfl_xor(ss, 16); ss += __shfl_xor(ss, 32);
                    const float rstd_row = rsqrtf(ss * (1.0f / 256.0f) + RMS_EPS);
                    const int cg64 = c0 >> 6, d = (c0 & 63) + (lane & 15);
                    const bool ropeseg = (cg64 < 8) && ((c0 & 63) == 0);
#pragma unroll
                    for (int j = 0; j < 4; ++j) {
                        const int t = (lane >> 4) * 4 + j;
                        float v = acc[j] * __shfl(rstd_row, t);
                        if (ropeseg) {
                            const float pr = __shfl_xor(v, 8);
                            const float cs = rope[t * 16 + 2 * (d & 7)], sn = rope[t * 16 + 2 * (d & 7) + 1];
                            v = (d & 8) ? (v * cs + pr * sn) : (v * cs - pr * sn);
                        }
#pragma unroll
                        for (int b = 0; b < 2; ++b) {
                            const size_t r = (size_t)b * TP + t;
                            if (cg64 < 8) ((bf16_t*)(ws + OFF_KA))[kimg_off(b, cg64, t, d)] = (bf16_t)f2bf(v);
                            else ((bf16_t*)(ws + OFF_VA))[vimg_off(b, cg64 - 8, t, d)] = (bf16_t)f2bf(v);
                        }
                    }
                }
            }
            if (ph == 2 && bid >= G - 16) {
                const int tid = ltid(), lane = tid & 63, wave = __builtin_amdgcn_readfirstlane(tid >> 6);
                const int i16 = bid - (G - 16), b = i16 >> 3, h = i16 & 7;
                const float* LOGF = (const float*)(ws + OFF_LOGF);
                float* CUM = (float*)(ws + OFF_CUM); float* CUMT = (float*)(ws + OFF_CUMT);
                double* part = (double*)smem;
                constexpr int CH = 17;
                float lv[CH];
                double sacc = 0.0;
#pragma unroll
                for (int k = 0; k < CH; ++k) { const int t = tid * CH + k; lv[k] = (t < T) ? LOGF[((size_t)b * TP + t) * 8 + h] : 0.f; }
#pragma unroll
                for (int k = 0; k < CH; ++k) sacc += (double)lv[k];
                double incl = sacc;
#pragma unroll
                for (int d = 1; d < 64; d <<= 1) { const double v = __shfl_up(incl, d); if (lane >= d) incl += v; }
                if (lane == 63) part[wave] = incl;
                __syncthreads();
                double run = incl - sacc;
                for (int w = 0; w < wave; ++w) run += part[w];
#pragma unroll
                for (int k = 0; k < CH; ++k) { const int t = tid * CH + k; run += (double)lv[k]; if (t < T) { const float cv = (float)(run * 1.4426950408889634); CUM[((size_t)b * TP + t) * 8 + h] = cv; CUMT[(size_t)(b * 8 + h) * TP + t] = cv; } }
                for (int t = T + tid; t < TP; t += NTHREADS) { CUM[((size_t)b * TP + t) * 8 + h] = 0.f; CUMT[(size_t)(b * 8 + h) * TP + t] = 0.f; }
                __syncthreads();
            }
            if (ph == 2) {
                const int tid = ltid(), lane = tid & 63, wave = __builtin_amdgcn_readfirstlane(tid >> 6);
                const bf16_t* KF = (const bf16_t*)(ws + OFF_KF);
                float* KN = (float*)(ws + OFF_KNORM);
                for (int it = bid * 8 + wave; it < NB * 8 * MW; it += G * 8) {
                    const int kt = it % MW, bh = it / MW, b = bh >> 3, h = bh & 7;
                    const bf16_t* kr = KF + ((size_t)b * TP + kt * 64 + lane) * 512 + h * 64;
                    float ss = 0.f;
#pragma unroll
                    for (int c = 0; c < 8; ++c) {
                        const uint4 u = *(const uint4*)(kr + c * 8);
                        const unsigned ww[4] = {u.x, u.y, u.z, u.w};
#pragma unroll
                        for (int e = 0; e < 4; ++e) { const float a0 = bf2f(ww[e] & 0xffffu), a1 = bf2f(ww[e] >> 16); ss = fmaf(a0, a0, fmaf(a1, a1, ss)); }
                    }
#pragma unroll
                    for (int o = 1; o < 64; o <<= 1) ss = fmaxf(ss, __shfl_xor(ss, o));
                    if (lane == 0) KN[it] = sqrtf(ss);
                }
            }
        }
        if (PH(3) && ph == 3) {
            const int tid = ltid(), lane = tid & 63, wave = __builtin_amdgcn_readfirstlane(tid >> 6); (void)lane; (void)wave;
            constexpr int N_FOX = 33 * 16, N_IDX2 = T / 8, N_CV2 = 512;
            int* qslot = (int*)(smem + LDS_BYTES - 16);
            for (;;) {
                __syncthreads();
                if (tid == 0) *qslot = (int)atomicAdd(&ctl[CW_Q3 + step], 1u);
                __syncthreads();
                const int it = *qslot;
                if (it >= N_FOX + N_IDX2 + N_CV2) break;
                if (it >= N_FOX + N_IDX2) {
                    KParams kq = kp; unsigned char* wsq = ws;
                    const int g2 = (it - (N_FOX + N_IDX2)) * 2;
#pragma unroll 1
                    for (int gg = 0; gg < 2; ++gg) xpose_group(g2 + gg, 4096, [kq, wsq](int t_) { return moe_tile(kq, wsq, t_); }, (float*)smem);
                    continue;
                }
                if (it < N_FOX) {
                    const int qb = 32 - it / 16, bh = it % 16;
                    const int kt0 = fox_prune(ws, bh >> 3, bh & 7, qb, smem);
                    ab::attn_unit<16, true>(bh >> 3, bh & 7, qb, (const ab::bf16*)(ws + OFF_QF), (const ab::bf16*)(ws + OFF_KF), (const ab::bf16*)(ws + OFF_VF), (ab::bf16*)(ws + OFF_YF),
                                           nullptr, (const float*)(ws + OFF_CUMT), kt0, (char*)smem);
                }
                else {
                    const int qg = (T / 8 - 1) - (it - N_FOX);
#pragma unroll 1
                    for (int bb = 0; bb < 2; ++bb) indexer_item(ws, bb, qg, smem);
                }
            }
        }
        if (PH(4) && ph == 4) {
            const int tid = ltid(), lane = tid & 63, wave = __builtin_amdgcn_readfirstlane(tid >> 6); (void)lane; (void)wave;
            constexpr int N_DSA = 33 * 16;
            int* qslot = (int*)(smem + LDS_BYTES - 16);
            for (;;) {
                __syncthreads();
                if (tid == 0) *qslot = (int)atomicAdd(&ctl[CW_Q4 + step], 1u);
                __syncthreads();
                const int it = *qslot;
                if (it >= N_DSA + 256) break;
                if (it >= N_DSA) {
                    KParams kq = kp; unsigned char* wsq = ws;
#pragma unroll 1
                    for (int gg = 0; gg < 2; ++gg) xpose_group(1024 + 2 * (it - N_DSA) + gg, 6144, [kq, wsq](int t_) { return moe_tile(kq, wsq, t_); }, (float*)smem);
                    continue;
                }
                const int qb = 32 - it / 16, bh = it % 16;
                ab::attn_unit<8, false>(bh >> 3, bh & 7, qb, (const ab::bf16*)(ws + OFF_QA), (const ab::bf16*)(ws + OFF_KA), (const ab::bf16*)(ws + OFF_VA), (ab::bf16*)(ws + OFF_YA),
                                        (const unsigned long long*)(ws + OFF_MASK), nullptr, 0, (char*)smem);
            }
        }
        if (PH(5) && ph == 5) {
            const int tid = ltid(), lane = tid & 63, wave = __builtin_amdgcn_readfirstlane(tid >> 6); (void)lane; (void)wave;
        }
        if (PH(7) && ph == 7) {
            const int tid = ltid(), lane = tid & 63, wave = __builtin_amdgcn_readfirstlane(tid >> 6);
            constexpr int AP = 264;
            bf16_t* Ahi = (bf16_t*)smem; bf16_t* Alo = Ahi + 64 * AP;
            bf16_t* WL = Alo + 64 * AP;
            float* LG = (float*)(smem + (2 * 64 + 96) * AP * 2);
            const float* g1 = kp->in[11]; const float* b1 = kp->in[12];
            const float* brg = kp->in[14]; const float* bre = kp->in[16];
            const bf16_t* wrt = (const bf16_t*)(ws + OFF_WRT);
            bf16_t* H1B = (bf16_t*)(ws + OFF_H1B);
            int* TOKL = (int*)(ws + OFF_TOKL); float* GW = (float*)(ws + OFF_GW);
            for (int tb = bid; tb < NTOK / 64; tb += G) {
                const int n0 = tb * 64 + wave * 8;
                f32x4 v[8][4];
#pragma unroll
                for (int tt = 0; tt < 8; ++tt)
#pragma unroll
                    for (int j = 0; j < 4; ++j) v[tt][j] = *(const f32x4*)(kp->out + (size_t)(n0 + tt) * 1024 + lane * 4 + 256 * j);
#pragma unroll
                for (int tt = 0; tt < 8; ++tt) {
                    float s_ = 0.f;
#pragma unroll
                    for (int j = 0; j < 4; ++j) s_ += (v[tt][j][0] + v[tt][j][1]) + (v[tt][j][2] + v[tt][j][3]);
                    const float mu = wave_sum(s_) * (1.0f / 1024.0f);
                    float q = 0.f;
#pragma unroll
                    for (int j = 0; j < 4; ++j) { const f32x4 d = v[tt][j] - mu; q += (d[0] * d[0] + d[1] * d[1]) + (d[2] * d[2] + d[3] * d[3]); }
                    const float rstd = rsqrtf(wave_sum(q) * (1.0f / 1024.0f) + LN_EPS);
#pragma unroll
                    for (int j = 0; j < 4; ++j) {
                        const f32x4 gg = *(const f32x4*)(g1 + lane * 4 + 256 * j), bb = *(const f32x4*)(b1 + lane * 4 + 256 * j);
                        v[tt][j] = (v[tt][j] - mu) * rstd * gg + bb;
                        store4bf(H1B + (size_t)(n0 + tt) * 1024 + lane * 4 + 256 * j, v[tt][j]);
                    }
                    if (lane == 0) { float* st1 = (float*)(ws + OFF_ST1); st1[2 * (n0 + tt)] = mu; st1[2 * (n0 + tt) + 1] = rstd; }
                }
                f32x4 acc0 = zero4(), acc1 = zero4();
                const int mt = wave & 3, nt0 = (wave < 4) ? 0 : 2;
                const bool two = wave < 4;
#pragma unroll
                for (int j = 0; j < 4; ++j) {
                    const int wrow = tid >> 5, wch = tid & 31;
                    const bf16_t* wsrc = wrt + (size_t)wrow * 1024 + j * 256 + wch * 8;
                    const uint4 w0 = *(const uint4*)(wsrc), w1 = *(const uint4*)(wsrc + 16 * 1024), w2 = *(const uint4*)(wsrc + 32 * 1024),
                                w3 = *(const uint4*)(wsrc + 48 * 1024), w4 = *(const uint4*)(wsrc + 64 * 1024), w5 = *(const uint4*)(wsrc + 80 * 1024);
                    __syncthreads();
#pragma unroll
                    for (int tt = 0; tt < 8; ++tt) {
                        const f32x4 x = v[tt][j];
                        const unsigned h0 = f2bf(x[0]), h1 = f2bf(x[1]), h2 = f2bf(x[2]), h3 = f2bf(x[3]);
                        uint2 hi, lo;
                        hi.x = h0 | (h1 << 16); hi.y = h2 | (h3 << 16);
                        lo.x = pk2(x[0] - bf2f(h0), x[1] - bf2f(h1)); lo.y = pk2(x[2] - bf2f(h2), x[3] - bf2f(h3));
                        *(uint2*)(Ahi + (wave * 8 + tt) * AP + lane * 4) = hi;
                        *(uint2*)(Alo + (wave * 8 + tt) * AP + lane * 4) = lo;
                    }
                    {
                        bf16_t* wd = WL + wrow * AP + wch * 8;
                        *(uint4*)(wd) = w0; *(uint4*)(wd + 16 * AP) = w1; *(uint4*)(wd + 32 * AP) = w2;
                        *(uint4*)(wd + 48 * AP) = w3; *(uint4*)(wd + 64 * AP) = w4; *(uint4*)(wd + 80 * AP) = w5;
                    }
                    __syncthreads();
#pragma unroll 2
                    for (int kk = 0; kk < 8; ++kk) {
                        const int ko = kk * 32 + (lane >> 4) * 8;
                        const bf16x8 ah = *(const bf16x8*)(Ahi + (mt * 16 + (lane & 15)) * AP + ko);
                        const bf16x8 al = *(const bf16x8*)(Alo + (mt * 16 + (lane & 15)) * AP + ko);
                        {
                            const bf16_t* wp = WL + (nt0 * 16 + (lane & 15)) * AP + ko;
                            const bf16x8 bh = *(const bf16x8*)wp, bl = *(const bf16x8*)(wp + 48 * AP);
                            acc0 = __builtin_amdgcn_mfma_f32_16x16x32_bf16(ah, bh, acc0, 0, 0, 0);
                            acc0 = __builtin_amdgcn_mfma_f32_16x16x32_bf16(ah, bl, acc0, 0, 0, 0);
                            acc0 = __builtin_amdgcn_mfma_f32_16x16x32_bf16(al, bh, acc0, 0, 0, 0);
                        }
                        if (two) {
                            const bf16_t* wp = WL + (16 + (lane & 15)) * AP + ko;
                            const bf16x8 bh = *(const bf16x8*)wp, bl = *(const bf16x8*)(wp + 48 * AP);
                            acc1 = __builtin_amdgcn_mfma_f32_16x16x32_bf16(ah, bh, acc1, 0, 0, 0);
                            acc1 = __builtin_amdgcn_mfma_f32_16x16x32_bf16(ah, bl, acc1, 0, 0, 0);
                            acc1 = __builtin_amdgcn_mfma_f32_16x16x32_bf16(al, bh, acc1, 0, 0, 0);
                        }
                    }
                }
#pragma unroll
                for (int i = 0; i < 4; ++i) {
                    LG[(mt * 16 + (lane >> 4) * 4 + i) * 49 + nt0 * 16 + (lane & 15)] = acc0[i];
                    if (two) LG[(mt * 16 + (lane >> 4) * 4 + i) * 49 + 16 + (lane & 15)] = acc1[i];
                }
                __syncthreads();
                int my_e1 = 0, my_e2 = 0; float my_g1 = 0.f, my_g2 = 0.f;
#pragma unroll 2
                for (int tt = 0; tt < 8; ++tt) {
                    float mylg = (lane < 36) ? LG[(wave * 8 + tt) * 49 + lane] : 0.f;
                    mylg += (lane < 4) ? brg[lane] : ((lane < 36) ? bre[lane - 4] : 0.f);
                    float gl[4];
#pragma unroll
                    for (int i = 0; i < 4; ++i) gl[i] = __shfl(mylg, i);
                    int gs = 0; float gm = gl[0];
#pragma unroll
                    for (int i = 1; i < 4; ++i) if (gl[i] > gm) { gm = gl[i]; gs = i; }
                    float den = 0.f;
#pragma unroll
                    for (int i = 0; i < 4; ++i) den += __expf(gl[i] - gm);
                    const float pg = 1.0f / den;
                    float el[8];
#pragma unroll
                    for (int j = 0; j < 8; ++j) el[j] = __shfl(mylg, 4 + gs * 8 + j);
                    int i1 = 0; float l1 = el[0];
#pragma unroll
                    for (int j = 1; j < 8; ++j) if (el[j] > l1) { l1 = el[j]; i1 = j; }
                    int i2 = -1; float l2 = -3.0e38f;
#pragma unroll
                    for (int j = 0; j < 8; ++j) if (j != i1 && el[j] > l2) { l2 = el[j]; i2 = j; }
                    const float w1 = 1.0f / (1.0f + __expf(l2 - l1)), w2 = 1.0f - w1;
                    if (lane == tt) { my_e1 = gs * 8 + i1; my_e2 = gs * 8 + i2; my_g1 = pg * w1; my_g2 = pg * w2; }
                }
                if (lane < 8) {
                    const int n = n0 + lane;
                    const unsigned p1 = atomicAdd(&ctl[CW_ECNT + my_e1], 1u);
                    const unsigned p2 = atomicAdd(&ctl[CW_ECNT + my_e2], 1u);
                    TOKL[my_e1 * 32768 + p1] = n * 2;
                    TOKL[my_e2 * 32768 + p2] = n * 2 + 1;
                    GW[n * 2] = my_g1; GW[n * 2 + 1] = my_g2;
                }
                __syncthreads();
            }
        }
        if (PH(8) && ph == 8) {
            const int tid = ltid(), lane = tid & 63, wave = __builtin_amdgcn_readfirstlane(tid >> 6); (void)lane; (void)wave;
            int* ecnt_s = (int*)(smem + LDS_BYTES - 1024);
            if (tid < 32) ecnt_s[tid] = (int)ctl[CW_ECNT + tid];
            __syncthreads();
            if (tid == 0) { int cp = 0, rb = 0; for (int e = 0; e < 32; ++e) { ecnt_s[32 + e] = cp; ecnt_s[64 + e] = rb; const int nc = (ecnt_s[e] + 255) >> 8; cp += nc; rb += nc * 256; } ecnt_s[96] = cp; }
            __syncthreads();
            const int nchunks = ecnt_s[96];
            const int* TOKL = (const int*)(ws + OFF_TOKL);
            bf16_t* HID = (bf16_t*)(ws + OFF_HID);
            const int NNT = (ph == 8) ? 4 : 8;
            for (int tile = bid; tile < nchunks * NNT; tile += G) {
                const int ch = tile / NNT, nt = tile % NNT;
                int e = 0;
#pragma unroll 1
                for (int k = 1; k < 32; ++k) if (ecnt_s[32 + k] <= ch) e = k;
                const int c_in_e = ch - ecnt_s[32 + e];
                const int cnt = ecnt_s[e];
                const int rowbase = ecnt_s[64 + e] + c_in_e * 256;
                const int pos0 = c_in_e * 256;
                const int rl = (wave >> 1) * 64, c4 = (lane >> 4) * 4;
                if (PH(8) && ph == 8) {
                    const bf16_t* H1B = (const bf16_t*)(ws + OFF_H1B);
                    const bf16_t* WGU = (const bf16_t*)(ws + OFF_WGU) + (size_t)e * 512 * 1024;
                    const bf16_t* ap[4]; const bf16_t* bp[2];
#pragma unroll
                    for (int i = 0; i < 4; ++i) {
                        int pos = pos0 + (tid >> 3) + 64 * i; pos = pos < cnt ? pos : cnt - 1;
                        const int aid = TOKL[e * 32768 + pos];
                        ap[i] = H1B + (size_t)(aid >> 1) * 1024 + (tid & 7) * 8;
                    }
#pragma unroll
                    for (int i = 0; i < 2; ++i) bp[i] = WGU + (size_t)(nt * 128 + (tid >> 3) + 64 * i) * 1024 + (tid & 7) * 8;
                    f32x4 acc[4][4]; zero_acc(acc);
                    gemm_core(ap, bp, 1024, (bf16_t*)smem, acc);
                    const int hc0 = (nt * 128 + (wave & 1) * 64) >> 1;
#pragma unroll
                    for (int mi = 0; mi < 4; ++mi) {
                        const int rr = rl + mi * 16 + (lane & 15);
                        bf16_t* dst = HID + (size_t)(rowbase + rr) * 256 + hc0 + c4;
#pragma unroll
                        for (int pr = 0; pr < 2; ++pr) {
                            f32x4 hv;
#pragma unroll
                            for (int j = 0; j < 4; ++j) { const float gte = acc[mi][2 * pr][j], up = acc[mi][2 * pr + 1][j]; hv[j] = gte * sigmoidf_(gte) * up; }
                            store4bf(dst + pr * 16, hv);
                        }
                    }
                } else {
                    const bf16_t* WD = (const bf16_t*)(ws + OFF_WD) + (size_t)e * 1024 * 256;
                    const float* GW = (const float*)(ws + OFF_GW);
                    bf16_t* SLOT = (bf16_t*)(ws + OFF_SLOT);
                    const bf16_t* ap[4]; const bf16_t* bp[2];
                    dense_ptrs(HID, 256, rowbase, WD, 256, nt * 128, ap, bp);
                    f32x4 acc[4][4]; zero_acc(acc);
                    gemm_core(ap, bp, 256, (bf16_t*)smem, acc);
                    const int cbase = nt * 128 + (wave & 1) * 64;
#pragma unroll
                    for (int mi = 0; mi < 4; ++mi) {
                        const int pos = pos0 + rl + mi * 16 + (lane & 15);
                        if (pos < cnt) {
                            const int aid = TOKL[e * 32768 + pos];
                            const float gw = GW[aid];
                            bf16_t* dst = SLOT + (size_t)aid * 1024 + cbase + c4;
#pragma unroll
                            for (int ni = 0; ni < 4; ++ni) store4bf(dst + ni * 16, acc[mi][ni] * gw);
                        }
                    }
                }
            }
        }
        if (PH(10) && ph == 10) {
            const int tid = ltid(), lane = tid & 63, wave = __builtin_amdgcn_readfirstlane(tid >> 6); (void)tid;
            const bf16_t* SLOT = (const bf16_t*)(ws + OFF_SLOT);
            const float* g2 = kp->in[20]; const float* b2 = kp->in[21];
            const float* g1 = kp->in[11]; const float* b1 = kp->in[12]; const float* st1 = (const float*)(ws + OFF_ST1);
            for (int n0 = (bid * 8 + wave) * 4; n0 < NTOK; n0 += G * 8 * 4) {
                f32x4 v[4][4];
#pragma unroll
                for (int rr = 0; rr < 4; ++rr) {
                    const int n = n0 + rr;
                    const float* row = kp->out + (size_t)n * 1024;
#pragma unroll
                    for (int j = 0; j < 4; ++j) {
                        const int c = lane * 4 + 256 * j;
                        const f32x4 uv = *(const f32x4*)(row + c);
                        const f32x4 g1v = *(const f32x4*)(g1 + c), b1v = *(const f32x4*)(b1 + c);
                        const f32x4 hv = (uv - st1[2 * n]) * st1[2 * n + 1] * g1v + b1v;
                        const uint2 u0 = *(const uint2*)(SLOT + (size_t)(2 * n) * 1024 + c), u1 = *(const uint2*)(SLOT + (size_t)(2 * n + 1) * 1024 + c);
                        f32x4 f; f[0] = bf2f(u0.x & 0xffffu) + bf2f(u1.x & 0xffffu); f[1] = bf2f(u0.x >> 16) + bf2f(u1.x >> 16);
                        f[2] = bf2f(u0.y & 0xffffu) + bf2f(u1.y & 0xffffu); f[3] = bf2f(u0.y >> 16) + bf2f(u1.y >> 16);
                        v[rr][j] = hv * ALPHA + f;
                    }
                }
#pragma unroll
                for (int rr = 0; rr < 4; ++rr) {
                    float s = 0.f;
#pragma unroll
                    for (int j = 0; j < 4; ++j) s += (v[rr][j][0] + v[rr][j][1]) + (v[rr][j][2] + v[rr][j][3]);
                    const float mu = wave_sum(s) * (1.0f / 1024.0f);
                    float q = 0.f;
#pragma unroll
                    for (int j = 0; j < 4; ++j) { const f32x4 d = v[rr][j] - mu; q += (d[0] * d[0] + d[1] * d[1]) + (d[2] * d[2] + d[3] * d[3]); }
                    const float rstd = rsqrtf(wave_sum(q) * (1.0f / 1024.0f) + LN_EPS);
                    float* row = kp->out + (size_t)(n0 + rr) * 1024;
#pragma unroll
                    for (int j = 0; j < 4; ++j) {
                        const int c = lane * 4 + 256 * j;
                        const f32x4 gg = *(const f32x4*)(g2 + c), bb = *(const f32x4*)(b2 + c);
                        *(f32x4*)(row + c) = (v[rr][j] - mu) * rstd * gg + bb;
                    }
                }
            }
        }
    }
}

extern "C" void kernel_launch(void* const* d_in, const int* in_sizes, int n_in, void* d_out, int out_size, void* d_ws, size_t ws_size, hipStream_t stream) {
    static int grid = 0;
    if (grid == 0) {
        int dev = 0, cus = 0, per_cu = 0;
        hipGetDevice(&dev);
        hipDeviceGetAttribute(&cus, hipDeviceAttributeMultiprocessorCount, dev);
        hipOccupancyMaxActiveBlocksPerMultiprocessor(&per_cu, (const void*)mega, NTHREADS, 0);
        if (per_cu < 1) per_cu = 1;
        if (per_cu > 1) per_cu = 1;
        grid = cus * per_cu;
        if (n_in != 22 || ws_size < WS_END) { fprintf(stderr, "kernel_launch: unexpected n_in %d / ws_size %zu (need %zu)\n", n_in, ws_size, (size_t)WS_END); }
    }
    hipMemsetAsync((char*)d_ws + OFF_CTL, 0, 32768, stream);
    Params p{};
    for (int i = 0; i < 22; ++i) p.in[i] = (const float*)d_in[i];
    p.out = (float*)d_out; p.ws = (unsigned char*)d_ws;
#if N_LAUNCH_MODE == 0
    p.ph_lo = 0; p.ph_hi = NPHASES + (REPEAT_PH >= 0 ? 1 : 0) + EXTRA_SYNCS;
    void* args[] = {&p};
    hipError_t e = hipLaunchCooperativeKernel((const void*)mega, dim3(grid), dim3(NTHREADS), args, 0, stream);
    if (e != hipSuccess) fprintf(stderr, "cooperative launch failed: %s (grid %d)\n", hipGetErrorString(e), grid);
#else
    for (int ph = 0; ph < NPHASES; ++ph) {
        p.ph_lo = ph; p.ph_hi = ph + 1;
        hipLaunchKernelGGL(mega, dim3(grid), dim3(NTHREADS), 0, stream, p);
    }
#endif
}
```

```cpp
#include <hip/hip_runtime.h>
#include <hip/hip_cooperative_groups.h>
#include <hip/hip_bf16.h>
#include <stdint.h>
#include <stdio.h>
namespace cg = cooperative_groups;

#ifndef ONLY_PHASE
#define ONLY_PHASE -1
#endif
#ifndef PH_MASK
#define PH_MASK 0x7ff
#endif
#define PH(k) ((ONLY_PHASE < 0 || ONLY_PHASE == (k)) && ((PH_MASK >> (k)) & 1))
#ifndef REPEAT_PH
#define REPEAT_PH -1
#endif
#ifndef IDX_REP_MFMA
#define IDX_REP_MFMA 1
#endif
#ifndef P7_REP
#define P7_REP 1
#endif
#ifndef P10_REP
#define P10_REP 1
#endif
#ifndef ATT_PROBE
#define ATT_PROBE 0
#endif
#ifndef IDX_PROBE
#define IDX_PROBE 0
#endif
#ifndef IDX_REP_SEL
#define IDX_REP_SEL 1
#endif
#ifndef IDX_REP
#define IDX_REP 1
#endif
#ifndef TIME_PH
#define TIME_PH -1
#endif
#ifndef TIME_BLK
#define TIME_BLK 0
#endif
#define TS_STAMP(id, slot) do { if (TIME_PH == 100 + (id) && blockIdx.x == TIME_BLK && threadIdx.x == 0) { const unsigned long long tt_ = wall_clock64(); \
    volatile __attribute__((address_space(3))) unsigned* ts_ = (volatile __attribute__((address_space(3))) unsigned*)(smem + LDS_BYTES - 64) + (slot); ts_[0] = (unsigned)tt_; ts_[1] = (unsigned)(tt_ >> 32); } } while (0)
#define TS_BEGIN(id) TS_STAMP(id, 4)
#define TS_END(id) TS_STAMP(id, 6)
#ifndef FUSE89
#define FUSE89 1
#endif
#ifndef EXTRA_SYNCS
#define EXTRA_SYNCS 0
#endif
#ifndef N_LAUNCH_MODE
#define N_LAUNCH_MODE 0
#endif

typedef unsigned short bf16_t;
typedef short bf16x8 __attribute__((ext_vector_type(8)));
typedef float f32x4 __attribute__((ext_vector_type(4)));
typedef float f32x16 __attribute__((ext_vector_type(16)));

constexpr int NB = 2, SEQ = 8192, DM = 1024, NMETA = 16;
constexpr int T = SEQ + NMETA;
constexpr int TP = 8448;
constexpr int R = NB * TP;
constexpr int NTOK = NB * SEQ;
constexpr int NP = 5120;
constexpr int MW = TP / 64;
constexpr float LN_EPS = 1e-5f, RMS_EPS = 1e-6f;
constexpr float ALPHA = 1.189207115002721f;
constexpr float LOG2E = 1.4426950408889634f;
constexpr float QSCALE = 0.125f * LOG2E;
constexpr int NTHREADS = 512;
constexpr int NPHASES = 11;

constexpr size_t al256(size_t x) { return (x + 255) & ~size_t(255); }
constexpr size_t OFF_CTL = 0;
constexpr size_t OFF_ROPE = 65536;
constexpr size_t OFF_STAT0 = OFF_ROPE + al256((size_t)TP * 16 * 4);
constexpr size_t OFF_WRT = OFF_STAT0 + al256((size_t)R * 8);
constexpr size_t OFF_WIN = OFF_WRT + (size_t)2 * 48 * 1024 * 2;
constexpr size_t OFF_WKV = OFF_WIN + (size_t)NP * 1024 * 2;
constexpr size_t OFF_WA = OFF_WKV + (size_t)1024 * 256 * 2;
constexpr size_t OFF_WF = OFF_WA + (size_t)1024 * 512 * 2;
constexpr size_t OFF_WO = OFF_WF + (size_t)1024 * 512 * 2;
constexpr size_t OFF_HB = OFF_WO + (size_t)1024 * 1024 * 2;
constexpr size_t OFF_HBM = OFF_HB + (size_t)NTOK * 1024 * 2;
constexpr size_t OFF_QI = OFF_HB + (size_t)R * 1024 * 2;
constexpr size_t OFF_QA = OFF_QI + (size_t)R * 512 * 2;
constexpr size_t OFF_QF = OFF_QA + (size_t)R * 512 * 2;
constexpr size_t OFF_KF = OFF_QF + (size_t)R * 512 * 2;
constexpr size_t OFF_VF = OFF_KF + (size_t)R * 512 * 2;
constexpr size_t OFF_KA = OFF_VF + (size_t)R * 512 * 2;
constexpr size_t OFF_VA = OFF_KA + (size_t)R * 512 * 2;
constexpr size_t OFF_KI = OFF_VA + (size_t)R * 512 * 2;
constexpr size_t OFF_WI = OFF_KI + (size_t)R * 64 * 2;
constexpr size_t OFF_LOGF = OFF_WI + (size_t)R * 8 * 4;
constexpr size_t OFF_CUM = OFF_LOGF + (size_t)R * 8 * 4;
constexpr size_t OFF_CUMT = OFF_CUM + (size_t)R * 8 * 4;
constexpr size_t OFF_KNORM = OFF_CUMT + (size_t)R * 8 * 4;
constexpr size_t OFF_CKV = OFF_KNORM + al256((size_t)NB * 8 * MW * 4);
constexpr size_t OFF_MASK = OFF_CKV + (size_t)R * 256 * 2;
constexpr size_t OFF_TOKL = OFF_MASK + (size_t)R * MW * 8;
constexpr size_t OFF_GW = OFF_TOKL + (size_t)32 * 32768 * 4;
constexpr int HID_ROWS = 32768 + 32 * 256;
constexpr size_t OFF_MCKV = OFF_GW + (size_t)NTOK * 2 * 4;
constexpr size_t OFF_ST1 = OFF_MCKV + 16 * 256 * 4;
constexpr size_t OFF_HID = OFF_ST1 + (size_t)NTOK * 2 * 4;
constexpr size_t OFF_YA = OFF_HID + (size_t)HID_ROWS * 256 * 2;
constexpr size_t OFF_YF = OFF_YA + (size_t)NTOK * 512 * 2;
constexpr size_t WS_END = OFF_YF + (size_t)NTOK * 512 * 2;
constexpr size_t OFF_WGU = OFF_HB;
constexpr size_t OFF_WD = OFF_WGU + (size_t)32 * 512 * 1024 * 2;
constexpr size_t OFF_MERGED = OFF_KF;
constexpr size_t OFF_H1B = OFF_YA;
constexpr size_t OFF_SLOT = OFF_QA;
static_assert(OFF_WD + (size_t)32 * 1024 * 256 * 2 <= OFF_QA, "moe weights fit in HB+QI");
static_assert(OFF_MERGED + (size_t)NTOK * 1024 * 2 <= OFF_KA, "merged fits");
static_assert(OFF_H1B + (size_t)NTOK * 1024 * 2 <= WS_END, "h1b fits");
static_assert(OFF_SLOT + (size_t)NTOK * 2 * 1024 * 2 <= OFF_KA, "slot fits");
static_assert(WS_END <= (size_t)256 * 1024 * 1024, "workspace");

constexpr int CW_Q3 = 0, CW_Q4 = 64, CW_ECNT = 128, ECS = 64, CW_DONE = 2304, CW_BAR = 4096;

constexpr int SCP = TP + 16;
constexpr int HP = 264;
constexpr int LDS_IDX = 8 * SCP * 2 + 8 * HP * 4;
constexpr int LDS_ROUTER = 36 * 1024 * 4;
constexpr int LDS_GEMM = 2 * (256 * 64 + 128 * 64) * 2 + 1024;
constexpr int LDS_BYTES = 150528;

struct Params {
    const float* in[22];
    float* out;
    unsigned char* ws;
    int ph_lo, ph_hi;
};

typedef const __attribute__((address_space(4))) Params* KParams;
__device__ __forceinline__ f32x4 zero4() { float z = 0.f; asm volatile("" : "+v"(z)); return (f32x4){z, z, z, z}; }
__device__ __forceinline__ uint4 zero4u() { unsigned z = 0u; asm volatile("" : "+v"(z)); return make_uint4(z, z, z, z); }
__device__ __forceinline__ int ltid() { int t = threadIdx.x; asm volatile("" : "+v"(t)); return t; }
__device__ __forceinline__ unsigned f2bf(float f) { unsigned u = __float_as_uint(f); return (u + 0x7fffu + ((u >> 16) & 1u)) >> 16; }
typedef __bf16 bf16x2_t __attribute__((ext_vector_type(2)));
typedef float f32x2 __attribute__((ext_vector_type(2)));
__device__ __forceinline__ unsigned pk2(float lo, float hi) { f32x2 v = {lo, hi}; bf16x2_t b = __builtin_convertvector(v, bf16x2_t); return __builtin_bit_cast(unsigned, b); }
__device__ __forceinline__ float bf2f(unsigned h) { return __uint_as_float(h << 16); }
template <int CTRL> __device__ __forceinline__ float dppf(float v) { return __uint_as_float((unsigned)__builtin_amdgcn_update_dpp(0, (int)__float_as_uint(v), CTRL, 0xf, 0xf, true)); }
__device__ __forceinline__ float wave_sum(float v) {
    v += dppf<0xB1>(v);
    v += dppf<0x4E>(v);
    v += dppf<0x124>(v);
    v += dppf<0x128>(v);
    const float a = __uint_as_float((unsigned)__builtin_amdgcn_readlane((int)__float_as_uint(v), 0)), b = __uint_as_float((unsigned)__builtin_amdgcn_readlane((int)__float_as_uint(v), 16));
    const float c = __uint_as_float((unsigned)__builtin_amdgcn_readlane((int)__float_as_uint(v), 32)), d = __uint_as_float((unsigned)__builtin_amdgcn_readlane((int)__float_as_uint(v), 48));
    return (a + b) + (c + d);
}
__device__ __forceinline__ float sigmoidf_(float v) { return 1.0f / (1.0f + __expf(-v)); }

__device__ __forceinline__ int win_oldcol(int n) {
    if (n < 1344) return n;
    if (n < 2880) return n + 8;
    if (n < 4928) return n + 16;
    if (n < 4936) return 1344 + (n - 4928);
    if (n < 4944) return 2888 + (n - 4936);
    return -1;
}

template <class ColMap>
__device__ __forceinline__ void xpose64(const float* __restrict__ src, int src_ld, bf16_t* __restrict__ dst, int dst_ld, int k0, int n0, ColMap cm,
                                        const float* __restrict__ kscale, float* tile) {
    const int tid = ltid();
    {
        const int nn = tid & 63; const int sc = cm(n0 + nn);
#pragma unroll
        for (int i = 0; i < 8; ++i) {
            const int kk = (tid >> 6) + 8 * i;
            float v = 0.f;
            if (sc >= 0) { v = src[(size_t)(k0 + kk) * src_ld + sc]; if (kscale) v *= kscale[k0 + kk]; }
            tile[kk * 65 + nn] = v;
        }
    }
    __syncthreads();
    {
        const int kp = tid & 31;
#pragma unroll
        for (int i = 0; i < 4; ++i) {
            const int nn = (tid >> 5) + 16 * i;
            const unsigned u = pk2(tile[(2 * kp) * 65 + nn], tile[(2 * kp + 1) * 65 + nn]);
            *(unsigned*)(dst + (size_t)(n0 + nn) * dst_ld + k0 + 2 * kp) = u;
        }
    }
    __syncthreads();
}


struct XTile { const float* src; bf16_t* dst; const float* kscale; int src_ld, dst_ld, k0, j0, rb, s16, winmap; };
template <class Decode>
__device__ __forceinline__ void xpose_group(int g4, int ntiles, Decode dec, float* tiles  ) {
    const int tid = ltid();
    const int nn = tid & 63, kr = tid >> 6;
    float v[4][8];
    XTile xt[4];
#pragma unroll
    for (int q = 0; q < 4; ++q) {
        const int it = g4 * 4 + q;
        if (it < ntiles) {
            xt[q] = dec(it);
            const int sc = xt[q].winmap ? win_oldcol(xt[q].j0 + nn) : (xt[q].j0 + nn);
#pragma unroll
            for (int i = 0; i < 8; ++i) {
                const int kk = kr + 8 * i;
                float x = 0.f;
                if (sc >= 0) x = xt[q].src[(size_t)(xt[q].k0 + kk) * xt[q].src_ld + sc];
                v[q][i] = x;
            }
        }
    }
#pragma unroll
    for (int q = 0; q < 4; ++q)
        if (g4 * 4 + q < ntiles) {
#pragma unroll
            for (int i = 0; i < 8; ++i) {
                const int kk = kr + 8 * i;
                float x = v[q][i];
                if (xt[q].kscale) x *= xt[q].kscale[xt[q].k0 + kk];
                tiles[q * 4160 + kk * 65 + nn] = x;
            }
        }
    __syncthreads();
    {
        const int kp = tid & 31;
#pragma unroll
        for (int q = 0; q < 4; ++q)
            if (g4 * 4 + q < ntiles) {
#pragma unroll
                for (int i = 0; i < 4; ++i) {
                    const int vr = (tid >> 5) + 16 * i;
                    const int row = xt[q].rb + (vr >> 4) * xt[q].s16 + (vr & 15);
                    *(unsigned*)(xt[q].dst + (size_t)row * xt[q].dst_ld + xt[q].k0 + 2 * kp) = pk2(tiles[q * 4160 + (2 * kp) * 65 + vr], tiles[q * 4160 + (2 * kp + 1) * 65 + vr]);
                }
            }
    }
    __syncthreads();
}
template <class Decode>
__device__ __forceinline__ void xpose_many(int ntiles, int G, int bid, Decode dec, float* tiles) {
    for (int g4 = bid; g4 * 4 < ntiles; g4 += G) xpose_group(g4, ntiles, dec, tiles);
}
__device__ __forceinline__ XTile moe_tile(KParams kq, unsigned char* wsq, int it) {
    XTile x; x.kscale = nullptr; x.winmap = 0;
    const int which = it / 2048, rem = it % 2048, e = rem / 64, i = rem % 64;
    if (which < 2) {
        x.src = kq->in[which == 0 ? 17 : 18] + (size_t)e * 1024 * 256; x.src_ld = 256;
        x.dst = (bf16_t*)(wsq + OFF_WGU) + (size_t)e * 512 * 1024; x.dst_ld = 1024;
        x.k0 = (i % 16) * 64; x.j0 = (i / 16) * 64; x.rb = (x.j0 >> 4) * 32 + which * 16; x.s16 = 32;
    } else {
        x.src = kq->in[19] + (size_t)e * 256 * 1024; x.src_ld = 1024;
        x.dst = (bf16_t*)(wsq + OFF_WD) + (size_t)e * 1024 * 256; x.dst_ld = 256;
        x.k0 = (i % 4) * 64; x.j0 = (i / 4) * 64; x.rb = x.j0; x.s16 = 16;
    }
    return x;
}

constexpr int GEMM_BUF = 256 * 64 + 128 * 64;
__device__ __forceinline__ void gemm_core(const bf16_t* const (&ap)[4], const bf16_t* const (&bp)[2], int K, bf16_t* sm, f32x4 (&acc)[4][4]) {
    const int tid = ltid(), lane = tid & 63, wave = __builtin_amdgcn_readfirstlane(tid >> 6);
    const int wm = wave >> 1, wn = wave & 1;
    const int swz = ((tid & 7) ^ ((tid >> 4) & 7)) * 8;
    const int woff = (tid >> 3) * 64 + swz;
    uint4 ra[4], rb[2];
#pragma unroll
    for (int i = 0; i < 4; ++i) ra[i] = *(const uint4*)(ap[i]);
#pragma unroll
    for (int i = 0; i < 2; ++i) rb[i] = *(const uint4*)(bp[i]);
#pragma unroll
    for (int i = 0; i < 4; ++i) *(uint4*)(sm + woff + 4096 * i) = ra[i];
#pragma unroll
    for (int i = 0; i < 2; ++i) *(uint4*)(sm + 16384 + woff + 4096 * i) = rb[i];
    __syncthreads();
    const int nk = K >> 6;
    const int rsw = (lane >> 1) & 7;
    for (int kt = 0; kt < nk; ++kt) {
        const int cur = kt & 1;
        if (kt + 1 < nk) {
#pragma unroll
            for (int i = 0; i < 4; ++i) ra[i] = *(const uint4*)(ap[i] + (kt + 1) * 64);
#pragma unroll
            for (int i = 0; i < 2; ++i) rb[i] = *(const uint4*)(bp[i] + (kt + 1) * 64);
        }
        const bf16_t* sa = sm + cur * GEMM_BUF;
        const bf16_t* sb = sa + 16384;
#pragma unroll
        for (int ks = 0; ks < 2; ++ks) {
            const int coff = ((ks * 4 + (lane >> 4)) ^ rsw) * 8;
            bf16x8 af[4], bfr[4];
#pragma unroll
            for (int mi = 0; mi < 4; ++mi) af[mi] = *(const bf16x8*)(sa + (wm * 64 + mi * 16 + (lane & 15)) * 64 + coff);
#pragma unroll
            for (int ni = 0; ni < 4; ++ni) bfr[ni] = *(const bf16x8*)(sb + (wn * 64 + ni * 16 + (lane & 15)) * 64 + coff);
#pragma unroll
            for (int mi = 0; mi < 4; ++mi)
#pragma unroll
                for (int ni = 0; ni < 4; ++ni) acc[mi][ni] = __builtin_amdgcn_mfma_f32_16x16x32_bf16(bfr[ni], af[mi], acc[mi][ni], 0, 0, 0);
        }
        if (kt + 1 < nk) {
            bf16_t* dn = sm + (cur ^ 1) * GEMM_BUF;
#pragma unroll
            for (int i = 0; i < 4; ++i) *(uint4*)(dn + woff + 4096 * i) = ra[i];
#pragma unroll
            for (int i = 0; i < 2; ++i) *(uint4*)(dn + 16384 + woff + 4096 * i) = rb[i];
        }
        __syncthreads();
    }
}
__device__ __forceinline__ void zero_acc(f32x4 (&acc)[4][4]) {
#pragma unroll
    for (int i = 0; i < 4; ++i)
#pragma unroll
        for (int j = 0; j < 4; ++j) acc[i][j] = zero4();
}
__device__ __forceinline__ void dense_ptrs(const bf16_t* A, int lda, int row0, const bf16_t* Bt, int ldb, int col0, const bf16_t* (&ap)[4], const bf16_t* (&bp)[2]) {
    const int tid = ltid();
#pragma unroll
    for (int i = 0; i < 4; ++i) ap[i] = A + (size_t)(row0 + (tid >> 3) + 64 * i) * lda + (tid & 7) * 8;
#pragma unroll
    for (int i = 0; i < 2; ++i) bp[i] = Bt + (size_t)(col0 + (tid >> 3) + 64 * i) * ldb + (tid & 7) * 8;
}

__device__ __forceinline__ void rope_tile(f32x4& v, const float* __restrict__ rope, int t, int lane) {
    const int ib = ((lane >> 4) & 1) * 4;
    const float* rp = rope + (size_t)t * 16 + ib * 2;
#pragma unroll
    for (int j = 0; j < 4; ++j) {
        const float x = v[j];
        const float pr = __shfl_xor(x, 32);
        const float c = rp[2 * j], s = rp[2 * j + 1];
        v[j] = (lane < 32) ? (x * c - pr * s) : (x * c + pr * s);
    }
}
__device__ __forceinline__ void store4bf(bf16_t* dst, const f32x4& v) {
    uint2 u; u.x = pk2(v[0], v[1]); u.y = pk2(v[2], v[3]);
    *(uint2*)dst = u;
}
__device__ __forceinline__ void store4bf_agent(bf16_t* dst, const f32x4& v) {
    const unsigned long long u = (unsigned long long)pk2(v[0], v[1]) | ((unsigned long long)pk2(v[2], v[3]) << 32);
    __hip_atomic_store((unsigned long long*)dst, u, __ATOMIC_RELAXED, __HIP_MEMORY_SCOPE_AGENT);
}

namespace pg8 {
#define PG8_LAS __attribute__((address_space(3)))
constexpr int BM = 256, BK = 64, HALF = 128, HTB = HALF * BK * 2  , STAGE_BYTES = 8 * HTB, NXCD = 8, WGM = 8;

__host__ __device__ __forceinline__ int lds_byte(int r, int c) { const int st = (r >> 4) * 2 + (c >> 5), rr = r & 15, cc = c & 31, ob = rr * 64 + cc * 2; return st * 1024 + (ob ^ (((ob >> 9) & 1) << 5)); }
__host__ __device__ __forceinline__ void stage_rc(int b, int& R, int& C) { const int st = b / 1024, sb = b % 1024, swz = sb ^ (((sb >> 9) & 1) << 5); R = (st >> 1) * 16 + swz / 64; C = (st & 1) * 32 + (swz % 64) / 2; }
__host__ __device__ __forceinline__ int perm32(int rho) { const int n = rho >> 4, i = rho & 15; return 8 * (i >> 2) + 4 * n + (i & 3); }

struct Unit { int pm, pn; };
struct Gemm { const bf16_t* A; const bf16_t* Bt; int M, N, K; };

struct StaticOrder {
    int nM, nN, nwg, G, c;
    const PG8_LAS int* tab;
    __host__ __device__ void init(int M, int N, int G_, int c_) { nM = M / BM; nN = N / BM; nwg = nM * nN; G = G_; c = c_; tab = nullptr; dep = nullptr; }
    const unsigned* dep;
    __device__ void init_moe(const PG8_LAS int* tab_, int G_, int c_, const unsigned* dep_) { nM = nN = nwg = 0; G = G_; c = c_; tab = tab_; dep = dep_; }
    __device__ bool next(int i, Unit& u) const {
        if (tab) {
            const int n9 = tab[96] * 4, rem = n9 % G, nlight = G - rem, r = (c - rem + G) % G;
            int L = r;
            if (i > 0) { if (r >= nlight) return false; L = G + (i - 1) * nlight + r; }
            if (L >= n9) return false;
            const int ch = L >> 2; int e = 0;
#pragma unroll 1
            for (int k = 1; k < 32; ++k) if (tab[32 + k] <= ch) e = k;
            u.pm = (tab[64 + e] >> 8) + (ch - tab[32 + e]); u.pn = e * 4 + (L & 3); return true;
        }
        const long L = (long)i * G + c; if (L >= nwg) return false;
        int wgid = (int)L; { const int q = nwg / NXCD, r = nwg % NXCD, xcd = wgid % NXCD, off = wgid / NXCD; wgid = (xcd < r ? xcd * (q + 1) : r * (q + 1) + (xcd - r) * q) + off; }
        const int nig = WGM * nN, gid = wgid / nig, fm = gid * WGM, gsz = (nM - fm) < WGM ? (nM - fm) : WGM;
        u.pm = fm + ((wgid % nig) % gsz); u.pn = (wgid % nig) / gsz; return true;
    }
    __device__ __forceinline__ void a_ready(const Unit& u) const {
        if (tab && dep) {
            if ((threadIdx.x & 63) == 0) { unsigned sp = 0; while (__hip_atomic_load(dep + u.pm, __ATOMIC_RELAXED, __HIP_MEMORY_SCOPE_AGENT) < 4u && ++sp < (1u << 22)) __builtin_amdgcn_s_sleep(2); }
            __builtin_amdgcn_fence(__ATOMIC_ACQUIRE, "agent");
        }
    }
    __device__ __forceinline__ void done(const Unit&) const {}
};

template <class Epi, class Sched, bool ALIGN_EPI = false, bool SP2 = false>
__device__ __forceinline__ void gemm_phase(PG8_LAS unsigned char* lds, const Gemm g, const Sched& S, const Epi& E) {
    const int tid = ltid(), wid = __builtin_amdgcn_readfirstlane(tid >> 6), lane = tid & 63, wr = wid >> 2, wc = wid & 3, fr = lane & 15, fq = lane >> 4;
    const int K = g.K, nt = K / BK;
    unsigned voffA[2], voffB[2];
#pragma unroll
    for (int i = 0; i < 2; ++i) { int R, C; stage_rc(tid * 16 + i * 8192, R, C); const int Rb = Epi::PERM ? ((R & ~31) + perm32(R & 31)) : R;
        voffA[i] = (unsigned)(R * K + C) * 2u; voffB[i] = (unsigned)(Rb * K + C) * 2u; }
    const size_t kstep = (size_t)(BK * 2);
    const size_t hstep = (size_t)HALF * K * 2;
    const size_t tstep = 2 * hstep;
    const unsigned ldsw = (unsigned)wid * 1024u;
    const int aoff = lds_byte(wr * 64 + fr, fq * 8), boff = lds_byte(wc * 32 + fr, fq * 8);
#define PG8_SA(b, h) (((b) * 2 + (h)) * HTB)
#define PG8_SB(b, h) ((4 + (b) * 2 + (h)) * HTB)
#define PG8_STAGE(bufoff, gbase, voff) do { _Pragma("unroll") for (int _i = 0; _i < 2; ++_i) \
        __builtin_amdgcn_global_load_lds((const unsigned*)((const char*)(gbase) + (voff)[_i]), (PG8_LAS unsigned*)(lds + (bufoff) + ldsw + _i * 8192), 16, 0, 0); } while (0)
#define PG8_LDA(dst, b, h) do { _Pragma("unroll") for (int m = 0; m < 4; ++m) _Pragma("unroll") for (int k = 0; k < 2; ++k) dst[m][k] = *(const PG8_LAS bf16x8*)(lds + PG8_SA(b, h) + aoff + m * 2048 + k * 1024); } while (0)
#define PG8_LDB(dst, b, h) do { _Pragma("unroll") for (int n = 0; n < 2; ++n) _Pragma("unroll") for (int k = 0; k < 2; ++k) dst[n][k] = *(const PG8_LAS bf16x8*)(lds + PG8_SB(b, h) + boff + n * 2048 + k * 1024); } while (0)
#define PG8_MMA(ai, bj, At, Bt) do { __builtin_amdgcn_s_setprio(1); _Pragma("unroll") for (int m = 0; m < 4; ++m) _Pragma("unroll") for (int n = 0; n < 2; ++n) _Pragma("unroll") for (int k = 0; k < 2; ++k) \
        acc[ai][bj][m][n] = __builtin_amdgcn_mfma_f32_16x16x32_bf16(Bt[n][k], At[m][k], acc[ai][bj][m][n], 0, 0, 0); __builtin_amdgcn_s_setprio(0); } while (0)
#define PG8_WAIT_V(n) asm volatile("s_waitcnt vmcnt(" #n ")" ::: "memory")
#define PG8_WAIT_L(n) asm volatile("s_waitcnt lgkmcnt(" #n ")" ::: "memory")
#define PG8_BAR __builtin_amdgcn_s_barrier()
#define PG8_SCHED __builtin_amdgcn_sched_barrier(0)
    Unit cur, nxt; int ui = 0;
    if (!S.next(0, cur)) return;
    f32x4 acc[2][2][4][2];
#pragma unroll
    for (int a = 0; a < 2; ++a)
#pragma unroll
        for (int b = 0; b < 2; ++b)
#pragma unroll
            for (int m = 0; m < 4; ++m)
#pragma unroll
                for (int n = 0; n < 2; ++n) acc[a][b][m][n] = zero4();
    bf16x8 At[4][2], B0[2][2], B1[2][2];
    const char* cA = (const char*)g.A + (size_t)cur.pm * tstep; const char* cB = (const char*)g.Bt + (size_t)cur.pn * tstep;
    S.a_ready(cur);
    if constexpr (SP2) {
        PG8_STAGE(PG8_SB(0, 0), cB, voffB); PG8_STAGE(PG8_SB(0, 1), cB + hstep, voffB); PG8_STAGE(PG8_SA(0, 0), cA, voffA); PG8_STAGE(PG8_SA(0, 1), cA + hstep, voffA);
        if (wr == 1) PG8_BAR;
        PG8_WAIT_V(2); PG8_BAR;
        PG8_STAGE(PG8_SB(1, 0), cB + kstep, voffB); PG8_STAGE(PG8_SA(1, 0), cA + kstep, voffA); PG8_STAGE(PG8_SB(1, 1), cB + hstep + kstep, voffB);
        PG8_WAIT_V(6); PG8_BAR;
    } else {
        PG8_STAGE(PG8_SB(0, 0), cB, voffB); PG8_STAGE(PG8_SA(0, 0), cA, voffA); PG8_STAGE(PG8_SB(0, 1), cB + hstep, voffB); PG8_STAGE(PG8_SA(0, 1), cA + hstep, voffA);
        if (wr == 1) PG8_BAR;
        PG8_WAIT_V(4); PG8_BAR;
        PG8_STAGE(PG8_SB(1, 0), cB + kstep, voffB); PG8_STAGE(PG8_SA(1, 0), cA + kstep, voffA); PG8_STAGE(PG8_SB(1, 1), cB + hstep + kstep, voffB);
        PG8_WAIT_V(6); PG8_BAR;
    }
    for (;;) {
        const bool has_next = S.next(ui + 1, nxt);
        const char* nA = has_next ? (const char*)g.A + (size_t)nxt.pm * tstep : cA; const char* nB = has_next ? (const char*)g.Bt + (size_t)nxt.pn * tstep : cB;
        for (int t = 0; t < nt; t += 2) {
            const bool last = (t == nt - 2);
            const char* a1 = cA + (size_t)(t + 1) * kstep;
            const char* a2 = last ? nA : cA + (size_t)(t + 2) * kstep; const char* b2 = last ? nB : cB + (size_t)(t + 2) * kstep;
            const char* a3 = a2 + kstep; const char* b3 = b2 + kstep;
            if (last && has_next) S.a_ready(nxt);
            if constexpr (SP2) {
            PG8_LDB(B0, 0, 0); PG8_LDB(B1, 0, 1); PG8_SCHED; PG8_LDA(At, 0, 0); PG8_STAGE(PG8_SA(1, 1), a1 + hstep, voffA);
            PG8_WAIT_V(8); PG8_WAIT_L(0); PG8_BAR; PG8_MMA(0, 0, At, B0); PG8_MMA(0, 1, At, B1); PG8_BAR; PG8_SCHED;
            PG8_LDA(At, 0, 1); PG8_STAGE(PG8_SB(0, 0), b2, voffB); PG8_STAGE(PG8_SB(0, 1), b2 + hstep, voffB); PG8_STAGE(PG8_SA(0, 0), a2, voffA);
            PG8_WAIT_V(8); PG8_WAIT_L(0); PG8_BAR; PG8_MMA(1, 0, At, B0); PG8_MMA(1, 1, At, B1); PG8_BAR; PG8_SCHED;
            PG8_LDB(B0, 1, 0); PG8_LDB(B1, 1, 1); PG8_SCHED; PG8_LDA(At, 1, 0); PG8_STAGE(PG8_SA(0, 1), a2 + hstep, voffA);
            PG8_WAIT_V(8); PG8_WAIT_L(0); PG8_BAR; PG8_MMA(0, 0, At, B0); PG8_MMA(0, 1, At, B1); PG8_BAR; PG8_SCHED;
            PG8_LDA(At, 1, 1); PG8_STAGE(PG8_SB(1, 0), b3, voffB); PG8_STAGE(PG8_SB(1, 1), b3 + hstep, voffB); PG8_STAGE(PG8_SA(1, 0), a3, voffA);
            PG8_WAIT_V(8); PG8_WAIT_L(0); PG8_BAR; PG8_MMA(1, 0, At, B0); PG8_MMA(1, 1, At, B1); PG8_BAR; PG8_SCHED;
            } else {
            PG8_LDB(B0, 0, 0); PG8_SCHED; PG8_LDA(At, 0, 0); PG8_STAGE(PG8_SA(1, 1), a1 + hstep, voffA);
            PG8_WAIT_L(8); PG8_BAR; PG8_WAIT_L(0); PG8_MMA(0, 0, At, B0); PG8_BAR; PG8_SCHED;
            PG8_LDB(B1, 0, 1); PG8_STAGE(PG8_SB(0, 0), b2, voffB);
            PG8_BAR; PG8_WAIT_L(0); PG8_MMA(0, 1, At, B1); PG8_BAR;
            PG8_LDA(At, 0, 1); PG8_STAGE(PG8_SA(0, 0), a2, voffA);
            PG8_BAR; PG8_WAIT_L(0); PG8_MMA(1, 0, At, B0); PG8_BAR; PG8_SCHED;
            PG8_STAGE(PG8_SB(0, 1), b2 + hstep, voffB);
            PG8_WAIT_V(6); PG8_BAR; PG8_MMA(1, 1, At, B1); PG8_BAR;
            PG8_LDB(B0, 1, 0); PG8_SCHED; PG8_LDA(At, 1, 0); PG8_STAGE(PG8_SA(0, 1), a2 + hstep, voffA);
            PG8_WAIT_L(8); PG8_BAR; PG8_WAIT_L(0); PG8_MMA(0, 0, At, B0); PG8_BAR; PG8_SCHED;
            PG8_LDB(B1, 1, 1); PG8_STAGE(PG8_SB(1, 0), b3, voffB);
            PG8_BAR; PG8_WAIT_L(0); PG8_MMA(0, 1, At, B1); PG8_BAR;
            PG8_LDA(At, 1, 1); PG8_STAGE(PG8_SA(1, 0), a3, voffA);
            PG8_BAR; PG8_WAIT_L(0); PG8_MMA(1, 0, At, B0); PG8_BAR; PG8_SCHED;
            PG8_STAGE(PG8_SB(1, 1), b3 + hstep, voffB);
            PG8_WAIT_V(6); PG8_BAR; PG8_MMA(1, 1, At, B1); PG8_BAR;
            }
        }
        if constexpr (ALIGN_EPI) { if (wr == 0) PG8_BAR; }
        if constexpr (!Epi::AFTER_DRAIN) { E(acc, cur, wr, wc, fr, fq); S.done(cur); }
        if (!has_next) break;
#pragma unroll
        for (int a = 0; a < 2; ++a)
#pragma unroll
            for (int b = 0; b < 2; ++b)
#pragma unroll
                for (int m = 0; m < 4; ++m)
#pragma unroll
                    for (int n = 0; n < 2; ++n) acc[a][b][m][n] = zero4();
        cur = nxt; cA = nA; cB = nB; ++ui;
        if constexpr (ALIGN_EPI) { if (wr == 1) PG8_BAR; }
    }
    PG8_WAIT_V(0);
    if constexpr (!ALIGN_EPI) { if (wr == 0) PG8_BAR; }
    PG8_BAR;
    if constexpr (Epi::AFTER_DRAIN) { E.fused(acc, cur, wr, wc, fr, fq, lds, wid, lane); S.done(cur); }
#undef PG8_SA
#undef PG8_SB
#undef PG8_STAGE
#undef PG8_LDA
#undef PG8_LDB
#undef PG8_MMA
#undef PG8_WAIT_V
#undef PG8_WAIT_L
#undef PG8_BAR
#undef PG8_SCHED
}
}

__device__ __forceinline__ int opaque(int v) { asm volatile("" : "+s"(v)); return v; }
__device__ __forceinline__ size_t kimg_off(int b, int h, int t, int d) { return ((((size_t)(b * 8 + h) * MW + (t >> 6)) * 8 + (d >> 3)) * 64 + (t & 63)) * 8 + (d & 7); }
__device__ __forceinline__ size_t vimg_off(int b, int h, int t, int d) { return ((((size_t)(b * 8 + h) * MW + (t >> 6)) * 2 + (d >> 5)) * 64 + (t & 63)) * 32 + (d & 31); }
__device__ __forceinline__ void store8bf(bf16_t* dst, const f32x4& a, const f32x4& b) {
    uint4 w; w.x = pk2(a[0], a[1]); w.y = pk2(a[2], a[3]); w.z = pk2(b[0], b[1]); w.w = pk2(b[2], b[3]);
    *(uint4*)dst = w;
}
__device__ __forceinline__ void rope8(f32x4& v0, f32x4& v1, const float* __restrict__ rope, int t, int fq) {
    const float* rp = rope + (size_t)t * 16;
#pragma unroll
    for (int j = 0; j < 4; ++j) {
        { const float x = v0[j]; const float pr = __shfl_xor(x, 16); const float c = rp[2 * j], sn = rp[2 * j + 1];
          v0[j] = (fq == 0) ? (x * c - pr * sn) : ((fq == 1) ? (x * c + pr * sn) : x); }
        { const float x = v1[j]; const float pr = __shfl_xor(x, 16); const float c = rp[2 * (4 + j)], sn = rp[2 * (4 + j) + 1];
          v1[j] = (fq == 0) ? (x * c - pr * sn) : ((fq == 1) ? (x * c + pr * sn) : x); }
    }
}
struct EpiInProj {
    static constexpr bool PERM = true, AFTER_DRAIN = false;
    template <int BJ> __device__ __forceinline__ void part(const f32x4 (&acc)[2][2][4][2], const pg8::Unit& u, int wr, int wc, int fr, int fq) const {
        KParams kpe = (KParams)__builtin_amdgcn_kernarg_segment_ptr(); asm volatile("" : "+s"(kpe));
        unsigned char* ws = kpe->ws; const float* rope = (const float*)(ws + OFF_ROPE);
        const int cb = 256 * u.pn + 128 * BJ + 32 * wc;
        const int cg64 = cb >> 6, hf = wc & 1;
        const int cig = hf * 32 + 8 * fq;
        if (cg64 >= 78) return;
        if (cg64 < 45) {
            size_t off; int pitch = 512, hd = 0; float scl = 1.0f; bool rp = false;
            if (cg64 < 8) { off = OFF_QA; hd = cg64; scl = QSCALE; rp = true; }
            else if (cg64 < 12) { off = OFF_CKV; pitch = 256; hd = cg64 - 8; }
            else if (cg64 < 20) { off = OFF_QI; hd = cg64 - 12; scl = 0.125f; rp = true; }
            else if (cg64 == 20) { off = OFF_KI; pitch = 64; rp = true; }
            else if (cg64 < 29) { off = OFF_QF; hd = cg64 - 21; scl = QSCALE; }
            else if (cg64 < 37) { off = OFF_KF; hd = cg64 - 29; }
            else { off = OFF_VF; hd = cg64 - 37; }
            bf16_t* base = (bf16_t*)(ws + off) + hd * 64 + cig;
            rp = rp && (hf == 0);
#pragma unroll
            for (int ai = 0; ai < 2; ++ai)
#pragma unroll
                for (int m = 0; m < 4; ++m) {
                    const int n = 256 * u.pm + 128 * ai + 64 * wr + 16 * m + fr;
                    const int b = n / SEQ, t = NMETA + n % SEQ, r = b * TP + t;
                    f32x4 v0 = acc[ai][BJ][m][0], v1 = acc[ai][BJ][m][1];
                    if (rp) rope8(v0, v1, rope, t, fq);
                    if (cg64 == 20) {
                        store8bf((bf16_t*)(ws + OFF_KI) + ((size_t)((b * (TP / 16) + (t >> 4)) * 2 + hf) * 64 + fq * 16 + (t & 15)) * 8, v0, v1);
                    } else
                    store8bf(base + (size_t)((cg64 >= 8 && cg64 < 12) ? n : r) * pitch, v0 * scl, v1 * scl);
                    asm volatile("" ::: "memory");
                }
        } else if (cg64 < 77) {
            bf16_t* gates = (bf16_t*)kpe->out + (cg64 - 45) * 64 + cig;
#pragma unroll
            for (int ai = 0; ai < 2; ++ai)
#pragma unroll
                for (int m = 0; m < 4; ++m) {
                    const int n = 256 * u.pm + 128 * ai + 64 * wr + 16 * m + fr;
                    {
                        f32x4 v0 = acc[ai][BJ][m][0], v1 = acc[ai][BJ][m][1];
#pragma unroll
                        for (int j = 0; j < 4; ++j) { v0[j] = sigmoidf_(v0[j]); v1[j] = sigmoidf_(v1[j]); }
                        store8bf(gates + (size_t)n * 2048, v0, v1);
                    }
                }
        } else if (hf == 0 && fq < 2) {
            float* WIo = (float*)(ws + OFF_WI); float* LOGF = (float*)(ws + OFF_LOGF); const float* bfg = kpe->in[5];
#pragma unroll
            for (int ai = 0; ai < 2; ++ai)
#pragma unroll
                for (int m = 0; m < 4; ++m) {
                    const int n = 256 * u.pm + 128 * ai + 64 * wr + 16 * m + fr;
                    const int r = (n / SEQ) * TP + NMETA + n % SEQ;
                    const f32x4 v0 = acc[ai][BJ][m][0], v1 = acc[ai][BJ][m][1];
                    if (fq == 0) {
                        *(f32x4*)(WIo + (size_t)r * 8) = v0 * 0.3535533905932738f; *(f32x4*)(WIo + (size_t)r * 8 + 4) = v1 * 0.3535533905932738f;
                    } else {
                        f32x4 o0, o1;
#pragma unroll
                        for (int j = 0; j < 4; ++j) {
                            const float z0 = v0[j] + bfg[j], z1 = v1[j] + bfg[4 + j];
                            o0[j] = fminf(z0, 0.f) - __logf(1.0f + __expf(-fabsf(z0)));
                            o1[j] = fminf(z1, 0.f) - __logf(1.0f + __expf(-fabsf(z1)));
                        }
                        float* lt = LOGF + (size_t)(n / SEQ) * 8 * TP + (NMETA + n % SEQ);
#pragma unroll
                        for (int j = 0; j < 4; ++j) { lt[(size_t)j * TP] = o0[j]; lt[(size_t)(4 + j) * TP] = o1[j]; }
                    }
                }
        }
    }
    __device__ __forceinline__ void operator()(const f32x4 (&acc)[2][2][4][2], const pg8::Unit& u, int wr, int wc, int fr, int fq) const {
        asm volatile("" : "+v"(fr), "+v"(fq));
        part<0>(acc, u, wr, wc, fr, fq); part<1>(acc, u, wr, wc, fr, fq);
    }
};
struct EpiKvUp {
    static constexpr bool PERM = true, AFTER_DRAIN = false;
    const PG8_LAS float* rs; const PG8_LAS int* tag;
    template <int BJ> __device__ __forceinline__ void part(const f32x4 (&acc)[2][2][4][2], const pg8::Unit& u, const PG8_LAS float* rsu, int wr, int wc, int fr, int fq) const {
        KParams kpe = (KParams)__builtin_amdgcn_kernarg_segment_ptr(); asm volatile("" : "+s"(kpe));
        unsigned char* ws = kpe->ws; const float* rope = (const float*)(ws + OFF_ROPE);
        const int cb = 256 * u.pn + 128 * BJ + 32 * wc;
        const int cg64 = cb >> 6, hf = wc & 1, cig = hf * 32 + 8 * fq;
        const bool isk = cg64 < 8, rp = isk && (hf == 0);
        bf16_t* base = (bf16_t*)(ws + (isk ? OFF_KA : OFF_VA)) + (isk ? cg64 : cg64 - 8) * 64 + cig;
#pragma unroll
        for (int ai = 0; ai < 2; ++ai)
#pragma unroll
            for (int m = 0; m < 4; ++m) {
                const int rl = 128 * ai + 64 * wr + 16 * m + fr;
                const int n = 256 * u.pm + rl, t = NMETA + n % SEQ, r = (n / SEQ) * TP + t;
                const float rstd = rsu[rl];
                f32x4 v0 = acc[ai][BJ][m][0] * rstd, v1 = acc[ai][BJ][m][1] * rstd;
                if (rp) rope8(v0, v1, rope, t, fq);
                store8bf((bf16_t*)(ws + (isk ? OFF_KA : OFF_VA)) + (isk ? kimg_off(n / SEQ, cg64, t, cig) : vimg_off(n / SEQ, cg64 - 8, t, cig)), v0, v1);
                asm volatile("" ::: "memory");
            }
    }
    __device__ __forceinline__ void operator()(const f32x4 (&acc)[2][2][4][2], const pg8::Unit& u, int wr, int wc, int fr, int fq) const {
        asm volatile("" : "+v"(fr), "+v"(fq));
        const PG8_LAS float* rsu = (tag[0] == u.pm) ? rs : rs + 256;
        part<0>(acc, u, rsu, wr, wc, fr, fq); part<1>(acc, u, rsu, wr, wc, fr, fq);
    }
};
#ifndef MGB
#define MGB 4
#endif
template <int PASS> struct EpiMerge {
    static constexpr bool PERM = true, AFTER_DRAIN = false;
    __device__ __forceinline__ void operator()(const f32x4 (&acc)[2][2][4][2], const pg8::Unit& u, int wr, int wc, int fr, int fq) const {
        asm volatile("" : "+v"(fr), "+v"(fq));
        KParams kpe = (KParams)__builtin_amdgcn_kernarg_segment_ptr(); asm volatile("" : "+s"(kpe));
        bf16_t* merged = (bf16_t*)(kpe->ws + OFF_MERGED); const bf16_t* gates = (const bf16_t*)kpe->out;
#pragma unroll
        for (int bj = 0; bj < 2; ++bj) {
            const int c = 256 * u.pn + 128 * bj + 32 * wc + 8 * fq;
            const size_t n0 = (size_t)(256 * u.pm + 64 * wr + fr);
#pragma unroll
            for (int i0 = 0; i0 < 8; i0 += MGB) {
                uint4 g[MGB], o[MGB];
#pragma unroll
                for (int i = 0; i < MGB; ++i) g[i] = *(const uint4*)(gates + (n0 + 128 * ((i0 + i) >> 2) + 16 * ((i0 + i) & 3)) * 2048 + PASS * 1024 + c);
                if (PASS == 1) {
#pragma unroll
                    for (int i = 0; i < MGB; ++i) o[i] = *(const uint4*)(merged + (n0 + 128 * ((i0 + i) >> 2) + 16 * ((i0 + i) & 3)) * 1024 + c);
                }
#pragma unroll
                for (int i = 0; i < MGB; ++i) {
                    const int ii = i0 + i;
                    f32x4 v0 = acc[ii >> 2][bj][ii & 3][0], v1 = acc[ii >> 2][bj][ii & 3][1];
                    v0 = v0 * (f32x4){bf2f(g[i].x & 0xffffu), bf2f(g[i].x >> 16), bf2f(g[i].y & 0xffffu), bf2f(g[i].y >> 16)};
                    v1 = v1 * (f32x4){bf2f(g[i].z & 0xffffu), bf2f(g[i].z >> 16), bf2f(g[i].w & 0xffffu), bf2f(g[i].w >> 16)};
                    if (PASS == 1) {
                        v0 = v0 + (f32x4){bf2f(o[i].x & 0xffffu), bf2f(o[i].x >> 16), bf2f(o[i].y & 0xffffu), bf2f(o[i].y >> 16)};
                        v1 = v1 + (f32x4){bf2f(o[i].z & 0xffffu), bf2f(o[i].z >> 16), bf2f(o[i].w & 0xffffu), bf2f(o[i].w >> 16)};
                    }
                    store8bf(merged + (n0 + 128 * (ii >> 2) + 16 * (ii & 3)) * 1024 + c, v0, v1);
                }
                asm volatile("" ::: "memory");
            }
        }
    }
};
struct EpiOutProj {
    static constexpr bool PERM = true, AFTER_DRAIN = false;
    __device__ __forceinline__ void operator()(const f32x4 (&acc)[2][2][4][2], const pg8::Unit& u, int wr, int wc, int fr, int fq) const {
        asm volatile("" : "+v"(fr), "+v"(fq));
        KParams kpe = (KParams)__builtin_amdgcn_kernarg_segment_ptr(); asm volatile("" : "+s"(kpe));
        const float* x = kpe->in[0]; const float* g0 = kpe->in[2]; const float* b0 = kpe->in[3]; float* out = kpe->out;
        const float* stat0 = (const float*)(kpe->ws + OFF_STAT0);
        const int c0 = 256 * u.pn + 32 * wc + 8 * fq;
        f32x4 gg[4], bb[4];
#pragma unroll
        for (int q = 0; q < 4; ++q) { gg[q] = *(const f32x4*)(g0 + c0 + 128 * (q >> 1) + 4 * (q & 1)) * ALPHA; bb[q] = *(const f32x4*)(b0 + c0 + 128 * (q >> 1) + 4 * (q & 1)) * ALPHA; }
#pragma unroll
        for (int rp = 0; rp < 4; ++rp) {
            f32x2 st[2]; f32x4 xv[2][4]; int nn_[2];
#pragma unroll
            for (int mm = 0; mm < 2; ++mm) {
                const int n = 256 * u.pm + 128 * (rp >> 1) + 64 * wr + 16 * ((rp & 1) * 2 + mm) + fr;
                nn_[mm] = n;
                st[mm] = *(const f32x2*)(stat0 + 2 * ((n / SEQ) * TP + NMETA + n % SEQ));
#pragma unroll
                for (int q = 0; q < 4; ++q) xv[mm][q] = *(const f32x4*)(x + (size_t)n * 1024 + c0 + 128 * (q >> 1) + 4 * (q & 1));
            }
#pragma unroll
            for (int mm = 0; mm < 2; ++mm) {
                const float mu = st[mm][0], rstd = st[mm][1];
#pragma unroll
                for (int q = 0; q < 4; ++q)
                    *(f32x4*)(out + (size_t)nn_[mm] * 1024 + c0 + 128 * (q >> 1) + 4 * (q & 1)) = (xv[mm][q] - mu) * rstd * gg[q] + bb[q] + acc[rp >> 1][q >> 1][(rp & 1) * 2 + mm][q & 1];
            }
        }
    }
};
struct EpiMoeDown {
    static constexpr bool PERM = true, AFTER_DRAIN = false;
    const PG8_LAS int* tab;
    __device__ __forceinline__ void operator()(const f32x4 (&acc)[2][2][4][2], const pg8::Unit& u, int wr, int wc, int fr, int fq) const {
        asm volatile("" : "+v"(fr), "+v"(fq));
        KParams kpe = (KParams)__builtin_amdgcn_kernarg_segment_ptr(); asm volatile("" : "+s"(kpe));
        unsigned char* ws = kpe->ws;
        const int* TOKL = (const int*)(ws + OFF_TOKL); const float* GW = (const float*)(ws + OFF_GW); bf16_t* SLOT = (bf16_t*)(ws + OFF_SLOT);
        const int e = u.pn >> 2, cnt = tab[e], pos0 = (u.pm - (tab[64 + e] >> 8)) * 256;
        const int cb = 256 * (u.pn & 3) + 32 * wc + 8 * fq;
        int aid[8]; float gw[8];
#pragma unroll
        for (int i = 0; i < 8; ++i) { const int pos = pos0 + 128 * (i >> 2) + 64 * wr + 16 * (i & 3) + fr; aid[i] = TOKL[e * 32768 + (pos < cnt ? pos : cnt - 1)]; }
#pragma unroll
        for (int i = 0; i < 8; ++i) gw[i] = GW[aid[i]];
#pragma unroll
        for (int ai = 0; ai < 2; ++ai)
#pragma unroll
            for (int m = 0; m < 4; ++m) {
                const int pos = pos0 + 128 * ai + 64 * wr + 16 * m + fr;
                if (pos < cnt) {
                    const float g = gw[ai * 4 + m];
                    bf16_t* dst = SLOT + (size_t)aid[ai * 4 + m] * 1024 + cb;
                    store8bf(dst, acc[ai][0][m][0] * g, acc[ai][0][m][1] * g);
                    store8bf(dst + 128, acc[ai][1][m][0] * g, acc[ai][1][m][1] * g);
                }
            }
    }
};
struct EpiAny {
    static constexpr bool PERM = true, AFTER_DRAIN = false;
    int kind; const PG8_LAS float* rs; const PG8_LAS int* tag;
    __device__ __forceinline__ void operator()(const f32x4 (&acc)[2][2][4][2], const pg8::Unit& u, int wr, int wc, int fr, int fq) const {
        if (kind == 0) { EpiInProj e{}; e(acc, u, wr, wc, fr, fq); }
        else if (kind == 1) { EpiKvUp e{rs, tag}; e(acc, u, wr, wc, fr, fq); }
        else if (kind == 2) { EpiMerge<0> e{}; e(acc, u, wr, wc, fr, fq); }
        else if (kind == 3) { EpiMerge<1> e{}; e(acc, u, wr, wc, fr, fq); }
        else if (kind == 4) { EpiOutProj e{}; e(acc, u, wr, wc, fr, fq); }
        else { EpiMoeDown e{tag}; e(acc, u, wr, wc, fr, fq); }
    }
};

template <int POS> __device__ __forceinline__ unsigned bitmask1(int m) { int r; asm("v_bfe_i32 %0, %1, %2, 1" : "=v"(r) : "v"(m), "n"(POS)); return (unsigned)r; }
typedef short s16x4 __attribute__((ext_vector_type(4)));
__device__ __forceinline__ s16x4 vtr16(const unsigned char* p) {
    return __builtin_bit_cast(s16x4, __builtin_amdgcn_ds_read_tr16_b64_v4i16((__attribute__((address_space(3))) s16x4*)p));
}
constexpr int AT_VP = 192;
constexpr int AT_K = 0, AT_V = 8192, AT_C = 8192 + 64 * AT_VP, AT_BUF = 8192 + 64 * AT_VP + 256;
template <bool FOX>
__device__ void attn_item(unsigned char* ws, int b, int h, int qb, unsigned char* smem) {
    constexpr int mode = 0;
    const bf16_t* Q = (const bf16_t*)(ws + (FOX ? OFF_QF : OFF_QA));
    bf16_t* Y = (bf16_t*)(ws + (FOX ? OFF_YF : OFF_YA));
    const bf16_t* Kg = (const bf16_t*)(ws + (FOX ? OFF_KF : OFF_KA));
    const bf16_t* Vt = (const bf16_t*)(ws + (FOX ? OFF_VF : OFF_VA));
    const float* cum = (const float*)(ws + OFF_CUM);
    const unsigned long long* mask = (const unsigned long long*)(ws + OFF_MASK);
    const int tid = ltid(), lane = tid & 63, wave = __builtin_amdgcn_readfirstlane(tid >> 6), hlf = lane >> 5;
    const int q0w = qb * 256 + wave * 32;
    const int qrow = q0w + (lane & 31);
    const size_t grow = (size_t)b * TP + qrow;
    const bool wave_on = q0w < T;
    bf16x8 qf[4];
#pragma unroll
    for (int ks = 0; ks < 4; ++ks) qf[ks] = *(const bf16x8*)(Q + grow * 512 + h * 64 + ks * 16 + hlf * 8);
    const int nkt = qb * 4 + 4;
    int kt0 = 0;
    if (FOX) {
        const float* knorm = (const float*)(ws + OFF_KNORM) + (size_t)(b * 8 + h) * MW;
        float* red = (float*)(smem + 2 * AT_BUF);
        float qq = 0.f;
#pragma unroll
        for (int ks = 0; ks < 4; ++ks)
#pragma unroll
            for (int e = 0; e < 8; ++e) { const float v = bf2f((unsigned)(unsigned short)qf[ks][e]); qq = fmaf(v, v, qq); }
        qq += __shfl_xor(qq, 32);
#pragma unroll
        for (int o = 1; o < 32; o <<= 1) qq = fmaxf(qq, __shfl_xor(qq, o));
        if (lane == 0) red[wave] = qq;
        __syncthreads();
        if (wave == 0) {
            float qm = red[0];
#pragma unroll
            for (int w = 1; w < 8; ++w) qm = fmaxf(qm, red[w]);
            const float Qn = sqrtf(qm) * 1.0001f;
            const float Kd = fmaxf(fmaxf(knorm[qb * 4], knorm[qb * 4 + 1]), fmaxf(knorm[qb * 4 + 2], knorm[qb * 4 + 3])) * 1.0001f;
            const float cfirst = cum[((size_t)b * TP + qb * 256) * 8 + h];
            bool keep0 = true, keep1 = true;
            if (lane < qb * 4) { const float bnd = Qn * (knorm[lane] * 1.0001f + Kd) + cfirst - cum[((size_t)b * TP + lane * 64 + 63) * 8 + h]; keep0 = !(bnd < -40.0f); }
            if (lane + 64 < qb * 4) { const float bnd = Qn * (knorm[lane + 64] * 1.0001f + Kd) + cfirst - cum[((size_t)b * TP + (lane + 64) * 64 + 63) * 8 + h]; keep1 = !(bnd < -40.0f); }
            const unsigned long long b0 = __ballot(keep0), b1 = __ballot(keep1);
            const int first = b0 ? (int)__builtin_ctzll(b0) : (b1 ? 64 + (int)__builtin_ctzll(b1) : 128);
            if (lane == 0) ((int*)red)[8] = first < qb * 4 ? first : qb * 4;
        }
        __syncthreads();
        kt0 = ((const int*)red)[8];
    }
    const int my_last = qb * 4 + (wave >> 1);
    f32x16 o0, o1;
#pragma unroll
    for (int i = 0; i < 16; ++i) { o0[i] = 0.f; o1[i] = 0.f; }
    float m_run = -1e30f, l_run = 0.f;
    const int skey = tid >> 3, sc = tid & 7;
    const bf16_t* kp = Kg + ((size_t)b * TP + skey) * 512 + h * 64 + sc * 8;
    const bf16_t* vp = Vt + ((size_t)b * TP + skey) * 512 + h * 64 + sc * 8;
    const int kw_off = skey * 128 + ((sc ^ ((skey >> 1) & 7)) * 16);
    const int vw_off = skey * AT_VP + sc * 16;
    uint4 rk = *(const uint4*)(kp + (size_t)kt0 * 64 * 512), rv = *(const uint4*)(vp + (size_t)kt0 * 64 * 512);
    float rc = 0.f;
    if (FOX && tid < 64) rc = cum[((size_t)b * TP + kt0 * 64 + tid) * 8 + h];
    unsigned long long mw = 0ull, mw_next = 0ull;
    if (!FOX) mw_next = mask[grow * MW + 0];
    for (int kt = kt0; kt < nkt; ++kt) {
        unsigned char* sb = smem + (kt & 1) * AT_BUF;
        if (mode != 3) {
        *(uint4*)(sb + AT_K + kw_off) = rk;
        *(uint4*)(sb + AT_V + vw_off) = rv;
        if (FOX && tid < 64) *(float*)(sb + AT_C + tid * 4) = rc;
        }
        mw = mw_next;
        if (mode != 3) __syncthreads();
        if (kt + 1 < nkt) {
            rk = *(const uint4*)(kp + (size_t)(kt + 1) * 64 * 512);
            rv = *(const uint4*)(vp + (size_t)(kt + 1) * 64 * 512);
            if (FOX && tid < 64) rc = cum[((size_t)b * TP + (kt + 1) * 64 + tid) * 8 + h];
            if (!FOX) mw_next = mask[grow * MW + kt + 1];
        }
        if (wave_on && kt <= my_last) {
            const bf16_t* Ks = (const bf16_t*)(sb + AT_K);
            const unsigned char* Vs = sb + AT_V;
            const float* Cs = (const float*)(sb + AT_C);
            f32x16 st[2];
#pragma unroll
            for (int sub = 0; sub < 2; ++sub) {
#pragma unroll
                for (int i = 0; i < 16; ++i) st[sub][i] = 0.f;
                const int krow = sub * 32 + (lane & 31);
                if (mode != 4)
#pragma unroll
                for (int ks = 0; ks < 4; ++ks) {
                    const bf16x8 kf = *(const bf16x8*)(Ks + krow * 64 + (((ks * 2 + hlf) ^ ((krow >> 1) & 7)) * 8));
                    st[sub] = __builtin_amdgcn_mfma_f32_32x32x16_bf16(kf, qf[ks], st[sub], 0, 0, 0);
                }
            }
            const bool diag = (kt == my_last);
            const int kbase = kt * 64 + 4 * hlf;
            float mx = -3.0e38f;
            if (FOX) {
#pragma unroll
                for (int sub = 0; sub < 2; ++sub)
#pragma unroll
                    for (int g = 0; g < 4; ++g) {
                        const f32x4 ck4 = *(const f32x4*)(Cs + sub * 32 + 8 * g + 4 * hlf);
#pragma unroll
                        for (int j = 0; j < 4; ++j) st[sub][g * 4 + j] -= ck4[j];
                    }
                if (diag) {
#pragma unroll
                    for (int sub = 0; sub < 2; ++sub)
#pragma unroll
                        for (int g = 0; g < 4; ++g)
#pragma unroll
                            for (int j = 0; j < 4; ++j) { const int key = kbase + sub * 32 + 8 * g + j; st[sub][g * 4 + j] = (key <= qrow) ? st[sub][g * 4 + j] : -3.0e38f; }
                }
            }
#pragma unroll
            for (int sub = 0; sub < 2; ++sub)
#pragma unroll
                for (int i = 0; i < 16; ++i) mx = fmaxf(mx, st[sub][i]);
            mx = fmaxf(mx, __shfl_xor(mx, 32));
            const float m_new = fmaxf(m_run, mx);
            const float alpha = __builtin_amdgcn_exp2f(m_run - m_new);
            m_run = m_new;
            float ls = 0.f;
            bf16x8 pf[2][2];
            {
                const int mb0 = (int)(unsigned)(mw >> (4 * hlf)), mb1 = (int)(unsigned)(mw >> (32 + 4 * hlf));
                unsigned pw[2][2][4];
#define ATT_PAIR(SUB, S2, J, MB) do { constexpr int r0_ = 8 * (S2) + (J), r1_ = r0_ + 1; \
                    float p0 = st[SUB][r0_], p1 = st[SUB][r1_]; \
                    if (mode != 5) { p0 = __builtin_amdgcn_exp2f(p0 - m_new); p1 = __builtin_amdgcn_exp2f(p1 - m_new); } \
                    if (!FOX && mode != 5) { p0 = __uint_as_float(__float_as_uint(p0) & bitmask1<8 * (r0_ >> 2) + (r0_ & 3)>(MB)); \
                                             p1 = __uint_as_float(__float_as_uint(p1) & bitmask1<8 * (r1_ >> 2) + (r1_ & 3)>(MB)); } \
                    ls += p0 + p1; pw[SUB][S2][(J) >> 1] = pk2(p0, p1); } while (0)
#define ATT_QUAD(SUB, S2, MB) ATT_PAIR(SUB, S2, 0, MB); ATT_PAIR(SUB, S2, 2, MB); ATT_PAIR(SUB, S2, 4, MB); ATT_PAIR(SUB, S2, 6, MB)
                ATT_QUAD(0, 0, mb0); ATT_QUAD(0, 1, mb0); ATT_QUAD(1, 0, mb1); ATT_QUAD(1, 1, mb1);
#undef ATT_QUAD
#undef ATT_PAIR
#pragma unroll
                for (int sub = 0; sub < 2; ++sub)
#pragma unroll
                    for (int s2 = 0; s2 < 2; ++s2) { uint4 t4 = make_uint4(pw[sub][s2][0], pw[sub][s2][1], pw[sub][s2][2], pw[sub][s2][3]); pf[sub][s2] = *(bf16x8*)&t4; }
            }
            l_run = l_run * alpha + ls;
            if (mode == 2) { asm volatile("" :: "v"(pf[0][0]), "v"(pf[0][1]), "v"(pf[1][0]), "v"(pf[1][1])); }
            else {
#pragma unroll
            for (int i = 0; i < 16; ++i) { o0[i] *= alpha; o1[i] *= alpha; }
#pragma unroll
            for (int sub = 0; sub < 2; ++sub)
#pragma unroll
                for (int s2 = 0; s2 < 2; ++s2) {
                    const int key0 = sub * 32 + 16 * s2 + 4 * hlf;
                    const unsigned char* vr = Vs + (key0 + ((lane & 15) >> 2)) * AT_VP + (16 * ((lane >> 4) & 1) + 4 * (lane & 3)) * 2;
                    {
                        const s16x4 a = vtr16(vr), c = vtr16(vr + 8 * AT_VP);
                        const bf16x8 vf = (bf16x8){a[0], a[1], a[2], a[3], c[0], c[1], c[2], c[3]};
                        o0 = __builtin_amdgcn_mfma_f32_32x32x16_bf16(vf, pf[sub][s2], o0, 0, 0, 0);
                    }
                    {
                        const s16x4 a = vtr16(vr + 64), c = vtr16(vr + 64 + 8 * AT_VP);
                        const bf16x8 vf = (bf16x8){a[0], a[1], a[2], a[3], c[0], c[1], c[2], c[3]};
                        o1 = __builtin_amdgcn_mfma_f32_32x32x16_bf16(vf, pf[sub][s2], o1, 0, 0, 0);
                    }
                }
            }
        }
    }
    __syncthreads();
    if (wave_on) {
        const float lt = l_run + __shfl_xor(l_run, 32);
        const float inv = 1.0f / lt;
        if (qrow >= NMETA && qrow < T && mode == 0) {
            bf16_t* yo = Y + ((size_t)b * SEQ + (qrow - NMETA)) * 512 + h * 64;
#pragma unroll
            for (int g = 0; g < 4; ++g) {
                const int d = 8 * g + 4 * hlf;
                store4bf(yo + d, (f32x4){o0[4 * g] * inv, o0[4 * g + 1] * inv, o0[4 * g + 2] * inv, o0[4 * g + 3] * inv});
                store4bf(yo + 32 + d, (f32x4){o1[4 * g] * inv, o1[4 * g + 1] * inv, o1[4 * g + 2] * inv, o1[4 * g + 3] * inv});
            }
        }
    }
}

namespace ab {
using bf16=__hip_bfloat16;
using bf16x8=__attribute__((ext_vector_type(8)))short;
using s16x4=__attribute__((ext_vector_type(4)))short;
using f32x16=__attribute__((ext_vector_type(16)))float;
using u32x4=__attribute__((ext_vector_type(4)))unsigned;
constexpr int BATCH=2,NHEAD=8,SEQ=8448  ,D=64,DM=NHEAD*D;
constexpr int NW=8,QBLK=32,QB=QBLK*NW,KVBLK=64,NQB=SEQ/QB;
constexpr int ATTN_PITCH=DM, ATTN_UNIT_ROWS=QB;
__device__ __forceinline__ int crow(int r,int hi){return (r&3)+8*(r>>2)+4*hi;}
#define SBAR() __builtin_amdgcn_sched_barrier(0)
__device__ __forceinline__ void cmask(f32x16&p0,f32x16&p1,int jb,int qrel,int hi){
  const float NEG=-INFINITY; int kb=64*jb+4*hi;
  #pragma unroll
  for(int r=0;r<16;++r){int kv=kb+(r&3)+8*(r>>2); if(kv>qrel)p0[r]=NEG; if(kv+32>qrel)p1[r]=NEG;}
}

constexpr int NSLOT=3, SLOTB=8192;
constexpr int LDS_K=0, LDS_V=NSLOT*SLOTB, LDS_WS=2*NSLOT*SLOTB, LDS_OST=LDS_WS+NW*64*4, LDS_BYTES=LDS_OST+NW*4096;
constexpr float C2=0.125f*1.4426950408889634f;
__device__ __forceinline__ void glds16(const void*gsrc,unsigned lds_dst){unsigned keep;
  asm volatile("s_mov_b32 %0, m0\n\ts_mov_b32 m0, %2\n\ts_nop 0\n\tglobal_load_lds_dwordx4 %1, off\n\ts_mov_b32 m0, %0":"=&s"(keep):"v"(gsrc),"s"(lds_dst):"memory");}
__device__ __forceinline__ float max3f(float a,float b,float c){float r;asm("v_max3_f32 %0, %1, %2, %3":"=v"(r):"v"(a),"v"(b),"v"(c));return r;}
__device__ __forceinline__ float max2f(float a,float b){float r;asm("v_max_f32_e32 %0, %1, %2":"=v"(r):"v"(a),"v"(b));return r;}
__device__ __forceinline__ float fadd_s(float a,float b){float r;asm("v_add_f32_e32 %0, %1, %2":"=v"(r):"v"(a),"v"(b));return r;}
__device__ __forceinline__ float fsub_s(float a,float b){float r;asm("v_sub_f32_e32 %0, %1, %2":"=v"(r):"v"(a),"v"(b));return r;}
typedef float f32x2_t __attribute__((ext_vector_type(2))); typedef __bf16 bf16x2_t __attribute__((ext_vector_type(2)));
__device__ __forceinline__ unsigned cvtpk_s(float lo,float hi){f32x2_t v={lo,hi};bf16x2_t b=__builtin_convertvector(v,bf16x2_t);return __builtin_bit_cast(unsigned,b);}
#define WAIT_BAR(N) asm volatile("s_waitcnt vmcnt(" #N ") lgkmcnt(0)\n\ts_barrier":::"memory")

__device__ __forceinline__ void qkt(f32x16&p0,f32x16&p1,const char*Kslot,const bf16x8*qr,const f32x16&negm,int r32,int hi){
  const char*kb=Kslot+hi*1024+r32*16;
  #pragma unroll
  for(int d0=0;d0<4;++d0){
    const bf16x8 b0=*reinterpret_cast<const bf16x8*>(kb+d0*2048);
    const bf16x8 b1=*reinterpret_cast<const bf16x8*>(kb+d0*2048+512);
    if(d0==0){p0=__builtin_amdgcn_mfma_f32_32x32x16_bf16(b0,qr[0],negm,0,0,0);p1=__builtin_amdgcn_mfma_f32_32x32x16_bf16(b1,qr[0],negm,0,0,0);}
    else{p0=__builtin_amdgcn_mfma_f32_32x32x16_bf16(b0,qr[d0],p0,0,0,0);p1=__builtin_amdgcn_mfma_f32_32x32x16_bf16(b1,qr[d0],p1,0,0,0);}}
}
typedef __attribute__((address_space(3))) const char* lds_cptr;
typedef short v4i16_t __attribute__((ext_vector_type(4)));
__device__ __forceinline__ void kload8(bf16x8*kf,lds_cptr kp){
  kf[0]=*(const __attribute__((address_space(3))) bf16x8*)(kp);      kf[1]=*(const __attribute__((address_space(3))) bf16x8*)(kp+512);
  kf[2]=*(const __attribute__((address_space(3))) bf16x8*)(kp+2048); kf[3]=*(const __attribute__((address_space(3))) bf16x8*)(kp+2560);
  kf[4]=*(const __attribute__((address_space(3))) bf16x8*)(kp+4096); kf[5]=*(const __attribute__((address_space(3))) bf16x8*)(kp+4608);
  kf[6]=*(const __attribute__((address_space(3))) bf16x8*)(kp+6144); kf[7]=*(const __attribute__((address_space(3))) bf16x8*)(kp+6656);
}
__device__ __forceinline__ void kload2(bf16x8*kf,lds_cptr kp,int j){ kf[2*j]=*(const __attribute__((address_space(3))) bf16x8*)(kp+j*2048); kf[2*j+1]=*(const __attribute__((address_space(3))) bf16x8*)(kp+j*2048+512); }
__device__ __forceinline__ s16x4 vtr(lds_cptr p){ return __builtin_bit_cast(s16x4,__builtin_amdgcn_ds_read_tr16_b64_v4i16((__attribute__((address_space(3))) v4i16_t*)p)); }
__device__ __forceinline__ float rowmax(const f32x16&p0,const f32x16&p1){
  float a=max3f(p0[0],p0[1],p1[0]),b=max3f(p0[2],p0[3],p1[1]);a=max3f(a,p1[2],p1[3]);
  #pragma unroll
  for(int r=4;r<16;r+=4){a=max3f(a,p0[r],p0[r+1]);b=max3f(b,p0[r+2],p0[r+3]);a=max3f(a,p1[r],p1[r+1]);b=max3f(b,p1[r+2],p1[r+3]);}
  const float m=max2f(a,b);
  auto rr=__builtin_amdgcn_permlane32_swap(__float_as_uint(m),__float_as_uint(m),false,false);
  return max2f(__uint_as_float(rr[0]),__uint_as_float(rr[1]));
}
__device__ __forceinline__ void pv(f32x16*o,int vb,bf16x8 pa0,bf16x8 pa1,bf16x8 pa2,bf16x8 pa3){
  #pragma unroll
  for(int d0=0;d0<2;++d0){s16x4 lo[4],hi[4];
    #pragma unroll
    for(int ks=0;ks<4;++ks){
      asm volatile("ds_read_b64_tr_b16 %0,%1 offset:%c2":"=&v"(lo[ks]):"v"(vb),"i"(d0*4096+ks*1024):"memory");
      asm volatile("ds_read_b64_tr_b16 %0,%1 offset:%c2":"=&v"(hi[ks]):"v"(vb),"i"(d0*4096+ks*1024+512):"memory");}
    asm volatile("s_waitcnt lgkmcnt(0)":::"memory");SBAR();
    #define PK(k) (bf16x8){lo[k][0],lo[k][1],lo[k][2],lo[k][3],hi[k][0],hi[k][1],hi[k][2],hi[k][3]}
    o[d0]=__builtin_amdgcn_mfma_f32_32x32x16_bf16(pa0,PK(0),o[d0],0,0,0);
    o[d0]=__builtin_amdgcn_mfma_f32_32x32x16_bf16(pa1,PK(1),o[d0],0,0,0);
    o[d0]=__builtin_amdgcn_mfma_f32_32x32x16_bf16(pa2,PK(2),o[d0],0,0,0);
    o[d0]=__builtin_amdgcn_mfma_f32_32x32x16_bf16(pa3,PK(3),o[d0],0,0,0);
    #undef PK
  }
}

#ifndef ATTN_STORE16
#define ATTN_STORE16(p,v) (*(u32x4*)(p)=(v))
#endif

template<int POS> __device__ __forceinline__ unsigned mbit(int m){int r;asm("v_bfe_i32 %0, %1, %2, 1":"=v"(r):"v"(m),"n"(POS));return (unsigned)r;}
#define AB_M1(P,R,MB) do{ if(!FOXB) P[R]=__uint_as_float(__float_as_uint(P[R])&mbit<8*((R)>>2)+((R)&3)>(MB)); }while(0)
#define AB_MASK16(P,MB) do{AB_M1(P,0,MB);AB_M1(P,1,MB);AB_M1(P,2,MB);AB_M1(P,3,MB);AB_M1(P,4,MB);AB_M1(P,5,MB);AB_M1(P,6,MB);AB_M1(P,7,MB);AB_M1(P,8,MB);AB_M1(P,9,MB);AB_M1(P,10,MB);AB_M1(P,11,MB);AB_M1(P,12,MB);AB_M1(P,13,MB);AB_M1(P,14,MB);AB_M1(P,15,MB);}while(0)
template<int THRL,bool FOXB> __device__ __forceinline__ void attn_unit(int b,int h,int qb,const bf16*Q,const bf16*__restrict__ K,const bf16*__restrict__ V,bf16*O,const unsigned long long*__restrict__ MK,const float*__restrict__ CK,int kt0,char*shm){
  const int tid=ltid(),lane=tid&63,r32=lane&31,hi=lane>>5; const int wid=__builtin_amdgcn_readfirstlane(tid>>6);
  const long rowbase=(long)b*SEQ; const int q0=qb*QB;
  const bf16*Qw=Q+(rowbase+q0+wid*QBLK)*DM+h*D;
  const long tstep=FOXB?(long)KVBLK*DM:4096;
  const bf16*Kh=FOXB?K+(rowbase+(long)kt0*KVBLK)*DM+h*D:K+(long)(b*NHEAD+h)*(SEQ/KVBLK)*4096,*Vh=FOXB?V+(rowbase+(long)kt0*KVBLK)*DM+h*D:V+(long)(b*NHEAD+h)*(SEQ/KVBLK)*4096;
  const unsigned lds0=(unsigned)(uintptr_t)shm;
  float*wsf=(float*)(shm+LDS_WS)+wid*64;
  const bf16*ksrc=FOXB?Kh+(long)lane*DM+wid*8:Kh+(wid*64+lane)*8;
  const bf16*vsrc=FOXB?Vh+(long)(16*(wid&3)+(lane>>2))*DM+(wid>>2)*32+(lane&3)*8:Vh+((wid>>2)*64+16*(wid&3))*32+lane*8;
  const unsigned kdst=lds0+LDS_K+wid*1024, vdst=lds0+LDS_V+wid*1024;
  #define DMA_K(t,slot) glds16(ksrc+(long)(t)*tstep,(unsigned)__builtin_amdgcn_readfirstlane(kdst+(slot)))
  #define DMA_V(t,slot) glds16(vsrc+(long)(t)*tstep,(unsigned)__builtin_amdgcn_readfirstlane(vdst+(slot)))
  const char*Kbase=shm+LDS_K; bf16x8 kf[8];
  const lds_cptr shm3=(lds_cptr)shm; const lds_cptr kp0=shm3+LDS_K+hi*1024+r32*16; const lds_cptr vp0=shm3+LDS_V+((lane>>4)&1)*32+(lane&3)*8+(4*hi+((lane&15)>>2))*64;
  const int NT=(q0+QB)/KVBLK-kt0;
  DMA_K(0,0);DMA_V(0,0);DMA_K(1,SLOTB);
  bf16x8 qr[4];
  #pragma unroll
  for(int d0=0;d0<4;++d0)qr[d0]=*reinterpret_cast<const bf16x8*>(&Qw[(long)r32*DM+d0*16+hi*8]);
  const lds_cptr qp0=shm3+LDS_OST+wid*4096+lane*16;
  #pragma unroll
  for(int d0=0;d0<4;++d0)*(__attribute__((address_space(3))) bf16x8*)(qp0+d0*1024)=qr[d0];
  #define QR(d) (*(const __attribute__((address_space(3))) bf16x8*)(qp0+(d)*1024))
  float mhat=0.f,l_reg=0.f;f32x16 o[2];o[0]=f32x16{};o[1]=f32x16{};f32x16 negm=f32x16{};asm volatile("":"+v"(negm));
  const int qrel=wid*QBLK+r32;
  const unsigned mrow_off=(unsigned)((rowbase+q0+qrel)*(SEQ/64));
  unsigned long long mw_cur=0ull; if(!FOXB) mw_cur=MK[mrow_off];
  float*ckring=(float*)(shm+LDS_BYTES); const unsigned ckoff=(unsigned)((b*NHEAD+h)*SEQ+kt0*KVBLK+lane); float ckreg=0.f;
  if(FOXB&&wid==0){ ckring[lane]=CK[ckoff]; ckring[64+lane]=CK[ckoff+64]; ckreg=CK[ckoff+128]; }
  #define CKBIAS(C0,C1,t) do{ if(FOXB){ const float*cks_=ckring+((t)%3)*64+4*hi; \
      _Pragma("unroll") for(int g_=0;g_<4;++g_){ const f32x4 ca_=*(const f32x4*)(cks_+8*g_), cb_=*(const f32x4*)(cks_+32+8*g_); \
        _Pragma("unroll") for(int j_=0;j_<4;++j_){ C0[4*g_+j_]-=ca_[j_]; C1[4*g_+j_]-=cb_[j_]; } } } }while(0)
  #define CMASK(P0,P1,t) do{int jb_=(t)-(NT-4); if(jb_>=0)cmask(P0,P1,jb_,qrel,hi);}while(0)
  bool resc=false;
  #define START(P0,P1) do{ const float rm=rowmax(P0,P1); resc=false; \
    { const float dl=rm; mhat=fadd_s(mhat,dl); \
      _Pragma("unroll") for(int r=0;r<16;++r){P0[r]=fsub_s(P0[r],dl);P1[r]=fsub_s(P1[r],dl);} \
      _Pragma("unroll") for(int r=0;r<16;++r)negm[r]=-mhat; asm volatile("":"+v"(negm)); } \
    _Pragma("unroll") for(int r=0;r<16;++r)P0[r]=__builtin_amdgcn_exp2f(P0[r]); }while(0)
  #define RESC() do{ if(resc){ asm volatile("s_waitcnt lgkmcnt(0)":::"memory"); \
      _Pragma("unroll") for(int d_=0;d_<2;++d_) _Pragma("unroll") for(int r=0;r<16;++r)o[d_][r]*=wsf[crow(r,hi)]; } }while(0)
  f32x16 pA0,pA1,pB0,pB1;
  int sl_prev=0,sl_cur=0,sl_next=SLOTB;
  #define ROT() do{sl_prev=sl_cur;sl_cur=sl_next;sl_next=(sl_next==(NSLOT-1)*SLOTB)?0:sl_next+SLOTB;}while(0)
  DMA_K(2,2*SLOTB);
  WAIT_BAR(3);
  qkt(pA0,pA1,Kbase,qr,negm,r32,hi);asm volatile("s_nop 15\n\ts_nop 7":"+v"(pA0),"+v"(pA1));CKBIAS(pA0,pA1,0);CMASK(pA0,pA1,0);
  START(pA0,pA1);
  _Pragma("unroll") for(int r=0;r<16;++r)pA1[r]=__builtin_amdgcn_exp2f(pA1[r]);
  WAIT_BAR(0);
  DMA_K(3,0);DMA_V(1,SLOTB);
  ROT();
  kload8(kf,kp0+sl_cur);
  WAIT_BAR(2);
  s16x4 vlo[8],vhi[8]; u32x4 pw0,pw1,pw2,pw3;
  #define PKW(P,B) cvtpk_s(P[B],P[B+1])
  #define PAF(k) __builtin_bit_cast(bf16x8,pw##k)
  #define VFR(i) (bf16x8){vlo[i][0],vlo[i][1],vlo[i][2],vlo[i][3],vhi[i][0],vhi[i][1],vhi[i][2],vhi[i][3]}
  #define PIN(x) asm volatile("":"+v"(x))
  #define MX3(a,b,c) __builtin_fmaxf(__builtin_fmaxf((a),(b)),(c))
  #define GAPA(MK_,MF,A0,A1,A2,A3,W0,W1,PW) do{ MF; MK_; sacc+=A0; sacc+=A1; sacc+=A2; sacc+=A3; PIN(sacc); W0; W1; PIN(PW); SBAR(); }while(0)
  #define MK4(P,R0,R1,R2,R3,MB) do{AB_M1(P,R0,MB);AB_M1(P,R1,MB);AB_M1(P,R2,MB);AB_M1(P,R3,MB);}while(0)
  #define EX(v) __builtin_amdgcn_exp2f(v)
  #define GAPB(MF,X,B) do{ MF; X[B]=EX(X[B]); X[B+1]=EX(X[B+1]); X[B+2]=EX(X[B+2]); X[B+3]=EX(X[B+3]); PIN(X); SBAR(); }while(0)
  #define VRD(i) do{ vlo[i]=vtr(vp_+(((i)>>2)*4096+((i)&3)*1024)); vhi[i]=vtr(vp_+(((i)>>2)*4096+((i)&3)*1024+512)); }while(0)
  #define KRD(G,j) do{ if(G){ kload2(kf,kp0+sl_next,j); SBAR(); } }while(0)
  #define STEP(C0,C1,P0,P1,t,GK,GV,GL) do{ SBAR(); \
    if(FOXB&&wid==0){ ckring[(((t)+1)%3)*64+lane]=ckreg; if((t)+2<NT) ckreg=CK[ckoff+((t)+2)*64]; } \
    const int mb0_=(int)(unsigned)(mw_cur>>(4*hi)), mb1_=(int)(unsigned)(mw_cur>>(32+4*hi)); AB_M1(P0,0,mb0_); AB_M1(P0,1,mb0_); \
    const lds_cptr vp_=vp0+sl_prev; \
    VRD(0); SBAR(); float sacc=(P0[0]+P0[1]); \
    GAPA(MK4(P0,2,3,4,5,mb0_), C0=__builtin_amdgcn_mfma_f32_32x32x16_bf16(kf[0],QR(0),negm,0,0,0), P0[2],P0[3],P0[4],P0[5],     pw0[0]=PKW(P0,0), pw0[1]=PKW(P0,2), pw0); \
    VRD(4); SBAR(); GAPA(MK4(P0,6,7,8,9,mb0_), C1=__builtin_amdgcn_mfma_f32_32x32x16_bf16(kf[1],QR(0),negm,0,0,0), P0[6],P0[7],P0[8],P0[9],     pw0[2]=PKW(P0,4), pw0[3]=PKW(P0,6), pw0); \
    VRD(1); SBAR(); GAPA(MK4(P0,10,11,12,13,mb0_), C0=__builtin_amdgcn_mfma_f32_32x32x16_bf16(kf[2],QR(1),C0,0,0,0),   P0[10],P0[11],P0[12],P0[13], pw1[0]=PKW(P0,8), pw1[1]=PKW(P0,10), pw1); \
    VRD(5); SBAR(); GAPA(do{AB_M1(P0,14,mb0_);AB_M1(P0,15,mb0_);AB_M1(P1,0,mb1_);AB_M1(P1,1,mb1_);}while(0), C1=__builtin_amdgcn_mfma_f32_32x32x16_bf16(kf[3],QR(1),C1,0,0,0),   P0[14],P0[15],P1[0],P1[1],   pw1[2]=PKW(P0,12),pw1[3]=PKW(P0,14), pw1); \
    VRD(2); SBAR(); GAPA(MK4(P1,2,3,4,5,mb1_), C0=__builtin_amdgcn_mfma_f32_32x32x16_bf16(kf[4],QR(2),C0,0,0,0),   P1[2],P1[3],P1[4],P1[5],     pw2[0]=PKW(P1,0), pw2[1]=PKW(P1,2), pw2); \
    VRD(6); SBAR(); GAPA(MK4(P1,6,7,8,9,mb1_), C1=__builtin_amdgcn_mfma_f32_32x32x16_bf16(kf[5],QR(2),C1,0,0,0),   P1[6],P1[7],P1[8],P1[9],     pw2[2]=PKW(P1,4), pw2[3]=PKW(P1,6), pw2); \
    VRD(3); SBAR(); GAPA(MK4(P1,10,11,12,13,mb1_), C0=__builtin_amdgcn_mfma_f32_32x32x16_bf16(kf[6],QR(3),C0,0,0,0),   P1[10],P1[11],P1[12],P1[13], pw3[0]=PKW(P1,8), pw3[1]=PKW(P1,10), pw3); \
    VRD(7); SBAR(); GAPA(do{AB_M1(P1,14,mb1_);AB_M1(P1,15,mb1_);}while(0), C1=__builtin_amdgcn_mfma_f32_32x32x16_bf16(kf[7],QR(3),C1,0,0,0),   P1[14],P1[15],0.f,0.f,       pw3[2]=PKW(P1,12),pw3[3]=PKW(P1,14), pw3); \
    l_reg+=sacc; if(!FOXB) mw_cur=MK[mrow_off+(t)]; \
    if(GK){DMA_K((t)+3,sl_cur);} if(GV){DMA_V((t)+1,sl_next);} \
    CKBIAS(C0,C1,t); CMASK(C0,C1,t); \
    { float a=MX3(C0[0],C0[1],C1[0]),b=MX3(C0[2],C0[3],C1[1]); a=MX3(a,C1[2],C1[3]); \
      _Pragma("unroll") for(int r=4;r<16;r+=4){a=MX3(a,C0[r],C0[r+1]);b=MX3(b,C0[r+2],C0[r+3]);a=MX3(a,C1[r],C1[r+1]);b=MX3(b,C1[r+2],C1[r+3]);} \
      float rm=__builtin_fmaxf(a,b); { auto rr=__builtin_amdgcn_permlane32_swap(__float_as_uint(rm),__float_as_uint(rm),false,false); rm=__builtin_fmaxf(__uint_as_float(rr[0]),__uint_as_float(rr[1])); } \
      resc=false; \
      if(__builtin_expect(__any(rm>(float)THRL),0)){ const float dl=__builtin_fmaxf(rm,0.f); mhat+=dl; \
        _Pragma("unroll") for(int r=0;r<16;++r){C0[r]-=dl;C1[r]-=dl;} \
        _Pragma("unroll") for(int r=0;r<16;++r)negm[r]=-mhat; asm volatile("":"+v"(negm)); \
        const float f=__builtin_amdgcn_exp2f(-dl); l_reg*=f; { int ri_=r32; asm volatile("":"+v"(ri_)); if(hi==0)wsf[ri_]=f; } resc=true; } } \
    SBAR(); \
    GAPB(o[0]=__builtin_amdgcn_mfma_f32_32x32x16_bf16(PAF(0),VFR(0),o[0],0,0,0), C0,0); \
    GAPB(o[1]=__builtin_amdgcn_mfma_f32_32x32x16_bf16(PAF(0),VFR(4),o[1],0,0,0), C0,4); \
    KRD(GL,0); GAPB(o[0]=__builtin_amdgcn_mfma_f32_32x32x16_bf16(PAF(1),VFR(1),o[0],0,0,0), C0,8); \
    KRD(GL,1); GAPB(o[1]=__builtin_amdgcn_mfma_f32_32x32x16_bf16(PAF(1),VFR(5),o[1],0,0,0), C0,12); \
    KRD(GL,2); GAPB(o[0]=__builtin_amdgcn_mfma_f32_32x32x16_bf16(PAF(2),VFR(2),o[0],0,0,0), C1,0); \
    KRD(GL,3); GAPB(o[1]=__builtin_amdgcn_mfma_f32_32x32x16_bf16(PAF(2),VFR(6),o[1],0,0,0), C1,4); \
    GAPB(o[0]=__builtin_amdgcn_mfma_f32_32x32x16_bf16(PAF(3),VFR(3),o[0],0,0,0), C1,8); \
    GAPB(o[1]=__builtin_amdgcn_mfma_f32_32x32x16_bf16(PAF(3),VFR(7),o[1],0,0,0), C1,12); \
    }while(0)
  int t=1;
  #undef CMASK
  #define CMASK(P0,P1,t) do{}while(0)
  for(;t+5<NT;t+=2){
    STEP(pB0,pB1,pA0,pA1,t,true,true,true);     WAIT_BAR(2); RESC(); ROT();
    STEP(pA0,pA1,pB0,pB1,t+1,true,true,true);   WAIT_BAR(2); RESC(); ROT();
  }
  #undef CMASK
  #define CMASK(P0,P1,t) do{int jb_=(t)-(NT-4); if(jb_>=0)cmask(P0,P1,jb_,qrel,hi);}while(0)
  #define ENDW(tt) do{ if((tt)+3<NT){WAIT_BAR(2);} else if((tt)+2<NT){WAIT_BAR(1);} else {WAIT_BAR(0);} }while(0)
  for(;t+1<NT;t+=2){
    STEP(pB0,pB1,pA0,pA1,t,(t+3<NT),(t+1<NT),(t+1<NT));       ENDW(t);   RESC(); ROT();
    STEP(pA0,pA1,pB0,pB1,t+1,(t+4<NT),(t+2<NT),(t+2<NT));     ENDW(t+1); RESC(); ROT();
  }
  STEP(pB0,pB1,pA0,pA1,NT-1,false,false,false); RESC();
  { const int mb0_=(int)(unsigned)(mw_cur>>(4*hi)), mb1_=(int)(unsigned)(mw_cur>>(32+4*hi)); AB_MASK16(pB0,mb0_); AB_MASK16(pB1,mb1_); }
  { float sacc=pB0[0]+pB0[1]; _Pragma("unroll") for(int r=2;r<16;++r)sacc+=pB0[r]; _Pragma("unroll") for(int r=0;r<16;++r)sacc+=pB1[r]; l_reg+=sacc;
    pw0=(u32x4){PKW(pB0,0),PKW(pB0,2),PKW(pB0,4),PKW(pB0,6)};pw1=(u32x4){PKW(pB0,8),PKW(pB0,10),PKW(pB0,12),PKW(pB0,14)};pw2=(u32x4){PKW(pB1,0),PKW(pB1,2),PKW(pB1,4),PKW(pB1,6)};pw3=(u32x4){PKW(pB1,8),PKW(pB1,10),PKW(pB1,12),PKW(pB1,14)};
    SBAR(); { int ln_=lane; asm volatile("":"+v"(ln_)); const int vb0=(int)(lds0+LDS_V)+((ln_>>4)&1)*32+(ln_&3)*8+(4*(ln_>>5)+((ln_&15)>>2))*64;
      pv(o,vb0+sl_cur,PAF(0),PAF(1),PAF(2),PAF(3)); } }
  #undef PKW
  #undef PAF
  #undef VFR
  #undef PIN
  #undef MX3
  #undef GAPA
  #undef MK4
  #undef GAPB
  #undef EX
  #undef VRD
  #undef KRD
  #undef STEP
  #undef ENDW
  {auto rr=__builtin_amdgcn_permlane32_swap(__float_as_uint(l_reg),__float_as_uint(l_reg),false,false);l_reg=__uint_as_float(rr[0])+__uint_as_float(rr[1]);}
  if(hi==0)wsf[32+r32]=l_reg;asm volatile("s_waitcnt lgkmcnt(0)":::"memory");
  float rli[16];
  #pragma unroll
  for(int r=0;r<16;++r)rli[r]=__builtin_amdgcn_rcpf(wsf[32+crow(r,hi)]);
  { bf16*stg=(bf16*)(shm+LDS_OST)+wid*2048;
    #pragma unroll
    for(int r=0;r<16;++r){const int orow=crow(r,hi);
      #pragma unroll
      for(int d0=0;d0<2;++d0)stg[orow*64+d0*32+r32]=__float2bfloat16(o[d0][r]*rli[r]);}
    asm volatile("s_waitcnt lgkmcnt(0)":::"memory");
    #pragma unroll
    for(int i=0;i<4;++i){const int row=i*8+(lane>>3),ch=lane&7; const u32x4 v=*(const u32x4*)(stg+row*64+ch*8); const int trow=q0+wid*QBLK+row;
      if(trow>=16&&trow<8208) ATTN_STORE16(O+((long)b*8192+(trow-16))*DM+h*D+ch*8,v);} }
  asm volatile("s_waitcnt lgkmcnt(0)\n\ts_barrier":::"memory");
  #undef DMA_K
  #undef DMA_V
  #undef CMASK
  #undef START
  #undef RESC
  #undef ROT
  #undef CKBIAS
  #undef QR
}
constexpr int ATTN_LDS_BYTES=LDS_BYTES;
#undef SBAR
#undef WAIT_BAR
}

__device__ __forceinline__ unsigned ordkey16(float s) {
    const _Float16 hf = (_Float16)(s + 0.0f);
    const unsigned bits = (unsigned)__builtin_bit_cast(unsigned short, hf);
    return (bits & 0x8000u) ? (~bits & 0xffffu) : (bits | 0x8000u);
}
template <int CTRL, int ROWMASK> __device__ __forceinline__ int dppi(int v) { return __builtin_amdgcn_update_dpp(0, v, CTRL, ROWMASK, 0xf, true); }
__device__ __forceinline__ int wave_incl_scan(int v) {
    v += dppi<0x111, 0xf>(v);
    v += dppi<0x112, 0xf>(v);
    v += dppi<0x114, 0xf>(v);
    v += dppi<0x118, 0xf>(v);
    v += dppi<0x142, 0xa>(v);
    v += dppi<0x143, 0xc>(v);
    return v;
}
__device__ __forceinline__ void hist_find(const unsigned* hist, int need, int lane, int& bin, int& above) {
    const uint4 c4 = *(const uint4*)(hist + 252 - 4 * lane);
    const int c0 = (int)c4.w, c1 = (int)c4.z, c2 = (int)c4.y, c3 = (int)c4.x;
    const int tot = c0 + c1 + c2 + c3;
    const int incl = wave_incl_scan(tot);
    const unsigned long long bal = __ballot(incl >= need);
    const int L = bal ? (int)__builtin_ctzll(bal) : 63;
    int mybin, myabove;
    {
        int cum = incl - tot;
        if (cum + c0 >= need) { mybin = 255 - 4 * lane; myabove = cum; }
        else { cum += c0;
            if (cum + c1 >= need) { mybin = 254 - 4 * lane; myabove = cum; }
            else { cum += c1;
                if (cum + c2 >= need) { mybin = 253 - 4 * lane; myabove = cum; }
                else { cum += c2; mybin = 252 - 4 * lane; myabove = cum; } } }
    }
    bin = __builtin_amdgcn_readlane(mybin, L); above = __builtin_amdgcn_readlane(myabove, L);
}
__device__ __forceinline__ unsigned fixkey16(float s) {
    const int v = (int)(__float_as_uint(fmaf(s, 2048.0f, 12582912.0f + 32768.0f)) - 0x4B400000u);
    return (unsigned)min(max(v, 1), 65535);
}
__device__ void indexer_item(unsigned char* ws, int b, int qg, unsigned char* smem) {
    const bf16_t* QI = (const bf16_t*)(ws + OFF_QI);
    const bf16_t* KI = (const bf16_t*)(ws + OFF_KI);
    const float* WI = (const float*)(ws + OFF_WI);
    unsigned long long* mask = (unsigned long long*)(ws + OFF_MASK);
    unsigned short* sc = (unsigned short*)smem;
    unsigned* hist_all = (unsigned*)(smem + 8 * SCP * 2);
    const int tid = ltid(), lane = tid & 63, wave = __builtin_amdgcn_readfirstlane(tid >> 6);
    const int t0 = qg * 8;
    const int g = lane >> 4, kc = lane & 15;
    for (int i = tid * 4; i < 8 * HP; i += NTHREADS * 4) *(uint4*)(hist_all + i) = zero4u();
    bf16x8 af[4][2];
#pragma unroll
    for (int mi = 0; mi < 4; ++mi) {
        const int q = (mi >> 1) * 4 + (kc >> 2), hh = (mi & 1) * 4 + (kc & 3);
#pragma unroll
        for (int ks = 0; ks < 2; ++ks) af[mi][ks] = *(const bf16x8*)(QI + ((size_t)b * TP + t0 + q) * 512 + hh * 64 + ks * 32 + g * 8);
    }
    float wq[2][8];
#pragma unroll
    for (int a = 0; a < 2; ++a)
#pragma unroll
        for (int hh = 0; hh < 8; ++hh) wq[a][hh] = WI[((size_t)b * TP + t0 + a * 4 + g) * 8 + hh];
    __syncthreads();
    const int ntile = (t0 + 8 + 15) >> 4;
    const bf16_t* kbase = KI + ((size_t)b * (TP / 16) * 2 * 64 + lane) * 8;
    for (int rep_ = 0; rep_ < IDX_REP_MFMA; ++rep_) {
    constexpr int U = 4;
    const f32x4 z4 = zero4();
    const int nfull = (t0 >= 15) ? ((t0 - 15) >> 4) + 1 : 0;
    unsigned short* scw0 = sc + g * SCP + kc;
    unsigned* hw0 = hist_all + g * HP;
    bf16x8 c0[U], c1[U];
#pragma unroll
    for (int u = 0; u < U; ++u) { const int kt = wave + 8 * u; if (kt < ntile) { const bf16_t* kr = kbase + (size_t)kt * 1024; c0[u] = *(const bf16x8*)kr; c1[u] = *(const bf16x8*)(kr + 512); } }
    for (int base = wave; base < ntile; base += 8 * U) {
        bf16x8 n0[U], n1[U];
#pragma unroll
        for (int u = 0; u < U; ++u) { const int kt = base + 8 * (U + u); n0[u] = c0[u]; n1[u] = c1[u]; if (kt < ntile && !(IDX_PROBE == 3 && rep_ > 0)) { const bf16_t* kr = kbase + (size_t)kt * 1024; n0[u] = *(const bf16x8*)kr; n1[u] = *(const bf16x8*)(kr + 512); } }
#pragma unroll
        for (int u = 0; u < U; ++u) {
            const int kt = base + 8 * u;
            if (kt < ntile) {
                f32x4 acc[4];
#pragma unroll
                for (int mi = 0; mi < 4; ++mi) {
                    acc[mi] = __builtin_amdgcn_mfma_f32_16x16x32_bf16(af[mi][0], c0[u], z4, 0, 0, 0);
                    acc[mi] = __builtin_amdgcn_mfma_f32_16x16x32_bf16(af[mi][1], c1[u], acc[mi], 0, 0, 0);
                }
                float s0 = 0.f, s1 = 0.f;
#pragma unroll
                for (int c = 0; c < 2; ++c)
#pragma unroll
                    for (int j = 0; j < 4; ++j) {
                        s0 = fmaf(wq[0][c * 4 + j], __builtin_amdgcn_fmed3f(acc[c][j], 0.f, 3.0e38f), s0);
                        s1 = fmaf(wq[1][c * 4 + j], __builtin_amdgcn_fmed3f(acc[2 + c][j], 0.f, 3.0e38f), s1);
                    }
                unsigned k0 = fixkey16(s0), k1 = fixkey16(s1);
                if ((IDX_PROBE == 1 || IDX_PROBE == 3) && rep_ > 0) { asm volatile("" :: "v"(k0), "v"(k1)); }
                else if (kt < nfull) {
                    scw0[kt * 16] = (unsigned short)k0; scw0[4 * SCP + kt * 16] = (unsigned short)k1;
                    if (rep_ == 0) { atomicAdd(&hw0[k0 >> 8], 1u); atomicAdd(&hw0[4 * HP + (k1 >> 8)], 1u); }
                } else {
                    const int key = kt * 16 + kc;
                    const bool ok0 = key <= t0 + g, ok1 = key <= t0 + 4 + g;
                    k0 = ok0 ? k0 : 0u; k1 = ok1 ? k1 : 0u;
                    scw0[kt * 16] = (unsigned short)k0; scw0[4 * SCP + kt * 16] = (unsigned short)k1;
                    if (rep_ == 0) { if (ok0) atomicAdd(&hw0[k0 >> 8], 1u); if (ok1) atomicAdd(&hw0[4 * HP + (k1 >> 8)], 1u); }
                }
            }
        }
#pragma unroll
        for (int u = 0; u < U; ++u) { c0[u] = n0[u]; c1[u] = n1[u]; }
    }
    }
    __syncthreads();
    for (int rep2_ = 0; rep2_ < IDX_REP_SEL; ++rep2_)
    {
        const int t = t0 + wave;
        const int n = t + 1;
        const unsigned short* row = sc + wave * SCP;
        unsigned* hist = hist_all + wave * HP;
        unsigned char* mrow = (unsigned char*)(mask + ((size_t)b * TP + t) * MW);
        const int nbytes = ((t >> 8) + 1) * 32;
        const int nit3 = (nbytes + 63) >> 6;
        unsigned Tkey = 0u; int rem = 0;
        if (n > 256) {
            const int nit = (n + 511) >> 9;
            int B1, above1;
            hist_find(hist, 256, lane, B1, above1);
            const int need2 = 256 - above1;
            __threadfence_block();
            *(uint4*)(hist + lane * 4) = zero4u();
            __threadfence_block();
            for (int it = 0; it < nit; ++it) {
                const int e0 = (it * 64 + lane) * 8;
                const uint4 v = *(const uint4*)(row + e0);
                const unsigned ww[4] = {v.x, v.y, v.z, v.w};
#pragma unroll
                for (int e = 0; e < 8; ++e) {
                    const unsigned k = (ww[e >> 1] >> ((e & 1) * 16)) & 0xffffu;
                    if (e0 + e < n && (int)(k >> 8) == B1) atomicAdd(&hist[k & 255u], 1u);
                }
            }
            __threadfence_block();
            int B2, above2;
            hist_find(hist, need2, lane, B2, above2);
            Tkey = ((unsigned)B1 << 8) | (unsigned)B2;
            rem = 256 - above1 - above2;
        }
        for (int it = 0; it < nit3; ++it) {
            const int e0 = (it * 64 + lane) * 8;
            const uint4 v = *(const uint4*)(row + e0);
            const unsigned ww[4] = {v.x, v.y, v.z, v.w};
            unsigned gtb = 0u, eqb = 0u;
#pragma unroll
            for (int e = 0; e < 8; ++e) {
                const unsigned k = (ww[e >> 1] >> ((e & 1) * 16)) & 0xffffu;
                const bool valid = (e0 + e) < n;
                gtb |= (valid && k > Tkey) ? (1u << e) : 0u;
                eqb |= (valid && k == Tkey) ? (1u << e) : 0u;
            }
            if (__ballot(eqb != 0u) != 0ull) {
                const int c = __popc(eqb);
                int incl = c;
#pragma unroll
                for (int d = 1; d < 64; d <<= 1) { const int vv = __shfl_up(incl, d); if (lane >= d) incl += vv; }
                int r = incl - c;
                unsigned tk = 0u;
#pragma unroll
                for (int e = 0; e < 8; ++e) if ((eqb >> e) & 1u) { if (r < rem) tk |= (1u << e); ++r; }
                rem -= __shfl(incl, 63) < rem ? __shfl(incl, 63) : rem;
                gtb |= tk;
            }
            const int bi = it * 64 + lane;
            if (bi < nbytes) mrow[bi] = (unsigned char)gtb;
        }
    }
    __syncthreads();
}

__device__ int fox_prune(unsigned char* ws, int b, int h, int qb, unsigned char* smem) {
    const int tid = ltid(), lane = tid & 63, wave = __builtin_amdgcn_readfirstlane(tid >> 6), hlf = lane >> 5;
    const bf16_t* Q = (const bf16_t*)(ws + OFF_QF);
    const float* cumt = (const float*)(ws + OFF_CUMT) + (size_t)(b * 8 + h) * TP;
    const float* knorm = (const float*)(ws + OFF_KNORM) + (size_t)(b * 8 + h) * MW;
    float* red = (float*)(smem + 90112);
    const size_t grow = (size_t)b * TP + qb * 256 + wave * 32 + (lane & 31);
    float qq = 0.f;
#pragma unroll
    for (int ks = 0; ks < 4; ++ks) {
        const bf16x8 qv = *(const bf16x8*)(Q + grow * 512 + h * 64 + ks * 16 + hlf * 8);
#pragma unroll
        for (int e = 0; e < 8; ++e) { const float v = bf2f((unsigned)(unsigned short)qv[e]); qq = fmaf(v, v, qq); }
    }
    qq += __shfl_xor(qq, 32);
#pragma unroll
    for (int o = 1; o < 32; o <<= 1) qq = fmaxf(qq, __shfl_xor(qq, o));
    if (lane == 0) red[wave] = qq;
    __syncthreads();
    if (wave == 0) {
        float qm = red[0];
#pragma unroll
        for (int w = 1; w < 8; ++w) qm = fmaxf(qm, red[w]);
        const float Qn = sqrtf(qm) * 1.0001f;
        const float Kd = fmaxf(fmaxf(knorm[qb * 4], knorm[qb * 4 + 1]), fmaxf(knorm[qb * 4 + 2], knorm[qb * 4 + 3])) * 1.0001f;
        const float cfirst = cumt[qb * 256];
        bool keep0 = true, keep1 = true;
        if (lane < qb * 4) { const float bnd = Qn * (knorm[lane] * 1.0001f + Kd) + cfirst - cumt[lane * 64 + 63]; keep0 = !(bnd < -40.0f); }
        if (lane + 64 < qb * 4) { const float bnd = Qn * (knorm[lane + 64] * 1.0001f + Kd) + cfirst - cumt[(lane + 64) * 64 + 63]; keep1 = !(bnd < -40.0f); }
        const unsigned long long b0 = __ballot(keep0), b1 = __ballot(keep1);
        const int first = b0 ? (int)__builtin_ctzll(b0) : (b1 ? 64 + (int)__builtin_ctzll(b1) : 128);
        if (lane == 0) ((int*)red)[8] = (first < qb * 4 ? first : qb * 4) & ~1;
    }
    __syncthreads();
    return ((const int*)red)[8];
}

#define LAS __attribute__((address_space(3)))
#define XB_TMO      128
#define XB_XCNT(j)  (256  + 64 * (j))
#define XB_XSUB(j)  (1280 + 64 * (j))
#define XB_XGEN(j)  (2304 + 64 * (j))
#define XB_TOP      3328
#define XB_TOPGEN   3392
#define XCD_BAR_WORDS 3456
#define XB_SPIN_CAP (1u << 18)
__device__ __forceinline__ unsigned xb_ld(unsigned* p)              { return __hip_atomic_load(p, __ATOMIC_RELAXED, __HIP_MEMORY_SCOPE_AGENT); }
__device__ __forceinline__ unsigned xb_add(unsigned* p, unsigned v) { return __hip_atomic_fetch_add(p, v, __ATOMIC_RELAXED, __HIP_MEMORY_SCOPE_AGENT); }
__device__ __forceinline__ unsigned xb_xcc_id() { return (unsigned)__builtin_amdgcn_s_getreg((3 << 11) | 20) & 0xFu; }
#define XB_SPIN(cond, bar) do { unsigned _sp = 0; while (cond) { __builtin_amdgcn_s_sleep(1); \
    if ((++_sp & 255u) == 0u) { if (xb_ld(&(bar)[XB_TMO])) break; if (_sp > XB_SPIN_CAP) { atomicAdd(&(bar)[XB_TMO], 1u); break; } } } } while (0)
struct XcdBarrier { unsigned* bar; unsigned x; volatile LAS unsigned* st; };
__device__ __forceinline__ XcdBarrier xcd_barrier_post(unsigned* bar, volatile LAS unsigned* st) {
    XcdBarrier b; b.bar = bar; b.x = xb_xcc_id(); b.st = st;
    if (threadIdx.x == 0) (void)xb_add(&bar[XB_XCNT(b.x)], 1u);
    return b;
}
__device__ __forceinline__ void xcd_barrier_complete(unsigned* bar, unsigned x, unsigned& nloc, unsigned& nx) {
    const unsigned G = gridDim.x * gridDim.y * gridDim.z;
    unsigned sum, cnt, mine, sp = 0u;
    for (;;) {
        sum = 0u; cnt = 0u; mine = 0u;
#pragma unroll
        for (unsigned j = 0; j < 16; ++j) { const unsigned c = xb_ld(&bar[XB_XCNT(j)]); sum += c; cnt += (c > 0u) ? 1u : 0u; mine = (j == x) ? c : mine; }
        if (sum == G) break;
        __builtin_amdgcn_s_sleep(1);
        if ((++sp & 255u) == 0u) { if (xb_ld(&bar[XB_TMO])) break; if (sp > XB_SPIN_CAP) { atomicAdd(&bar[XB_TMO], 1u); break; } }
    }
    nloc = mine > 0u ? mine : 1u; nx = cnt > 0u ? cnt : 1u;
}
__device__ __forceinline__ void xcd_barrier(const XcdBarrier& b) {
    asm volatile("s_waitcnt vmcnt(0)" ::: "memory");
    __syncthreads();
    if (threadIdx.x == 0) {
        unsigned* bar = b.bar;
        __builtin_amdgcn_s_waitcnt(0);
        unsigned nloc = b.st[0], nx = b.st[1];
        if (nloc == 0u) { xcd_barrier_complete(bar, b.x, nloc, nx); b.st[0] = nloc; b.st[1] = nx; }
        const unsigned old = xb_add(&bar[XB_XSUB(b.x)], 1u);
        const unsigned gen = old / nloc;
        if (old + 1u == (gen + 1u) * nloc) {
            __builtin_amdgcn_fence(__ATOMIC_RELEASE, "agent");
            asm volatile("s_waitcnt vmcnt(0)" ::: "memory");
            const unsigned og = xb_add(&bar[XB_TOP], 1u);
            const unsigned tg = og / nx;
            if (og + 1u == (tg + 1u) * nx) xb_add(&bar[XB_TOPGEN], 1u);
            else XB_SPIN(xb_ld(&bar[XB_TOPGEN]) == tg, bar);
            __builtin_amdgcn_fence(__ATOMIC_ACQUIRE, "agent");
            xb_add(&bar[XB_XGEN(b.x)], 1u);
            asm volatile("s_waitcnt vmcnt(0)" ::: "memory");
        } else {
            XB_SPIN(xb_ld(&bar[XB_XGEN(b.x)]) == gen, bar);
            __builtin_amdgcn_fence(__ATOMIC_ACQUIRE, "agent");
            asm volatile("s_waitcnt vmcnt(0)" ::: "memory");
        }
    }
    __syncthreads();
}

__global__ void __launch_bounds__(NTHREADS, 2) mega(Params p) {
    __shared__ __attribute__((aligned(16))) unsigned char smem[LDS_BYTES];
    volatile LAS unsigned* bst = (volatile LAS unsigned*)(smem + LDS_BYTES - 64);
    if (threadIdx.x < 2) bst[threadIdx.x] = 0u;
    __syncthreads();
    (void)xcd_barrier_post((unsigned*)(p.ws + OFF_CTL) + CW_BAR, bst);

#pragma unroll 1
    for (int step = p.ph_lo; step < p.ph_hi; ++step) {
        if (step > p.ph_lo && !(FUSE89 && REPEAT_PH < 0 && step == 9)) {
            KParams kpb = (KParams)__builtin_amdgcn_kernarg_segment_ptr(); asm volatile("" : "+s"(kpb));
            XcdBarrier gb; gb.bar = (unsigned*)(kpb->ws + OFF_CTL) + CW_BAR; gb.x = xb_xcc_id(); gb.st = (volatile LAS unsigned*)(smem + LDS_BYTES - 64);
            xcd_barrier(gb);
        }
        if (TIME_PH >= 0 && TIME_PH < 100 && blockIdx.x == 0 && threadIdx.x == 0 && (step == TIME_PH || step == TIME_PH + 1)) {
            const unsigned long long tt = wall_clock64(); volatile LAS unsigned* ts = (volatile LAS unsigned*)(smem + LDS_BYTES - 64) + (step == TIME_PH ? 4 : 6);
            ts[0] = (unsigned)tt; ts[1] = (unsigned)(tt >> 32);
        }
        const int ph = (REPEAT_PH >= 0 && step > REPEAT_PH) ? step - 1 : step;
        KParams kp = (KParams)__builtin_amdgcn_kernarg_segment_ptr(); asm volatile("" : "+s"(kp));
        unsigned char* ws = kp->ws;
        const int G = gridDim.x, bid = blockIdx.x;
        unsigned* ctl = (unsigned*)(ws + OFF_CTL);
        const float* rope = (const float*)(ws + OFF_ROPE);
        float* stat0 = (float*)(ws + OFF_STAT0);
        const float* x = kp->in[0];
        if (PH(0) && ph == 0) {
            const int tid = ltid(), lane = tid & 63, wave = __builtin_amdgcn_readfirstlane(tid >> 6); (void)lane; (void)wave;
            {
                bf16_t* HB = (bf16_t*)(ws + OFF_HB); bf16_t* HBM = (bf16_t*)(ws + OFF_HBM);
                const float* g0 = kp->in[2]; const float* b0 = kp->in[3];
                auto ln_rows = [&](const float* src0, bf16_t* dst0, int i0, int stride, int lim, bool meta) {
                    f32x4 v[4][4];
#pragma unroll
                    for (int k = 0; k < 4; ++k) {
                        const int i = (i0 + k * stride < lim) ? i0 + k * stride : i0;
#pragma unroll
                        for (int j = 0; j < 4; ++j) v[k][j] = *(const f32x4*)(src0 + (size_t)i * 1024 + lane * 4 + 256 * j);
                    }
#pragma unroll
                    for (int k = 0; k < 4; ++k) {
                        const int i = (i0 + k * stride < lim) ? i0 + k * stride : i0;
                        float s = 0.f;
#pragma unroll
                        for (int j = 0; j < 4; ++j) s += (v[k][j][0] + v[k][j][1]) + (v[k][j][2] + v[k][j][3]);
                        const float mu = wave_sum(s) * (1.0f / 1024.0f);
                        float q = 0.f;
#pragma unroll
                        for (int j = 0; j < 4; ++j) { const f32x4 d = v[k][j] - mu; q += (d[0] * d[0] + d[1] * d[1]) + (d[2] * d[2] + d[3] * d[3]); }
                        const float rstd = rsqrtf(wave_sum(q) * (1.0f / 1024.0f) + LN_EPS);
#pragma unroll
                        for (int j = 0; j < 4; ++j) {
                            const f32x4 gg = *(const f32x4*)(g0 + lane * 4 + 256 * j), bb = *(const f32x4*)(b0 + lane * 4 + 256 * j);
                            store4bf(dst0 + (size_t)i * 1024 + lane * 4 + 256 * j, (v[k][j] - mu) * rstd * gg + bb);
                        }
                        if (lane == 0 && !meta) { const int r = (i / SEQ) * TP + NMETA + i % SEQ; stat0[2 * r] = mu; stat0[2 * r + 1] = rstd; }
                    }
                };
                for (int i0 = bid * 8 + wave; i0 < NTOK; i0 += G * 8 * 4) ln_rows(x, HB, i0, G * 8, NTOK, false);
                if (bid * 8 + wave < NMETA / 4) ln_rows(kp->in[1], HBM, bid * 8 + wave, NMETA / 4, NMETA, true);
            }
            {
                float* ropew = (float*)(ws + OFF_ROPE);
                for (int i = bid * NTHREADS + tid; i < TP * 8; i += G * NTHREADS) {
                    const int t = i >> 3, k = i & 7;
                    const float invf[8] = {1.0f, 0.1939227432012558f, 0.03760603070259094f, 0.007292664609849453f, 0.0014142135623842478f,
                                           0.00027424818836152554f, 5.3182957344688475e-05f, 1.0313385246263351e-05f};
                    float iv = invf[0];
#pragma unroll
                    for (int kk = 1; kk < 8; ++kk) iv = (k == kk) ? invf[kk] : iv;
                    const float ang = (float)t * iv;
                    ropew[2 * i] = cosf(ang); ropew[2 * i + 1] = sinf(ang);
                }
            }
            {
                bf16_t* wrt = (bf16_t*)(ws + OFF_WRT);
                const float* wrg = kp->in[13]; const float* wre = kp->in[15];
                for (int i = bid * NTHREADS + tid; i < 48 * 1024; i += G * NTHREADS) {
                    const int e = i >> 10, k = i & 1023;
                    const float w = (e < 4) ? wrg[k * 4 + e] : ((e < 36) ? wre[k * 32 + (e - 4)] : 0.f);
                    const unsigned hi = f2bf(w);
                    wrt[i] = (bf16_t)hi; wrt[48 * 1024 + i] = (bf16_t)f2bf(w - bf2f(hi));
                }
            }
            {
                KParams kq = kp;
                unsigned char* wsq = ws;
                constexpr int N_WIN = 16 * 80, N_KV = 4 * 16, N_A = 8 * 16, N_F = 8 * 16, N_O = 16 * 16;
                constexpr int NT = N_WIN + N_KV + N_A + N_F + N_O;
                auto dec = [kq, wsq](int it) -> XTile {
                    XTile x; x.kscale = nullptr; x.winmap = 0; x.s16 = 16;
                    int i = it;
                    if (i < N_WIN) { x.src = kq->in[4]; x.src_ld = 4944; x.dst = (bf16_t*)(wsq + OFF_WIN); x.dst_ld = 1024; x.k0 = (i % 16) * 64; x.j0 = (i / 16) * 64; x.winmap = 1; }
                    else if ((i -= N_WIN) < N_KV) { x.src = kq->in[7]; x.src_ld = 1024; x.dst = (bf16_t*)(wsq + OFF_WKV); x.dst_ld = 256; x.k0 = (i % 4) * 64; x.j0 = (i / 4) * 64; x.kscale = kq->in[6]; }
                    else if ((i -= N_KV) < N_A) { x.src = kq->in[8]; x.src_ld = 1024; x.dst = (bf16_t*)(wsq + OFF_WA); x.dst_ld = 512; x.k0 = (i % 8) * 64; x.j0 = (i / 8) * 64; }
                    else if ((i -= N_A) < N_F) { x.src = kq->in[9]; x.src_ld = 1024; x.dst = (bf16_t*)(wsq + OFF_WF); x.dst_ld = 512; x.k0 = (i % 8) * 64; x.j0 = (i / 8) * 64; }
                    else { i -= N_F; x.src = kq->in[10]; x.src_ld = 1024; x.dst = (bf16_t*)(wsq + OFF_WO); x.dst_ld = 1024; x.k0 = (i % 16) * 64; x.j0 = (i / 16) * 64; }
                    x.rb = x.j0;
                    return x;
                };
                xpose_many(NT, G, bid, dec, (float*)smem);
            }
        }
        if ((PH(1) && ph == 1) || (PH(2) && ph == 2) || (PH(5) && ph == 5) || (PH(6) && ph == 6) || (PH(9) && ph == 9)) {
            {
            }
            float* rs = (float*)(smem + pg8::STAGE_BYTES);
            int* tag = (int*)(smem + pg8::STAGE_BYTES + 2048);
            if (ph == 2) TS_BEGIN(1);
            if (ph == 2) {
                const int tid = ltid();
                const bf16_t* CKV = (const bf16_t*)(ws + OFF_CKV);
                pg8::StaticOrder S; S.init(NTOK, 1024, G, bid);
                pg8::Unit u;
                for (int i = 0; i < 2; ++i) {
                    if (!S.next(i, u)) { if (tid == 0) tag[i] = -1; continue; }
                    if (tid == 0) tag[i] = u.pm;
                    const bf16_t* rp = CKV + (size_t)(u.pm * 256 + (tid >> 1)) * 256 + (tid & 1) * 128;
                    float ss = 0.f;
#pragma unroll
                    for (int c = 0; c < 16; ++c) {
                        const uint4 uu = *(const uint4*)(rp + c * 8);
                        const unsigned ww[4] = {uu.x, uu.y, uu.z, uu.w};
#pragma unroll
                        for (int e = 0; e < 4; ++e) { const float a0 = bf2f(ww[e] & 0xffffu), a1 = bf2f(ww[e] >> 16); ss = fmaf(a0, a0, fmaf(a1, a1, ss)); }
                    }
                    ss += __shfl_xor(ss, 1);
                    if ((tid & 1) == 0) rs[i * 256 + (tid >> 1)] = rsqrtf(ss * (1.0f / 256.0f) + RMS_EPS);
                }
                __syncthreads();
            }
            if (ph == 9) {
                const int tid = ltid();
                if (tid < 32) tag[tid] = (int)ctl[CW_ECNT + tid * ECS];
                __syncthreads();
                if (tid == 0) { int cp = 0, rb = 0; for (int e = 0; e < 32; ++e) { tag[32 + e] = cp; tag[64 + e] = rb; const int nc = (tag[e] + 255) >> 8; cp += nc; rb += nc * 256; } tag[96] = cp; }
                __syncthreads();
            }
            const int njobs = (ph == 5) ? 2 : 1;
#pragma unroll 1
            for (int job = 0; job < njobs; ++job) {
                pg8::Gemm g; int kind;
                if (ph == 1) { g = pg8::Gemm{(const bf16_t*)(ws + OFF_HB), (const bf16_t*)(ws + OFF_WIN), NTOK, NP, 1024}; kind = 0; }
                else if (ph == 2) { g = pg8::Gemm{(const bf16_t*)(ws + OFF_CKV), (const bf16_t*)(ws + OFF_WKV), NTOK, 1024, 256}; kind = 1; }
                else if (ph == 5) { g = (job == 0) ? pg8::Gemm{(const bf16_t*)(ws + OFF_YA), (const bf16_t*)(ws + OFF_WA), NTOK, 1024, 512}
                                                   : pg8::Gemm{(const bf16_t*)(ws + OFF_YF), (const bf16_t*)(ws + OFF_WF), NTOK, 1024, 512}; kind = 2 + job; }
                else if (ph == 6) { g = pg8::Gemm{(const bf16_t*)(ws + OFF_MERGED), (const bf16_t*)(ws + OFF_WO), NTOK, 1024, 1024}; kind = 4; }
                else { g = pg8::Gemm{(const bf16_t*)(ws + OFF_HID), (const bf16_t*)(ws + OFF_WD), HID_ROWS, 32 * 1024, 256}; kind = 5; }
                pg8::StaticOrder S; S.init(g.M, g.N, G, bid);
                if (ph == 9) S.init_moe((const PG8_LAS int*)tag, G, bid, (FUSE89 && REPEAT_PH < 0) ? (const unsigned*)ctl + CW_DONE : nullptr);
                EpiAny E{kind, (const PG8_LAS float*)rs, (const PG8_LAS int*)tag};
                if (ph == 2) { TS_END(1); TS_BEGIN(2); }
                pg8::gemm_phase<EpiAny, pg8::StaticOrder, true, true>((PG8_LAS unsigned char*)smem, g, S, E);
                if (ph == 2) { TS_END(2); TS_BEGIN(3); }
            }
            if (ph == 1) {
                const int tid = ltid(), lane = tid & 63, wave = __builtin_amdgcn_readfirstlane(tid >> 6);
                const int gw = (wave == 0) ? bid : 1 << 20;
                if (gw <= 180) {
                    const bf16_t* HBM = (const bf16_t*)(ws + OFF_HBM); const bf16_t* WIN = (const bf16_t*)(ws + OFF_WIN);
                    const int c0 = (gw < 180) ? gw * 16 : 4928;
                    f32x4 acc = zero4();
                    const bf16_t* ap_ = HBM + (size_t)(lane & 15) * 1024 + (lane >> 4) * 8;
                    const bf16_t* bp_ = WIN + (size_t)(c0 + (lane & 15)) * 1024 + (lane >> 4) * 8;
#pragma unroll 16
                    for (int kk = 0; kk < 32; ++kk) acc = __builtin_amdgcn_mfma_f32_16x16x32_bf16(*(const bf16x8*)(ap_ + kk * 32), *(const bf16x8*)(bp_ + kk * 32), acc, 0, 0, 0);
                    const int cg64 = c0 >> 6, d = (c0 & 63) + (lane & 15);
                    const bool ropeseg = (cg64 < 8 || (cg64 >= 12 && cg64 <= 20)) && ((c0 & 63) == 0);
                    const float* bfg = kp->in[5];
#pragma unroll
                    for (int j = 0; j < 4; ++j) {
                        const int t = (lane >> 4) * 4 + j;
                        float v = acc[j];
                        if (ropeseg) {
                            const float pr = __shfl_xor(v, 8);
                            const float cs = rope[t * 16 + 2 * (d & 7)], sn = rope[t * 16 + 2 * (d & 7) + 1];
                            v = (d & 8) ? (v * cs + pr * sn) : (v * cs - pr * sn);
                        }
#pragma unroll
                        for (int b = 0; b < 2; ++b) {
                            const size_t r = (size_t)b * TP + t;
                            if (cg64 < 8) ((bf16_t*)(ws + OFF_QA))[r * 512 + cg64 * 64 + d] = (bf16_t)f2bf(v * QSCALE);
                            else if (cg64 < 12) { if (b == 0) ((float*)(ws + OFF_MCKV))[t * 256 + (cg64 - 8) * 64 + d] = v; }
                            else if (cg64 < 20) ((bf16_t*)(ws + OFF_QI))[r * 512 + (cg64 - 12) * 64 + d] = (bf16_t)f2bf(v * 0.125f);
                            else if (cg64 == 20) ((bf16_t*)(ws + OFF_KI))[((size_t)((b * (TP / 16) + (t >> 4)) * 2 + (d >> 5)) * 64 + ((d & 31) >> 3) * 16 + (t & 15)) * 8 + (d & 7)] = (bf16_t)f2bf(v);
                            else if (cg64 < 29) ((bf16_t*)(ws + OFF_QF))[r * 512 + (cg64 - 21) * 64 + d] = (bf16_t)f2bf(v * QSCALE);
                            else if (cg64 < 37) ((bf16_t*)(ws + OFF_KF))[r * 512 + (cg64 - 29) * 64 + d] = (bf16_t)f2bf(v);
                            else if (cg64 < 45) ((bf16_t*)(ws + OFF_VF))[r * 512 + (cg64 - 37) * 64 + d] = (bf16_t)f2bf(v);
                            else if (d < 8) ((float*)(ws + OFF_WI))[r * 8 + d] = v * 0.3535533905932738f;
                            else { const float z = v + bfg[d - 8]; ((float*)(ws + OFF_LOGF))[(size_t)(b * 8 + (d - 8)) * TP + t] = fminf(z, 0.f) - __logf(1.0f + __expf(-fabsf(z))); }
                        }
                    }
                }
            }
            if (ph == 2) {
                const int tid = ltid(), lane = tid & 63, wave = __builtin_amdgcn_readfirstlane(tid >> 6);
                const int gw = (wave == 0) ? bid : 1 << 20;
                if (gw < 64) {
                    const float* MC = (const float*)(ws + OFF_MCKV); const bf16_t* WKV = (const bf16_t*)(ws + OFF_WKV);
                    const int c0 = gw * 16;
                    f32x4 acc = zero4(); float ss = 0.f;
                    const float* ap_ = MC + (lane & 15) * 256 + (lane >> 4) * 8;
                    const bf16_t* bp_ = WKV + (size_t)(c0 + (lane & 15)) * 256 + (lane >> 4) * 8;
#pragma unroll
                    for (int kk = 0; kk < 8; ++kk) {
                        const f32x4 a0 = *(const f32x4*)(ap_ + kk * 32), a1 = *(const f32x4*)(ap_ + kk * 32 + 4);
                        uint4 au; au.x = pk2(a0[0], a0[1]); au.y = pk2(a0[2], a0[3]); au.z = pk2(a1[0], a1[1]); au.w = pk2(a1[2], a1[3]);
                        const unsigned aw[4] = {au.x, au.y, au.z, au.w};
#pragma unroll
                        for (int e = 0; e < 4; ++e) { const float x0 = bf2f(aw[e] & 0xffffu), x1 = bf2f(aw[e] >> 16); ss = fmaf(x0, x0, fmaf(x1, x1, ss)); }
                        acc = __builtin_amdgcn_mfma_f32_16x16x32_bf16(*(bf16x8*)&au, *(const bf16x8*)(bp_ + kk * 32), acc, 0, 0, 0);
                    }
                    ss += __shfl_xor(ss, 16); ss += __shfl_xor(ss, 32);
                    const float rstd_row = rsqrtf(ss * (1.0f / 256.0f) + RMS_EPS);
                    const int cg64 = c0 >> 6, d = (c0 & 63) + (lane & 15);
                    const bool ropeseg = (cg64 < 8) && ((c0 & 63) == 0);
#pragma unroll
                    for (int j = 0; j < 4; ++j) {
                        const int t = (lane >> 4) * 4 + j;
                        float v = acc[j] * __shfl(rstd_row, t);
                        if (ropeseg) {
                            const float pr = __shfl_xor(v, 8);
                            const float cs = rope[t * 16 + 2 * (d & 7)], sn = rope[t * 16 + 2 * (d & 7) + 1];
                            v = (d & 8) ? (v * cs + pr * sn) : (v * cs - pr * sn);
                        }
#pragma unroll
                        for (int b = 0; b < 2; ++b) {
                            const size_t r = (size_t)b * TP + t;
                            if (cg64 < 8) ((bf16_t*)(ws + OFF_KA))[kimg_off(b, cg64, t, d)] = (bf16_t)f2bf(v);
                            else ((bf16_t*)(ws + OFF_VA))[vimg_off(b, cg64 - 8, t, d)] = (bf16_t)f2bf(v);
                        }
                    }
                }
            }
            if (ph == 2) { TS_END(3); TS_BEGIN(4); }
            if (ph == 2 && bid >= G - 16) {
                const int tid = ltid(), lane = tid & 63, wave = __builtin_amdgcn_readfirstlane(tid >> 6);
                const int i16 = bid - (G - 16), b = i16 >> 3, h = i16 & 7;
                const float* LOGT = (const float*)(ws + OFF_LOGF) + (size_t)(b * 8 + h) * TP;
                float* CUMT = (float*)(ws + OFF_CUMT) + (size_t)(b * 8 + h) * TP;
                float* seq = (float*)smem;
                double* part = (double*)(smem + 512 * 17 * 4);
                constexpr int CH = 17;
                for (int i = tid; i < 512 * CH; i += NTHREADS) seq[i] = (i < T) ? LOGT[i] : 0.f;
                __syncthreads();
                float lv[CH];
                double sacc = 0.0;
#pragma unroll
                for (int k = 0; k < CH; ++k) lv[k] = seq[tid * CH + k];
#pragma unroll
                for (int k = 0; k < CH; ++k) sacc += (double)lv[k];
                double incl = sacc;
#pragma unroll
                for (int d = 1; d < 64; d <<= 1) { const double v = __shfl_up(incl, d); if (lane >= d) incl += v; }
                if (lane == 63) part[wave] = incl;
                __syncthreads();
                double run = incl - sacc;
                for (int w = 0; w < wave; ++w) run += part[w];
#pragma unroll
                for (int k = 0; k < CH; ++k) { run += (double)lv[k]; seq[tid * CH + k] = (float)(run * 1.4426950408889634); }
                __syncthreads();
                for (int i = tid; i < TP; i += NTHREADS) CUMT[i] = (i < T) ? seq[i] : 0.f;
                __syncthreads();
            }
            if (ph == 2) { TS_END(4); TS_BEGIN(5); }
            if (ph == 2) {
                const int tid = ltid(), lane = tid & 63, wave = __builtin_amdgcn_readfirstlane(tid >> 6);
                const bf16_t* KF = (const bf16_t*)(ws + OFF_KF);
                float* KN = (float*)(ws + OFF_KNORM);
                for (int it = bid * 8 + wave; it < NB * 8 * MW; it += G * 8) {
                    const int kt = it % MW, bh = it / MW, b = bh >> 3, h = bh & 7;
                    const bf16_t* kr = KF + ((size_t)b * TP + kt * 64 + lane) * 512 + h * 64;
                    float ss = 0.f;
#pragma unroll
                    for (int c = 0; c < 8; ++c) {
                        const uint4 u = *(const uint4*)(kr + c * 8);
                        const unsigned ww[4] = {u.x, u.y, u.z, u.w};
#pragma unroll
                        for (int e = 0; e < 4; ++e) { const float a0 = bf2f(ww[e] & 0xffffu), a1 = bf2f(ww[e] >> 16); ss = fmaf(a0, a0, fmaf(a1, a1, ss)); }
                    }
#pragma unroll
                    for (int o = 1; o < 64; o <<= 1) ss = fmaxf(ss, __shfl_xor(ss, o));
                    if (lane == 0) KN[it] = sqrtf(ss);
                }
            }
            if (ph == 2) TS_END(5);
        }
        if (PH(3) && ph == 3) {
            const int tid = ltid(), lane = tid & 63, wave = __builtin_amdgcn_readfirstlane(tid >> 6); (void)lane; (void)wave;
            constexpr int N_FOX = 33 * 16, N_IDX2 = T / 8, N_CV2 = 512;
            int* qslot = (int*)(smem + LDS_BYTES - 16);
            for (;;) {
                __syncthreads();
                if (tid == 0) *qslot = (int)atomicAdd(&ctl[CW_Q3 + step], 1u);
                __syncthreads();
                const int it = *qslot;
                if (it >= N_FOX + N_IDX2 + N_CV2) break;
                if (it >= N_FOX + N_IDX2) {
                    KParams kq = kp; unsigned char* wsq = ws;
                    const int g2 = (it - (N_FOX + N_IDX2)) * 2;
#pragma unroll 1
                    for (int gg = 0; gg < 2; ++gg) xpose_group(g2 + gg, 4096, [kq, wsq](int t_) { return moe_tile(kq, wsq, t_); }, (float*)smem);
                    continue;
                }
                if (it < N_FOX) {
                    const int qb = 32 - it / 16, bh = it % 16;
                    const int kt0 = fox_prune(ws, bh >> 3, bh & 7, qb, smem);
                    ab::attn_unit<16, true>(bh >> 3, bh & 7, qb, (const ab::bf16*)(ws + OFF_QF), (const ab::bf16*)(ws + OFF_KF), (const ab::bf16*)(ws + OFF_VF), (ab::bf16*)(ws + OFF_YF),
                                           nullptr, (const float*)(ws + OFF_CUMT), kt0, (char*)smem);
                }
                else {
                    const int qg = (T / 8 - 1) - (it - N_FOX);
#pragma unroll 1
                    for (int bb = 0; bb < 2; ++bb) indexer_item(ws, bb, qg, smem);
                }
            }
        }
        if (PH(4) && ph == 4) {
            const int tid = ltid(), lane = tid & 63, wave = __builtin_amdgcn_readfirstlane(tid >> 6); (void)lane; (void)wave;
            constexpr int N_DSA = 33 * 16;
            int* qslot = (int*)(smem + LDS_BYTES - 16);
            for (;;) {
                __syncthreads();
                if (tid == 0) *qslot = (int)atomicAdd(&ctl[CW_Q4 + step], 1u);
                __syncthreads();
                const int it = *qslot;
                if (it >= N_DSA + 256) break;
                if (it >= N_DSA) {
                    KParams kq = kp; unsigned char* wsq = ws;
#pragma unroll 1
                    for (int gg = 0; gg < 2; ++gg) xpose_group(1024 + 2 * (it - N_DSA) + gg, 6144, [kq, wsq](int t_) { return moe_tile(kq, wsq, t_); }, (float*)smem);
                    continue;
                }
                const int qb = 32 - it / 16, bh = it % 16;
                ab::attn_unit<8, false>(bh >> 3, bh & 7, qb, (const ab::bf16*)(ws + OFF_QA), (const ab::bf16*)(ws + OFF_KA), (const ab::bf16*)(ws + OFF_VA), (ab::bf16*)(ws + OFF_YA),
                                        (const unsigned long long*)(ws + OFF_MASK), nullptr, 0, (char*)smem);
            }
        }
        if (PH(5) && ph == 5) {
            const int tid = ltid(), lane = tid & 63, wave = __builtin_amdgcn_readfirstlane(tid >> 6); (void)lane; (void)wave;
        }
        if (PH(7) && ph == 7) {
            const int tid = ltid(), lane = tid & 63, wave = __builtin_amdgcn_readfirstlane(tid >> 6);
            constexpr int AP = 264;
            bf16_t* Ahi = (bf16_t*)smem; bf16_t* Alo = Ahi + 64 * AP;
            bf16_t* WL = Alo + 64 * AP;
            float* LG = (float*)(smem + (2 * 64 + 96) * AP * 2);
            const float* g1 = kp->in[11]; const float* b1 = kp->in[12];
            const float* brg = kp->in[14]; const float* bre = kp->in[16];
            const bf16_t* wrt = (const bf16_t*)(ws + OFF_WRT);
            bf16_t* H1B = (bf16_t*)(ws + OFF_H1B);
            int* TOKL = (int*)(ws + OFF_TOKL); float* GW = (float*)(ws + OFF_GW);
            unsigned* lcnt = (unsigned*)(LG + 64 * 49);
            for (int tb = bid; tb < NTOK / 64; tb += G) {
                const int n0 = tb * 64 + wave * 8;
                if (tid < 32) lcnt[tid] = 0u;
                f32x4 v[8][4];
#pragma unroll
                for (int tt = 0; tt < 8; ++tt)
#pragma unroll
                    for (int j = 0; j < 4; ++j) v[tt][j] = *(const f32x4*)(kp->out + (size_t)(n0 + tt) * 1024 + lane * 4 + 256 * j);
#pragma unroll
                for (int tt = 0; tt < 8; ++tt) {
                    float s_ = 0.f;
#pragma unroll
                    for (int j = 0; j < 4; ++j) s_ += (v[tt][j][0] + v[tt][j][1]) + (v[tt][j][2] + v[tt][j][3]);
                    const float mu = wave_sum(s_) * (1.0f / 1024.0f);
                    float q = 0.f;
#pragma unroll
                    for (int j = 0; j < 4; ++j) { const f32x4 d = v[tt][j] - mu; q += (d[0] * d[0] + d[1] * d[1]) + (d[2] * d[2] + d[3] * d[3]); }
                    const float rstd = rsqrtf(wave_sum(q) * (1.0f / 1024.0f) + LN_EPS);
#pragma unroll
                    for (int j = 0; j < 4; ++j) {
                        const f32x4 gg = *(const f32x4*)(g1 + lane * 4 + 256 * j), bb = *(const f32x4*)(b1 + lane * 4 + 256 * j);
                        v[tt][j] = (v[tt][j] - mu) * rstd * gg + bb;
                        store4bf(H1B + (size_t)(n0 + tt) * 1024 + lane * 4 + 256 * j, v[tt][j]);
                    }
                    if (lane == 0) { float* st1 = (float*)(ws + OFF_ST1); st1[2 * (n0 + tt)] = mu; st1[2 * (n0 + tt) + 1] = rstd; }
                }
                f32x4 acc0 = zero4(), acc1 = zero4();
                const int mt = wave & 3, nt0 = (wave < 4) ? 0 : 2;
                const bool two = wave < 4;
#pragma unroll
                for (int j = 0; j < 4; ++j) {
                    const int wrow = tid >> 5, wch = tid & 31;
                    const bf16_t* wsrc = wrt + (size_t)wrow * 1024 + j * 256 + wch * 8;
                    const uint4 w0 = *(const uint4*)(wsrc), w1 = *(const uint4*)(wsrc + 16 * 1024), w2 = *(const uint4*)(wsrc + 32 * 1024),
                                w3 = *(const uint4*)(wsrc + 48 * 1024), w4 = *(const uint4*)(wsrc + 64 * 1024), w5 = *(const uint4*)(wsrc + 80 * 1024);
                    __syncthreads();
#pragma unroll
                    for (int tt = 0; tt < 8; ++tt) {
                        const f32x4 x = v[tt][j];
                        const unsigned h0 = f2bf(x[0]), h1 = f2bf(x[1]), h2 = f2bf(x[2]), h3 = f2bf(x[3]);
                        uint2 hi, lo;
                        hi.x = h0 | (h1 << 16); hi.y = h2 | (h3 << 16);
                        lo.x = pk2(x[0] - bf2f(h0), x[1] - bf2f(h1)); lo.y = pk2(x[2] - bf2f(h2), x[3] - bf2f(h3));
                        *(uint2*)(Ahi + (wave * 8 + tt) * AP + lane * 4) = hi;
                        *(uint2*)(Alo + (wave * 8 + tt) * AP + lane * 4) = lo;
                    }
                    {
                        bf16_t* wd = WL + wrow * AP + wch * 8;
                        *(uint4*)(wd) = w0; *(uint4*)(wd + 16 * AP) = w1; *(uint4*)(wd + 32 * AP) = w2;
                        *(uint4*)(wd + 48 * AP) = w3; *(uint4*)(wd + 64 * AP) = w4; *(uint4*)(wd + 80 * AP) = w5;
                    }
                    __syncthreads();
#pragma unroll 2
                    for (int kk = 0; kk < 8; ++kk) {
                        const int ko = kk * 32 + (lane >> 4) * 8;
                        const bf16x8 ah = *(const bf16x8*)(Ahi + (mt * 16 + (lane & 15)) * AP + ko);
                        const bf16x8 al = *(const bf16x8*)(Alo + (mt * 16 + (lane & 15)) * AP + ko);
                        {
                            const bf16_t* wp = WL + (nt0 * 16 + (lane & 15)) * AP + ko;
                            const bf16x8 bh = *(const bf16x8*)wp, bl = *(const bf16x8*)(wp + 48 * AP);
                            acc0 = __builtin_amdgcn_mfma_f32_16x16x32_bf16(ah, bh, acc0, 0, 0, 0);
                            acc0 = __builtin_amdgcn_mfma_f32_16x16x32_bf16(ah, bl, acc0, 0, 0, 0);
                            acc0 = __builtin_amdgcn_mfma_f32_16x16x32_bf16(al, bh, acc0, 0, 0, 0);
                        }
                        if (two) {
                            const bf16_t* wp = WL + (16 + (lane & 15)) * AP + ko;
                            const bf16x8 bh = *(const bf16x8*)wp, bl = *(const bf16x8*)(wp + 48 * AP);
                            acc1 = __builtin_amdgcn_mfma_f32_16x16x32_bf16(ah, bh, acc1, 0, 0, 0);
                            acc1 = __builtin_amdgcn_mfma_f32_16x16x32_bf16(ah, bl, acc1, 0, 0, 0);
                            acc1 = __builtin_amdgcn_mfma_f32_16x16x32_bf16(al, bh, acc1, 0, 0, 0);
                        }
                    }
                }
#pragma unroll
                for (int i = 0; i < 4; ++i) {
                    LG[(mt * 16 + (lane >> 4) * 4 + i) * 49 + nt0 * 16 + (lane & 15)] = acc0[i];
                    if (two) LG[(mt * 16 + (lane >> 4) * 4 + i) * 49 + 16 + (lane & 15)] = acc1[i];
                }
                __syncthreads();
                int my_e1 = 0, my_e2 = 0; float my_g1 = 0.f, my_g2 = 0.f;
#pragma unroll 2
                for (int tt = 0; tt < 8; ++tt) {
                    float mylg = (lane < 36) ? LG[(wave * 8 + tt) * 49 + lane] : 0.f;
                    mylg += (lane < 4) ? brg[lane] : ((lane < 36) ? bre[lane - 4] : 0.f);
                    float gl[4];
#pragma unroll
                    for (int i = 0; i < 4; ++i) gl[i] = __shfl(mylg, i);
                    int gs = 0; float gm = gl[0];
#pragma unroll
                    for (int i = 1; i < 4; ++i) if (gl[i] > gm) { gm = gl[i]; gs = i; }
                    float den = 0.f;
#pragma unroll
                    for (int i = 0; i < 4; ++i) den += __expf(gl[i] - gm);
                    const float pg = 1.0f / den;
                    float el[8];
#pragma unroll
                    for (int j = 0; j < 8; ++j) el[j] = __shfl(mylg, 4 + gs * 8 + j);
                    int i1 = 0; float l1 = el[0];
#pragma unroll
                    for (int j = 1; j < 8; ++j) if (el[j] > l1) { l1 = el[j]; i1 = j; }
                    int i2 = -1; float l2 = -3.0e38f;
#pragma unroll
                    for (int j = 0; j < 8; ++j) if (j != i1 && el[j] > l2) { l2 = el[j]; i2 = j; }
                    const float w1 = 1.0f / (1.0f + __expf(l2 - l1)), w2 = 1.0f - w1;
                    if (lane == tt) { my_e1 = gs * 8 + i1; my_e2 = gs * 8 + i2; my_g1 = pg * w1; my_g2 = pg * w2; }
                }
                unsigned r1 = 0, r2 = 0;
                if (lane < 8) { r1 = atomicAdd(&lcnt[my_e1], 1u); r2 = atomicAdd(&lcnt[my_e2], 1u); }
                __syncthreads();
                if (tid < 32) { const int t2 = ltid(); const unsigned c = lcnt[t2]; lcnt[32 + t2] = c ? atomicAdd(&ctl[CW_ECNT + t2 * ECS], c) : 0u; }
                __syncthreads();
                if (lane < 8) {
                    const int n = n0 + lane;
                    TOKL[my_e1 * 32768 + lcnt[32 + my_e1] + r1] = n * 2;
                    TOKL[my_e2 * 32768 + lcnt[32 + my_e2] + r2] = n * 2 + 1;
                    GW[n * 2] = my_g1; GW[n * 2 + 1] = my_g2;
                }
                __syncthreads();
            }
        }
        if (PH(8) && ph == 8) {
            const int tid = ltid(), lane = tid & 63, wave = __builtin_amdgcn_readfirstlane(tid >> 6); (void)lane; (void)wave;
            int* ecnt_s = (int*)(smem + LDS_BYTES - 1024);
            if (tid < 32) ecnt_s[tid] = (int)ctl[CW_ECNT + tid * ECS];
            __syncthreads();
            if (tid == 0) { int cp = 0, rb = 0; for (int e = 0; e < 32; ++e) { ecnt_s[32 + e] = cp; ecnt_s[64 + e] = rb; const int nc = (ecnt_s[e] + 255) >> 8; cp += nc; rb += nc * 256; } ecnt_s[96] = cp; }
            __syncthreads();
            const int nchunks = ecnt_s[96];
            const int* TOKL = (const int*)(ws + OFF_TOKL);
            bf16_t* HID = (bf16_t*)(ws + OFF_HID);
            const int NNT = (ph == 8) ? 4 : 8;
            for (int tile = bid; tile < nchunks * NNT; tile += G) {
                const int ch = tile / NNT, nt = tile % NNT;
                int e = 0;
#pragma unroll 1
                for (int k = 1; k < 32; ++k) if (ecnt_s[32 + k] <= ch) e = k;
                const int c_in_e = ch - ecnt_s[32 + e];
                const int cnt = ecnt_s[e];
                const int rowbase = ecnt_s[64 + e] + c_in_e * 256;
                const int pos0 = c_in_e * 256;
                const int rl = (wave >> 1) * 64, c4 = (lane >> 4) * 4;
                if (PH(8) && ph == 8) {
                    const bf16_t* H1B = (const bf16_t*)(ws + OFF_H1B);
                    const bf16_t* WGU = (const bf16_t*)(ws + OFF_WGU) + (size_t)e * 512 * 1024;
                    const bf16_t* ap[4]; const bf16_t* bp[2];
#pragma unroll
                    for (int i = 0; i < 4; ++i) {
                        int pos = pos0 + (tid >> 3) + 64 * i; pos = pos < cnt ? pos : cnt - 1;
                        const int aid = TOKL[e * 32768 + pos];
                        ap[i] = H1B + (size_t)(aid >> 1) * 1024 + (tid & 7) * 8;
                    }
#pragma unroll
                    for (int i = 0; i < 2; ++i) bp[i] = WGU + (size_t)(nt * 128 + (tid >> 3) + 64 * i) * 1024 + (tid & 7) * 8;
                    f32x4 acc[4][4]; zero_acc(acc);
                    gemm_core(ap, bp, 1024, (bf16_t*)smem, acc);
                    const int hc0 = (nt * 128 + (wave & 1) * 64) >> 1;
#pragma unroll
                    for (int mi = 0; mi < 4; ++mi) {
                        const int rr = rl + mi * 16 + (lane & 15);
                        bf16_t* dst = HID + (size_t)(rowbase + rr) * 256 + hc0 + c4;
#pragma unroll
                        for (int pr = 0; pr < 2; ++pr) {
                            f32x4 hv;
#pragma unroll
                            for (int j = 0; j < 4; ++j) { const float gte = acc[mi][2 * pr][j], up = acc[mi][2 * pr + 1][j]; hv[j] = gte * sigmoidf_(gte) * up; }
                            if (FUSE89) store4bf_agent(dst + pr * 16, hv); else store4bf(dst + pr * 16, hv);
                        }
                    }
                    if (FUSE89) {
                        asm volatile("s_waitcnt vmcnt(0)" ::: "memory");
                        __syncthreads();
                        if (ltid() == 0) (void)__hip_atomic_fetch_add(&ctl[CW_DONE + ch], 1u, __ATOMIC_RELAXED, __HIP_MEMORY_SCOPE_AGENT);
                    }
                } else {
                    const bf16_t* WD = (const bf16_t*)(ws + OFF_WD) + (size_t)e * 1024 * 256;
                    const float* GW = (const float*)(ws + OFF_GW);
                    bf16_t* SLOT = (bf16_t*)(ws + OFF_SLOT);
                    const bf16_t* ap[4]; const bf16_t* bp[2];
                    dense_ptrs(HID, 256, rowbase, WD, 256, nt * 128, ap, bp);
                    f32x4 acc[4][4]; zero_acc(acc);
                    gemm_core(ap, bp, 256, (bf16_t*)smem, acc);
                    const int cbase = nt * 128 + (wave & 1) * 64;
#pragma unroll
                    for (int mi = 0; mi < 4; ++mi) {
                        const int pos = pos0 + rl + mi * 16 + (lane & 15);
                        if (pos < cnt) {
                            const int aid = TOKL[e * 32768 + pos];
                            const float gw = GW[aid];
                            bf16_t* dst = SLOT + (size_t)aid * 1024 + cbase + c4;
#pragma unroll
                            for (int ni = 0; ni < 4; ++ni) store4bf(dst + ni * 16, acc[mi][ni] * gw);
                        }
                    }
                }
            }
        }
        if (PH(10) && ph == 10) {
            const int tid = ltid(), lane = tid & 63, wave = __builtin_amdgcn_readfirstlane(tid >> 6); (void)tid;
            const bf16_t* SLOT = (const bf16_t*)(ws + OFF_SLOT);
            const float* g2 = kp->in[20]; const float* b2 = kp->in[21];
            const bf16_t* H1B = (const bf16_t*)(ws + OFF_H1B);
            for (int n0 = (bid * 8 + wave) * 4; n0 < NTOK; n0 += G * 8 * 4) {
                f32x4 v[4][4];
#pragma unroll
                for (int rr = 0; rr < 4; ++rr) {
                    const int n = n0 + rr;
#pragma unroll
                    for (int j = 0; j < 4; ++j) {
                        const int c = lane * 4 + 256 * j;
                        const uint2 hb = *(const uint2*)(H1B + (size_t)n * 1024 + c);
                        const f32x4 hv = {bf2f(hb.x & 0xffffu), bf2f(hb.x >> 16), bf2f(hb.y & 0xffffu), bf2f(hb.y >> 16)};
                        const uint2 u0 = *(const uint2*)(SLOT + (size_t)(2 * n) * 1024 + c), u1 = *(const uint2*)(SLOT + (size_t)(2 * n + 1) * 1024 + c);
                        f32x4 f; f[0] = bf2f(u0.x & 0xffffu) + bf2f(u1.x & 0xffffu); f[1] = bf2f(u0.x >> 16) + bf2f(u1.x >> 16);
                        f[2] = bf2f(u0.y & 0xffffu) + bf2f(u1.y & 0xffffu); f[3] = bf2f(u0.y >> 16) + bf2f(u1.y >> 16);
                        v[rr][j] = hv * ALPHA + f;
                    }
                }
#pragma unroll
                for (int rr = 0; rr < 4; ++rr) {
                    float s = 0.f;
#pragma unroll
                    for (int j = 0; j < 4; ++j) s += (v[rr][j][0] + v[rr][j][1]) + (v[rr][j][2] + v[rr][j][3]);
                    const float mu = wave_sum(s) * (1.0f / 1024.0f);
                    float q = 0.f;
#pragma unroll
                    for (int j = 0; j < 4; ++j) { const f32x4 d = v[rr][j] - mu; q += (d[0] * d[0] + d[1] * d[1]) + (d[2] * d[2] + d[3] * d[3]); }
                    const float rstd = rsqrtf(wave_sum(q) * (1.0f / 1024.0f) + LN_EPS);
                    float* row = kp->out + (size_t)(n0 + rr) * 1024;
#pragma unroll
                    for (int j = 0; j < 4; ++j) {
                        const int c = lane * 4 + 256 * j;
                        const f32x4 gg = *(const f32x4*)(g2 + c), bb = *(const f32x4*)(b2 + c);
                        *(f32x4*)(row + c) = (v[rr][j] - mu) * rstd * gg + bb;
                    }
                }
            }
        }
    }
    if (TIME_PH >= 0 && blockIdx.x == (TIME_PH >= 100 ? TIME_BLK : 0)) {
        __syncthreads();
        if (threadIdx.x == 0) {
            volatile LAS unsigned* ts = (volatile LAS unsigned*)(smem + LDS_BYTES - 64);
            const unsigned long long t0 = ((unsigned long long)ts[5] << 32) | ts[4];
            const unsigned long long tnow = wall_clock64();
            const unsigned long long t1 = (TIME_PH == NPHASES - 1) ? tnow : (((unsigned long long)ts[7] << 32) | ts[6]);
            unsigned long long d = t1 - t0; if (d > 100000ull) d = 100000ull;
            while (wall_clock64() - tnow < d) __builtin_amdgcn_s_sleep(8);
        }
    }
}

extern "C" void kernel_launch(void* const* d_in, const int* in_sizes, int n_in, void* d_out, int out_size, void* d_ws, size_t ws_size, hipStream_t stream) {
    static int grid = 0;
    if (grid == 0) {
        int dev = 0, cus = 0, per_cu = 0;
        hipGetDevice(&dev);
        hipDeviceGetAttribute(&cus, hipDeviceAttributeMultiprocessorCount, dev);
        hipOccupancyMaxActiveBlocksPerMultiprocessor(&per_cu, (const void*)mega, NTHREADS, 0);
        if (per_cu < 1) per_cu = 1;
        if (per_cu > 1) per_cu = 1;
        grid = cus * per_cu;
        if (n_in != 22 || ws_size < WS_END) { fprintf(stderr, "kernel_launch: unexpected n_in %d / ws_size %zu (need %zu)\n", n_in, ws_size, (size_t)WS_END); }
    }
    hipMemsetAsync((char*)d_ws + OFF_CTL, 0, 32768, stream);
    Params p{};
    for (int i = 0; i < 22; ++i) p.in[i] = (const float*)d_in[i];
    p.out = (float*)d_out; p.ws = (unsigned char*)d_ws;
#if N_LAUNCH_MODE == 0
    p.ph_lo = 0; p.ph_hi = NPHASES + (REPEAT_PH >= 0 ? 1 : 0) + EXTRA_SYNCS;
    void* args[] = {&p};
    hipError_t e = hipLaunchCooperativeKernel((const void*)mega, dim3(grid), dim3(NTHREADS), args, 0, stream);
    if (e != hipSuccess) fprintf(stderr, "cooperative launch failed: %s (grid %d)\n", hipGetErrorString(e), grid);
#else
    for (int ph = 0; ph < NPHASES; ++ph) {
        p.ph_lo = ph; p.ph_hi = ph + 1;
        hipLaunchKernelGGL(mega, dim3(grid), dim3(NTHREADS), 0, stream, p);
    }
#endif
}
```

```cpp
#include <hip/hip_runtime.h>
#include <hip/hip_cooperative_groups.h>
#include <hip/hip_bf16.h>
#include <stdint.h>
#include <stdio.h>
namespace cg = cooperative_groups;

#ifndef ONLY_PHASE
#define ONLY_PHASE -1
#endif
#ifndef PH_MASK
#define PH_MASK 0x7ff
#endif
#define PH(k) ((ONLY_PHASE < 0 || ONLY_PHASE == (k)) && ((PH_MASK >> (k)) & 1))
#ifndef REPEAT_PH
#define REPEAT_PH -1
#endif
#ifndef IDX_REP_MFMA
#define IDX_REP_MFMA 1
#endif
#ifndef P7_REP
#define P7_REP 1
#endif
#ifndef P10_REP
#define P10_REP 1
#endif
#ifndef ATT_PROBE
#define ATT_PROBE 0
#endif
#ifndef IDX_PROBE
#define IDX_PROBE 0
#endif
#ifndef IDX_REP_SEL
#define IDX_REP_SEL 1
#endif
#ifndef IDX_REP
#define IDX_REP 1
#endif
#ifndef TIME_PH
#define TIME_PH -1
#endif
#ifndef TIME_BLK
#define TIME_BLK 0
#endif
#define TS_STAMP(id, slot) do { if (TIME_PH == 100 + (id) && blockIdx.x == TIME_BLK && threadIdx.x == 0) { const unsigned long long tt_ = wall_clock64(); \
    volatile __attribute__((address_space(3))) unsigned* ts_ = (volatile __attribute__((address_space(3))) unsigned*)(smem + LDS_BYTES - 64) + (slot); ts_[0] = (unsigned)tt_; ts_[1] = (unsigned)(tt_ >> 32); } } while (0)
#define TS_BEGIN(id) TS_STAMP(id, 4)
#define TS_END(id) TS_STAMP(id, 6)
#ifndef FUSE89
#define FUSE89 1
#endif
#ifndef EXTRA_SYNCS
#define EXTRA_SYNCS 0
#endif
#ifndef N_LAUNCH_MODE
#define N_LAUNCH_MODE 0
#endif

typedef unsigned short bf16_t;
typedef short bf16x8 __attribute__((ext_vector_type(8)));
typedef float f32x4 __attribute__((ext_vector_type(4)));
typedef float f32x16 __attribute__((ext_vector_type(16)));

constexpr int NB = 2, SEQ = 8192, DM = 1024, NMETA = 16;
constexpr int T = SEQ + NMETA;
constexpr int TP = 8448;
constexpr int R = NB * TP;
constexpr int NTOK = NB * SEQ;
constexpr int NP = 5120;
constexpr int MW = TP / 64;
constexpr float LN_EPS = 1e-5f, RMS_EPS = 1e-6f;
constexpr float ALPHA = 1.189207115002721f;
constexpr float LOG2E = 1.4426950408889634f;
constexpr float QSCALE = 0.125f * LOG2E;
constexpr int NTHREADS = 512;
constexpr int NPHASES = 11;

constexpr size_t al256(size_t x) { return (x + 255) & ~size_t(255); }
constexpr size_t OFF_CTL = 0;
constexpr size_t OFF_ROPE = 65536;
constexpr size_t OFF_STAT0 = OFF_ROPE + al256((size_t)TP * 16 * 4);
constexpr size_t OFF_WRT = OFF_STAT0 + al256((size_t)R * 8);
constexpr size_t OFF_WIN = OFF_WRT + (size_t)2 * 48 * 1024 * 2;
constexpr size_t OFF_WKV = OFF_WIN + (size_t)NP * 1024 * 2;
constexpr size_t OFF_WA = OFF_WKV + (size_t)1024 * 256 * 2;
constexpr size_t OFF_WF = OFF_WA + (size_t)1024 * 512 * 2;
constexpr size_t OFF_WO = OFF_WF + (size_t)1024 * 512 * 2;
constexpr size_t OFF_HB = OFF_WO + (size_t)1024 * 1024 * 2;
constexpr size_t OFF_HBM = OFF_HB + (size_t)NTOK * 1024 * 2;
constexpr size_t OFF_QI = OFF_HB + (size_t)R * 1024 * 2;
constexpr size_t OFF_QA = OFF_QI + (size_t)R * 512 * 2;
constexpr size_t OFF_QF = OFF_QA + (size_t)R * 512 * 2;
constexpr size_t OFF_KF = OFF_QF + (size_t)R * 512 * 2;
constexpr size_t OFF_VF = OFF_KF + (size_t)R * 512 * 2;
constexpr size_t OFF_KA = OFF_VF + (size_t)R * 512 * 2;
constexpr size_t OFF_VA = OFF_KA + (size_t)R * 512 * 2;
constexpr size_t OFF_KI = OFF_VA + (size_t)R * 512 * 2;
constexpr size_t OFF_WI = OFF_KI + (size_t)R * 64 * 2;
constexpr size_t OFF_LOGF = OFF_WI + (size_t)R * 8 * 4;
constexpr size_t OFF_CUM = OFF_LOGF + (size_t)R * 8 * 4;
constexpr size_t OFF_CUMT = OFF_CUM + (size_t)R * 8 * 4;
constexpr size_t OFF_KNORM = OFF_CUMT + (size_t)R * 8 * 4;
constexpr size_t OFF_CKV = OFF_KNORM + al256((size_t)NB * 8 * MW * 4);
constexpr size_t OFF_MASK = OFF_CKV + (size_t)R * 256 * 2;
constexpr size_t OFF_TOKL = OFF_MASK + (size_t)R * MW * 8;
constexpr size_t OFF_GW = OFF_TOKL + (size_t)32 * 32768 * 4;
constexpr int HID_ROWS = 32768 + 32 * 256;
constexpr size_t OFF_MCKV = OFF_GW + (size_t)NTOK * 2 * 4;
constexpr size_t OFF_ST1 = OFF_MCKV + 16 * 256 * 4;
constexpr size_t OFF_HID = OFF_ST1 + (size_t)NTOK * 2 * 4;
constexpr size_t OFF_YA = OFF_HID + (size_t)HID_ROWS * 256 * 2;
constexpr size_t OFF_YF = OFF_YA + (size_t)NTOK * 512 * 2;
constexpr size_t WS_END = OFF_YF + (size_t)NTOK * 512 * 2;
constexpr size_t OFF_WGU = OFF_HB;
constexpr size_t OFF_WD = OFF_WGU + (size_t)32 * 512 * 1024 * 2;
constexpr size_t OFF_MERGED = OFF_KF;
constexpr size_t OFF_H1B = OFF_YA;
constexpr size_t OFF_SLOT = OFF_QA;
static_assert(OFF_WD + (size_t)32 * 1024 * 256 * 2 <= OFF_QA, "moe weights fit in HB+QI");
static_assert(OFF_MERGED + (size_t)NTOK * 1024 * 2 <= OFF_KA, "merged fits");
static_assert(OFF_H1B + (size_t)NTOK * 1024 * 2 <= WS_END, "h1b fits");
static_assert(OFF_SLOT + (size_t)NTOK * 2 * 1024 * 2 <= OFF_KA, "slot fits");
static_assert(WS_END <= (size_t)256 * 1024 * 1024, "workspace");

constexpr int CW_Q3 = 0, CW_Q4 = 64, CW_ECNT = 128, ECS = 64, CW_DONE = 2304, CW_BAR = 4096;

constexpr int SCP = TP + 16;
constexpr int HP = 264;
constexpr int LDS_IDX = 8 * SCP * 2 + 8 * HP * 4;
constexpr int LDS_ROUTER = 36 * 1024 * 4;
constexpr int LDS_GEMM = 2 * (256 * 64 + 128 * 64) * 2 + 1024;
constexpr int LDS_BYTES = 150528;

struct Params {
    const float* in[22];
    float* out;
    unsigned char* ws;
    int ph_lo, ph_hi;
};

typedef const __attribute__((address_space(4))) Params* KParams;
__device__ __forceinline__ f32x4 zero4() { float z = 0.f; asm volatile("" : "+v"(z)); return (f32x4){z, z, z, z}; }
__device__ __forceinline__ uint4 zero4u() { unsigned z = 0u; asm volatile("" : "+v"(z)); return make_uint4(z, z, z, z); }
__device__ __forceinline__ int ltid() { int t = threadIdx.x; asm volatile("" : "+v"(t)); return t; }
__device__ __forceinline__ unsigned f2bf(float f) { unsigned u = __float_as_uint(f); return (u + 0x7fffu + ((u >> 16) & 1u)) >> 16; }
typedef __bf16 bf16x2_t __attribute__((ext_vector_type(2)));
typedef float f32x2 __attribute__((ext_vector_type(2)));
__device__ __forceinline__ unsigned pk2(float lo, float hi) { f32x2 v = {lo, hi}; bf16x2_t b = __builtin_convertvector(v, bf16x2_t); return __builtin_bit_cast(unsigned, b); }
__device__ __forceinline__ float bf2f(unsigned h) { return __uint_as_float(h << 16); }
template <int CTRL> __device__ __forceinline__ float dppf(float v) { return __uint_as_float((unsigned)__builtin_amdgcn_update_dpp(0, (int)__float_as_uint(v), CTRL, 0xf, 0xf, true)); }
__device__ __forceinline__ float wave_sum(float v) {
    v += dppf<0xB1>(v);
    v += dppf<0x4E>(v);
    v += dppf<0x124>(v);
    v += dppf<0x128>(v);
    const float a = __uint_as_float((unsigned)__builtin_amdgcn_readlane((int)__float_as_uint(v), 0)), b = __uint_as_float((unsigned)__builtin_amdgcn_readlane((int)__float_as_uint(v), 16));
    const float c = __uint_as_float((unsigned)__builtin_amdgcn_readlane((int)__float_as_uint(v), 32)), d = __uint_as_float((unsigned)__builtin_amdgcn_readlane((int)__float_as_uint(v), 48));
    return (a + b) + (c + d);
}
__device__ __forceinline__ float sigmoidf_(float v) { return 1.0f / (1.0f + __expf(-v)); }

__device__ __forceinline__ int win_oldcol(int n) {
    if (n < 1344) return n;
    if (n < 2880) return n + 8;
    if (n < 4928) return n + 16;
    if (n < 4936) return 1344 + (n - 4928);
    if (n < 4944) return 2888 + (n - 4936);
    return -1;
}

template <class ColMap>
__device__ __forceinline__ void xpose64(const float* __restrict__ src, int src_ld, bf16_t* __restrict__ dst, int dst_ld, int k0, int n0, ColMap cm,
                                        const float* __restrict__ kscale, float* tile) {
    const int tid = ltid();
    {
        const int nn = tid & 63; const int sc = cm(n0 + nn);
#pragma unroll
        for (int i = 0; i < 8; ++i) {
            const int kk = (tid >> 6) + 8 * i;
            float v = 0.f;
            if (sc >= 0) { v = src[(size_t)(k0 + kk) * src_ld + sc]; if (kscale) v *= kscale[k0 + kk]; }
            tile[kk * 65 + nn] = v;
        }
    }
    __syncthreads();
    {
        const int kp = tid & 31;
#pragma unroll
        for (int i = 0; i < 4; ++i) {
            const int nn = (tid >> 5) + 16 * i;
            const unsigned u = pk2(tile[(2 * kp) * 65 + nn], tile[(2 * kp + 1) * 65 + nn]);
            *(unsigned*)(dst + (size_t)(n0 + nn) * dst_ld + k0 + 2 * kp) = u;
        }
    }
    __syncthreads();
}


struct XTile { const float* src; bf16_t* dst; const float* kscale; int src_ld, dst_ld, k0, j0, rb, s16, winmap; };
template <class Decode>
__device__ __forceinline__ void xpose_group(int g4, int ntiles, Decode dec, float* tiles  ) {
    const int tid = ltid();
    const int nn = tid & 63, kr = tid >> 6;
    float v[4][8];
    XTile xt[4];
#pragma unroll
    for (int q = 0; q < 4; ++q) {
        const int it = g4 * 4 + q;
        if (it < ntiles) {
            xt[q] = dec(it);
            const int sc = xt[q].winmap ? win_oldcol(xt[q].j0 + nn) : (xt[q].j0 + nn);
#pragma unroll
            for (int i = 0; i < 8; ++i) {
                const int kk = kr + 8 * i;
                float x = 0.f;
                if (sc >= 0) x = xt[q].src[(size_t)(xt[q].k0 + kk) * xt[q].src_ld + sc];
                v[q][i] = x;
            }
        }
    }
#pragma unroll
    for (int q = 0; q < 4; ++q)
        if (g4 * 4 + q < ntiles) {
#pragma unroll
            for (int i = 0; i < 8; ++i) {
                const int kk = kr + 8 * i;
                float x = v[q][i];
                if (xt[q].kscale) x *= xt[q].kscale[xt[q].k0 + kk];
                tiles[q * 4160 + kk * 65 + nn] = x;
            }
        }
    __syncthreads();
    {
        const int kp = tid & 31;
#pragma unroll
        for (int q = 0; q < 4; ++q)
            if (g4 * 4 + q < ntiles) {
#pragma unroll
                for (int i = 0; i < 4; ++i) {
                    const int vr = (tid >> 5) + 16 * i;
                    const int row = xt[q].rb + (vr >> 4) * xt[q].s16 + (vr & 15);
                    *(unsigned*)(xt[q].dst + (size_t)row * xt[q].dst_ld + xt[q].k0 + 2 * kp) = pk2(tiles[q * 4160 + (2 * kp) * 65 + vr], tiles[q * 4160 + (2 * kp + 1) * 65 + vr]);
                }
            }
    }
    __syncthreads();
}
template <class Decode>
__device__ __forceinline__ void xpose_many(int ntiles, int G, int bid, Decode dec, float* tiles) {
    for (int g4 = bid; g4 * 4 < ntiles; g4 += G) xpose_group(g4, ntiles, dec, tiles);
}
__device__ __forceinline__ XTile moe_tile(KParams kq, unsigned char* wsq, int it) {
    XTile x; x.kscale = nullptr; x.winmap = 0;
    const int which = it / 2048, rem = it % 2048, e = rem / 64, i = rem % 64;
    if (which < 2) {
        x.src = kq->in[which == 0 ? 17 : 18] + (size_t)e * 1024 * 256; x.src_ld = 256;
        x.dst = (bf16_t*)(wsq + OFF_WGU) + (size_t)e * 512 * 1024; x.dst_ld = 1024;
        x.k0 = (i % 16) * 64; x.j0 = (i / 16) * 64; x.rb = (x.j0 >> 4) * 32 + which * 16; x.s16 = 32;
    } else {
        x.src = kq->in[19] + (size_t)e * 256 * 1024; x.src_ld = 1024;
        x.dst = (bf16_t*)(wsq + OFF_WD) + (size_t)e * 1024 * 256; x.dst_ld = 256;
        x.k0 = (i % 4) * 64; x.j0 = (i / 4) * 64; x.rb = x.j0; x.s16 = 16;
    }
    return x;
}

constexpr int GEMM_BUF = 256 * 64 + 128 * 64;
__device__ __forceinline__ void gemm_core(const bf16_t* const (&ap)[4], const bf16_t* const (&bp)[2], int K, bf16_t* sm, f32x4 (&acc)[4][4]) {
    const int tid = ltid(), lane = tid & 63, wave = __builtin_amdgcn_readfirstlane(tid >> 6);
    const int wm = wave >> 1, wn = wave & 1;
    const int swz = ((tid & 7) ^ ((tid >> 4) & 7)) * 8;
    const int woff = (tid >> 3) * 64 + swz;
    uint4 ra[4], rb[2];
#pragma unroll
    for (int i = 0; i < 4; ++i) ra[i] = *(const uint4*)(ap[i]);
#pragma unroll
    for (int i = 0; i < 2; ++i) rb[i] = *(const uint4*)(bp[i]);
#pragma unroll
    for (int i = 0; i < 4; ++i) *(uint4*)(sm + woff + 4096 * i) = ra[i];
#pragma unroll
    for (int i = 0; i < 2; ++i) *(uint4*)(sm + 16384 + woff + 4096 * i) = rb[i];
    __syncthreads();
    const int nk = K >> 6;
    const int rsw = (lane >> 1) & 7;
    for (int kt = 0; kt < nk; ++kt) {
        const int cur = kt & 1;
        if (kt + 1 < nk) {
#pragma unroll
            for (int i = 0; i < 4; ++i) ra[i] = *(const uint4*)(ap[i] + (kt + 1) * 64);
#pragma unroll
            for (int i = 0; i < 2; ++i) rb[i] = *(const uint4*)(bp[i] + (kt + 1) * 64);
        }
        const bf16_t* sa = sm + cur * GEMM_BUF;
        const bf16_t* sb = sa + 16384;
#pragma unroll
        for (int ks = 0; ks < 2; ++ks) {
            const int coff = ((ks * 4 + (lane >> 4)) ^ rsw) * 8;
            bf16x8 af[4], bfr[4];
#pragma unroll
            for (int mi = 0; mi < 4; ++mi) af[mi] = *(const bf16x8*)(sa + (wm * 64 + mi * 16 + (lane & 15)) * 64 + coff);
#pragma unroll
            for (int ni = 0; ni < 4; ++ni) bfr[ni] = *(const bf16x8*)(sb + (wn * 64 + ni * 16 + (lane & 15)) * 64 + coff);
#pragma unroll
            for (int mi = 0; mi < 4; ++mi)
#pragma unroll
                for (int ni = 0; ni < 4; ++ni) acc[mi][ni] = __builtin_amdgcn_mfma_f32_16x16x32_bf16(bfr[ni], af[mi], acc[mi][ni], 0, 0, 0);
        }
        if (kt + 1 < nk) {
            bf16_t* dn = sm + (cur ^ 1) * GEMM_BUF;
#pragma unroll
            for (int i = 0; i < 4; ++i) *(uint4*)(dn + woff + 4096 * i) = ra[i];
#pragma unroll
            for (int i = 0; i < 2; ++i) *(uint4*)(dn + 16384 + woff + 4096 * i) = rb[i];
        }
        __syncthreads();
    }
}
__device__ __forceinline__ void zero_acc(f32x4 (&acc)[4][4]) {
#pragma unroll
    for (int i = 0; i < 4; ++i)
#pragma unroll
        for (int j = 0; j < 4; ++j) acc[i][j] = zero4();
}
__device__ __forceinline__ void dense_ptrs(const bf16_t* A, int lda, int row0, const bf16_t* Bt, int ldb, int col0, const bf16_t* (&ap)[4], const bf16_t* (&bp)[2]) {
    const int tid = ltid();
#pragma unroll
    for (int i = 0; i < 4; ++i) ap[i] = A + (size_t)(row0 + (tid >> 3) + 64 * i) * lda + (tid & 7) * 8;
#pragma unroll
    for (int i = 0; i < 2; ++i) bp[i] = Bt + (size_t)(col0 + (tid >> 3) + 64 * i) * ldb + (tid & 7) * 8;
}

__device__ __forceinline__ void rope_tile(f32x4& v, const float* __restrict__ rope, int t, int lane) {
    const int ib = ((lane >> 4) & 1) * 4;
    const float* rp = rope + (size_t)t * 16 + ib * 2;
#pragma unroll
    for (int j = 0; j < 4; ++j) {
        const float x = v[j];
        const float pr = __shfl_xor(x, 32);
        const float c = rp[2 * j], s = rp[2 * j + 1];
        v[j] = (lane < 32) ? (x * c - pr * s) : (x * c + pr * s);
    }
}
__device__ __forceinline__ void store4bf(bf16_t* dst, const f32x4& v) {
    uint2 u; u.x = pk2(v[0], v[1]); u.y = pk2(v[2], v[3]);
    *(uint2*)dst = u;
}
__device__ __forceinline__ void store4bf_agent(bf16_t* dst, const f32x4& v) {
    const unsigned long long u = (unsigned long long)pk2(v[0], v[1]) | ((unsigned long long)pk2(v[2], v[3]) << 32);
    __hip_atomic_store((unsigned long long*)dst, u, __ATOMIC_RELAXED, __HIP_MEMORY_SCOPE_AGENT);
}

namespace pg8 {
#define PG8_LAS __attribute__((address_space(3)))
constexpr int BM = 256, BK = 64, HALF = 128, HTB = HALF * BK * 2  , STAGE_BYTES = 8 * HTB, NXCD = 8, WGM = 8;

__host__ __device__ __forceinline__ int lds_byte(int r, int c) { const int st = (r >> 4) * 2 + (c >> 5), rr = r & 15, cc = c & 31, ob = rr * 64 + cc * 2; return st * 1024 + (ob ^ (((ob >> 9) & 1) << 5)); }
__host__ __device__ __forceinline__ void stage_rc(int b, int& R, int& C) { const int st = b / 1024, sb = b % 1024, swz = sb ^ (((sb >> 9) & 1) << 5); R = (st >> 1) * 16 + swz / 64; C = (st & 1) * 32 + (swz % 64) / 2; }
__host__ __device__ __forceinline__ int perm32(int rho) { const int n = rho >> 4, i = rho & 15; return 8 * (i >> 2) + 4 * n + (i & 3); }

struct Unit { int pm, pn; };
struct Gemm { const bf16_t* A; const bf16_t* Bt; int M, N, K; };

struct StaticOrder {
    int nM, nN, nwg, G, c;
    const PG8_LAS int* tab;
    __host__ __device__ void init(int M, int N, int G_, int c_) { nM = M / BM; nN = N / BM; nwg = nM * nN; G = G_; c = c_; tab = nullptr; dep = nullptr; }
    const unsigned* dep;
    __device__ void init_moe(const PG8_LAS int* tab_, int G_, int c_, const unsigned* dep_) { nM = nN = nwg = 0; G = G_; c = c_; tab = tab_; dep = dep_; }
    __device__ bool next(int i, Unit& u) const {
        if (tab) {
            const int n9 = tab[96] * 4, rem = n9 % G, nlight = G - rem, r = (c - rem + G) % G;
            int L = r;
            if (i > 0) { if (r >= nlight) return false; L = G + (i - 1) * nlight + r; }
            if (L >= n9) return false;
            const int ch = L >> 2; int e = 0;
#pragma unroll 1
            for (int k = 1; k < 32; ++k) if (tab[32 + k] <= ch) e = k;
            u.pm = (tab[64 + e] >> 8) + (ch - tab[32 + e]); u.pn = e * 4 + (L & 3); return true;
        }
        const long L = (long)i * G + c; if (L >= nwg) return false;
        int wgid = (int)L; { const int q = nwg / NXCD, r = nwg % NXCD, xcd = wgid % NXCD, off = wgid / NXCD; wgid = (xcd < r ? xcd * (q + 1) : r * (q + 1) + (xcd - r) * q) + off; }
        const int nig = WGM * nN, gid = wgid / nig, fm = gid * WGM, gsz = (nM - fm) < WGM ? (nM - fm) : WGM;
        u.pm = fm + ((wgid % nig) % gsz); u.pn = (wgid % nig) / gsz; return true;
    }
    __device__ __forceinline__ void a_ready(const Unit& u) const {
        if (tab && dep) {
            if ((threadIdx.x & 63) == 0) { unsigned sp = 0; while (__hip_atomic_load(dep + u.pm, __ATOMIC_RELAXED, __HIP_MEMORY_SCOPE_AGENT) < 4u && ++sp < (1u << 22)) __builtin_amdgcn_s_sleep(2); }
            asm volatile("" ::: "memory");
        }
    }
    __device__ __forceinline__ void done(const Unit&) const {}
};

template <class Epi, class Sched, bool ALIGN_EPI = false, bool SP2 = false>
__device__ __forceinline__ void gemm_phase(PG8_LAS unsigned char* lds, const Gemm g, const Sched& S, const Epi& E) {
    const int tid = ltid(), wid = __builtin_amdgcn_readfirstlane(tid >> 6), lane = tid & 63, wr = wid >> 2, wc = wid & 3, fr = lane & 15, fq = lane >> 4;
    const int K = g.K, nt = K / BK;
    unsigned voffA[2], voffB[2];
#pragma unroll
    for (int i = 0; i < 2; ++i) { int R, C; stage_rc(tid * 16 + i * 8192, R, C); const int Rb = Epi::PERM ? ((R & ~31) + perm32(R & 31)) : R;
        voffA[i] = (unsigned)(R * K + C) * 2u; voffB[i] = (unsigned)(Rb * K + C) * 2u; }
    const size_t kstep = (size_t)(BK * 2);
    const size_t hstep = (size_t)HALF * K * 2;
    const size_t tstep = 2 * hstep;
    const unsigned ldsw = (unsigned)wid * 1024u;
    const int aoff = lds_byte(wr * 64 + fr, fq * 8), boff = lds_byte(wc * 32 + fr, fq * 8);
#define PG8_SA(b, h) (((b) * 2 + (h)) * HTB)
#define PG8_SB(b, h) ((4 + (b) * 2 + (h)) * HTB)
#define PG8_STAGE(bufoff, gbase, voff) do { _Pragma("unroll") for (int _i = 0; _i < 2; ++_i) \
        __builtin_amdgcn_global_load_lds((const unsigned*)((const char*)(gbase) + (voff)[_i]), (PG8_LAS unsigned*)(lds + (bufoff) + ldsw + _i * 8192), 16, 0, 0); } while (0)
#define PG8_LDA(dst, b, h) do { _Pragma("unroll") for (int m = 0; m < 4; ++m) _Pragma("unroll") for (int k = 0; k < 2; ++k) dst[m][k] = *(const PG8_LAS bf16x8*)(lds + PG8_SA(b, h) + aoff + m * 2048 + k * 1024); } while (0)
#define PG8_LDB(dst, b, h) do { _Pragma("unroll") for (int n = 0; n < 2; ++n) _Pragma("unroll") for (int k = 0; k < 2; ++k) dst[n][k] = *(const PG8_LAS bf16x8*)(lds + PG8_SB(b, h) + boff + n * 2048 + k * 1024); } while (0)
#define PG8_MMA(ai, bj, At, Bt) do { __builtin_amdgcn_s_setprio(1); _Pragma("unroll") for (int m = 0; m < 4; ++m) _Pragma("unroll") for (int n = 0; n < 2; ++n) _Pragma("unroll") for (int k = 0; k < 2; ++k) \
        acc[ai][bj][m][n] = __builtin_amdgcn_mfma_f32_16x16x32_bf16(Bt[n][k], At[m][k], acc[ai][bj][m][n], 0, 0, 0); __builtin_amdgcn_s_setprio(0); } while (0)
#define PG8_WAIT_V(n) asm volatile("s_waitcnt vmcnt(" #n ")" ::: "memory")
#define PG8_WAIT_L(n) asm volatile("s_waitcnt lgkmcnt(" #n ")" ::: "memory")
#define PG8_BAR __builtin_amdgcn_s_barrier()
#define PG8_SCHED __builtin_amdgcn_sched_barrier(0)
    Unit cur, nxt; int ui = 0;
    if (!S.next(0, cur)) return;
    f32x4 acc[2][2][4][2];
#pragma unroll
    for (int a = 0; a < 2; ++a)
#pragma unroll
        for (int b = 0; b < 2; ++b)
#pragma unroll
            for (int m = 0; m < 4; ++m)
#pragma unroll
                for (int n = 0; n < 2; ++n) acc[a][b][m][n] = zero4();
    bf16x8 At[4][2], B0[2][2], B1[2][2];
    const char* cA = (const char*)g.A + (size_t)cur.pm * tstep; const char* cB = (const char*)g.Bt + (size_t)cur.pn * tstep;
    S.a_ready(cur);
    if constexpr (SP2) {
        PG8_STAGE(PG8_SB(0, 0), cB, voffB); PG8_STAGE(PG8_SB(0, 1), cB + hstep, voffB); PG8_STAGE(PG8_SA(0, 0), cA, voffA); PG8_STAGE(PG8_SA(0, 1), cA + hstep, voffA);
        if (wr == 1) PG8_BAR;
        PG8_WAIT_V(2); PG8_BAR;
        PG8_STAGE(PG8_SB(1, 0), cB + kstep, voffB); PG8_STAGE(PG8_SA(1, 0), cA + kstep, voffA); PG8_STAGE(PG8_SB(1, 1), cB + hstep + kstep, voffB);
        PG8_WAIT_V(6); PG8_BAR;
    } else {
        PG8_STAGE(PG8_SB(0, 0), cB, voffB); PG8_STAGE(PG8_SA(0, 0), cA, voffA); PG8_STAGE(PG8_SB(0, 1), cB + hstep, voffB); PG8_STAGE(PG8_SA(0, 1), cA + hstep, voffA);
        if (wr == 1) PG8_BAR;
        PG8_WAIT_V(4); PG8_BAR;
        PG8_STAGE(PG8_SB(1, 0), cB + kstep, voffB); PG8_STAGE(PG8_SA(1, 0), cA + kstep, voffA); PG8_STAGE(PG8_SB(1, 1), cB + hstep + kstep, voffB);
        PG8_WAIT_V(6); PG8_BAR;
    }
    for (;;) {
        const bool has_next = S.next(ui + 1, nxt);
        const char* nA = has_next ? (const char*)g.A + (size_t)nxt.pm * tstep : cA; const char* nB = has_next ? (const char*)g.Bt + (size_t)nxt.pn * tstep : cB;
        for (int t = 0; t < nt; t += 2) {
            const bool last = (t == nt - 2);
            const char* a1 = cA + (size_t)(t + 1) * kstep;
            const char* a2 = last ? nA : cA + (size_t)(t + 2) * kstep; const char* b2 = last ? nB : cB + (size_t)(t + 2) * kstep;
            const char* a3 = a2 + kstep; const char* b3 = b2 + kstep;
            if (last && has_next) S.a_ready(nxt);
            if constexpr (SP2) {
            PG8_LDB(B0, 0, 0); PG8_LDB(B1, 0, 1); PG8_SCHED; PG8_LDA(At, 0, 0); PG8_STAGE(PG8_SA(1, 1), a1 + hstep, voffA);
            PG8_WAIT_V(8); PG8_WAIT_L(0); PG8_BAR; PG8_MMA(0, 0, At, B0); PG8_MMA(0, 1, At, B1); PG8_BAR; PG8_SCHED;
            PG8_LDA(At, 0, 1); PG8_STAGE(PG8_SB(0, 0), b2, voffB); PG8_STAGE(PG8_SB(0, 1), b2 + hstep, voffB); PG8_STAGE(PG8_SA(0, 0), a2, voffA);
            PG8_WAIT_V(8); PG8_WAIT_L(0); PG8_BAR; PG8_MMA(1, 0, At, B0); PG8_MMA(1, 1, At, B1); PG8_BAR; PG8_SCHED;
            PG8_LDB(B0, 1, 0); PG8_LDB(B1, 1, 1); PG8_SCHED; PG8_LDA(At, 1, 0); PG8_STAGE(PG8_SA(0, 1), a2 + hstep, voffA);
            PG8_WAIT_V(8); PG8_WAIT_L(0); PG8_BAR; PG8_MMA(0, 0, At, B0); PG8_MMA(0, 1, At, B1); PG8_BAR; PG8_SCHED;
            PG8_LDA(At, 1, 1); PG8_STAGE(PG8_SB(1, 0), b3, voffB); PG8_STAGE(PG8_SB(1, 1), b3 + hstep, voffB); PG8_STAGE(PG8_SA(1, 0), a3, voffA);
            PG8_WAIT_V(8); PG8_WAIT_L(0); PG8_BAR; PG8_MMA(1, 0, At, B0); PG8_MMA(1, 1, At, B1); PG8_BAR; PG8_SCHED;
            } else {
            PG8_LDB(B0, 0, 0); PG8_SCHED; PG8_LDA(At, 0, 0); PG8_STAGE(PG8_SA(1, 1), a1 + hstep, voffA);
            PG8_WAIT_L(8); PG8_BAR; PG8_WAIT_L(0); PG8_MMA(0, 0, At, B0); PG8_BAR; PG8_SCHED;
            PG8_LDB(B1, 0, 1); PG8_STAGE(PG8_SB(0, 0), b2, voffB);
            PG8_BAR; PG8_WAIT_L(0); PG8_MMA(0, 1, At, B1); PG8_BAR;
            PG8_LDA(At, 0, 1); PG8_STAGE(PG8_SA(0, 0), a2, voffA);
            PG8_BAR; PG8_WAIT_L(0); PG8_MMA(1, 0, At, B0); PG8_BAR; PG8_SCHED;
            PG8_STAGE(PG8_SB(0, 1), b2 + hstep, voffB);
            PG8_WAIT_V(6); PG8_BAR; PG8_MMA(1, 1, At, B1); PG8_BAR;
            PG8_LDB(B0, 1, 0); PG8_SCHED; PG8_LDA(At, 1, 0); PG8_STAGE(PG8_SA(0, 1), a2 + hstep, voffA);
            PG8_WAIT_L(8); PG8_BAR; PG8_WAIT_L(0); PG8_MMA(0, 0, At, B0); PG8_BAR; PG8_SCHED;
            PG8_LDB(B1, 1, 1); PG8_STAGE(PG8_SB(1, 0), b3, voffB);
            PG8_BAR; PG8_WAIT_L(0); PG8_MMA(0, 1, At, B1); PG8_BAR;
            PG8_LDA(At, 1, 1); PG8_STAGE(PG8_SA(1, 0), a3, voffA);
            PG8_BAR; PG8_WAIT_L(0); PG8_MMA(1, 0, At, B0); PG8_BAR; PG8_SCHED;
            PG8_STAGE(PG8_SB(1, 1), b3 + hstep, voffB);
            PG8_WAIT_V(6); PG8_BAR; PG8_MMA(1, 1, At, B1); PG8_BAR;
            }
        }
        if constexpr (ALIGN_EPI) { if (wr == 0) PG8_BAR; }
        if constexpr (!Epi::AFTER_DRAIN) { E(acc, cur, wr, wc, fr, fq); S.done(cur); }
        if (!has_next) break;
#pragma unroll
        for (int a = 0; a < 2; ++a)
#pragma unroll
            for (int b = 0; b < 2; ++b)
#pragma unroll
                for (int m = 0; m < 4; ++m)
#pragma unroll
                    for (int n = 0; n < 2; ++n) acc[a][b][m][n] = zero4();
        cur = nxt; cA = nA; cB = nB; ++ui;
        if constexpr (ALIGN_EPI) { if (wr == 1) PG8_BAR; }
    }
    PG8_WAIT_V(0);
    if constexpr (!ALIGN_EPI) { if (wr == 0) PG8_BAR; }
    PG8_BAR;
    if constexpr (Epi::AFTER_DRAIN) { E.fused(acc, cur, wr, wc, fr, fq, lds, wid, lane); S.done(cur); }
#undef PG8_SA
#undef PG8_SB
#undef PG8_STAGE
#undef PG8_LDA
#undef PG8_LDB
#undef PG8_MMA
#undef PG8_WAIT_V
#undef PG8_WAIT_L
#undef PG8_BAR
#undef PG8_SCHED
}
}

__device__ __forceinline__ int opaque(int v) { asm volatile("" : "+s"(v)); return v; }
__device__ __forceinline__ size_t kimg_off(int b, int h, int t, int d) { return ((((size_t)(b * 8 + h) * MW + (t >> 6)) * 8 + (d >> 3)) * 64 + (t & 63)) * 8 + (d & 7); }
__device__ __forceinline__ size_t vimg_off(int b, int h, int t, int d) { return ((((size_t)(b * 8 + h) * MW + (t >> 6)) * 2 + (d >> 5)) * 64 + (t & 63)) * 32 + (d & 31); }
__device__ __forceinline__ void store8bf(bf16_t* dst, const f32x4& a, const f32x4& b) {
    uint4 w; w.x = pk2(a[0], a[1]); w.y = pk2(a[2], a[3]); w.z = pk2(b[0], b[1]); w.w = pk2(b[2], b[3]);
    *(uint4*)dst = w;
}
__device__ __forceinline__ void rope8(f32x4& v0, f32x4& v1, const float* __restrict__ rope, int t, int fq) {
    const float* rp = rope + (size_t)t * 16;
#pragma unroll
    for (int j = 0; j < 4; ++j) {
        { const float x = v0[j]; const float pr = __shfl_xor(x, 16); const float c = rp[2 * j], sn = rp[2 * j + 1];
          v0[j] = (fq == 0) ? (x * c - pr * sn) : ((fq == 1) ? (x * c + pr * sn) : x); }
        { const float x = v1[j]; const float pr = __shfl_xor(x, 16); const float c = rp[2 * (4 + j)], sn = rp[2 * (4 + j) + 1];
          v1[j] = (fq == 0) ? (x * c - pr * sn) : ((fq == 1) ? (x * c + pr * sn) : x); }
    }
}
struct EpiInProj {
    static constexpr bool PERM = true, AFTER_DRAIN = false;
    template <int BJ> __device__ __forceinline__ void part(const f32x4 (&acc)[2][2][4][2], const pg8::Unit& u, int wr, int wc, int fr, int fq) const {
        KParams kpe = (KParams)__builtin_amdgcn_kernarg_segment_ptr(); asm volatile("" : "+s"(kpe));
        unsigned char* ws = kpe->ws; const float* rope = (const float*)(ws + OFF_ROPE);
        const int cb = 256 * u.pn + 128 * BJ + 32 * wc;
        const int cg64 = cb >> 6, hf = wc & 1;
        const int cig = hf * 32 + 8 * fq;
        if (cg64 >= 78) return;
        if (cg64 < 45) {
            size_t off; int pitch = 512, hd = 0; float scl = 1.0f; bool rp = false;
            if (cg64 < 8) { off = OFF_QA; hd = cg64; scl = QSCALE; rp = true; }
            else if (cg64 < 12) { off = OFF_CKV; pitch = 256; hd = cg64 - 8; }
            else if (cg64 < 20) { off = OFF_QI; hd = cg64 - 12; scl = 0.125f; rp = true; }
            else if (cg64 == 20) { off = OFF_KI; pitch = 64; rp = true; }
            else if (cg64 < 29) { off = OFF_QF; hd = cg64 - 21; scl = QSCALE; }
            else if (cg64 < 37) { off = OFF_KF; hd = cg64 - 29; }
            else { off = OFF_VF; hd = cg64 - 37; }
            bf16_t* base = (bf16_t*)(ws + off) + hd * 64 + cig;
            rp = rp && (hf == 0);
#pragma unroll
            for (int ai = 0; ai < 2; ++ai)
#pragma unroll
                for (int m = 0; m < 4; ++m) {
                    const int n = 256 * u.pm + 128 * ai + 64 * wr + 16 * m + fr;
                    const int b = n / SEQ, t = NMETA + n % SEQ, r = b * TP + t;
                    f32x4 v0 = acc[ai][BJ][m][0], v1 = acc[ai][BJ][m][1];
                    if (rp) rope8(v0, v1, rope, t, fq);
                    if (cg64 == 20) {
                        store8bf((bf16_t*)(ws + OFF_KI) + ((size_t)((b * (TP / 16) + (t >> 4)) * 2 + hf) * 64 + fq * 16 + (t & 15)) * 8, v0, v1);
                    } else
                    store8bf(base + (size_t)((cg64 >= 8 && cg64 < 12) ? n : r) * pitch, v0 * scl, v1 * scl);
                    asm volatile("" ::: "memory");
                }
        } else if (cg64 < 77) {
            bf16_t* gates = (bf16_t*)kpe->out + (cg64 - 45) * 64 + cig;
#pragma unroll
            for (int ai = 0; ai < 2; ++ai)
#pragma unroll
                for (int m = 0; m < 4; ++m) {
                    const int n = 256 * u.pm + 128 * ai + 64 * wr + 16 * m + fr;
                    {
                        f32x4 v0 = acc[ai][BJ][m][0], v1 = acc[ai][BJ][m][1];
#pragma unroll
                        for (int j = 0; j < 4; ++j) { v0[j] = sigmoidf_(v0[j]); v1[j] = sigmoidf_(v1[j]); }
                        store8bf(gates + (size_t)n * 2048, v0, v1);
                    }
                }
        } else if (hf == 0 && fq < 2) {
            float* WIo = (float*)(ws + OFF_WI); float* LOGF = (float*)(ws + OFF_LOGF); const float* bfg = kpe->in[5];
#pragma unroll
            for (int ai = 0; ai < 2; ++ai)
#pragma unroll
                for (int m = 0; m < 4; ++m) {
                    const int n = 256 * u.pm + 128 * ai + 64 * wr + 16 * m + fr;
                    const int r = (n / SEQ) * TP + NMETA + n % SEQ;
                    const f32x4 v0 = acc[ai][BJ][m][0], v1 = acc[ai][BJ][m][1];
                    if (fq == 0) {
                        *(f32x4*)(WIo + (size_t)r * 8) = v0 * 0.3535533905932738f; *(f32x4*)(WIo + (size_t)r * 8 + 4) = v1 * 0.3535533905932738f;
                    } else {
                        f32x4 o0, o1;
#pragma unroll
                        for (int j = 0; j < 4; ++j) {
                            const float z0 = v0[j] + bfg[j], z1 = v1[j] + bfg[4 + j];
                            o0[j] = fminf(z0, 0.f) - __logf(1.0f + __expf(-fabsf(z0)));
                            o1[j] = fminf(z1, 0.f) - __logf(1.0f + __expf(-fabsf(z1)));
                        }
                        float* lt = LOGF + (size_t)(n / SEQ) * 8 * TP + (NMETA + n % SEQ);
#pragma unroll
                        for (int j = 0; j < 4; ++j) { lt[(size_t)j * TP] = o0[j]; lt[(size_t)(4 + j) * TP] = o1[j]; }
                    }
                }
        }
    }
    __device__ __forceinline__ void operator()(const f32x4 (&acc)[2][2][4][2], const pg8::Unit& u, int wr, int wc, int fr, int fq) const {
        asm volatile("" : "+v"(fr), "+v"(fq));
        part<0>(acc, u, wr, wc, fr, fq); part<1>(acc, u, wr, wc, fr, fq);
    }
};
struct EpiKvUp {
    static constexpr bool PERM = true, AFTER_DRAIN = false;
    const PG8_LAS float* rs; const PG8_LAS int* tag;
    template <int BJ> __device__ __forceinline__ void part(const f32x4 (&acc)[2][2][4][2], const pg8::Unit& u, const PG8_LAS float* rsu, int wr, int wc, int fr, int fq) const {
        KParams kpe = (KParams)__builtin_amdgcn_kernarg_segment_ptr(); asm volatile("" : "+s"(kpe));
        unsigned char* ws = kpe->ws; const float* rope = (const float*)(ws + OFF_ROPE);
        const int cb = 256 * u.pn + 128 * BJ + 32 * wc;
        const int cg64 = cb >> 6, hf = wc & 1, cig = hf * 32 + 8 * fq;
        const bool isk = cg64 < 8, rp = isk && (hf == 0);
        bf16_t* base = (bf16_t*)(ws + (isk ? OFF_KA : OFF_VA)) + (isk ? cg64 : cg64 - 8) * 64 + cig;
#pragma unroll
        for (int ai = 0; ai < 2; ++ai)
#pragma unroll
            for (int m = 0; m < 4; ++m) {
                const int rl = 128 * ai + 64 * wr + 16 * m + fr;
                const int n = 256 * u.pm + rl, t = NMETA + n % SEQ, r = (n / SEQ) * TP + t;
                const float rstd = rsu[rl];
                f32x4 v0 = acc[ai][BJ][m][0] * rstd, v1 = acc[ai][BJ][m][1] * rstd;
                if (rp) rope8(v0, v1, rope, t, fq);
                store8bf((bf16_t*)(ws + (isk ? OFF_KA : OFF_VA)) + (isk ? kimg_off(n / SEQ, cg64, t, cig) : vimg_off(n / SEQ, cg64 - 8, t, cig)), v0, v1);
                asm volatile("" ::: "memory");
            }
    }
    __device__ __forceinline__ void operator()(const f32x4 (&acc)[2][2][4][2], const pg8::Unit& u, int wr, int wc, int fr, int fq) const {
        asm volatile("" : "+v"(fr), "+v"(fq));
        const PG8_LAS float* rsu = (tag[0] == u.pm) ? rs : rs + 256;
        part<0>(acc, u, rsu, wr, wc, fr, fq); part<1>(acc, u, rsu, wr, wc, fr, fq);
    }
};
#ifndef MGB
#define MGB 4
#endif
template <int PASS> struct EpiMerge {
    static constexpr bool PERM = true, AFTER_DRAIN = false;
    __device__ __forceinline__ void operator()(const f32x4 (&acc)[2][2][4][2], const pg8::Unit& u, int wr, int wc, int fr, int fq) const {
        asm volatile("" : "+v"(fr), "+v"(fq));
        KParams kpe = (KParams)__builtin_amdgcn_kernarg_segment_ptr(); asm volatile("" : "+s"(kpe));
        bf16_t* merged = (bf16_t*)(kpe->ws + OFF_MERGED); const bf16_t* gates = (const bf16_t*)kpe->out;
#pragma unroll
        for (int bj = 0; bj < 2; ++bj) {
            const int c = 256 * u.pn + 128 * bj + 32 * wc + 8 * fq;
            const size_t n0 = (size_t)(256 * u.pm + 64 * wr + fr);
#pragma unroll
            for (int i0 = 0; i0 < 8; i0 += MGB) {
                uint4 g[MGB], o[MGB];
#pragma unroll
                for (int i = 0; i < MGB; ++i) g[i] = *(const uint4*)(gates + (n0 + 128 * ((i0 + i) >> 2) + 16 * ((i0 + i) & 3)) * 2048 + PASS * 1024 + c);
                if (PASS == 1) {
#pragma unroll
                    for (int i = 0; i < MGB; ++i) o[i] = *(const uint4*)(merged + (n0 + 128 * ((i0 + i) >> 2) + 16 * ((i0 + i) & 3)) * 1024 + c);
                }
#pragma unroll
                for (int i = 0; i < MGB; ++i) {
                    const int ii = i0 + i;
                    f32x4 v0 = acc[ii >> 2][bj][ii & 3][0], v1 = acc[ii >> 2][bj][ii & 3][1];
                    v0 = v0 * (f32x4){bf2f(g[i].x & 0xffffu), bf2f(g[i].x >> 16), bf2f(g[i].y & 0xffffu), bf2f(g[i].y >> 16)};
                    v1 = v1 * (f32x4){bf2f(g[i].z & 0xffffu), bf2f(g[i].z >> 16), bf2f(g[i].w & 0xffffu), bf2f(g[i].w >> 16)};
                    if (PASS == 1) {
                        v0 = v0 + (f32x4){bf2f(o[i].x & 0xffffu), bf2f(o[i].x >> 16), bf2f(o[i].y & 0xffffu), bf2f(o[i].y >> 16)};
                        v1 = v1 + (f32x4){bf2f(o[i].z & 0xffffu), bf2f(o[i].z >> 16), bf2f(o[i].w & 0xffffu), bf2f(o[i].w >> 16)};
                    }
                    store8bf(merged + (n0 + 128 * (ii >> 2) + 16 * (ii & 3)) * 1024 + c, v0, v1);
                }
                asm volatile("" ::: "memory");
            }
        }
    }
};
struct EpiOutProj {
    static constexpr bool PERM = true, AFTER_DRAIN = false;
    __device__ __forceinline__ void operator()(const f32x4 (&acc)[2][2][4][2], const pg8::Unit& u, int wr, int wc, int fr, int fq) const {
        asm volatile("" : "+v"(fr), "+v"(fq));
        KParams kpe = (KParams)__builtin_amdgcn_kernarg_segment_ptr(); asm volatile("" : "+s"(kpe));
        const float* x = kpe->in[0]; const float* g0 = kpe->in[2]; const float* b0 = kpe->in[3]; float* out = kpe->out;
        const float* stat0 = (const float*)(kpe->ws + OFF_STAT0);
        const int c0 = 256 * u.pn + 32 * wc + 8 * fq;
        f32x4 gg[4], bb[4];
#pragma unroll
        for (int q = 0; q < 4; ++q) { gg[q] = *(const f32x4*)(g0 + c0 + 128 * (q >> 1) + 4 * (q & 1)) * ALPHA; bb[q] = *(const f32x4*)(b0 + c0 + 128 * (q >> 1) + 4 * (q & 1)) * ALPHA; }
#pragma unroll
        for (int rp = 0; rp < 4; ++rp) {
            f32x2 st[2]; f32x4 xv[2][4]; int nn_[2];
#pragma unroll
            for (int mm = 0; mm < 2; ++mm) {
                const int n = 256 * u.pm + 128 * (rp >> 1) + 64 * wr + 16 * ((rp & 1) * 2 + mm) + fr;
                nn_[mm] = n;
                st[mm] = *(const f32x2*)(stat0 + 2 * ((n / SEQ) * TP + NMETA + n % SEQ));
#pragma unroll
                for (int q = 0; q < 4; ++q) xv[mm][q] = *(const f32x4*)(x + (size_t)n * 1024 + c0 + 128 * (q >> 1) + 4 * (q & 1));
            }
#pragma unroll
            for (int mm = 0; mm < 2; ++mm) {
                const float mu = st[mm][0], rstd = st[mm][1];
#pragma unroll
                for (int q = 0; q < 4; ++q)
                    *(f32x4*)(out + (size_t)nn_[mm] * 1024 + c0 + 128 * (q >> 1) + 4 * (q & 1)) = (xv[mm][q] - mu) * rstd * gg[q] + bb[q] + acc[rp >> 1][q >> 1][(rp & 1) * 2 + mm][q & 1];
            }
        }
    }
};
struct EpiMoeDown {
    static constexpr bool PERM = true, AFTER_DRAIN = false;
    const PG8_LAS int* tab;
    __device__ __forceinline__ void operator()(const f32x4 (&acc)[2][2][4][2], const pg8::Unit& u, int wr, int wc, int fr, int fq) const {
        asm volatile("" : "+v"(fr), "+v"(fq));
        KParams kpe = (KParams)__builtin_amdgcn_kernarg_segment_ptr(); asm volatile("" : "+s"(kpe));
        unsigned char* ws = kpe->ws;
        const int* TOKL = (const int*)(ws + OFF_TOKL); const float* GW = (const float*)(ws + OFF_GW); bf16_t* SLOT = (bf16_t*)(ws + OFF_SLOT);
        const int e = u.pn >> 2, cnt = tab[e], pos0 = (u.pm - (tab[64 + e] >> 8)) * 256;
        const int cb = 256 * (u.pn & 3) + 32 * wc + 8 * fq;
        int aid[8]; float gw[8];
#pragma unroll
        for (int i = 0; i < 8; ++i) { const int pos = pos0 + 128 * (i >> 2) + 64 * wr + 16 * (i & 3) + fr; aid[i] = TOKL[e * 32768 + (pos < cnt ? pos : cnt - 1)]; }
#pragma unroll
        for (int i = 0; i < 8; ++i) gw[i] = GW[aid[i]];
#pragma unroll
        for (int ai = 0; ai < 2; ++ai)
#pragma unroll
            for (int m = 0; m < 4; ++m) {
                const int pos = pos0 + 128 * ai + 64 * wr + 16 * m + fr;
                if (pos < cnt) {
                    const float g = gw[ai * 4 + m];
                    bf16_t* dst = SLOT + (size_t)aid[ai * 4 + m] * 1024 + cb;
                    store8bf(dst, acc[ai][0][m][0] * g, acc[ai][0][m][1] * g);
                    store8bf(dst + 128, acc[ai][1][m][0] * g, acc[ai][1][m][1] * g);
                }
            }
    }
};
struct EpiAny {
    static constexpr bool PERM = true, AFTER_DRAIN = false;
    int kind; const PG8_LAS float* rs; const PG8_LAS int* tag;
    __device__ __forceinline__ void operator()(const f32x4 (&acc)[2][2][4][2], const pg8::Unit& u, int wr, int wc, int fr, int fq) const {
        if (kind == 0) { EpiInProj e{}; e(acc, u, wr, wc, fr, fq); }
        else if (kind == 1) { EpiKvUp e{rs, tag}; e(acc, u, wr, wc, fr, fq); }
        else if (kind == 2) { EpiMerge<0> e{}; e(acc, u, wr, wc, fr, fq); }
        else if (kind == 3) { EpiMerge<1> e{}; e(acc, u, wr, wc, fr, fq); }
        else if (kind == 4) { EpiOutProj e{}; e(acc, u, wr, wc, fr, fq); }
        else { EpiMoeDown e{tag}; e(acc, u, wr, wc, fr, fq); }
    }
};

template <int POS> __device__ __forceinline__ unsigned bitmask1(int m) { int r; asm("v_bfe_i32 %0, %1, %2, 1" : "=v"(r) : "v"(m), "n"(POS)); return (unsigned)r; }
typedef short s16x4 __attribute__((ext_vector_type(4)));
__device__ __forceinline__ s16x4 vtr16(const unsigned char* p) {
    return __builtin_bit_cast(s16x4, __builtin_amdgcn_ds_read_tr16_b64_v4i16((__attribute__((address_space(3))) s16x4*)p));
}
constexpr int AT_VP = 192;
constexpr int AT_K = 0, AT_V = 8192, AT_C = 8192 + 64 * AT_VP, AT_BUF = 8192 + 64 * AT_VP + 256;
template <bool FOX>
__device__ void attn_item(unsigned char* ws, int b, int h, int qb, unsigned char* smem) {
    constexpr int mode = 0;
    const bf16_t* Q = (const bf16_t*)(ws + (FOX ? OFF_QF : OFF_QA));
    bf16_t* Y = (bf16_t*)(ws + (FOX ? OFF_YF : OFF_YA));
    const bf16_t* Kg = (const bf16_t*)(ws + (FOX ? OFF_KF : OFF_KA));
    const bf16_t* Vt = (const bf16_t*)(ws + (FOX ? OFF_VF : OFF_VA));
    const float* cum = (const float*)(ws + OFF_CUM);
    const unsigned long long* mask = (const unsigned long long*)(ws + OFF_MASK);
    const int tid = ltid(), lane = tid & 63, wave = __builtin_amdgcn_readfirstlane(tid >> 6), hlf = lane >> 5;
    const int q0w = qb * 256 + wave * 32;
    const int qrow = q0w + (lane & 31);
    const size_t grow = (size_t)b * TP + qrow;
    const bool wave_on = q0w < T;
    bf16x8 qf[4];
#pragma unroll
    for (int ks = 0; ks < 4; ++ks) qf[ks] = *(const bf16x8*)(Q + grow * 512 + h * 64 + ks * 16 + hlf * 8);
    const int nkt = qb * 4 + 4;
    int kt0 = 0;
    if (FOX) {
        const float* knorm = (const float*)(ws + OFF_KNORM) + (size_t)(b * 8 + h) * MW;
        float* red = (float*)(smem + 2 * AT_BUF);
        float qq = 0.f;
#pragma unroll
        for (int ks = 0; ks < 4; ++ks)
#pragma unroll
            for (int e = 0; e < 8; ++e) { const float v = bf2f((unsigned)(unsigned short)qf[ks][e]); qq = fmaf(v, v, qq); }
        qq += __shfl_xor(qq, 32);
#pragma unroll
        for (int o = 1; o < 32; o <<= 1) qq = fmaxf(qq, __shfl_xor(qq, o));
        if (lane == 0) red[wave] = qq;
        __syncthreads();
        if (wave == 0) {
            float qm = red[0];
#pragma unroll
            for (int w = 1; w < 8; ++w) qm = fmaxf(qm, red[w]);
            const float Qn = sqrtf(qm) * 1.0001f;
            const float Kd = fmaxf(fmaxf(knorm[qb * 4], knorm[qb * 4 + 1]), fmaxf(knorm[qb * 4 + 2], knorm[qb * 4 + 3])) * 1.0001f;
            const float cfirst = cum[((size_t)b * TP + qb * 256) * 8 + h];
            bool keep0 = true, keep1 = true;
            if (lane < qb * 4) { const float bnd = Qn * (knorm[lane] * 1.0001f + Kd) + cfirst - cum[((size_t)b * TP + lane * 64 + 63) * 8 + h]; keep0 = !(bnd < -40.0f); }
            if (lane + 64 < qb * 4) { const float bnd = Qn * (knorm[lane + 64] * 1.0001f + Kd) + cfirst - cum[((size_t)b * TP + (lane + 64) * 64 + 63) * 8 + h]; keep1 = !(bnd < -40.0f); }
            const unsigned long long b0 = __ballot(keep0), b1 = __ballot(keep1);
            const int first = b0 ? (int)__builtin_ctzll(b0) : (b1 ? 64 + (int)__builtin_ctzll(b1) : 128);
            if (lane == 0) ((int*)red)[8] = first < qb * 4 ? first : qb * 4;
        }
        __syncthreads();
        kt0 = ((const int*)red)[8];
    }
    const int my_last = qb * 4 + (wave >> 1);
    f32x16 o0, o1;
#pragma unroll
    for (int i = 0; i < 16; ++i) { o0[i] = 0.f; o1[i] = 0.f; }
    float m_run = -1e30f, l_run = 0.f;
    const int skey = tid >> 3, sc = tid & 7;
    const bf16_t* kp = Kg + ((size_t)b * TP + skey) * 512 + h * 64 + sc * 8;
    const bf16_t* vp = Vt + ((size_t)b * TP + skey) * 512 + h * 64 + sc * 8;
    const int kw_off = skey * 128 + ((sc ^ ((skey >> 1) & 7)) * 16);
    const int vw_off = skey * AT_VP + sc * 16;
    uint4 rk = *(const uint4*)(kp + (size_t)kt0 * 64 * 512), rv = *(const uint4*)(vp + (size_t)kt0 * 64 * 512);
    float rc = 0.f;
    if (FOX && tid < 64) rc = cum[((size_t)b * TP + kt0 * 64 + tid) * 8 + h];
    unsigned long long mw = 0ull, mw_next = 0ull;
    if (!FOX) mw_next = mask[grow * MW + 0];
    for (int kt = kt0; kt < nkt; ++kt) {
        unsigned char* sb = smem + (kt & 1) * AT_BUF;
        if (mode != 3) {
        *(uint4*)(sb + AT_K + kw_off) = rk;
        *(uint4*)(sb + AT_V + vw_off) = rv;
        if (FOX && tid < 64) *(float*)(sb + AT_C + tid * 4) = rc;
        }
        mw = mw_next;
        if (mode != 3) __syncthreads();
        if (kt + 1 < nkt) {
            rk = *(const uint4*)(kp + (size_t)(kt + 1) * 64 * 512);
            rv = *(const uint4*)(vp + (size_t)(kt + 1) * 64 * 512);
            if (FOX && tid < 64) rc = cum[((size_t)b * TP + (kt + 1) * 64 + tid) * 8 + h];
            if (!FOX) mw_next = mask[grow * MW + kt + 1];
        }
        if (wave_on && kt <= my_last) {
            const bf16_t* Ks = (const bf16_t*)(sb + AT_K);
            const unsigned char* Vs = sb + AT_V;
            const float* Cs = (const float*)(sb + AT_C);
            f32x16 st[2];
#pragma unroll
            for (int sub = 0; sub < 2; ++sub) {
#pragma unroll
                for (int i = 0; i < 16; ++i) st[sub][i] = 0.f;
                const int krow = sub * 32 + (lane & 31);
                if (mode != 4)
#pragma unroll
                for (int ks = 0; ks < 4; ++ks) {
                    const bf16x8 kf = *(const bf16x8*)(Ks + krow * 64 + (((ks * 2 + hlf) ^ ((krow >> 1) & 7)) * 8));
                    st[sub] = __builtin_amdgcn_mfma_f32_32x32x16_bf16(kf, qf[ks], st[sub], 0, 0, 0);
                }
            }
            const bool diag = (kt == my_last);
            const int kbase = kt * 64 + 4 * hlf;
            float mx = -3.0e38f;
            if (FOX) {
#pragma unroll
                for (int sub = 0; sub < 2; ++sub)
#pragma unroll
                    for (int g = 0; g < 4; ++g) {
                        const f32x4 ck4 = *(const f32x4*)(Cs + sub * 32 + 8 * g + 4 * hlf);
#pragma unroll
                        for (int j = 0; j < 4; ++j) st[sub][g * 4 + j] -= ck4[j];
                    }
                if (diag) {
#pragma unroll
                    for (int sub = 0; sub < 2; ++sub)
#pragma unroll
                        for (int g = 0; g < 4; ++g)
#pragma unroll
                            for (int j = 0; j < 4; ++j) { const int key = kbase + sub * 32 + 8 * g + j; st[sub][g * 4 + j] = (key <= qrow) ? st[sub][g * 4 + j] : -3.0e38f; }
                }
            }
#pragma unroll
            for (int sub = 0; sub < 2; ++sub)
#pragma unroll
                for (int i = 0; i < 16; ++i) mx = fmaxf(mx, st[sub][i]);
            mx = fmaxf(mx, __shfl_xor(mx, 32));
            const float m_new = fmaxf(m_run, mx);
            const float alpha = __builtin_amdgcn_exp2f(m_run - m_new);
            m_run = m_new;
            float ls = 0.f;
            bf16x8 pf[2][2];
            {
                const int mb0 = (int)(unsigned)(mw >> (4 * hlf)), mb1 = (int)(unsigned)(mw >> (32 + 4 * hlf));
                unsigned pw[2][2][4];
#define ATT_PAIR(SUB, S2, J, MB) do { constexpr int r0_ = 8 * (S2) + (J), r1_ = r0_ + 1; \
                    float p0 = st[SUB][r0_], p1 = st[SUB][r1_]; \
                    if (mode != 5) { p0 = __builtin_amdgcn_exp2f(p0 - m_new); p1 = __builtin_amdgcn_exp2f(p1 - m_new); } \
                    if (!FOX && mode != 5) { p0 = __uint_as_float(__float_as_uint(p0) & bitmask1<8 * (r0_ >> 2) + (r0_ & 3)>(MB)); \
                                             p1 = __uint_as_float(__float_as_uint(p1) & bitmask1<8 * (r1_ >> 2) + (r1_ & 3)>(MB)); } \
                    ls += p0 + p1; pw[SUB][S2][(J) >> 1] = pk2(p0, p1); } while (0)
#define ATT_QUAD(SUB, S2, MB) ATT_PAIR(SUB, S2, 0, MB); ATT_PAIR(SUB, S2, 2, MB); ATT_PAIR(SUB, S2, 4, MB); ATT_PAIR(SUB, S2, 6, MB)
                ATT_QUAD(0, 0, mb0); ATT_QUAD(0, 1, mb0); ATT_QUAD(1, 0, mb1); ATT_QUAD(1, 1, mb1);
#undef ATT_QUAD
#undef ATT_PAIR
#pragma unroll
                for (int sub = 0; sub < 2; ++sub)
#pragma unroll
                    for (int s2 = 0; s2 < 2; ++s2) { uint4 t4 = make_uint4(pw[sub][s2][0], pw[sub][s2][1], pw[sub][s2][2], pw[sub][s2][3]); pf[sub][s2] = *(bf16x8*)&t4; }
            }
            l_run = l_run * alpha + ls;
            if (mode == 2) { asm volatile("" :: "v"(pf[0][0]), "v"(pf[0][1]), "v"(pf[1][0]), "v"(pf[1][1])); }
            else {
#pragma unroll
            for (int i = 0; i < 16; ++i) { o0[i] *= alpha; o1[i] *= alpha; }
#pragma unroll
            for (int sub = 0; sub < 2; ++sub)
#pragma unroll
                for (int s2 = 0; s2 < 2; ++s2) {
                    const int key0 = sub * 32 + 16 * s2 + 4 * hlf;
                    const unsigned char* vr = Vs + (key0 + ((lane & 15) >> 2)) * AT_VP + (16 * ((lane >> 4) & 1) + 4 * (lane & 3)) * 2;
                    {
                        const s16x4 a = vtr16(vr), c = vtr16(vr + 8 * AT_VP);
                        const bf16x8 vf = (bf16x8){a[0], a[1], a[2], a[3], c[0], c[1], c[2], c[3]};
                        o0 = __builtin_amdgcn_mfma_f32_32x32x16_bf16(vf, pf[sub][s2], o0, 0, 0, 0);
                    }
                    {
                        const s16x4 a = vtr16(vr + 64), c = vtr16(vr + 64 + 8 * AT_VP);
                        const bf16x8 vf = (bf16x8){a[0], a[1], a[2], a[3], c[0], c[1], c[2], c[3]};
                        o1 = __builtin_amdgcn_mfma_f32_32x32x16_bf16(vf, pf[sub][s2], o1, 0, 0, 0);
                    }
                }
            }
        }
    }
    __syncthreads();
    if (wave_on) {
        const float lt = l_run + __shfl_xor(l_run, 32);
        const float inv = 1.0f / lt;
        if (qrow >= NMETA && qrow < T && mode == 0) {
            bf16_t* yo = Y + ((size_t)b * SEQ + (qrow - NMETA)) * 512 + h * 64;
#pragma unroll
            for (int g = 0; g < 4; ++g) {
                const int d = 8 * g + 4 * hlf;
                store4bf(yo + d, (f32x4){o0[4 * g] * inv, o0[4 * g + 1] * inv, o0[4 * g + 2] * inv, o0[4 * g + 3] * inv});
                store4bf(yo + 32 + d, (f32x4){o1[4 * g] * inv, o1[4 * g + 1] * inv, o1[4 * g + 2] * inv, o1[4 * g + 3] * inv});
            }
        }
    }
}

namespace ab {
using bf16=__hip_bfloat16;
using bf16x8=__attribute__((ext_vector_type(8)))short;
using s16x4=__attribute__((ext_vector_type(4)))short;
using f32x16=__attribute__((ext_vector_type(16)))float;
using u32x4=__attribute__((ext_vector_type(4)))unsigned;
constexpr int BATCH=2,NHEAD=8,SEQ=8448  ,D=64,DM=NHEAD*D;
constexpr int NW=8,QBLK=32,QB=QBLK*NW,KVBLK=64,NQB=SEQ/QB;
constexpr int ATTN_PITCH=DM, ATTN_UNIT_ROWS=QB;
__device__ __forceinline__ int crow(int r,int hi){return (r&3)+8*(r>>2)+4*hi;}
#define SBAR() __builtin_amdgcn_sched_barrier(0)
__device__ __forceinline__ void cmask(f32x16&p0,f32x16&p1,int jb,int qrel,int hi){
  const float NEG=-INFINITY; int kb=64*jb+4*hi;
  #pragma unroll
  for(int r=0;r<16;++r){int kv=kb+(r&3)+8*(r>>2); if(kv>qrel)p0[r]=NEG; if(kv+32>qrel)p1[r]=NEG;}
}

constexpr int NSLOT=3, SLOTB=8192;
constexpr int LDS_K=0, LDS_V=NSLOT*SLOTB, LDS_WS=2*NSLOT*SLOTB, LDS_OST=LDS_WS+NW*64*4, LDS_BYTES=LDS_OST+NW*4096;
constexpr float C2=0.125f*1.4426950408889634f;
__device__ __forceinline__ void glds16(const void*gsrc,unsigned lds_dst){unsigned keep;
  asm volatile("s_mov_b32 %0, m0\n\ts_mov_b32 m0, %2\n\ts_nop 0\n\tglobal_load_lds_dwordx4 %1, off\n\ts_mov_b32 m0, %0":"=&s"(keep):"v"(gsrc),"s"(lds_dst):"memory");}
__device__ __forceinline__ float max3f(float a,float b,float c){float r;asm("v_max3_f32 %0, %1, %2, %3":"=v"(r):"v"(a),"v"(b),"v"(c));return r;}
__device__ __forceinline__ float max2f(float a,float b){float r;asm("v_max_f32_e32 %0, %1, %2":"=v"(r):"v"(a),"v"(b));return r;}
__device__ __forceinline__ float fadd_s(float a,float b){float r;asm("v_add_f32_e32 %0, %1, %2":"=v"(r):"v"(a),"v"(b));return r;}
__device__ __forceinline__ float fsub_s(float a,float b){float r;asm("v_sub_f32_e32 %0, %1, %2":"=v"(r):"v"(a),"v"(b));return r;}
typedef float f32x2_t __attribute__((ext_vector_type(2))); typedef __bf16 bf16x2_t __attribute__((ext_vector_type(2)));
__device__ __forceinline__ unsigned cvtpk_s(float lo,float hi){f32x2_t v={lo,hi};bf16x2_t b=__builtin_convertvector(v,bf16x2_t);return __builtin_bit_cast(unsigned,b);}
#define WAIT_BAR(N) asm volatile("s_waitcnt vmcnt(" #N ") lgkmcnt(0)\n\ts_barrier":::"memory")

__device__ __forceinline__ void qkt(f32x16&p0,f32x16&p1,const char*Kslot,const bf16x8*qr,const f32x16&negm,int r32,int hi){
  const char*kb=Kslot+hi*1024+r32*16;
  #pragma unroll
  for(int d0=0;d0<4;++d0){
    const bf16x8 b0=*reinterpret_cast<const bf16x8*>(kb+d0*2048);
    const bf16x8 b1=*reinterpret_cast<const bf16x8*>(kb+d0*2048+512);
    if(d0==0){p0=__builtin_amdgcn_mfma_f32_32x32x16_bf16(b0,qr[0],negm,0,0,0);p1=__builtin_amdgcn_mfma_f32_32x32x16_bf16(b1,qr[0],negm,0,0,0);}
    else{p0=__builtin_amdgcn_mfma_f32_32x32x16_bf16(b0,qr[d0],p0,0,0,0);p1=__builtin_amdgcn_mfma_f32_32x32x16_bf16(b1,qr[d0],p1,0,0,0);}}
}
typedef __attribute__((address_space(3))) const char* lds_cptr;
typedef short v4i16_t __attribute__((ext_vector_type(4)));
__device__ __forceinline__ void kload8(bf16x8*kf,lds_cptr kp){
  kf[0]=*(const __attribute__((address_space(3))) bf16x8*)(kp);      kf[1]=*(const __attribute__((address_space(3))) bf16x8*)(kp+512);
  kf[2]=*(const __attribute__((address_space(3))) bf16x8*)(kp+2048); kf[3]=*(const __attribute__((address_space(3))) bf16x8*)(kp+2560);
  kf[4]=*(const __attribute__((address_space(3))) bf16x8*)(kp+4096); kf[5]=*(const __attribute__((address_space(3))) bf16x8*)(kp+4608);
  kf[6]=*(const __attribute__((address_space(3))) bf16x8*)(kp+6144); kf[7]=*(const __attribute__((address_space(3))) bf16x8*)(kp+6656);
}
__device__ __forceinline__ void kload2(bf16x8*kf,lds_cptr kp,int j){ kf[2*j]=*(const __attribute__((address_space(3))) bf16x8*)(kp+j*2048); kf[2*j+1]=*(const __attribute__((address_space(3))) bf16x8*)(kp+j*2048+512); }
__device__ __forceinline__ s16x4 vtr(lds_cptr p){ return __builtin_bit_cast(s16x4,__builtin_amdgcn_ds_read_tr16_b64_v4i16((__attribute__((address_space(3))) v4i16_t*)p)); }
__device__ __forceinline__ float rowmax(const f32x16&p0,const f32x16&p1){
  float a=max3f(p0[0],p0[1],p1[0]),b=max3f(p0[2],p0[3],p1[1]);a=max3f(a,p1[2],p1[3]);
  #pragma unroll
  for(int r=4;r<16;r+=4){a=max3f(a,p0[r],p0[r+1]);b=max3f(b,p0[r+2],p0[r+3]);a=max3f(a,p1[r],p1[r+1]);b=max3f(b,p1[r+2],p1[r+3]);}
  const float m=max2f(a,b);
  auto rr=__builtin_amdgcn_permlane32_swap(__float_as_uint(m),__float_as_uint(m),false,false);
  return max2f(__uint_as_float(rr[0]),__uint_as_float(rr[1]));
}
__device__ __forceinline__ void pv(f32x16*o,int vb,bf16x8 pa0,bf16x8 pa1,bf16x8 pa2,bf16x8 pa3){
  #pragma unroll
  for(int d0=0;d0<2;++d0){s16x4 lo[4],hi[4];
    #pragma unroll
    for(int ks=0;ks<4;++ks){
      asm volatile("ds_read_b64_tr_b16 %0,%1 offset:%c2":"=&v"(lo[ks]):"v"(vb),"i"(d0*4096+ks*1024):"memory");
      asm volatile("ds_read_b64_tr_b16 %0,%1 offset:%c2":"=&v"(hi[ks]):"v"(vb),"i"(d0*4096+ks*1024+512):"memory");}
    asm volatile("s_waitcnt lgkmcnt(0)":::"memory");SBAR();
    #define PK(k) (bf16x8){lo[k][0],lo[k][1],lo[k][2],lo[k][3],hi[k][0],hi[k][1],hi[k][2],hi[k][3]}
    o[d0]=__builtin_amdgcn_mfma_f32_32x32x16_bf16(pa0,PK(0),o[d0],0,0,0);
    o[d0]=__builtin_amdgcn_mfma_f32_32x32x16_bf16(pa1,PK(1),o[d0],0,0,0);
    o[d0]=__builtin_amdgcn_mfma_f32_32x32x16_bf16(pa2,PK(2),o[d0],0,0,0);
    o[d0]=__builtin_amdgcn_mfma_f32_32x32x16_bf16(pa3,PK(3),o[d0],0,0,0);
    #undef PK
  }
}

#ifndef ATTN_STORE16
#define ATTN_STORE16(p,v) (*(u32x4*)(p)=(v))
#endif

template<int POS> __device__ __forceinline__ unsigned mbit(int m){int r;asm("v_bfe_i32 %0, %1, %2, 1":"=v"(r):"v"(m),"n"(POS));return (unsigned)r;}
#define AB_M1(P,R,MB) do{ if(!FOXB) P[R]=__uint_as_float(__float_as_uint(P[R])&mbit<8*((R)>>2)+((R)&3)>(MB)); }while(0)
#define AB_MASK16(P,MB) do{AB_M1(P,0,MB);AB_M1(P,1,MB);AB_M1(P,2,MB);AB_M1(P,3,MB);AB_M1(P,4,MB);AB_M1(P,5,MB);AB_M1(P,6,MB);AB_M1(P,7,MB);AB_M1(P,8,MB);AB_M1(P,9,MB);AB_M1(P,10,MB);AB_M1(P,11,MB);AB_M1(P,12,MB);AB_M1(P,13,MB);AB_M1(P,14,MB);AB_M1(P,15,MB);}while(0)
template<int THRL,bool FOXB> __device__ __forceinline__ void attn_unit(int b,int h,int qb,const bf16*Q,const bf16*__restrict__ K,const bf16*__restrict__ V,bf16*O,const unsigned long long*__restrict__ MK,const float*__restrict__ CK,int kt0,char*shm){
  const int tid=ltid(),lane=tid&63,r32=lane&31,hi=lane>>5; const int wid=__builtin_amdgcn_readfirstlane(tid>>6);
  const long rowbase=(long)b*SEQ; const int q0=qb*QB;
  const bf16*Qw=Q+(rowbase+q0+wid*QBLK)*DM+h*D;
  const long tstep=FOXB?(long)KVBLK*DM:4096;
  const bf16*Kh=FOXB?K+(rowbase+(long)kt0*KVBLK)*DM+h*D:K+(long)(b*NHEAD+h)*(SEQ/KVBLK)*4096,*Vh=FOXB?V+(rowbase+(long)kt0*KVBLK)*DM+h*D:V+(long)(b*NHEAD+h)*(SEQ/KVBLK)*4096;
  const unsigned lds0=(unsigned)(uintptr_t)shm;
  float*wsf=(float*)(shm+LDS_WS)+wid*64;
  const bf16*ksrc=FOXB?Kh+(long)lane*DM+wid*8:Kh+(wid*64+lane)*8;
  const bf16*vsrc=FOXB?Vh+(long)(16*(wid&3)+(lane>>2))*DM+(wid>>2)*32+(lane&3)*8:Vh+((wid>>2)*64+16*(wid&3))*32+lane*8;
  const unsigned kdst=lds0+LDS_K+wid*1024, vdst=lds0+LDS_V+wid*1024;
  #define DMA_K(t,slot) glds16(ksrc+(long)(t)*tstep,(unsigned)__builtin_amdgcn_readfirstlane(kdst+(slot)))
  #define DMA_V(t,slot) glds16(vsrc+(long)(t)*tstep,(unsigned)__builtin_amdgcn_readfirstlane(vdst+(slot)))
  const char*Kbase=shm+LDS_K; bf16x8 kf[8];
  const lds_cptr shm3=(lds_cptr)shm; const lds_cptr kp0=shm3+LDS_K+hi*1024+r32*16; const lds_cptr vp0=shm3+LDS_V+((lane>>4)&1)*32+(lane&3)*8+(4*hi+((lane&15)>>2))*64;
  const int NT=(q0+QB)/KVBLK-kt0;
  DMA_K(0,0);DMA_V(0,0);DMA_K(1,SLOTB);
  bf16x8 qr[4];
  #pragma unroll
  for(int d0=0;d0<4;++d0)qr[d0]=*reinterpret_cast<const bf16x8*>(&Qw[(long)r32*DM+d0*16+hi*8]);
  const lds_cptr qp0=shm3+LDS_OST+wid*4096+lane*16;
  #pragma unroll
  for(int d0=0;d0<4;++d0)*(__attribute__((address_space(3))) bf16x8*)(qp0+d0*1024)=qr[d0];
  #define QR(d) (*(const __attribute__((address_space(3))) bf16x8*)(qp0+(d)*1024))
  float mhat=0.f,l_reg=0.f;f32x16 o[2];o[0]=f32x16{};o[1]=f32x16{};f32x16 negm=f32x16{};asm volatile("":"+v"(negm));
  const int qrel=wid*QBLK+r32;
  const unsigned mrow_off=(unsigned)((rowbase+q0+qrel)*(SEQ/64));
  unsigned long long mw_cur=0ull; if(!FOXB) mw_cur=MK[mrow_off];
  float*ckring=(float*)(shm+LDS_BYTES); const unsigned ckoff=(unsigned)((b*NHEAD+h)*SEQ+kt0*KVBLK+lane); float ckreg=0.f;
  if(FOXB&&wid==0){ ckring[lane]=CK[ckoff]; ckring[64+lane]=CK[ckoff+64]; ckreg=CK[ckoff+128]; }
  #define CKBIAS(C0,C1,t) do{ if(FOXB){ const float*cks_=ckring+((t)%3)*64+4*hi; \
      _Pragma("unroll") for(int g_=0;g_<4;++g_){ const f32x4 ca_=*(const f32x4*)(cks_+8*g_), cb_=*(const f32x4*)(cks_+32+8*g_); \
        _Pragma("unroll") for(int j_=0;j_<4;++j_){ C0[4*g_+j_]-=ca_[j_]; C1[4*g_+j_]-=cb_[j_]; } } } }while(0)
  #define CMASK(P0,P1,t) do{int jb_=(t)-(NT-4); if(jb_>=0)cmask(P0,P1,jb_,qrel,hi);}while(0)
  bool resc=false;
  #define START(P0,P1) do{ const float rm=rowmax(P0,P1); resc=false; \
    { const float dl=rm; mhat=fadd_s(mhat,dl); \
      _Pragma("unroll") for(int r=0;r<16;++r){P0[r]=fsub_s(P0[r],dl);P1[r]=fsub_s(P1[r],dl);} \
      _Pragma("unroll") for(int r=0;r<16;++r)negm[r]=-mhat; asm volatile("":"+v"(negm)); } \
    _Pragma("unroll") for(int r=0;r<16;++r)P0[r]=__builtin_amdgcn_exp2f(P0[r]); }while(0)
  #define RESC() do{ if(resc){ asm volatile("s_waitcnt lgkmcnt(0)":::"memory"); \
      _Pragma("unroll") for(int d_=0;d_<2;++d_) _Pragma("unroll") for(int r=0;r<16;++r)o[d_][r]*=wsf[crow(r,hi)]; } }while(0)
  f32x16 pA0,pA1,pB0,pB1;
  int sl_prev=0,sl_cur=0,sl_next=SLOTB;
  #define ROT() do{sl_prev=sl_cur;sl_cur=sl_next;sl_next=(sl_next==(NSLOT-1)*SLOTB)?0:sl_next+SLOTB;}while(0)
  DMA_K(2,2*SLOTB);
  WAIT_BAR(3);
  qkt(pA0,pA1,Kbase,qr,negm,r32,hi);asm volatile("s_nop 15\n\ts_nop 7":"+v"(pA0),"+v"(pA1));CKBIAS(pA0,pA1,0);CMASK(pA0,pA1,0);
  START(pA0,pA1);
  _Pragma("unroll") for(int r=0;r<16;++r)pA1[r]=__builtin_amdgcn_exp2f(pA1[r]);
  WAIT_BAR(0);
  DMA_K(3,0);DMA_V(1,SLOTB);
  ROT();
  kload8(kf,kp0+sl_cur);
  WAIT_BAR(2);
  s16x4 vlo[8],vhi[8]; u32x4 pw0,pw1,pw2,pw3;
  #define PKW(P,B) cvtpk_s(P[B],P[B+1])
  #define PAF(k) __builtin_bit_cast(bf16x8,pw##k)
  #define VFR(i) (bf16x8){vlo[i][0],vlo[i][1],vlo[i][2],vlo[i][3],vhi[i][0],vhi[i][1],vhi[i][2],vhi[i][3]}
  #define PIN(x) asm volatile("":"+v"(x))
  #define MX3(a,b,c) __builtin_fmaxf(__builtin_fmaxf((a),(b)),(c))
  #define GAPA(MK_,MF,A0,A1,A2,A3,W0,W1,PW) do{ MF; MK_; sacc+=A0; sacc+=A1; sacc+=A2; sacc+=A3; PIN(sacc); W0; W1; PIN(PW); SBAR(); }while(0)
  #define MK4(P,R0,R1,R2,R3,MB) do{AB_M1(P,R0,MB);AB_M1(P,R1,MB);AB_M1(P,R2,MB);AB_M1(P,R3,MB);}while(0)
  #define EX(v) __builtin_amdgcn_exp2f(v)
  #define GAPB(MF,X,B) do{ MF; X[B]=EX(X[B]); X[B+1]=EX(X[B+1]); X[B+2]=EX(X[B+2]); X[B+3]=EX(X[B+3]); PIN(X); SBAR(); }while(0)
  #define VRD(i) do{ vlo[i]=vtr(vp_+(((i)>>2)*4096+((i)&3)*1024)); vhi[i]=vtr(vp_+(((i)>>2)*4096+((i)&3)*1024+512)); }while(0)
  #define KRD(G,j) do{ if(G){ kload2(kf,kp0+sl_next,j); SBAR(); } }while(0)
  #define STEP(C0,C1,P0,P1,t,GK,GV,GL) do{ SBAR(); \
    if(FOXB&&wid==0){ ckring[(((t)+1)%3)*64+lane]=ckreg; if((t)+2<NT) ckreg=CK[ckoff+((t)+2)*64]; } \
    const int mb0_=(int)(unsigned)(mw_cur>>(4*hi)), mb1_=(int)(unsigned)(mw_cur>>(32+4*hi)); AB_M1(P0,0,mb0_); AB_M1(P0,1,mb0_); \
    const lds_cptr vp_=vp0+sl_prev; \
    VRD(0); SBAR(); float sacc=(P0[0]+P0[1]); \
    GAPA(MK4(P0,2,3,4,5,mb0_), C0=__builtin_amdgcn_mfma_f32_32x32x16_bf16(kf[0],QR(0),negm,0,0,0), P0[2],P0[3],P0[4],P0[5],     pw0[0]=PKW(P0,0), pw0[1]=PKW(P0,2), pw0); \
    VRD(4); SBAR(); GAPA(MK4(P0,6,7,8,9,mb0_), C1=__builtin_amdgcn_mfma_f32_32x32x16_bf16(kf[1],QR(0),negm,0,0,0), P0[6],P0[7],P0[8],P0[9],     pw0[2]=PKW(P0,4), pw0[3]=PKW(P0,6), pw0); \
    VRD(1); SBAR(); GAPA(MK4(P0,10,11,12,13,mb0_), C0=__builtin_amdgcn_mfma_f32_32x32x16_bf16(kf[2],QR(1),C0,0,0,0),   P0[10],P0[11],P0[12],P0[13], pw1[0]=PKW(P0,8), pw1[1]=PKW(P0,10), pw1); \
    VRD(5); SBAR(); GAPA(do{AB_M1(P0,14,mb0_);AB_M1(P0,15,mb0_);AB_M1(P1,0,mb1_);AB_M1(P1,1,mb1_);}while(0), C1=__builtin_amdgcn_mfma_f32_32x32x16_bf16(kf[3],QR(1),C1,0,0,0),   P0[14],P0[15],P1[0],P1[1],   pw1[2]=PKW(P0,12),pw1[3]=PKW(P0,14), pw1); \
    VRD(2); SBAR(); GAPA(MK4(P1,2,3,4,5,mb1_), C0=__builtin_amdgcn_mfma_f32_32x32x16_bf16(kf[4],QR(2),C0,0,0,0),   P1[2],P1[3],P1[4],P1[5],     pw2[0]=PKW(P1,0), pw2[1]=PKW(P1,2), pw2); \
    VRD(6); SBAR(); GAPA(MK4(P1,6,7,8,9,mb1_), C1=__builtin_amdgcn_mfma_f32_32x32x16_bf16(kf[5],QR(2),C1,0,0,0),   P1[6],P1[7],P1[8],P1[9],     pw2[2]=PKW(P1,4), pw2[3]=PKW(P1,6), pw2); \
    VRD(3); SBAR(); GAPA(MK4(P1,10,11,12,13,mb1_), C0=__builtin_amdgcn_mfma_f32_32x32x16_bf16(kf[6],QR(3),C0,0,0,0),   P1[10],P1[11],P1[12],P1[13], pw3[0]=PKW(P1,8), pw3[1]=PKW(P1,10), pw3); \
    VRD(7); SBAR(); GAPA(do{AB_M1(P1,14,mb1_);AB_M1(P1,15,mb1_);}while(0), C1=__builtin_amdgcn_mfma_f32_32x32x16_bf16(kf[7],QR(3),C1,0,0,0),   P1[14],P1[15],0.f,0.f,       pw3[2]=PKW(P1,12),pw3[3]=PKW(P1,14), pw3); \
    l_reg+=sacc; if(!FOXB) mw_cur=MK[mrow_off+(t)]; \
    if(GK){DMA_K((t)+3,sl_cur);} if(GV){DMA_V((t)+1,sl_next);} \
    CKBIAS(C0,C1,t); CMASK(C0,C1,t); \
    { float a=MX3(C0[0],C0[1],C1[0]),b=MX3(C0[2],C0[3],C1[1]); a=MX3(a,C1[2],C1[3]); \
      _Pragma("unroll") for(int r=4;r<16;r+=4){a=MX3(a,C0[r],C0[r+1]);b=MX3(b,C0[r+2],C0[r+3]);a=MX3(a,C1[r],C1[r+1]);b=MX3(b,C1[r+2],C1[r+3]);} \
      float rm=__builtin_fmaxf(a,b); { auto rr=__builtin_amdgcn_permlane32_swap(__float_as_uint(rm),__float_as_uint(rm),false,false); rm=__builtin_fmaxf(__uint_as_float(rr[0]),__uint_as_float(rr[1])); } \
      resc=false; \
      if(__builtin_expect(__any(rm>(float)THRL),0)){ const float dl=__builtin_fmaxf(rm,0.f); mhat+=dl; \
        _Pragma("unroll") for(int r=0;r<16;++r){C0[r]-=dl;C1[r]-=dl;} \
        _Pragma("unroll") for(int r=0;r<16;++r)negm[r]=-mhat; asm volatile("":"+v"(negm)); \
        const float f=__builtin_amdgcn_exp2f(-dl); l_reg*=f; { int ri_=r32; asm volatile("":"+v"(ri_)); if(hi==0)wsf[ri_]=f; } resc=true; } } \
    SBAR(); \
    GAPB(o[0]=__builtin_amdgcn_mfma_f32_32x32x16_bf16(PAF(0),VFR(0),o[0],0,0,0), C0,0); \
    GAPB(o[1]=__builtin_amdgcn_mfma_f32_32x32x16_bf16(PAF(0),VFR(4),o[1],0,0,0), C0,4); \
    KRD(GL,0); GAPB(o[0]=__builtin_amdgcn_mfma_f32_32x32x16_bf16(PAF(1),VFR(1),o[0],0,0,0), C0,8); \
    KRD(GL,1); GAPB(o[1]=__builtin_amdgcn_mfma_f32_32x32x16_bf16(PAF(1),VFR(5),o[1],0,0,0), C0,12); \
    KRD(GL,2); GAPB(o[0]=__builtin_amdgcn_mfma_f32_32x32x16_bf16(PAF(2),VFR(2),o[0],0,0,0), C1,0); \
    KRD(GL,3); GAPB(o[1]=__builtin_amdgcn_mfma_f32_32x32x16_bf16(PAF(2),VFR(6),o[1],0,0,0), C1,4); \
    GAPB(o[0]=__builtin_amdgcn_mfma_f32_32x32x16_bf16(PAF(3),VFR(3),o[0],0,0,0), C1,8); \
    GAPB(o[1]=__builtin_amdgcn_mfma_f32_32x32x16_bf16(PAF(3),VFR(7),o[1],0,0,0), C1,12); \
    }while(0)
  int t=1;
  #undef CMASK
  #define CMASK(P0,P1,t) do{}while(0)
  for(;t+5<NT;t+=2){
    STEP(pB0,pB1,pA0,pA1,t,true,true,true);     WAIT_BAR(2); RESC(); ROT();
    STEP(pA0,pA1,pB0,pB1,t+1,true,true,true);   WAIT_BAR(2); RESC(); ROT();
  }
  #undef CMASK
  #define CMASK(P0,P1,t) do{int jb_=(t)-(NT-4); if(jb_>=0)cmask(P0,P1,jb_,qrel,hi);}while(0)
  #define ENDW(tt) do{ if((tt)+3<NT){WAIT_BAR(2);} else if((tt)+2<NT){WAIT_BAR(1);} else {WAIT_BAR(0);} }while(0)
  for(;t+1<NT;t+=2){
    STEP(pB0,pB1,pA0,pA1,t,(t+3<NT),(t+1<NT),(t+1<NT));       ENDW(t);   RESC(); ROT();
    STEP(pA0,pA1,pB0,pB1,t+1,(t+4<NT),(t+2<NT),(t+2<NT));     ENDW(t+1); RESC(); ROT();
  }
  STEP(pB0,pB1,pA0,pA1,NT-1,false,false,false); RESC();
  { const int mb0_=(int)(unsigned)(mw_cur>>(4*hi)), mb1_=(int)(unsigned)(mw_cur>>(32+4*hi)); AB_MASK16(pB0,mb0_); AB_MASK16(pB1,mb1_); }
  { float sacc=pB0[0]+pB0[1]; _Pragma("unroll") for(int r=2;r<16;++r)sacc+=pB0[r]; _Pragma("unroll") for(int r=0;r<16;++r)sacc+=pB1[r]; l_reg+=sacc;
    pw0=(u32x4){PKW(pB0,0),PKW(pB0,2),PKW(pB0,4),PKW(pB0,6)};pw1=(u32x4){PKW(pB0,8),PKW(pB0,10),PKW(pB0,12),PKW(pB0,14)};pw2=(u32x4){PKW(pB1,0),PKW(pB1,2),PKW(pB1,4),PKW(pB1,6)};pw3=(u32x4){PKW(pB1,8),PKW(pB1,10),PKW(pB1,12),PKW(pB1,14)};
    SBAR(); { int ln_=lane; asm volatile("":"+v"(ln_)); const int vb0=(int)(lds0+LDS_V)+((ln_>>4)&1)*32+(ln_&3)*8+(4*(ln_>>5)+((ln_&15)>>2))*64;
      pv(o,vb0+sl_cur,PAF(0),PAF(1),PAF(2),PAF(3)); } }
  #undef PKW
  #undef PAF
  #undef VFR
  #undef PIN
  #undef MX3
  #undef GAPA
  #undef MK4
  #undef GAPB
  #undef EX
  #undef VRD
  #undef KRD
  #undef STEP
  #undef ENDW
  {auto rr=__builtin_amdgcn_permlane32_swap(__float_as_uint(l_reg),__float_as_uint(l_reg),false,false);l_reg=__uint_as_float(rr[0])+__uint_as_float(rr[1]);}
  if(hi==0)wsf[32+r32]=l_reg;asm volatile("s_waitcnt lgkmcnt(0)":::"memory");
  float rli[16];
  #pragma unroll
  for(int r=0;r<16;++r)rli[r]=__builtin_amdgcn_rcpf(wsf[32+crow(r,hi)]);
  { bf16*stg=(bf16*)(shm+LDS_OST)+wid*2048;
    #pragma unroll
    for(int r=0;r<16;++r){const int orow=crow(r,hi);
      #pragma unroll
      for(int d0=0;d0<2;++d0)stg[orow*64+d0*32+r32]=__float2bfloat16(o[d0][r]*rli[r]);}
    asm volatile("s_waitcnt lgkmcnt(0)":::"memory");
    #pragma unroll
    for(int i=0;i<4;++i){const int row=i*8+(lane>>3),ch=lane&7; const u32x4 v=*(const u32x4*)(stg+row*64+ch*8); const int trow=q0+wid*QBLK+row;
      if(trow>=16&&trow<8208) ATTN_STORE16(O+((long)b*8192+(trow-16))*DM+h*D+ch*8,v);} }
  asm volatile("s_waitcnt lgkmcnt(0)\n\ts_barrier":::"memory");
  #undef DMA_K
  #undef DMA_V
  #undef CMASK
  #undef START
  #undef RESC
  #undef ROT
  #undef CKBIAS
  #undef QR
}
constexpr int ATTN_LDS_BYTES=LDS_BYTES;
#undef SBAR
#undef WAIT_BAR
}

__device__ __forceinline__ unsigned ordkey16(float s) {
    const _Float16 hf = (_Float16)(s + 0.0f);
    const unsigned bits = (unsigned)__builtin_bit_cast(unsigned short, hf);
    return (bits & 0x8000u) ? (~bits & 0xffffu) : (bits | 0x8000u);
}
template <int CTRL, int ROWMASK> __device__ __forceinline__ int dppi(int v) { return __builtin_amdgcn_update_dpp(0, v, CTRL, ROWMASK, 0xf, true); }
__device__ __forceinline__ int wave_incl_scan(int v) {
    v += dppi<0x111, 0xf>(v);
    v += dppi<0x112, 0xf>(v);
    v += dppi<0x114, 0xf>(v);
    v += dppi<0x118, 0xf>(v);
    v += dppi<0x142, 0xa>(v);
    v += dppi<0x143, 0xc>(v);
    return v;
}
__device__ __forceinline__ void hist_find(const unsigned* hist, int need, int lane, int& bin, int& above) {
    const uint4 c4 = *(const uint4*)(hist + 252 - 4 * lane);
    const int c0 = (int)c4.w, c1 = (int)c4.z, c2 = (int)c4.y, c3 = (int)c4.x;
    const int tot = c0 + c1 + c2 + c3;
    const int incl = wave_incl_scan(tot);
    const unsigned long long bal = __ballot(incl >= need);
    const int L = bal ? (int)__builtin_ctzll(bal) : 63;
    int mybin, myabove;
    {
        int cum = incl - tot;
        if (cum + c0 >= need) { mybin = 255 - 4 * lane; myabove = cum; }
        else { cum += c0;
            if (cum + c1 >= need) { mybin = 254 - 4 * lane; myabove = cum; }
            else { cum += c1;
                if (cum + c2 >= need) { mybin = 253 - 4 * lane; myabove = cum; }
                else { cum += c2; mybin = 252 - 4 * lane; myabove = cum; } } }
    }
    bin = __builtin_amdgcn_readlane(mybin, L); above = __builtin_amdgcn_readlane(myabove, L);
}
__device__ __forceinline__ unsigned fixkey16(float s) {
    const int v = (int)(__float_as_uint(fmaf(s, 2048.0f, 12582912.0f + 32768.0f)) - 0x4B400000u);
    return (unsigned)min(max(v, 1), 65535);
}
__device__ void indexer_item(unsigned char* ws, int b, int qg, unsigned char* smem) {
    const bf16_t* QI = (const bf16_t*)(ws + OFF_QI);
    const bf16_t* KI = (const bf16_t*)(ws + OFF_KI);
    const float* WI = (const float*)(ws + OFF_WI);
    unsigned long long* mask = (unsigned long long*)(ws + OFF_MASK);
    unsigned short* sc = (unsigned short*)smem;
    unsigned* hist_all = (unsigned*)(smem + 8 * SCP * 2);
    const int tid = ltid(), lane = tid & 63, wave = __builtin_amdgcn_readfirstlane(tid >> 6);
    const int t0 = qg * 8;
    const int g = lane >> 4, kc = lane & 15;
    for (int i = tid * 4; i < 8 * HP; i += NTHREADS * 4) *(uint4*)(hist_all + i) = zero4u();
    bf16x8 af[4][2];
#pragma unroll
    for (int mi = 0; mi < 4; ++mi) {
        const int q = (mi >> 1) * 4 + (kc >> 2), hh = (mi & 1) * 4 + (kc & 3);
#pragma unroll
        for (int ks = 0; ks < 2; ++ks) af[mi][ks] = *(const bf16x8*)(QI + ((size_t)b * TP + t0 + q) * 512 + hh * 64 + ks * 32 + g * 8);
    }
    float wq[2][8];
#pragma unroll
    for (int a = 0; a < 2; ++a)
#pragma unroll
        for (int hh = 0; hh < 8; ++hh) wq[a][hh] = WI[((size_t)b * TP + t0 + a * 4 + g) * 8 + hh];
    __syncthreads();
    const int ntile = (t0 + 8 + 15) >> 4;
    const bf16_t* kbase = KI + ((size_t)b * (TP / 16) * 2 * 64 + lane) * 8;
    for (int rep_ = 0; rep_ < IDX_REP_MFMA; ++rep_) {
    constexpr int U = 4;
    const f32x4 z4 = zero4();
    const int nfull = (t0 >= 15) ? ((t0 - 15) >> 4) + 1 : 0;
    unsigned short* scw0 = sc + g * SCP + kc;
    unsigned* hw0 = hist_all + g * HP;
    bf16x8 c0[U], c1[U];
#pragma unroll
    for (int u = 0; u < U; ++u) { const int kt = wave + 8 * u; if (kt < ntile) { const bf16_t* kr = kbase + (size_t)kt * 1024; c0[u] = *(const bf16x8*)kr; c1[u] = *(const bf16x8*)(kr + 512); } }
    for (int base = wave; base < ntile; base += 8 * U) {
        bf16x8 n0[U], n1[U];
#pragma unroll
        for (int u = 0; u < U; ++u) { const int kt = base + 8 * (U + u); n0[u] = c0[u]; n1[u] = c1[u]; if (kt < ntile && !(IDX_PROBE == 3 && rep_ > 0)) { const bf16_t* kr = kbase + (size_t)kt * 1024; n0[u] = *(const bf16x8*)kr; n1[u] = *(const bf16x8*)(kr + 512); } }
#pragma unroll
        for (int u = 0; u < U; ++u) {
            const int kt = base + 8 * u;
            if (kt < ntile) {
                f32x4 acc[4];
#pragma unroll
                for (int mi = 0; mi < 4; ++mi) {
                    acc[mi] = __builtin_amdgcn_mfma_f32_16x16x32_bf16(af[mi][0], c0[u], z4, 0, 0, 0);
                    acc[mi] = __builtin_amdgcn_mfma_f32_16x16x32_bf16(af[mi][1], c1[u], acc[mi], 0, 0, 0);
                }
                float s0 = 0.f, s1 = 0.f;
#pragma unroll
                for (int c = 0; c < 2; ++c)
#pragma unroll
                    for (int j = 0; j < 4; ++j) {
                        s0 = fmaf(wq[0][c * 4 + j], __builtin_amdgcn_fmed3f(acc[c][j], 0.f, 3.0e38f), s0);
                        s1 = fmaf(wq[1][c * 4 + j], __builtin_amdgcn_fmed3f(acc[2 + c][j], 0.f, 3.0e38f), s1);
                    }
                unsigned k0 = fixkey16(s0), k1 = fixkey16(s1);
                if ((IDX_PROBE == 1 || IDX_PROBE == 3) && rep_ > 0) { asm volatile("" :: "v"(k0), "v"(k1)); }
                else if (kt < nfull) {
                    scw0[kt * 16] = (unsigned short)k0; scw0[4 * SCP + kt * 16] = (unsigned short)k1;
                    if (rep_ == 0) { atomicAdd(&hw0[k0 >> 8], 1u); atomicAdd(&hw0[4 * HP + (k1 >> 8)], 1u); }
                } else {
                    const int key = kt * 16 + kc;
                    const bool ok0 = key <= t0 + g, ok1 = key <= t0 + 4 + g;
                    k0 = ok0 ? k0 : 0u; k1 = ok1 ? k1 : 0u;
                    scw0[kt * 16] = (unsigned short)k0; scw0[4 * SCP + kt * 16] = (unsigned short)k1;
                    if (rep_ == 0) { if (ok0) atomicAdd(&hw0[k0 >> 8], 1u); if (ok1) atomicAdd(&hw0[4 * HP + (k1 >> 8)], 1u); }
                }
            }
        }
#pragma unroll
        for (int u = 0; u < U; ++u) { c0[u] = n0[u]; c1[u] = n1[u]; }
    }
    }
    __syncthreads();
    for (int rep2_ = 0; rep2_ < IDX_REP_SEL; ++rep2_)
    {
        const int t = t0 + wave;
        const int n = t + 1;
        const unsigned short* row = sc + wave * SCP;
        unsigned* hist = hist_all + wave * HP;
        unsigned char* mrow = (unsigned char*)(mask + ((size_t)b * TP + t) * MW);
        const int nbytes = ((t >> 8) + 1) * 32;
        const int nit3 = (nbytes + 63) >> 6;
        unsigned Tkey = 0u; int rem = 0;
        if (n > 256) {
            const int nit = (n + 511) >> 9;
            int B1, above1;
            hist_find(hist, 256, lane, B1, above1);
            const int need2 = 256 - above1;
            __threadfence_block();
            *(uint4*)(hist + lane * 4) = zero4u();
            __threadfence_block();
            for (int it = 0; it < nit; ++it) {
                const int e0 = (it * 64 + lane) * 8;
                const uint4 v = *(const uint4*)(row + e0);
                const unsigned ww[4] = {v.x, v.y, v.z, v.w};
#pragma unroll
                for (int e = 0; e < 8; ++e) {
                    const unsigned k = (ww[e >> 1] >> ((e & 1) * 16)) & 0xffffu;
                    if (e0 + e < n && (int)(k >> 8) == B1) atomicAdd(&hist[k & 255u], 1u);
                }
            }
            __threadfence_block();
            int B2, above2;
            hist_find(hist, need2, lane, B2, above2);
            Tkey = ((unsigned)B1 << 8) | (unsigned)B2;
            rem = 256 - above1 - above2;
        }
        for (int it = 0; it < nit3; ++it) {
            const int e0 = (it * 64 + lane) * 8;
            const uint4 v = *(const uint4*)(row + e0);
            const unsigned ww[4] = {v.x, v.y, v.z, v.w};
            unsigned gtb = 0u, eqb = 0u;
#pragma unroll
            for (int e = 0; e < 8; ++e) {
                const unsigned k = (ww[e >> 1] >> ((e & 1) * 16)) & 0xffffu;
                const bool valid = (e0 + e) < n;
                gtb |= (valid && k > Tkey) ? (1u << e) : 0u;
                eqb |= (valid && k == Tkey) ? (1u << e) : 0u;
            }
            if (__ballot(eqb != 0u) != 0ull) {
                const int c = __popc(eqb);
                int incl = c;
#pragma unroll
                for (int d = 1; d < 64; d <<= 1) { const int vv = __shfl_up(incl, d); if (lane >= d) incl += vv; }
                int r = incl - c;
                unsigned tk = 0u;
#pragma unroll
                for (int e = 0; e < 8; ++e) if ((eqb >> e) & 1u) { if (r < rem) tk |= (1u << e); ++r; }
                rem -= __shfl(incl, 63) < rem ? __shfl(incl, 63) : rem;
                gtb |= tk;
            }
            const int bi = it * 64 + lane;
            if (bi < nbytes) mrow[bi] = (unsigned char)gtb;
        }
    }
    __syncthreads();
}

__device__ int fox_prune(unsigned char* ws, int b, int h, int qb, unsigned char* smem) {
    const int tid = ltid(), lane = tid & 63, wave = __builtin_amdgcn_readfirstlane(tid >> 6), hlf = lane >> 5;
    const bf16_t* Q = (const bf16_t*)(ws + OFF_QF);
    const float* cumt = (const float*)(ws + OFF_CUMT) + (size_t)(b * 8 + h) * TP;
    const float* knorm = (const float*)(ws + OFF_KNORM) + (size_t)(b * 8 + h) * MW;
    float* red = (float*)(smem + 90112);
    const size_t grow = (size_t)b * TP + qb * 256 + wave * 32 + (lane & 31);
    float qq = 0.f;
#pragma unroll
    for (int ks = 0; ks < 4; ++ks) {
        const bf16x8 qv = *(const bf16x8*)(Q + grow * 512 + h * 64 + ks * 16 + hlf * 8);
#pragma unroll
        for (int e = 0; e < 8; ++e) { const float v = bf2f((unsigned)(unsigned short)qv[e]); qq = fmaf(v, v, qq); }
    }
    qq += __shfl_xor(qq, 32);
#pragma unroll
    for (int o = 1; o < 32; o <<= 1) qq = fmaxf(qq, __shfl_xor(qq, o));
    if (lane == 0) red[wave] = qq;
    __syncthreads();
    if (wave == 0) {
        float qm = red[0];
#pragma unroll
        for (int w = 1; w < 8; ++w) qm = fmaxf(qm, red[w]);
        const float Qn = sqrtf(qm) * 1.0001f;
        const float Kd = fmaxf(fmaxf(knorm[qb * 4], knorm[qb * 4 + 1]), fmaxf(knorm[qb * 4 + 2], knorm[qb * 4 + 3])) * 1.0001f;
        const float cfirst = cumt[qb * 256];
        bool keep0 = true, keep1 = true;
        if (lane < qb * 4) { const float bnd = Qn * (knorm[lane] * 1.0001f + Kd) + cfirst - cumt[lane * 64 + 63]; keep0 = !(bnd < -40.0f); }
        if (lane + 64 < qb * 4) { const float bnd = Qn * (knorm[lane + 64] * 1.0001f + Kd) + cfirst - cumt[(lane + 64) * 64 + 63]; keep1 = !(bnd < -40.0f); }
        const unsigned long long b0 = __ballot(keep0), b1 = __ballot(keep1);
        const int first = b0 ? (int)__builtin_ctzll(b0) : (b1 ? 64 + (int)__builtin_ctzll(b1) : 128);
        if (lane == 0) ((int*)red)[8] = (first < qb * 4 ? first : qb * 4) & ~1;
    }
    __syncthreads();
    return ((const int*)red)[8];
}

#define LAS __attribute__((address_space(3)))
#define XB_TMO      128
#define XB_XCNT(j)  (256  + 64 * (j))
#define XB_XSUB(j)  (1280 + 64 * (j))
#define XB_XGEN(j)  (2304 + 64 * (j))
#define XB_TOP      3328
#define XB_TOPGEN   3392
#define XCD_BAR_WORDS 3456
#define XB_SPIN_CAP (1u << 18)
__device__ __forceinline__ unsigned xb_ld(unsigned* p)              { return __hip_atomic_load(p, __ATOMIC_RELAXED, __HIP_MEMORY_SCOPE_AGENT); }
__device__ __forceinline__ unsigned xb_add(unsigned* p, unsigned v) { return __hip_atomic_fetch_add(p, v, __ATOMIC_RELAXED, __HIP_MEMORY_SCOPE_AGENT); }
__device__ __forceinline__ unsigned xb_xcc_id() { return (unsigned)__builtin_amdgcn_s_getreg((3 << 11) | 20) & 0xFu; }
#define XB_SPIN(cond, bar) do { unsigned _sp = 0; while (cond) { __builtin_amdgcn_s_sleep(1); \
    if ((++_sp & 255u) == 0u) { if (xb_ld(&(bar)[XB_TMO])) break; if (_sp > XB_SPIN_CAP) { atomicAdd(&(bar)[XB_TMO], 1u); break; } } } } while (0)
struct XcdBarrier { unsigned* bar; unsigned x; volatile LAS unsigned* st; };
__device__ __forceinline__ XcdBarrier xcd_barrier_post(unsigned* bar, volatile LAS unsigned* st) {
    XcdBarrier b; b.bar = bar; b.x = xb_xcc_id(); b.st = st;
    if (threadIdx.x == 0) (void)xb_add(&bar[XB_XCNT(b.x)], 1u);
    return b;
}
__device__ __forceinline__ void xcd_barrier_complete(unsigned* bar, unsigned x, unsigned& nloc, unsigned& nx) {
    const unsigned G = gridDim.x * gridDim.y * gridDim.z;
    unsigned sum, cnt, mine, sp = 0u;
    for (;;) {
        sum = 0u; cnt = 0u; mine = 0u;
#pragma unroll
        for (unsigned j = 0; j < 16; ++j) { const unsigned c = xb_ld(&bar[XB_XCNT(j)]); sum += c; cnt += (c > 0u) ? 1u : 0u; mine = (j == x) ? c : mine; }
        if (sum == G) break;
        __builtin_amdgcn_s_sleep(1);
        if ((++sp & 255u) == 0u) { if (xb_ld(&bar[XB_TMO])) break; if (sp > XB_SPIN_CAP) { atomicAdd(&bar[XB_TMO], 1u); break; } }
    }
    nloc = mine > 0u ? mine : 1u; nx = cnt > 0u ? cnt : 1u;
}
__device__ __forceinline__ void xcd_barrier(const XcdBarrier& b) {
    asm volatile("s_waitcnt vmcnt(0)" ::: "memory");
    __syncthreads();
    if (threadIdx.x == 0) {
        unsigned* bar = b.bar;
        __builtin_amdgcn_s_waitcnt(0);
        unsigned nloc = b.st[0], nx = b.st[1];
        if (nloc == 0u) { xcd_barrier_complete(bar, b.x, nloc, nx); b.st[0] = nloc; b.st[1] = nx; }
        const unsigned old = xb_add(&bar[XB_XSUB(b.x)], 1u);
        const unsigned gen = old / nloc;
        if (old + 1u == (gen + 1u) * nloc) {
            __builtin_amdgcn_fence(__ATOMIC_RELEASE, "agent");
            asm volatile("s_waitcnt vmcnt(0)" ::: "memory");
            const unsigned og = xb_add(&bar[XB_TOP], 1u);
            const unsigned tg = og / nx;
            if (og + 1u == (tg + 1u) * nx) xb_add(&bar[XB_TOPGEN], 1u);
            else XB_SPIN(xb_ld(&bar[XB_TOPGEN]) == tg, bar);
            __builtin_amdgcn_fence(__ATOMIC_ACQUIRE, "agent");
            xb_add(&bar[XB_XGEN(b.x)], 1u);
            asm volatile("s_waitcnt vmcnt(0)" ::: "memory");
        } else {
            XB_SPIN(xb_ld(&bar[XB_XGEN(b.x)]) == gen, bar);
            __builtin_amdgcn_fence(__ATOMIC_ACQUIRE, "agent");
            asm volatile("s_waitcnt vmcnt(0)" ::: "memory");
        }
    }
    __syncthreads();
}

__global__ void __launch_bounds__(NTHREADS, 2) mega(Params p) {
    __shared__ __attribute__((aligned(16))) unsigned char smem[LDS_BYTES];
    volatile LAS unsigned* bst = (volatile LAS unsigned*)(smem + LDS_BYTES - 64);
    if (threadIdx.x < 2) bst[threadIdx.x] = 0u;
    __syncthreads();
    (void)xcd_barrier_post((unsigned*)(p.ws + OFF_CTL) + CW_BAR, bst);

#pragma unroll 1
    for (int step = p.ph_lo; step < p.ph_hi; ++step) {
        if (step > p.ph_lo && !(FUSE89 && REPEAT_PH < 0 && step == 9)) {
            KParams kpb = (KParams)__builtin_amdgcn_kernarg_segment_ptr(); asm volatile("" : "+s"(kpb));
            XcdBarrier gb; gb.bar = (unsigned*)(kpb->ws + OFF_CTL) + CW_BAR; gb.x = xb_xcc_id(); gb.st = (volatile LAS unsigned*)(smem + LDS_BYTES - 64);
            xcd_barrier(gb);
        }
        if (TIME_PH >= 0 && TIME_PH < 100 && blockIdx.x == 0 && threadIdx.x == 0 && (step == TIME_PH || step == TIME_PH + 1)) {
            const unsigned long long tt = wall_clock64(); volatile LAS unsigned* ts = (volatile LAS unsigned*)(smem + LDS_BYTES - 64) + (step == TIME_PH ? 4 : 6);
            ts[0] = (unsigned)tt; ts[1] = (unsigned)(tt >> 32);
        }
        const int ph = (REPEAT_PH >= 0 && step > REPEAT_PH) ? step - 1 : step;
        KParams kp = (KParams)__builtin_amdgcn_kernarg_segment_ptr(); asm volatile("" : "+s"(kp));
        unsigned char* ws = kp->ws;
        const int G = gridDim.x, bid = blockIdx.x;
        unsigned* ctl = (unsigned*)(ws + OFF_CTL);
        const float* rope = (const float*)(ws + OFF_ROPE);
        float* stat0 = (float*)(ws + OFF_STAT0);
        const float* x = kp->in[0];
        if (PH(0) && ph == 0) {
            const int tid = ltid(), lane = tid & 63, wave = __builtin_amdgcn_readfirstlane(tid >> 6); (void)lane; (void)wave;
            {
                bf16_t* HB = (bf16_t*)(ws + OFF_HB); bf16_t* HBM = (bf16_t*)(ws + OFF_HBM);
                const float* g0 = kp->in[2]; const float* b0 = kp->in[3];
                auto ln_rows = [&](const float* src0, bf16_t* dst0, int i0, int stride, int lim, bool meta) {
                    f32x4 v[4][4];
#pragma unroll
                    for (int k = 0; k < 4; ++k) {
                        const int i = (i0 + k * stride < lim) ? i0 + k * stride : i0;
#pragma unroll
                        for (int j = 0; j < 4; ++j) v[k][j] = *(const f32x4*)(src0 + (size_t)i * 1024 + lane * 4 + 256 * j);
                    }
#pragma unroll
                    for (int k = 0; k < 4; ++k) {
                        const int i = (i0 + k * stride < lim) ? i0 + k * stride : i0;
                        float s = 0.f;
#pragma unroll
                        for (int j = 0; j < 4; ++j) s += (v[k][j][0] + v[k][j][1]) + (v[k][j][2] + v[k][j][3]);
                        const float mu = wave_sum(s) * (1.0f / 1024.0f);
                        float q = 0.f;
#pragma unroll
                        for (int j = 0; j < 4; ++j) { const f32x4 d = v[k][j] - mu; q += (d[0] * d[0] + d[1] * d[1]) + (d[2] * d[2] + d[3] * d[3]); }
                        const float rstd = rsqrtf(wave_sum(q) * (1.0f / 1024.0f) + LN_EPS);
#pragma unroll
                        for (int j = 0; j < 4; ++j) {
                            const f32x4 gg = *(const f32x4*)(g0 + lane * 4 + 256 * j), bb = *(const f32x4*)(b0 + lane * 4 + 256 * j);
                            store4bf(dst0 + (size_t)i * 1024 + lane * 4 + 256 * j, (v[k][j] - mu) * rstd * gg + bb);
                        }
                        if (lane == 0 && !meta) { const int r = (i / SEQ) * TP + NMETA + i % SEQ; stat0[2 * r] = mu; stat0[2 * r + 1] = rstd; }
                    }
                };
                for (int i0 = bid * 8 + wave; i0 < NTOK; i0 += G * 8 * 4) ln_rows(x, HB, i0, G * 8, NTOK, false);
                if (bid * 8 + wave < NMETA / 4) ln_rows(kp->in[1], HBM, bid * 8 + wave, NMETA / 4, NMETA, true);
            }
            {
                float* ropew = (float*)(ws + OFF_ROPE);
                for (int i = bid * NTHREADS + tid; i < TP * 8; i += G * NTHREADS) {
                    const int t = i >> 3, k = i & 7;
                    const float invf[8] = {1.0f, 0.1939227432012558f, 0.03760603070259094f, 0.007292664609849453f, 0.0014142135623842478f,
                                           0.00027424818836152554f, 5.3182957344688475e-05f, 1.0313385246263351e-05f};
                    float iv = invf[0];
#pragma unroll
                    for (int kk = 1; kk < 8; ++kk) iv = (k == kk) ? invf[kk] : iv;
                    const float ang = (float)t * iv;
                    ropew[2 * i] = cosf(ang); ropew[2 * i + 1] = sinf(ang);
                }
            }
            {
                bf16_t* wrt = (bf16_t*)(ws + OFF_WRT);
                const float* wrg = kp->in[13]; const float* wre = kp->in[15];
                for (int i = bid * NTHREADS + tid; i < 48 * 1024; i += G * NTHREADS) {
                    const int e = i >> 10, k = i & 1023;
                    const float w = (e < 4) ? wrg[k * 4 + e] : ((e < 36) ? wre[k * 32 + (e - 4)] : 0.f);
                    const unsigned hi = f2bf(w);
                    wrt[i] = (bf16_t)hi; wrt[48 * 1024 + i] = (bf16_t)f2bf(w - bf2f(hi));
                }
            }
            {
                KParams kq = kp;
                unsigned char* wsq = ws;
                constexpr int N_WIN = 16 * 80, N_KV = 4 * 16, N_A = 8 * 16, N_F = 8 * 16, N_O = 16 * 16;
                constexpr int NT = N_WIN + N_KV + N_A + N_F + N_O;
                auto dec = [kq, wsq](int it) -> XTile {
                    XTile x; x.kscale = nullptr; x.winmap = 0; x.s16 = 16;
                    int i = it;
                    if (i < N_WIN) { x.src = kq->in[4]; x.src_ld = 4944; x.dst = (bf16_t*)(wsq + OFF_WIN); x.dst_ld = 1024; x.k0 = (i % 16) * 64; x.j0 = (i / 16) * 64; x.winmap = 1; }
                    else if ((i -= N_WIN) < N_KV) { x.src = kq->in[7]; x.src_ld = 1024; x.dst = (bf16_t*)(wsq + OFF_WKV); x.dst_ld = 256; x.k0 = (i % 4) * 64; x.j0 = (i / 4) * 64; x.kscale = kq->in[6]; }
                    else if ((i -= N_KV) < N_A) { x.src = kq->in[8]; x.src_ld = 1024; x.dst = (bf16_t*)(wsq + OFF_WA); x.dst_ld = 512; x.k0 = (i % 8) * 64; x.j0 = (i / 8) * 64; }
                    else if ((i -= N_A) < N_F) { x.src = kq->in[9]; x.src_ld = 1024; x.dst = (bf16_t*)(wsq + OFF_WF); x.dst_ld = 512; x.k0 = (i % 8) * 64; x.j0 = (i / 8) * 64; }
                    else { i -= N_F; x.src = kq->in[10]; x.src_ld = 1024; x.dst = (bf16_t*)(wsq + OFF_WO); x.dst_ld = 1024; x.k0 = (i % 16) * 64; x.j0 = (i / 16) * 64; }
                    x.rb = x.j0;
                    return x;
                };
                xpose_many(NT, G, bid, dec, (float*)smem);
            }
        }
        if ((PH(1) && ph == 1) || (PH(2) && ph == 2) || (PH(5) && ph == 5) || (PH(6) && ph == 6) || (PH(9) && ph == 9)) {
            {
            }
            float* rs = (float*)(smem + pg8::STAGE_BYTES);
            int* tag = (int*)(smem + pg8::STAGE_BYTES + 2048);
            if (ph == 2) TS_BEGIN(1);
            if (ph == 2) {
                const int tid = ltid();
                const bf16_t* CKV = (const bf16_t*)(ws + OFF_CKV);
                pg8::StaticOrder S; S.init(NTOK, 1024, G, bid);
                pg8::Unit u;
                for (int i = 0; i < 2; ++i) {
                    if (!S.next(i, u)) { if (tid == 0) tag[i] = -1; continue; }
                    if (tid == 0) tag[i] = u.pm;
                    const bf16_t* rp = CKV + (size_t)(u.pm * 256 + (tid >> 1)) * 256 + (tid & 1) * 128;
                    float ss = 0.f;
#pragma unroll
                    for (int c = 0; c < 16; ++c) {
                        const uint4 uu = *(const uint4*)(rp + c * 8);
                        const unsigned ww[4] = {uu.x, uu.y, uu.z, uu.w};
#pragma unroll
                        for (int e = 0; e < 4; ++e) { const float a0 = bf2f(ww[e] & 0xffffu), a1 = bf2f(ww[e] >> 16); ss = fmaf(a0, a0, fmaf(a1, a1, ss)); }
                    }
                    ss += __shfl_xor(ss, 1);
                    if ((tid & 1) == 0) rs[i * 256 + (tid >> 1)] = rsqrtf(ss * (1.0f / 256.0f) + RMS_EPS);
                }
                __syncthreads();
            }
            if (ph == 9) {
                const int tid = ltid();
                if (tid < 32) tag[tid] = (int)ctl[CW_ECNT + tid * ECS];
                __syncthreads();
                if (tid == 0) { int cp = 0, rb = 0; for (int e = 0; e < 32; ++e) { tag[32 + e] = cp; tag[64 + e] = rb; const int nc = (tag[e] + 255) >> 8; cp += nc; rb += nc * 256; } tag[96] = cp; }
                __syncthreads();
            }
            const int njobs = (ph == 5) ? 2 : 1;
#pragma unroll 1
            for (int job = 0; job < njobs; ++job) {
                pg8::Gemm g; int kind;
                if (ph == 1) { g = pg8::Gemm{(const bf16_t*)(ws + OFF_HB), (const bf16_t*)(ws + OFF_WIN), NTOK, NP, 1024}; kind = 0; }
                else if (ph == 2) { g = pg8::Gemm{(const bf16_t*)(ws + OFF_CKV), (const bf16_t*)(ws + OFF_WKV), NTOK, 1024, 256}; kind = 1; }
                else if (ph == 5) { g = (job == 0) ? pg8::Gemm{(const bf16_t*)(ws + OFF_YA), (const bf16_t*)(ws + OFF_WA), NTOK, 1024, 512}
                                                   : pg8::Gemm{(const bf16_t*)(ws + OFF_YF), (const bf16_t*)(ws + OFF_WF), NTOK, 1024, 512}; kind = 2 + job; }
                else if (ph == 6) { g = pg8::Gemm{(const bf16_t*)(ws + OFF_MERGED), (const bf16_t*)(ws + OFF_WO), NTOK, 1024, 1024}; kind = 4; }
                else { g = pg8::Gemm{(const bf16_t*)(ws + OFF_HID), (const bf16_t*)(ws + OFF_WD), HID_ROWS, 32 * 1024, 256}; kind = 5; }
                pg8::StaticOrder S; S.init(g.M, g.N, G, bid);
                if (ph == 9) S.init_moe((const PG8_LAS int*)tag, G, bid, (FUSE89 && REPEAT_PH < 0) ? (const unsigned*)ctl + CW_DONE : nullptr);
                EpiAny E{kind, (const PG8_LAS float*)rs, (const PG8_LAS int*)tag};
                if (ph == 2) { TS_END(1); TS_BEGIN(2); }
                pg8::gemm_phase<EpiAny, pg8::StaticOrder, true, true>((PG8_LAS unsigned char*)smem, g, S, E);
                if (ph == 2) { TS_END(2); TS_BEGIN(3); }
            }
            if (ph == 1) {
                const int tid = ltid(), lane = tid & 63, wave = __builtin_amdgcn_readfirstlane(tid >> 6);
                const int gw = (wave == 0) ? bid : 1 << 20;
                if (gw <= 180) {
                    const bf16_t* HBM = (const bf16_t*)(ws + OFF_HBM); const bf16_t* WIN = (const bf16_t*)(ws + OFF_WIN);
                    const int c0 = (gw < 180) ? gw * 16 : 4928;
                    f32x4 acc = zero4();
                    const bf16_t* ap_ = HBM + (size_t)(lane & 15) * 1024 + (lane >> 4) * 8;
                    const bf16_t* bp_ = WIN + (size_t)(c0 + (lane & 15)) * 1024 + (lane >> 4) * 8;
#pragma unroll 16
                    for (int kk = 0; kk < 32; ++kk) acc = __builtin_amdgcn_mfma_f32_16x16x32_bf16(*(const bf16x8*)(ap_ + kk * 32), *(const bf16x8*)(bp_ + kk * 32), acc, 0, 0, 0);
                    const int cg64 = c0 >> 6, d = (c0 & 63) + (lane & 15);
                    const bool ropeseg = (cg64 < 8 || (cg64 >= 12 && cg64 <= 20)) && ((c0 & 63) == 0);
                    const float* bfg = kp->in[5];
#pragma unroll
                    for (int j = 0; j < 4; ++j) {
                        const int t = (lane >> 4) * 4 + j;
                        float v = acc[j];
                        if (ropeseg) {
                            const float pr = __shfl_xor(v, 8);
                            const float cs = rope[t * 16 + 2 * (d & 7)], sn = rope[t * 16 + 2 * (d & 7) + 1];
                            v = (d & 8) ? (v * cs + pr * sn) : (v * cs - pr * sn);
                        }
#pragma unroll
                        for (int b = 0; b < 2; ++b) {
                            const size_t r = (size_t)b * TP + t;
                            if (cg64 < 8) ((bf16_t*)(ws + OFF_QA))[r * 512 + cg64 * 64 + d] = (bf16_t)f2bf(v * QSCALE);
                            else if (cg64 < 12) { if (b == 0) ((float*)(ws + OFF_MCKV))[t * 256 + (cg64 - 8) * 64 + d] = v; }
                            else if (cg64 < 20) ((bf16_t*)(ws + OFF_QI))[r * 512 + (cg64 - 12) * 64 + d] = (bf16_t)f2bf(v * 0.125f);
                            else if (cg64 == 20) ((bf16_t*)(ws + OFF_KI))[((size_t)((b * (TP / 16) + (t >> 4)) * 2 + (d >> 5)) * 64 + ((d & 31) >> 3) * 16 + (t & 15)) * 8 + (d & 7)] = (bf16_t)f2bf(v);
                            else if (cg64 < 29) ((bf16_t*)(ws + OFF_QF))[r * 512 + (cg64 - 21) * 64 + d] = (bf16_t)f2bf(v * QSCALE);
                            else if (cg64 < 37) ((bf16_t*)(ws + OFF_KF))[r * 512 + (cg64 - 29) * 64 + d] = (bf16_t)f2bf(v);
                            else if (cg64 < 45) ((bf16_t*)(ws + OFF_VF))[r * 512 + (cg64 - 37) * 64 + d] = (bf16_t)f2bf(v);
                            else if (d < 8) ((float*)(ws + OFF_WI))[r * 8 + d] = v * 0.3535533905932738f;
                            else { const float z = v + bfg[d - 8]; ((float*)(ws + OFF_LOGF))[(size_t)(b * 8 + (d - 8)) * TP + t] = fminf(z, 0.f) - __logf(1.0f + __expf(-fabsf(z))); }
                        }
                    }
                }
            }
            if (ph == 2) {
                const int tid = ltid(), lane = tid & 63, wave = __builtin_amdgcn_readfirstlane(tid >> 6);
                const int gw = (wave == 0) ? bid : 1 << 20;
                if (gw < 64) {
                    const float* MC = (const float*)(ws + OFF_MCKV); const bf16_t* WKV = (const bf16_t*)(ws + OFF_WKV);
                    const int c0 = gw * 16;
                    f32x4 acc = zero4(); float ss = 0.f;
                    const float* ap_ = MC + (lane & 15) * 256 + (lane >> 4) * 8;
                    const bf16_t* bp_ = WKV + (size_t)(c0 + (lane & 15)) * 256 + (lane >> 4) * 8;
#pragma unroll
                    for (int kk = 0; kk < 8; ++kk) {
                        const f32x4 a0 = *(const f32x4*)(ap_ + kk * 32), a1 = *(const f32x4*)(ap_ + kk * 32 + 4);
                        uint4 au; au.x = pk2(a0[0], a0[1]); au.y = pk2(a0[2], a0[3]); au.z = pk2(a1[0], a1[1]); au.w = pk2(a1[2], a1[3]);
                        const unsigned aw[4] = {au.x, au.y, au.z, au.w};
#pragma unroll
                        for (int e = 0; e < 4; ++e) { const float x0 = bf2f(aw[e] & 0xffffu), x1 = bf2f(aw[e] >> 16); ss = fmaf(x0, x0, fmaf(x1, x1, ss)); }
                        acc = __builtin_amdgcn_mfma_f32_16x16x32_bf16(*(bf16x8*)&au, *(const bf16x8*)(bp_ + kk * 32), acc, 0, 0, 0);
                    }
                    ss += __shfl_xor(ss, 16); ss += __shfl_xor(ss, 32);
                    const float rstd_row = rsqrtf(ss * (1.0f / 256.0f) + RMS_EPS);
                    const int cg64 = c0 >> 6, d = (c0 & 63) + (lane & 15);
                    const bool ropeseg = (cg64 < 8) && ((c0 & 63) == 0);
#pragma unroll
                    for (int j = 0; j < 4; ++j) {
                        const int t = (lane >> 4) * 4 + j;
                        float v = acc[j] * __shfl(rstd_row, t);
                        if (ropeseg) {
                            const float pr = __shfl_xor(v, 8);
                            const float cs = rope[t * 16 + 2 * (d & 7)], sn = rope[t * 16 + 2 * (d & 7) + 1];
                            v = (d & 8) ? (v * cs + pr * sn) : (v * cs - pr * sn);
                        }
#pragma unroll
                        for (int b = 0; b < 2; ++b) {
                            const size_t r = (size_t)b * TP + t;
                            if (cg64 < 8) ((bf16_t*)(ws + OFF_KA))[kimg_off(b, cg64, t, d)] = (bf16_t)f2bf(v);
                            else ((bf16_t*)(ws + OFF_VA))[vimg_off(b, cg64 - 8, t, d)] = (bf16_t)f2bf(v);
                        }
                    }
                }
            }
            if (ph == 2) { TS_END(3); TS_BEGIN(4); }
            if (ph == 2 && bid >= G - 16) {
                const int tid = ltid(), lane = tid & 63, wave = __builtin_amdgcn_readfirstlane(tid >> 6);
                const int i16 = bid - (G - 16), b = i16 >> 3, h = i16 & 7;
                const float* LOGT = (const float*)(ws + OFF_LOGF) + (size_t)(b * 8 + h) * TP;
                float* CUMT = (float*)(ws + OFF_CUMT) + (size_t)(b * 8 + h) * TP;
                float* seq = (float*)smem;
                double* part = (double*)(smem + 512 * 17 * 4);
                constexpr int CH = 17;
                for (int i = tid; i < 512 * CH; i += NTHREADS) seq[i] = (i < T) ? LOGT[i] : 0.f;
                __syncthreads();
                float lv[CH];
                double sacc = 0.0;
#pragma unroll
                for (int k = 0; k < CH; ++k) lv[k] = seq[tid * CH + k];
#pragma unroll
                for (int k = 0; k < CH; ++k) sacc += (double)lv[k];
                double incl = sacc;
#pragma unroll
                for (int d = 1; d < 64; d <<= 1) { const double v = __shfl_up(incl, d); if (lane >= d) incl += v; }
                if (lane == 63) part[wave] = incl;
                __syncthreads();
                double run = incl - sacc;
                for (int w = 0; w < wave; ++w) run += part[w];
#pragma unroll
                for (int k = 0; k < CH; ++k) { run += (double)lv[k]; seq[tid * CH + k] = (float)(run * 1.4426950408889634); }
                __syncthreads();
                for (int i = tid; i < TP; i += NTHREADS) CUMT[i] = (i < T) ? seq[i] : 0.f;
                __syncthreads();
            }
            if (ph == 2) { TS_END(4); TS_BEGIN(5); }
            if (ph == 2) {
                const int tid = ltid(), lane = tid & 63, wave = __builtin_amdgcn_readfirstlane(tid >> 6);
                const bf16_t* KF = (const bf16_t*)(ws + OFF_KF);
                float* KN = (float*)(ws + OFF_KNORM);
                for (int it = bid * 8 + wave; it < NB * 8 * MW; it += G * 8) {
                    const int kt = it % MW, bh = it / MW, b = bh >> 3, h = bh & 7;
                    const bf16_t* kr = KF + ((size_t)b * TP + kt * 64 + lane) * 512 + h * 64;
                    float ss = 0.f;
#pragma unroll
                    for (int c = 0; c < 8; ++c) {
                        const uint4 u = *(const uint4*)(kr + c * 8);
                        const unsigned ww[4] = {u.x, u.y, u.z, u.w};
#pragma unroll
                        for (int e = 0; e < 4; ++e) { const float a0 = bf2f(ww[e] & 0xffffu), a1 = bf2f(ww[e] >> 16); ss = fmaf(a0, a0, fmaf(a1, a1, ss)); }
                    }
#pragma unroll
                    for (int o = 1; o < 64; o <<= 1) ss = fmaxf(ss, __shfl_xor(ss, o));
                    if (lane == 0) KN[it] = sqrtf(ss);
                }
            }
            if (ph == 2) TS_END(5);
        }
        if (PH(3) && ph == 3) {
            const int tid = ltid(), lane = tid & 63, wave = __builtin_amdgcn_readfirstlane(tid >> 6); (void)lane; (void)wave;
            constexpr int N_FOX = 33 * 16, N_IDX2 = T / 8, N_CV2 = 512;
            int* qslot = (int*)(smem + LDS_BYTES - 16);
            for (;;) {
                __syncthreads();
                if (tid == 0) *qslot = (int)atomicAdd(&ctl[CW_Q3 + step], 1u);
                __syncthreads();
                const int it = *qslot;
                if (it >= N_FOX + N_IDX2 + N_CV2) break;
                if (it >= N_FOX + N_IDX2) {
                    KParams kq = kp; unsigned char* wsq = ws;
                    const int g2 = (it - (N_FOX + N_IDX2)) * 2;
#pragma unroll 1
                    for (int gg = 0; gg < 2; ++gg) xpose_group(g2 + gg, 4096, [kq, wsq](int t_) { return moe_tile(kq, wsq, t_); }, (float*)smem);
                    continue;
                }
                if (it < N_FOX) {
                    const int qb = 32 - it / 16, bh = it % 16;
                    const int kt0 = fox_prune(ws, bh >> 3, bh & 7, qb, smem);
                    ab::attn_unit<16, true>(bh >> 3, bh & 7, qb, (const ab::bf16*)(ws + OFF_QF), (const ab::bf16*)(ws + OFF_KF), (const ab::bf16*)(ws + OFF_VF), (ab::bf16*)(ws + OFF_YF),
                                           nullptr, (const float*)(ws + OFF_CUMT), kt0, (char*)smem);
                }
                else {
                    const int qg = (T / 8 - 1) - (it - N_FOX);
#pragma unroll 1
                    for (int bb = 0; bb < 2; ++bb) indexer_item(ws, bb, qg, smem);
                }
            }
        }
        if (PH(4) && ph == 4) {
            const int tid = ltid(), lane = tid & 63, wave = __builtin_amdgcn_readfirstlane(tid >> 6); (void)lane; (void)wave;
            constexpr int N_DSA = 33 * 16;
            int* qslot = (int*)(smem + LDS_BYTES - 16);
            for (;;) {
                __syncthreads();
                if (tid == 0) *qslot = (int)atomicAdd(&ctl[CW_Q4 + step], 1u);
                __syncthreads();
                const int it = *qslot;
                if (it >= N_DSA + 256) break;
                if (it >= N_DSA) {
                    KParams kq = kp; unsigned char* wsq = ws;
#pragma unroll 1
                    for (int gg = 0; gg < 2; ++gg) xpose_group(1024 + 2 * (it - N_DSA) + gg, 6144, [kq, wsq](int t_) { return moe_tile(kq, wsq, t_); }, (float*)smem);
                    continue;
                }
                const int qb = 32 - it / 16, bh = it % 16;
                ab::attn_unit<8, false>(bh >> 3, bh & 7, qb, (const ab::bf16*)(ws + OFF_QA), (const ab::bf16*)(ws + OFF_KA), (const ab::bf16*)(ws + OFF_VA), (ab::bf16*)(ws + OFF_YA),
                                        (const unsigned long long*)(ws + OFF_MASK), nullptr, 0, (char*)smem);
            }
        }
        if (PH(5) && ph == 5) {
            const int tid = ltid(), lane = tid & 63, wave = __builtin_amdgcn_readfirstlane(tid >> 6); (void)lane; (void)wave;
        }
        if (PH(7) && ph == 7) {
            const int tid = ltid(), lane = tid & 63, wave = __builtin_amdgcn_readfirstlane(tid >> 6);
            constexpr int AP = 264;
            bf16_t* Ahi = (bf16_t*)smem; bf16_t* Alo = Ahi + 64 * AP;
            bf16_t* WL = Alo + 64 * AP;
            float* LG = (float*)(smem + (2 * 64 + 96) * AP * 2);
            const float* g1 = kp->in[11]; const float* b1 = kp->in[12];
            const float* brg = kp->in[14]; const float* bre = kp->in[16];
            const bf16_t* wrt = (const bf16_t*)(ws + OFF_WRT);
            bf16_t* H1B = (bf16_t*)(ws + OFF_H1B);
            int* TOKL = (int*)(ws + OFF_TOKL); float* GW = (float*)(ws + OFF_GW);
            unsigned* lcnt = (unsigned*)(LG + 64 * 49);
            for (int tb = bid; tb < NTOK / 64; tb += G) {
                const int n0 = tb * 64 + wave * 8;
                if (tid < 32) lcnt[tid] = 0u;
                f32x4 v[8][4];
#pragma unroll
                for (int tt = 0; tt < 8; ++tt)
#pragma unroll
                    for (int j = 0; j < 4; ++j) v[tt][j] = *(const f32x4*)(kp->out + (size_t)(n0 + tt) * 1024 + lane * 4 + 256 * j);
#pragma unroll
                for (int tt = 0; tt < 8; ++tt) {
                    float s_ = 0.f;
#pragma unroll
                    for (int j = 0; j < 4; ++j) s_ += (v[tt][j][0] + v[tt][j][1]) + (v[tt][j][2] + v[tt][j][3]);
                    const float mu = wave_sum(s_) * (1.0f / 1024.0f);
                    float q = 0.f;
#pragma unroll
                    for (int j = 0; j < 4; ++j) { const f32x4 d = v[tt][j] - mu; q += (d[0] * d[0] + d[1] * d[1]) + (d[2] * d[2] + d[3] * d[3]); }
                    const float rstd = rsqrtf(wave_sum(q) * (1.0f / 1024.0f) + LN_EPS);
#pragma unroll
                    for (int j = 0; j < 4; ++j) {
                        const f32x4 gg = *(const f32x4*)(g1 + lane * 4 + 256 * j), bb = *(const f32x4*)(b1 + lane * 4 + 256 * j);
                        v[tt][j] = (v[tt][j] - mu) * rstd * gg + bb;
                        store4bf(H1B + (size_t)(n0 + tt) * 1024 + lane * 4 + 256 * j, v[tt][j]);
                    }
                    if (lane == 0) { float* st1 = (float*)(ws + OFF_ST1); st1[2 * (n0 + tt)] = mu; st1[2 * (n0 + tt) + 1] = rstd; }
                }
                f32x4 acc0 = zero4(), acc1 = zero4();
                const int mt = wave & 3, nt0 = (wave < 4) ? 0 : 2;
                const bool two = wave < 4;
#pragma unroll
                for (int j = 0; j < 4; ++j) {
                    const int wrow = tid >> 5, wch = tid & 31;
                    const bf16_t* wsrc = wrt + (size_t)wrow * 1024 + j * 256 + wch * 8;
                    const uint4 w0 = *(const uint4*)(wsrc), w1 = *(const uint4*)(wsrc + 16 * 1024), w2 = *(const uint4*)(wsrc + 32 * 1024),
                                w3 = *(const uint4*)(wsrc + 48 * 1024), w4 = *(const uint4*)(wsrc + 64 * 1024), w5 = *(const uint4*)(wsrc + 80 * 1024);
                    __syncthreads();
#pragma unroll
                    for (int tt = 0; tt < 8; ++tt) {
                        const f32x4 x = v[tt][j];
                        const unsigned h0 = f2bf(x[0]), h1 = f2bf(x[1]), h2 = f2bf(x[2]), h3 = f2bf(x[3]);
                        uint2 hi, lo;
                        hi.x = h0 | (h1 << 16); hi.y = h2 | (h3 << 16);
                        lo.x = pk2(x[0] - bf2f(h0), x[1] - bf2f(h1)); lo.y = pk2(x[2] - bf2f(h2), x[3] - bf2f(h3));
                        *(uint2*)(Ahi + (wave * 8 + tt) * AP + lane * 4) = hi;
                        *(uint2*)(Alo + (wave * 8 + tt) * AP + lane * 4) = lo;
                    }
                    {
                        bf16_t* wd = WL + wrow * AP + wch * 8;
                        *(uint4*)(wd) = w0; *(uint4*)(wd + 16 * AP) = w1; *(uint4*)(wd + 32 * AP) = w2;
                        *(uint4*)(wd + 48 * AP) = w3; *(uint4*)(wd + 64 * AP) = w4; *(uint4*)(wd + 80 * AP) = w5;
                    }
                    __syncthreads();
#pragma unroll 2
                    for (int kk = 0; kk < 8; ++kk) {
                        const int ko = kk * 32 + (lane >> 4) * 8;
                        const bf16x8 ah = *(const bf16x8*)(Ahi + (mt * 16 + (lane & 15)) * AP + ko);
                        const bf16x8 al = *(const bf16x8*)(Alo + (mt * 16 + (lane & 15)) * AP + ko);
                        {
                            const bf16_t* wp = WL + (nt0 * 16 + (lane & 15)) * AP + ko;
                            const bf16x8 bh = *(const bf16x8*)wp, bl = *(const bf16x8*)(wp + 48 * AP);
                            acc0 = __builtin_amdgcn_mfma_f32_16x16x32_bf16(ah, bh, acc0, 0, 0, 0);
                            acc0 = __builtin_amdgcn_mfma_f32_16x16x32_bf16(ah, bl, acc0, 0, 0, 0);
                            acc0 = __builtin_amdgcn_mfma_f32_16x16x32_bf16(al, bh, acc0, 0, 0, 0);
                        }
                        if (two) {
                            const bf16_t* wp = WL + (16 + (lane & 15)) * AP + ko;
                            const bf16x8 bh = *(const bf16x8*)wp, bl = *(const bf16x8*)(wp + 48 * AP);
                            acc1 = __builtin_amdgcn_mfma_f32_16x16x32_bf16(ah, bh, acc1, 0, 0, 0);
                            acc1 = __builtin_amdgcn_mfma_f32_16x16x32_bf16(ah, bl, acc1, 0, 0, 0);
                            acc1 = __builtin_amdgcn_mfma_f32_16x16x32_bf16(al, bh, acc1, 0, 0, 0);
                        }
                    }
                }
#pragma unroll
                for (int i = 0; i < 4; ++i) {
                    LG[(mt * 16 + (lane >> 4) * 4 + i) * 49 + nt0 * 16 + (lane & 15)] = acc0[i];
                    if (two) LG[(mt * 16 + (lane >> 4) * 4 + i) * 49 + 16 + (lane & 15)] = acc1[i];
                }
                __syncthreads();
                int my_e1 = 0, my_e2 = 0; float my_g1 = 0.f, my_g2 = 0.f;
#pragma unroll 2
                for (int tt = 0; tt < 8; ++tt) {
                    float mylg = (lane < 36) ? LG[(wave * 8 + tt) * 49 + lane] : 0.f;
                    mylg += (lane < 4) ? brg[lane] : ((lane < 36) ? bre[lane - 4] : 0.f);
                    float gl[4];
#pragma unroll
                    for (int i = 0; i < 4; ++i) gl[i] = __shfl(mylg, i);
                    int gs = 0; float gm = gl[0];
#pragma unroll
                    for (int i = 1; i < 4; ++i) if (gl[i] > gm) { gm = gl[i]; gs = i; }
                    float den = 0.f;
#pragma unroll
                    for (int i = 0; i < 4; ++i) den += __expf(gl[i] - gm);
                    const float pg = 1.0f / den;
                    float el[8];
#pragma unroll
                    for (int j = 0; j < 8; ++j) el[j] = __shfl(mylg, 4 + gs * 8 + j);
                    int i1 = 0; float l1 = el[0];
#pragma unroll
                    for (int j = 1; j < 8; ++j) if (el[j] > l1) { l1 = el[j]; i1 = j; }
                    int i2 = -1; float l2 = -3.0e38f;
#pragma unroll
                    for (int j = 0; j < 8; ++j) if (j != i1 && el[j] > l2) { l2 = el[j]; i2 = j; }
                    const float w1 = 1.0f / (1.0f + __expf(l2 - l1)), w2 = 1.0f - w1;
                    if (lane == tt) { my_e1 = gs * 8 + i1; my_e2 = gs * 8 + i2; my_g1 = pg * w1; my_g2 = pg * w2; }
                }
                unsigned r1 = 0, r2 = 0;
                if (lane < 8) { r1 = atomicAdd(&lcnt[my_e1], 1u); r2 = atomicAdd(&lcnt[my_e2], 1u); }
                __syncthreads();
                if (tid < 32) { const int t2 = ltid(); const unsigned c = lcnt[t2]; lcnt[32 + t2] = c ? atomicAdd(&ctl[CW_ECNT + t2 * ECS], c) : 0u; }
                __syncthreads();
                if (lane < 8) {
                    const int n = n0 + lane;
                    TOKL[my_e1 * 32768 + lcnt[32 + my_e1] + r1] = n * 2;
                    TOKL[my_e2 * 32768 + lcnt[32 + my_e2] + r2] = n * 2 + 1;
                    GW[n * 2] = my_g1; GW[n * 2 + 1] = my_g2;
                }
                __syncthreads();
            }
        }
        if (PH(8) && ph == 8) {
            const int tid = ltid(), lane = tid & 63, wave = __builtin_amdgcn_readfirstlane(tid >> 6); (void)lane; (void)wave;
            int* ecnt_s = (int*)(smem + LDS_BYTES - 1024);
            if (tid < 32) ecnt_s[tid] = (int)ctl[CW_ECNT + tid * ECS];
            __syncthreads();
            if (tid == 0) { int cp = 0, rb = 0; for (int e = 0; e < 32; ++e) { ecnt_s[32 + e] = cp; ecnt_s[64 + e] = rb; const int nc = (ecnt_s[e] + 255) >> 8; cp += nc; rb += nc * 256; } ecnt_s[96] = cp; }
            __syncthreads();
            const int nchunks = ecnt_s[96];
            const int* TOKL = (const int*)(ws + OFF_TOKL);
            bf16_t* HID = (bf16_t*)(ws + OFF_HID);
            const int NNT = (ph == 8) ? 4 : 8;
            for (int tile = bid; tile < nchunks * NNT; tile += G) {
                const int ch = tile / NNT, nt = tile % NNT;
                int e = 0;
#pragma unroll 1
                for (int k = 1; k < 32; ++k) if (ecnt_s[32 + k] <= ch) e = k;
                const int c_in_e = ch - ecnt_s[32 + e];
                const int cnt = ecnt_s[e];
                const int rowbase = ecnt_s[64 + e] + c_in_e * 256;
                const int pos0 = c_in_e * 256;
                const int rl = (wave >> 1) * 64, c4 = (lane >> 4) * 4;
                if (PH(8) && ph == 8) {
                    const bf16_t* H1B = (const bf16_t*)(ws + OFF_H1B);
                    const bf16_t* WGU = (const bf16_t*)(ws + OFF_WGU) + (size_t)e * 512 * 1024;
                    const bf16_t* ap[4]; const bf16_t* bp[2];
#pragma unroll
                    for (int i = 0; i < 4; ++i) {
                        int pos = pos0 + (tid >> 3) + 64 * i; pos = pos < cnt ? pos : cnt - 1;
                        const int aid = TOKL[e * 32768 + pos];
                        ap[i] = H1B + (size_t)(aid >> 1) * 1024 + (tid & 7) * 8;
                    }
#pragma unroll
                    for (int i = 0; i < 2; ++i) bp[i] = WGU + (size_t)(nt * 128 + (tid >> 3) + 64 * i) * 1024 + (tid & 7) * 8;
                    f32x4 acc[4][4]; zero_acc(acc);
                    gemm_core(ap, bp, 1024, (bf16_t*)smem, acc);
                    const int hc0 = (nt * 128 + (wave & 1) * 64) >> 1;
#pragma unroll
                    for (int mi = 0; mi < 4; ++mi) {
                        const int rr = rl + mi * 16 + (lane & 15);
                        bf16_t* dst = HID + (size_t)(rowbase + rr) * 256 + hc0 + c4;
#pragma unroll
                        for (int pr = 0; pr < 2; ++pr) {
                            f32x4 hv;
#pragma unroll
                            for (int j = 0; j < 4; ++j) { const float gte = acc[mi][2 * pr][j], up = acc[mi][2 * pr + 1][j]; hv[j] = gte * sigmoidf_(gte) * up; }
                            if (FUSE89) store4bf_agent(dst + pr * 16, hv); else store4bf(dst + pr * 16, hv);
                        }
                    }
                    if (FUSE89) {
                        asm volatile("s_waitcnt vmcnt(0)" ::: "memory");
                        __syncthreads();
                        if (ltid() == 0) (void)__hip_atomic_fetch_add(&ctl[CW_DONE + ch], 1u, __ATOMIC_RELAXED, __HIP_MEMORY_SCOPE_AGENT);
                    }
                } else {
                    const bf16_t* WD = (const bf16_t*)(ws + OFF_WD) + (size_t)e * 1024 * 256;
                    const float* GW = (const float*)(ws + OFF_GW);
                    bf16_t* SLOT = (bf16_t*)(ws + OFF_SLOT);
                    const bf16_t* ap[4]; const bf16_t* bp[2];
                    dense_ptrs(HID, 256, rowbase, WD, 256, nt * 128, ap, bp);
                    f32x4 acc[4][4]; zero_acc(acc);
                    gemm_core(ap, bp, 256, (bf16_t*)smem, acc);
                    const int cbase = nt * 128 + (wave & 1) * 64;
#pragma unroll
                    for (int mi = 0; mi < 4; ++mi) {
                        const int pos = pos0 + rl + mi * 16 + (lane & 15);
                        if (pos < cnt) {
                            const int aid = TOKL[e * 32768 + pos];
                            const float gw = GW[aid];
                            bf16_t* dst = SLOT + (size_t)aid * 1024 + cbase + c4;
#pragma unroll
                            for (int ni = 0; ni < 4; ++ni) store4bf(dst + ni * 16, acc[mi][ni] * gw);
                        }
                    }
                }
            }
        }
        if (PH(10) && ph == 10) {
            const int tid = ltid(), lane = tid & 63, wave = __builtin_amdgcn_readfirstlane(tid >> 6); (void)tid;
            const bf16_t* SLOT = (const bf16_t*)(ws + OFF_SLOT);
            const float* g2 = kp->in[20]; const float* b2 = kp->in[21];
            const bf16_t* H1B = (const bf16_t*)(ws + OFF_H1B);
            for (int n0 = (bid * 8 + wave) * 4; n0 < NTOK; n0 += G * 8 * 4) {
                f32x4 v[4][4];
#pragma unroll
                for (int rr = 0; rr < 4; ++rr) {
                    const int n = n0 + rr;
#pragma unroll
                    for (int j = 0; j < 4; ++j) {
                        const int c = lane * 4 + 256 * j;
                        const uint2 hb = *(const uint2*)(H1B + (size_t)n * 1024 + c);
                        const f32x4 hv = {bf2f(hb.x & 0xffffu), bf2f(hb.x >> 16), bf2f(hb.y & 0xffffu), bf2f(hb.y >> 16)};
                        const uint2 u0 = *(const uint2*)(SLOT + (size_t)(2 * n) * 1024 + c), u1 = *(const uint2*)(SLOT + (size_t)(2 * n + 1) * 1024 + c);
                        f32x4 f; f[0] = bf2f(u0.x & 0xffffu) + bf2f(u1.x & 0xffffu); f[1] = bf2f(u0.x >> 16) + bf2f(u1.x >> 16);
                        f[2] = bf2f(u0.y & 0xffffu) + bf2f(u1.y & 0xffffu); f[3] = bf2f(u0.y >> 16) + bf2f(u1.y >> 16);
                        v[rr][j] = hv * ALPHA + f;
                    }
                }
#pragma unroll
                for (int rr = 0; rr < 4; ++rr) {
                    float s = 0.f;
#pragma unroll
                    for (int j = 0; j < 4; ++j) s += (v[rr][j][0] + v[rr][j][1]) + (v[rr][j][2] + v[rr][j][3]);
                    const float mu = wave_sum(s) * (1.0f / 1024.0f);
                    float q = 0.f;
#pragma unroll
                    for (int j = 0; j < 4; ++j) { const f32x4 d = v[rr][j] - mu; q += (d[0] * d[0] + d[1] * d[1]) + (d[2] * d[2] + d[3] * d[3]); }
                    const float rstd = rsqrtf(wave_sum(q) * (1.0f / 1024.0f) + LN_EPS);
                    float* row = kp->out + (size_t)(n0 + rr) * 1024;
#pragma unroll
                    for (int j = 0; j < 4; ++j) {
                        const int c = lane * 4 + 256 * j;
                        const f32x4 gg = *(const f32x4*)(g2 + c), bb = *(const f32x4*)(b2 + c);
                        *(f32x4*)(row + c) = (v[rr][j] - mu) * rstd * gg + bb;
                    }
                }
            }
        }
    }
    if (TIME_PH >= 0 && blockIdx.x == (TIME_PH >= 100 ? TIME_BLK : 0)) {
        __syncthreads();
        if (threadIdx.x == 0) {
            volatile LAS unsigned* ts = (volatile LAS unsigned*)(smem + LDS_BYTES - 64);
            const unsigned long long t0 = ((unsigned long long)ts[5] << 32) | ts[4];
            const unsigned long long tnow = wall_clock64();
            const unsigned long long t1 = (TIME_PH == NPHASES - 1) ? tnow : (((unsigned long long)ts[7] << 32) | ts[6]);
            unsigned long long d = t1 - t0; if (d > 100000ull) d = 100000ull;
            while (wall_clock64() - tnow < d) __builtin_amdgcn_s_sleep(8);
        }
    }
}

extern "C" void kernel_launch(void* const* d_in, const int* in_sizes, int n_in, void* d_out, int out_size, void* d_ws, size_t ws_size, hipStream_t stream) {
    static int grid = 0;
    if (grid == 0) {
        int dev = 0, cus = 0, per_cu = 0;
        hipGetDevice(&dev);
        hipDeviceGetAttribute(&cus, hipDeviceAttributeMultiprocessorCount, dev);
        hipOccupancyMaxActiveBlocksPerMultiprocessor(&per_cu, (const void*)mega, NTHREADS, 0);
        if (per_cu < 1) per_cu = 1;
        if (per_cu > 1) per_cu = 1;
        grid = cus * per_cu;
        if (n_in != 22 || ws_size < WS_END) { fprintf(stderr, "kernel_launch: unexpected n_in %d / ws_size %zu (need %zu)\n", n_in, ws_size, (size_t)WS_END); }
    }
    hipMemsetAsync((char*)d_ws + OFF_CTL, 0, 32768, stream);
    Params p{};
    for (int i = 0; i < 22; ++i) p.in[i] = (const float*)d_in[i];
    p.out = (float*)d_out; p.ws = (unsigned char*)d_ws;
#if N_LAUNCH_MODE == 0
    p.ph_lo = 0; p.ph_hi = NPHASES + (REPEAT_PH >= 0 ? 1 : 0) + EXTRA_SYNCS;
    void* args[] = {&p};
    hipError_t e = hipLaunchCooperativeKernel((const void*)mega, dim3(grid), dim3(NTHREADS), args, 0, stream);
    if (e != hipSuccess) fprintf(stderr, "cooperative launch failed: %s (grid %d)\n", hipGetErrorString(e), grid);
#else
    for (int ph = 0; ph < NPHASES; ++ph) {
        p.ph_lo = ph; p.ph_hi = ph + 1;
        hipLaunchKernelGGL(mega, dim3(grid), dim3(NTHREADS), 0, stream, p);
    }
#endif
}
```

```cpp
#include <hip/hip_runtime.h>
#include <hip/hip_cooperative_groups.h>
#include <hip/hip_bf16.h>
#include <stdint.h>
#include <stdio.h>
namespace cg = cooperative_groups;

#ifndef ONLY_PHASE
#define ONLY_PHASE -1
#endif
#ifndef PH_MASK
#define PH_MASK 0x7ff
#endif
#define PH(k) ((ONLY_PHASE < 0 || ONLY_PHASE == (k)) && ((PH_MASK >> (k)) & 1))
#ifndef REPEAT_PH
#define REPEAT_PH -1
#endif
#ifndef IDX_REP_MFMA
#define IDX_REP_MFMA 1
#endif
#ifndef P7_REP
#define P7_REP 1
#endif
#ifndef P10_REP
#define P10_REP 1
#endif
#ifndef ATT_PROBE
#define ATT_PROBE 0
#endif
#ifndef IDX_PROBE
#define IDX_PROBE 0
#endif
#ifndef IDX_REP_SEL
#define IDX_REP_SEL 1
#endif
#ifndef IDX_REP
#define IDX_REP 1
#endif
#ifndef TIME_PH
#define TIME_PH -1
#endif
#ifndef TIME_BLK
#define TIME_BLK 0
#endif
#define TS_STAMP(id, slot) do { if (TIME_PH == 100 + (id) && blockIdx.x == TIME_BLK && threadIdx.x == 0) { const unsigned long long tt_ = wall_clock64(); \
    volatile __attribute__((address_space(3))) unsigned* ts_ = (volatile __attribute__((address_space(3))) unsigned*)(smem + LDS_BYTES - 64) + (slot); ts_[0] = (unsigned)tt_; ts_[1] = (unsigned)(tt_ >> 32); } } while (0)
#define TS_BEGIN(id) TS_STAMP(id, 4)
#define TS_END(id) TS_STAMP(id, 6)
#ifndef FUSE89
#define FUSE89 1
#endif
#ifndef EXTRA_SYNCS
#define EXTRA_SYNCS 0
#endif
#ifndef N_LAUNCH_MODE
#define N_LAUNCH_MODE 0
#endif

typedef unsigned short bf16_t;
typedef short bf16x8 __attribute__((ext_vector_type(8)));
typedef float f32x4 __attribute__((ext_vector_type(4)));
typedef float f32x16 __attribute__((ext_vector_type(16)));

constexpr int NB = 2, SEQ = 8192, DM = 1024, NMETA = 16;
constexpr int T = SEQ + NMETA;
constexpr int TP = 8448;
constexpr int R = NB * TP;
constexpr int NTOK = NB * SEQ;
constexpr int NP = 5120;
constexpr int MW = TP / 64;
constexpr float LN_EPS = 1e-5f, RMS_EPS = 1e-6f;
constexpr float ALPHA = 1.189207115002721f;
constexpr float LOG2E = 1.4426950408889634f;
constexpr float QSCALE = 0.125f * LOG2E;
constexpr int NTHREADS = 512;
constexpr int NPHASES = 11;

constexpr size_t al256(size_t x) { return (x + 255) & ~size_t(255); }
constexpr size_t OFF_CTL = 0;
constexpr size_t OFF_ROPE = 65536;
constexpr size_t OFF_STAT0 = OFF_ROPE + al256((size_t)TP * 16 * 4);
constexpr size_t OFF_WRT = OFF_STAT0 + al256((size_t)R * 8);
constexpr size_t OFF_WIN = OFF_WRT + (size_t)2 * 48 * 1024 * 2;
constexpr size_t OFF_WKV = OFF_WIN + (size_t)NP * 1024 * 2;
constexpr size_t OFF_WA = OFF_WKV + (size_t)1024 * 256 * 2;
constexpr size_t OFF_WF = OFF_WA + (size_t)1024 * 512 * 2;
constexpr size_t OFF_WO = OFF_WF + (size_t)1024 * 512 * 2;
constexpr size_t OFF_HB = OFF_WO + (size_t)1024 * 1024 * 2;
constexpr size_t OFF_HBM = OFF_HB + (size_t)NTOK * 1024 * 2;
constexpr size_t OFF_QI = OFF_HB + (size_t)R * 1024 * 2;
constexpr size_t OFF_QA = OFF_QI + (size_t)R * 512 * 2;
constexpr size_t OFF_QF = OFF_QA + (size_t)R * 512 * 2;
constexpr size_t OFF_KF = OFF_QF + (size_t)R * 512 * 2;
constexpr size_t OFF_VF = OFF_KF + (size_t)R * 512 * 2;
constexpr size_t OFF_KA = OFF_VF + (size_t)R * 512 * 2;
constexpr size_t OFF_VA = OFF_KA + (size_t)R * 512 * 2;
constexpr size_t OFF_KI = OFF_VA + (size_t)R * 512 * 2;
constexpr size_t OFF_WI = OFF_KI + (size_t)R * 64 * 2;
constexpr size_t OFF_LOGF = OFF_WI + (size_t)R * 8 * 4;
constexpr size_t OFF_CUM = OFF_LOGF + (size_t)R * 8 * 4;
constexpr size_t OFF_CUMT = OFF_CUM + (size_t)R * 8 * 4;
constexpr size_t OFF_KNORM = OFF_CUMT + (size_t)R * 8 * 4;
constexpr size_t OFF_CKV = OFF_KNORM + al256((size_t)NB * 8 * MW * 4);
constexpr size_t OFF_MASK = OFF_CKV + (size_t)R * 256 * 2;
constexpr size_t OFF_TOKL = OFF_MASK + (size_t)R * MW * 8;
constexpr size_t OFF_GW = OFF_TOKL + (size_t)32 * 32768 * 4;
constexpr int HID_ROWS = 32768 + 32 * 256;
constexpr size_t OFF_MCKV = OFF_GW + (size_t)NTOK * 2 * 4;
constexpr size_t OFF_ST1 = OFF_MCKV + 16 * 256 * 4;
constexpr size_t OFF_HID = OFF_ST1 + (size_t)NTOK * 2 * 4;
constexpr size_t OFF_YA = OFF_HID + (size_t)HID_ROWS * 256 * 2;
constexpr size_t OFF_YF = OFF_YA + (size_t)NTOK * 512 * 2;
constexpr size_t WS_END = OFF_YF + (size_t)NTOK * 512 * 2;
constexpr size_t OFF_WGU = OFF_HB;
constexpr size_t OFF_WD = OFF_WGU + (size_t)32 * 512 * 1024 * 2;
constexpr size_t OFF_MERGED = OFF_KF;
constexpr size_t OFF_H1B = OFF_YA;
constexpr size_t OFF_SLOT = OFF_QA;
static_assert(OFF_WD + (size_t)32 * 1024 * 256 * 2 <= OFF_QA, "moe weights fit in HB+QI");
static_assert(OFF_MERGED + (size_t)NTOK * 1024 * 2 <= OFF_KA, "merged fits");
static_assert(OFF_H1B + (size_t)NTOK * 1024 * 2 <= WS_END, "h1b fits");
static_assert(OFF_SLOT + (size_t)NTOK * 2 * 1024 * 2 <= OFF_KA, "slot fits");
static_assert(WS_END <= (size_t)256 * 1024 * 1024, "workspace");

constexpr int CW_Q3 = 0, CW_Q4 = 64, CW_ECNT = 128, ECS = 64, CW_DONE = 2304, CW_BAR = 4096;

constexpr int SCP = TP + 16;
constexpr int HP = 264;
constexpr int LDS_IDX = 8 * SCP * 2 + 8 * HP * 4;
constexpr int LDS_ROUTER = 36 * 1024 * 4;
constexpr int LDS_GEMM = 2 * (256 * 64 + 128 * 64) * 2 + 1024;
constexpr int LDS_BYTES = 150528;

struct Params {
    const float* in[22];
    float* out;
    unsigned char* ws;
    int ph_lo, ph_hi;
};

typedef const __attribute__((address_space(4))) Params* KParams;
__device__ __forceinline__ f32x4 zero4() { float z = 0.f; asm volatile("" : "+v"(z)); return (f32x4){z, z, z, z}; }
__device__ __forceinline__ uint4 zero4u() { unsigned z = 0u; asm volatile("" : "+v"(z)); return make_uint4(z, z, z, z); }
__device__ __forceinline__ int ltid() { int t = threadIdx.x; asm volatile("" : "+v"(t)); return t; }
__device__ __forceinline__ unsigned f2bf(float f) { unsigned u = __float_as_uint(f); return (u + 0x7fffu + ((u >> 16) & 1u)) >> 16; }
typedef __bf16 bf16x2_t __attribute__((ext_vector_type(2)));
typedef float f32x2 __attribute__((ext_vector_type(2)));
__device__ __forceinline__ unsigned pk2(float lo, float hi) { f32x2 v = {lo, hi}; bf16x2_t b = __builtin_convertvector(v, bf16x2_t); return __builtin_bit_cast(unsigned, b); }
__device__ __forceinline__ float bf2f(unsigned h) { return __uint_as_float(h << 16); }
template <int CTRL> __device__ __forceinline__ float dppf(float v) { return __uint_as_float((unsigned)__builtin_amdgcn_update_dpp(0, (int)__float_as_uint(v), CTRL, 0xf, 0xf, true)); }
__device__ __forceinline__ float wave_sum(float v) {
    v += dppf<0xB1>(v);
    v += dppf<0x4E>(v);
    v += dppf<0x124>(v);
    v += dppf<0x128>(v);
    const float a = __uint_as_float((unsigned)__builtin_amdgcn_readlane((int)__float_as_uint(v), 0)), b = __uint_as_float((unsigned)__builtin_amdgcn_readlane((int)__float_as_uint(v), 16));
    const float c = __uint_as_float((unsigned)__builtin_amdgcn_readlane((int)__float_as_uint(v), 32)), d = __uint_as_float((unsigned)__builtin_amdgcn_readlane((int)__float_as_uint(v), 48));
    return (a + b) + (c + d);
}
__device__ __forceinline__ float sigmoidf_(float v) { return 1.0f / (1.0f + __expf(-v)); }

__device__ __forceinline__ int win_oldcol(int n) {
    if (n < 1344) return n;
    if (n < 2880) return n + 8;
    if (n < 4928) return n + 16;
    if (n < 4936) return 1344 + (n - 4928);
    if (n < 4944) return 2888 + (n - 4936);
    return -1;
}

template <class ColMap>
__device__ __forceinline__ void xpose64(const float* __restrict__ src, int src_ld, bf16_t* __restrict__ dst, int dst_ld, int k0, int n0, ColMap cm,
                                        const float* __restrict__ kscale, float* tile) {
    const int tid = ltid();
    {
        const int nn = tid & 63; const int sc = cm(n0 + nn);
#pragma unroll
        for (int i = 0; i < 8; ++i) {
            const int kk = (tid >> 6) + 8 * i;
            float v = 0.f;
            if (sc >= 0) { v = src[(size_t)(k0 + kk) * src_ld + sc]; if (kscale) v *= kscale[k0 + kk]; }
            tile[kk * 65 + nn] = v;
        }
    }
    __syncthreads();
    {
        const int kp = tid & 31;
#pragma unroll
        for (int i = 0; i < 4; ++i) {
            const int nn = (tid >> 5) + 16 * i;
            const unsigned u = pk2(tile[(2 * kp) * 65 + nn], tile[(2 * kp + 1) * 65 + nn]);
            *(unsigned*)(dst + (size_t)(n0 + nn) * dst_ld + k0 + 2 * kp) = u;
        }
    }
    __syncthreads();
}


struct XTile { const float* src; bf16_t* dst; const float* kscale; int src_ld, dst_ld, k0, j0, rb, s16, winmap; };
template <class Decode>
__device__ __forceinline__ void xpose_group(int g4, int ntiles, Decode dec, float* tiles  ) {
    const int tid = ltid();
    const int nn = tid & 63, kr = tid >> 6;
    float v[4][8];
    XTile xt[4];
#pragma unroll
    for (int q = 0; q < 4; ++q) {
        const int it = g4 * 4 + q;
        if (it < ntiles) {
            xt[q] = dec(it);
            const int sc = xt[q].winmap ? win_oldcol(xt[q].j0 + nn) : (xt[q].j0 + nn);
#pragma unroll
            for (int i = 0; i < 8; ++i) {
                const int kk = kr + 8 * i;
                float x = 0.f;
                if (sc >= 0) x = xt[q].src[(size_t)(xt[q].k0 + kk) * xt[q].src_ld + sc];
                v[q][i] = x;
            }
        }
    }
#pragma unroll
    for (int q = 0; q < 4; ++q)
        if (g4 * 4 + q < ntiles) {
#pragma unroll
            for (int i = 0; i < 8; ++i) {
                const int kk = kr + 8 * i;
                float x = v[q][i];
                if (xt[q].kscale) x *= xt[q].kscale[xt[q].k0 + kk];
                tiles[q * 4160 + kk * 65 + nn] = x;
            }
        }
    __syncthreads();
    {
        const int kp = tid & 31;
#pragma unroll
        for (int q = 0; q < 4; ++q)
            if (g4 * 4 + q < ntiles) {
#pragma unroll
                for (int i = 0; i < 4; ++i) {
                    const int vr = (tid >> 5) + 16 * i;
                    const int row = xt[q].rb + (vr >> 4) * xt[q].s16 + (vr & 15);
                    *(unsigned*)(xt[q].dst + (size_t)row * xt[q].dst_ld + xt[q].k0 + 2 * kp) = pk2(tiles[q * 4160 + (2 * kp) * 65 + vr], tiles[q * 4160 + (2 * kp + 1) * 65 + vr]);
                }
            }
    }
    __syncthreads();
}
template <class Decode>
__device__ __forceinline__ void xpose_many(int ntiles, int G, int bid, Decode dec, float* tiles) {
    for (int g4 = bid; g4 * 4 < ntiles; g4 += G) xpose_group(g4, ntiles, dec, tiles);
}
__device__ __forceinline__ XTile moe_tile(KParams kq, unsigned char* wsq, int it) {
    XTile x; x.kscale = nullptr; x.winmap = 0;
    const int which = it / 2048, rem = it % 2048, e = rem / 64, i = rem % 64;
    if (which < 2) {
        x.src = kq->in[which == 0 ? 17 : 18] + (size_t)e * 1024 * 256; x.src_ld = 256;
        x.dst = (bf16_t*)(wsq + OFF_WGU) + (size_t)e * 512 * 1024; x.dst_ld = 1024;
        x.k0 = (i % 16) * 64; x.j0 = (i / 16) * 64; x.rb = (x.j0 >> 4) * 32 + which * 16; x.s16 = 32;
    } else {
        x.src = kq->in[19] + (size_t)e * 256 * 1024; x.src_ld = 1024;
        x.dst = (bf16_t*)(wsq + OFF_WD) + (size_t)e * 1024 * 256; x.dst_ld = 256;
        x.k0 = (i % 4) * 64; x.j0 = (i / 4) * 64; x.rb = x.j0; x.s16 = 16;
    }
    return x;
}

constexpr int GEMM_BUF = 256 * 64 + 128 * 64;
__device__ __forceinline__ void gemm_core(const bf16_t* const (&ap)[4], const bf16_t* const (&bp)[2], int K, bf16_t* sm, f32x4 (&acc)[4][4]) {
    const int tid = ltid(), lane = tid & 63, wave = __builtin_amdgcn_readfirstlane(tid >> 6);
    const int wm = wave >> 1, wn = wave & 1;
    const int swz = ((tid & 7) ^ ((tid >> 4) & 7)) * 8;
    const int woff = (tid >> 3) * 64 + swz;
    uint4 ra[4], rb[2];
#pragma unroll
    for (int i = 0; i < 4; ++i) ra[i] = *(const uint4*)(ap[i]);
#pragma unroll
    for (int i = 0; i < 2; ++i) rb[i] = *(const uint4*)(bp[i]);
#pragma unroll
    for (int i = 0; i < 4; ++i) *(uint4*)(sm + woff + 4096 * i) = ra[i];
#pragma unroll
    for (int i = 0; i < 2; ++i) *(uint4*)(sm + 16384 + woff + 4096 * i) = rb[i];
    __syncthreads();
    const int nk = K >> 6;
    const int rsw = (lane >> 1) & 7;
    for (int kt = 0; kt < nk; ++kt) {
        const int cur = kt & 1;
        if (kt + 1 < nk) {
#pragma unroll
            for (int i = 0; i < 4; ++i) ra[i] = *(const uint4*)(ap[i] + (kt + 1) * 64);
#pragma unroll
            for (int i = 0; i < 2; ++i) rb[i] = *(const uint4*)(bp[i] + (kt + 1) * 64);
        }
        const bf16_t* sa = sm + cur * GEMM_BUF;
        const bf16_t* sb = sa + 16384;
#pragma unroll
        for (int ks = 0; ks < 2; ++ks) {
            const int coff = ((ks * 4 + (lane >> 4)) ^ rsw) * 8;
            bf16x8 af[4], bfr[4];
#pragma unroll
            for (int mi = 0; mi < 4; ++mi) af[mi] = *(const bf16x8*)(sa + (wm * 64 + mi * 16 + (lane & 15)) * 64 + coff);
#pragma unroll
            for (int ni = 0; ni < 4; ++ni) bfr[ni] = *(const bf16x8*)(sb + (wn * 64 + ni * 16 + (lane & 15)) * 64 + coff);
#pragma unroll
            for (int mi = 0; mi < 4; ++mi)
#pragma unroll
                for (int ni = 0; ni < 4; ++ni) acc[mi][ni] = __builtin_amdgcn_mfma_f32_16x16x32_bf16(bfr[ni], af[mi], acc[mi][ni], 0, 0, 0);
        }
        if (kt + 1 < nk) {
            bf16_t* dn = sm + (cur ^ 1) * GEMM_BUF;
#pragma unroll
            for (int i = 0; i < 4; ++i) *(uint4*)(dn + woff + 4096 * i) = ra[i];
#pragma unroll
            for (int i = 0; i < 2; ++i) *(uint4*)(dn + 16384 + woff + 4096 * i) = rb[i];
        }
        __syncthreads();
    }
}
__device__ __forceinline__ void zero_acc(f32x4 (&acc)[4][4]) {
#pragma unroll
    for (int i = 0; i < 4; ++i)
#pragma unroll
        for (int j = 0; j < 4; ++j) acc[i][j] = zero4();
}
__device__ __forceinline__ void gemm_core3(const bf16_t* const (&ap)[4], const bf16_t* const (&bp)[2], int K, unsigned char* smem_, f32x4 (&acc)[4][4]) {
    typedef __attribute__((address_space(3))) unsigned lds_u32;
    const int tid = ltid(), lane = tid & 63, wave = __builtin_amdgcn_readfirstlane(tid >> 6);
    const int wm = wave >> 1, wn = wave & 1;
    const int csrc = ((tid & 7) ^ ((tid >> 4) & 7)) * 8;
    const bf16_t* sm = (const bf16_t*)smem_;
    const int nk = K >> 6;
    const int rsw = (lane >> 1) & 7;
#define GC3_ISSUE(kt_, st_) do { \
        _Pragma("unroll") for (int i = 0; i < 4; ++i) __builtin_amdgcn_global_load_lds((const unsigned*)(ap[i] + (kt_) * 64 + csrc), (lds_u32*)(smem_ + ((st_) * GEMM_BUF + (64 * i + 8 * wave) * 64) * 2), 16, 0, 0); \
        _Pragma("unroll") for (int i = 0; i < 2; ++i) __builtin_amdgcn_global_load_lds((const unsigned*)(bp[i] + (kt_) * 64 + csrc), (lds_u32*)(smem_ + ((st_) * GEMM_BUF + 16384 + (64 * i + 8 * wave) * 64) * 2), 16, 0, 0); } while (0)
    GC3_ISSUE(0, 0);
    if (nk > 1) GC3_ISSUE(1, 1);
    int st = 0;
    for (int kt = 0; kt < nk; ++kt) {
        if (kt + 1 < nk) asm volatile("s_waitcnt vmcnt(6)" ::: "memory"); else asm volatile("s_waitcnt vmcnt(0)" ::: "memory");
        __builtin_amdgcn_s_barrier(); asm volatile("" ::: "memory");
        if (kt + 2 < nk) { const int s2 = (st >= 1) ? st - 1 : 2; GC3_ISSUE(kt + 2, s2); }
        const bf16_t* sa = sm + st * GEMM_BUF;
        const bf16_t* sb = sa + 16384;
#pragma unroll
        for (int ks = 0; ks < 2; ++ks) {
            const int coff = ((ks * 4 + (lane >> 4)) ^ rsw) * 8;
            bf16x8 af[4], bfr[4];
#pragma unroll
            for (int mi = 0; mi < 4; ++mi) af[mi] = *(const bf16x8*)(sa + (wm * 64 + mi * 16 + (lane & 15)) * 64 + coff);
#pragma unroll
            for (int ni = 0; ni < 4; ++ni) bfr[ni] = *(const bf16x8*)(sb + (wn * 64 + ni * 16 + (lane & 15)) * 64 + coff);
#pragma unroll
            for (int mi = 0; mi < 4; ++mi)
#pragma unroll
                for (int ni = 0; ni < 4; ++ni) acc[mi][ni] = __builtin_amdgcn_mfma_f32_16x16x32_bf16(bfr[ni], af[mi], acc[mi][ni], 0, 0, 0);
        }
        st = (st == 2) ? 0 : st + 1;
    }
    __syncthreads();
#undef GC3_ISSUE
}
__device__ __forceinline__ void dense_ptrs(const bf16_t* A, int lda, int row0, const bf16_t* Bt, int ldb, int col0, const bf16_t* (&ap)[4], const bf16_t* (&bp)[2]) {
    const int tid = ltid();
#pragma unroll
    for (int i = 0; i < 4; ++i) ap[i] = A + (size_t)(row0 + (tid >> 3) + 64 * i) * lda + (tid & 7) * 8;
#pragma unroll
    for (int i = 0; i < 2; ++i) bp[i] = Bt + (size_t)(col0 + (tid >> 3) + 64 * i) * ldb + (tid & 7) * 8;
}

__device__ __forceinline__ void rope_tile(f32x4& v, const float* __restrict__ rope, int t, int lane) {
    const int ib = ((lane >> 4) & 1) * 4;
    const float* rp = rope + (size_t)t * 16 + ib * 2;
#pragma unroll
    for (int j = 0; j < 4; ++j) {
        const float x = v[j];
        const float pr = __shfl_xor(x, 32);
        const float c = rp[2 * j], s = rp[2 * j + 1];
        v[j] = (lane < 32) ? (x * c - pr * s) : (x * c + pr * s);
    }
}
__device__ __forceinline__ void store4bf(bf16_t* dst, const f32x4& v) {
    uint2 u; u.x = pk2(v[0], v[1]); u.y = pk2(v[2], v[3]);
    *(uint2*)dst = u;
}
__device__ __forceinline__ void store4bf_agent(bf16_t* dst, const f32x4& v) {
    const unsigned long long u = (unsigned long long)pk2(v[0], v[1]) | ((unsigned long long)pk2(v[2], v[3]) << 32);
    __hip_atomic_store((unsigned long long*)dst, u, __ATOMIC_RELAXED, __HIP_MEMORY_SCOPE_AGENT);
}

namespace pg8 {
#define PG8_LAS __attribute__((address_space(3)))
constexpr int BM = 256, BK = 64, HALF = 128, HTB = HALF * BK * 2  , STAGE_BYTES = 8 * HTB, NXCD = 8, WGM = 8;

__host__ __device__ __forceinline__ int lds_byte(int r, int c) { const int st = (r >> 4) * 2 + (c >> 5), rr = r & 15, cc = c & 31, ob = rr * 64 + cc * 2; return st * 1024 + (ob ^ (((ob >> 9) & 1) << 5)); }
__host__ __device__ __forceinline__ void stage_rc(int b, int& R, int& C) { const int st = b / 1024, sb = b % 1024, swz = sb ^ (((sb >> 9) & 1) << 5); R = (st >> 1) * 16 + swz / 64; C = (st & 1) * 32 + (swz % 64) / 2; }
__host__ __device__ __forceinline__ int perm32(int rho) { const int n = rho >> 4, i = rho & 15; return 8 * (i >> 2) + 4 * n + (i & 3); }

struct Unit { int pm, pn; };
struct Gemm { const bf16_t* A; const bf16_t* Bt; int M, N, K; };

struct StaticOrder {
    int nM, nN, nwg, G, c;
    const PG8_LAS int* tab;
    __host__ __device__ void init(int M, int N, int G_, int c_) { nM = M / BM; nN = N / BM; nwg = nM * nN; G = G_; c = c_; tab = nullptr; dep = nullptr; }
    const unsigned* dep;
    __device__ void init_moe(const PG8_LAS int* tab_, int G_, int c_, const unsigned* dep_) { nM = nN = nwg = 0; G = G_; c = c_; tab = tab_; dep = dep_; }
    __device__ bool next(int i, Unit& u) const {
        if (tab) {
            const int n9 = tab[96] * 4, rem = n9 % G, nlight = G - rem, r = (c - rem + G) % G;
            int L = r;
            if (i > 0) { if (r >= nlight) return false; L = G + (i - 1) * nlight + r; }
            if (L >= n9) return false;
            const int ch = L >> 2; int e = 0;
#pragma unroll 1
            for (int k = 1; k < 32; ++k) if (tab[32 + k] <= ch) e = k;
            u.pm = (tab[64 + e] >> 8) + (ch - tab[32 + e]); u.pn = e * 4 + (L & 3); return true;
        }
        const long L = (long)i * G + c; if (L >= nwg) return false;
        int wgid = (int)L; { const int q = nwg / NXCD, r = nwg % NXCD, xcd = wgid % NXCD, off = wgid / NXCD; wgid = (xcd < r ? xcd * (q + 1) : r * (q + 1) + (xcd - r) * q) + off; }
        const int nig = WGM * nN, gid = wgid / nig, fm = gid * WGM, gsz = (nM - fm) < WGM ? (nM - fm) : WGM;
        u.pm = fm + ((wgid % nig) % gsz); u.pn = (wgid % nig) / gsz; return true;
    }
    __device__ __forceinline__ void a_ready(const Unit& u) const {
        if (tab && dep) {
            if ((threadIdx.x & 63) == 0) { unsigned sp = 0; while (__hip_atomic_load(dep + u.pm, __ATOMIC_RELAXED, __HIP_MEMORY_SCOPE_AGENT) < 4u && ++sp < (1u << 22)) __builtin_amdgcn_s_sleep(2); }
            asm volatile("" ::: "memory");
        }
    }
    __device__ __forceinline__ void done(const Unit&) const {}
};

template <class Epi, class Sched, bool ALIGN_EPI = false, bool SP2 = false>
__device__ __forceinline__ void gemm_phase(PG8_LAS unsigned char* lds, const Gemm g, const Sched& S, const Epi& E) {
    const int tid = ltid(), wid = __builtin_amdgcn_readfirstlane(tid >> 6), lane = tid & 63, wr = wid >> 2, wc = wid & 3, fr = lane & 15, fq = lane >> 4;
    const int K = g.K, nt = K / BK;
    unsigned voffA[2], voffB[2];
#pragma unroll
    for (int i = 0; i < 2; ++i) { int R, C; stage_rc(tid * 16 + i * 8192, R, C); const int Rb = Epi::PERM ? ((R & ~31) + perm32(R & 31)) : R;
        voffA[i] = (unsigned)(R * K + C) * 2u; voffB[i] = (unsigned)(Rb * K + C) * 2u; }
    const size_t kstep = (size_t)(BK * 2);
    const size_t hstep = (size_t)HALF * K * 2;
    const size_t tstep = 2 * hstep;
    const unsigned ldsw = (unsigned)wid * 1024u;
    const int aoff = lds_byte(wr * 64 + fr, fq * 8), boff = lds_byte(wc * 32 + fr, fq * 8);
#define PG8_SA(b, h) (((b) * 2 + (h)) * HTB)
#define PG8_SB(b, h) ((4 + (b) * 2 + (h)) * HTB)
#define PG8_STAGE(bufoff, gbase, voff) do { _Pragma("unroll") for (int _i = 0; _i < 2; ++_i) \
        __builtin_amdgcn_global_load_lds((const unsigned*)((const char*)(gbase) + (voff)[_i]), (PG8_LAS unsigned*)(lds + (bufoff) + ldsw + _i * 8192), 16, 0, 0); } while (0)
#define PG8_LDA(dst, b, h) do { _Pragma("unroll") for (int m = 0; m < 4; ++m) _Pragma("unroll") for (int k = 0; k < 2; ++k) dst[m][k] = *(const PG8_LAS bf16x8*)(lds + PG8_SA(b, h) + aoff + m * 2048 + k * 1024); } while (0)
#define PG8_LDB(dst, b, h) do { _Pragma("unroll") for (int n = 0; n < 2; ++n) _Pragma("unroll") for (int k = 0; k < 2; ++k) dst[n][k] = *(const PG8_LAS bf16x8*)(lds + PG8_SB(b, h) + boff + n * 2048 + k * 1024); } while (0)
#define PG8_MMA(ai, bj, At, Bt) do { __builtin_amdgcn_s_setprio(1); _Pragma("unroll") for (int m = 0; m < 4; ++m) _Pragma("unroll") for (int n = 0; n < 2; ++n) _Pragma("unroll") for (int k = 0; k < 2; ++k) \
        acc[ai][bj][m][n] = __builtin_amdgcn_mfma_f32_16x16x32_bf16(Bt[n][k], At[m][k], acc[ai][bj][m][n], 0, 0, 0); __builtin_amdgcn_s_setprio(0); } while (0)
#define PG8_WAIT_V(n) asm volatile("s_waitcnt vmcnt(" #n ")" ::: "memory")
#define PG8_WAIT_L(n) asm volatile("s_waitcnt lgkmcnt(" #n ")" ::: "memory")
#define PG8_BAR __builtin_amdgcn_s_barrier()
#define PG8_SCHED __builtin_amdgcn_sched_barrier(0)
    Unit cur, nxt; int ui = 0;
    if (!S.next(0, cur)) return;
    f32x4 acc[2][2][4][2];
#pragma unroll
    for (int a = 0; a < 2; ++a)
#pragma unroll
        for (int b = 0; b < 2; ++b)
#pragma unroll
            for (int m = 0; m < 4; ++m)
#pragma unroll
                for (int n = 0; n < 2; ++n) acc[a][b][m][n] = zero4();
    bf16x8 At[4][2], B0[2][2], B1[2][2];
    const char* cA = (const char*)g.A + (size_t)cur.pm * tstep; const char* cB = (const char*)g.Bt + (size_t)cur.pn * tstep;
    S.a_ready(cur);
    if constexpr (SP2) {
        PG8_STAGE(PG8_SB(0, 0), cB, voffB); PG8_STAGE(PG8_SB(0, 1), cB + hstep, voffB); PG8_STAGE(PG8_SA(0, 0), cA, voffA); PG8_STAGE(PG8_SA(0, 1), cA + hstep, voffA);
        if (wr == 1) PG8_BAR;
        PG8_WAIT_V(2); PG8_BAR;
        PG8_STAGE(PG8_SB(1, 0), cB + kstep, voffB); PG8_STAGE(PG8_SA(1, 0), cA + kstep, voffA); PG8_STAGE(PG8_SB(1, 1), cB + hstep + kstep, voffB);
        PG8_WAIT_V(6); PG8_BAR;
    } else {
        PG8_STAGE(PG8_SB(0, 0), cB, voffB); PG8_STAGE(PG8_SA(0, 0), cA, voffA); PG8_STAGE(PG8_SB(0, 1), cB + hstep, voffB); PG8_STAGE(PG8_SA(0, 1), cA + hstep, voffA);
        if (wr == 1) PG8_BAR;
        PG8_WAIT_V(4); PG8_BAR;
        PG8_STAGE(PG8_SB(1, 0), cB + kstep, voffB); PG8_STAGE(PG8_SA(1, 0), cA + kstep, voffA); PG8_STAGE(PG8_SB(1, 1), cB + hstep + kstep, voffB);
        PG8_WAIT_V(6); PG8_BAR;
    }
    for (;;) {
        const bool has_next = S.next(ui + 1, nxt);
        const char* nA = has_next ? (const char*)g.A + (size_t)nxt.pm * tstep : cA; const char* nB = has_next ? (const char*)g.Bt + (size_t)nxt.pn * tstep : cB;
        for (int t = 0; t < nt; t += 2) {
            const bool last = (t == nt - 2);
            const char* a1 = cA + (size_t)(t + 1) * kstep;
            const char* a2 = last ? nA : cA + (size_t)(t + 2) * kstep; const char* b2 = last ? nB : cB + (size_t)(t + 2) * kstep;
            const char* a3 = a2 + kstep; const char* b3 = b2 + kstep;
            if (last && has_next) S.a_ready(nxt);
            if constexpr (SP2) {
            PG8_LDB(B0, 0, 0); PG8_LDB(B1, 0, 1); PG8_SCHED; PG8_LDA(At, 0, 0); PG8_STAGE(PG8_SA(1, 1), a1 + hstep, voffA);
            PG8_WAIT_V(8); PG8_WAIT_L(0); PG8_BAR; PG8_MMA(0, 0, At, B0); PG8_MMA(0, 1, At, B1); PG8_BAR; PG8_SCHED;
            PG8_LDA(At, 0, 1); PG8_STAGE(PG8_SB(0, 0), b2, voffB); PG8_STAGE(PG8_SB(0, 1), b2 + hstep, voffB); PG8_STAGE(PG8_SA(0, 0), a2, voffA);
            PG8_WAIT_V(8); PG8_WAIT_L(0); PG8_BAR; PG8_MMA(1, 0, At, B0); PG8_MMA(1, 1, At, B1); PG8_BAR; PG8_SCHED;
            PG8_LDB(B0, 1, 0); PG8_LDB(B1, 1, 1); PG8_SCHED; PG8_LDA(At, 1, 0); PG8_STAGE(PG8_SA(0, 1), a2 + hstep, voffA);
            PG8_WAIT_V(8); PG8_WAIT_L(0); PG8_BAR; PG8_MMA(0, 0, At, B0); PG8_MMA(0, 1, At, B1); PG8_BAR; PG8_SCHED;
            PG8_LDA(At, 1, 1); PG8_STAGE(PG8_SB(1, 0), b3, voffB); PG8_STAGE(PG8_SB(1, 1), b3 + hstep, voffB); PG8_STAGE(PG8_SA(1, 0), a3, voffA);
            PG8_WAIT_V(8); PG8_WAIT_L(0); PG8_BAR; PG8_MMA(1, 0, At, B0); PG8_MMA(1, 1, At, B1); PG8_BAR; PG8_SCHED;
            } else {
            PG8_LDB(B0, 0, 0); PG8_SCHED; PG8_LDA(At, 0, 0); PG8_STAGE(PG8_SA(1, 1), a1 + hstep, voffA);
            PG8_WAIT_L(8); PG8_BAR; PG8_WAIT_L(0); PG8_MMA(0, 0, At, B0); PG8_BAR; PG8_SCHED;
            PG8_LDB(B1, 0, 1); PG8_STAGE(PG8_SB(0, 0), b2, voffB);
            PG8_BAR; PG8_WAIT_L(0); PG8_MMA(0, 1, At, B1); PG8_BAR;
            PG8_LDA(At, 0, 1); PG8_STAGE(PG8_SA(0, 0), a2, voffA);
            PG8_BAR; PG8_WAIT_L(0); PG8_MMA(1, 0, At, B0); PG8_BAR; PG8_SCHED;
            PG8_STAGE(PG8_SB(0, 1), b2 + hstep, voffB);
            PG8_WAIT_V(6); PG8_BAR; PG8_MMA(1, 1, At, B1); PG8_BAR;
            PG8_LDB(B0, 1, 0); PG8_SCHED; PG8_LDA(At, 1, 0); PG8_STAGE(PG8_SA(0, 1), a2 + hstep, voffA);
            PG8_WAIT_L(8); PG8_BAR; PG8_WAIT_L(0); PG8_MMA(0, 0, At, B0); PG8_BAR; PG8_SCHED;
            PG8_LDB(B1, 1, 1); PG8_STAGE(PG8_SB(1, 0), b3, voffB);
            PG8_BAR; PG8_WAIT_L(0); PG8_MMA(0, 1, At, B1); PG8_BAR;
            PG8_LDA(At, 1, 1); PG8_STAGE(PG8_SA(1, 0), a3, voffA);
            PG8_BAR; PG8_WAIT_L(0); PG8_MMA(1, 0, At, B0); PG8_BAR; PG8_SCHED;
            PG8_STAGE(PG8_SB(1, 1), b3 + hstep, voffB);
            PG8_WAIT_V(6); PG8_BAR; PG8_MMA(1, 1, At, B1); PG8_BAR;
            }
        }
        if constexpr (ALIGN_EPI) { if (wr == 0) PG8_BAR; }
        if constexpr (!Epi::AFTER_DRAIN) { E(acc, cur, wr, wc, fr, fq); S.done(cur); }
        if (!has_next) break;
#pragma unroll
        for (int a = 0; a < 2; ++a)
#pragma unroll
            for (int b = 0; b < 2; ++b)
#pragma unroll
                for (int m = 0; m < 4; ++m)
#pragma unroll
                    for (int n = 0; n < 2; ++n) acc[a][b][m][n] = zero4();
        cur = nxt; cA = nA; cB = nB; ++ui;
        if constexpr (ALIGN_EPI) { if (wr == 1) PG8_BAR; }
    }
    PG8_WAIT_V(0);
    if constexpr (!ALIGN_EPI) { if (wr == 0) PG8_BAR; }
    PG8_BAR;
    if constexpr (Epi::AFTER_DRAIN) { E.fused(acc, cur, wr, wc, fr, fq, lds, wid, lane); S.done(cur); }
#undef PG8_SA
#undef PG8_SB
#undef PG8_STAGE
#undef PG8_LDA
#undef PG8_LDB
#undef PG8_MMA
#undef PG8_WAIT_V
#undef PG8_WAIT_L
#undef PG8_BAR
#undef PG8_SCHED
}
}

__device__ __forceinline__ int opaque(int v) { asm volatile("" : "+s"(v)); return v; }
__device__ __forceinline__ size_t kimg_off(int b, int h, int t, int d) { return ((((size_t)(b * 8 + h) * MW + (t >> 6)) * 8 + (d >> 3)) * 64 + (t & 63)) * 8 + (d & 7); }
__device__ __forceinline__ size_t vimg_off(int b, int h, int t, int d) { return ((((size_t)(b * 8 + h) * MW + (t >> 6)) * 2 + (d >> 5)) * 64 + (t & 63)) * 32 + (d & 31); }
__device__ __forceinline__ void store8bf(bf16_t* dst, const f32x4& a, const f32x4& b) {
    uint4 w; w.x = pk2(a[0], a[1]); w.y = pk2(a[2], a[3]); w.z = pk2(b[0], b[1]); w.w = pk2(b[2], b[3]);
    *(uint4*)dst = w;
}
__device__ __forceinline__ void rope8(f32x4& v0, f32x4& v1, const float* __restrict__ rope, int t, int fq) {
    const float* rp = rope + (size_t)t * 16;
#pragma unroll
    for (int j = 0; j < 4; ++j) {
        { const float x = v0[j]; const float pr = __shfl_xor(x, 16); const float c = rp[2 * j], sn = rp[2 * j + 1];
          v0[j] = (fq == 0) ? (x * c - pr * sn) : ((fq == 1) ? (x * c + pr * sn) : x); }
        { const float x = v1[j]; const float pr = __shfl_xor(x, 16); const float c = rp[2 * (4 + j)], sn = rp[2 * (4 + j) + 1];
          v1[j] = (fq == 0) ? (x * c - pr * sn) : ((fq == 1) ? (x * c + pr * sn) : x); }
    }
}
struct EpiInProj {
    static constexpr bool PERM = true, AFTER_DRAIN = false;
    template <int BJ> __device__ __forceinline__ void part(const f32x4 (&acc)[2][2][4][2], const pg8::Unit& u, int wr, int wc, int fr, int fq) const {
        KParams kpe = (KParams)__builtin_amdgcn_kernarg_segment_ptr(); asm volatile("" : "+s"(kpe));
        unsigned char* ws = kpe->ws; const float* rope = (const float*)(ws + OFF_ROPE);
        const int cb = 256 * u.pn + 128 * BJ + 32 * wc;
        const int cg64 = cb >> 6, hf = wc & 1;
        const int cig = hf * 32 + 8 * fq;
        if (cg64 >= 78) return;
        if (cg64 < 45) {
            size_t off; int pitch = 512, hd = 0; float scl = 1.0f; bool rp = false;
            if (cg64 < 8) { off = OFF_QA; hd = cg64; scl = QSCALE; rp = true; }
            else if (cg64 < 12) { off = OFF_CKV; pitch = 256; hd = cg64 - 8; }
            else if (cg64 < 20) { off = OFF_QI; hd = cg64 - 12; scl = 0.125f; rp = true; }
            else if (cg64 == 20) { off = OFF_KI; pitch = 64; rp = true; }
            else if (cg64 < 29) { off = OFF_QF; hd = cg64 - 21; scl = QSCALE; }
            else if (cg64 < 37) { off = OFF_KF; hd = cg64 - 29; }
            else { off = OFF_VF; hd = cg64 - 37; }
            bf16_t* base = (bf16_t*)(ws + off) + hd * 64 + cig;
            rp = rp && (hf == 0);
#pragma unroll
            for (int ai = 0; ai < 2; ++ai)
#pragma unroll
                for (int m = 0; m < 4; ++m) {
                    const int n = 256 * u.pm + 128 * ai + 64 * wr + 16 * m + fr;
                    const int b = n / SEQ, t = NMETA + n % SEQ, r = b * TP + t;
                    f32x4 v0 = acc[ai][BJ][m][0], v1 = acc[ai][BJ][m][1];
                    if (rp) rope8(v0, v1, rope, t, fq);
                    if (cg64 == 20) {
                        store8bf((bf16_t*)(ws + OFF_KI) + ((size_t)((b * (TP / 16) + (t >> 4)) * 2 + hf) * 64 + fq * 16 + (t & 15)) * 8, v0, v1);
                    } else
                    store8bf(base + (size_t)((cg64 >= 8 && cg64 < 12) ? n : r) * pitch, v0 * scl, v1 * scl);
                    asm volatile("" ::: "memory");
                }
        } else if (cg64 < 77) {
            bf16_t* gates = (bf16_t*)kpe->out + (cg64 - 45) * 64 + cig;
#pragma unroll
            for (int ai = 0; ai < 2; ++ai)
#pragma unroll
                for (int m = 0; m < 4; ++m) {
                    const int n = 256 * u.pm + 128 * ai + 64 * wr + 16 * m + fr;
                    {
                        f32x4 v0 = acc[ai][BJ][m][0], v1 = acc[ai][BJ][m][1];
#pragma unroll
                        for (int j = 0; j < 4; ++j) { v0[j] = sigmoidf_(v0[j]); v1[j] = sigmoidf_(v1[j]); }
                        store8bf(gates + (size_t)n * 2048, v0, v1);
                    }
                }
        } else if (hf == 0 && fq < 2) {
            float* WIo = (float*)(ws + OFF_WI); float* LOGF = (float*)(ws + OFF_LOGF); const float* bfg = kpe->in[5];
#pragma unroll
            for (int ai = 0; ai < 2; ++ai)
#pragma unroll
                for (int m = 0; m < 4; ++m) {
                    const int n = 256 * u.pm + 128 * ai + 64 * wr + 16 * m + fr;
                    const int r = (n / SEQ) * TP + NMETA + n % SEQ;
                    const f32x4 v0 = acc[ai][BJ][m][0], v1 = acc[ai][BJ][m][1];
                    if (fq == 0) {
                        *(f32x4*)(WIo + (size_t)r * 8) = v0 * 0.3535533905932738f; *(f32x4*)(WIo + (size_t)r * 8 + 4) = v1 * 0.3535533905932738f;
                    } else {
                        f32x4 o0, o1;
#pragma unroll
                        for (int j = 0; j < 4; ++j) {
                            const float z0 = v0[j] + bfg[j], z1 = v1[j] + bfg[4 + j];
                            o0[j] = fminf(z0, 0.f) - __logf(1.0f + __expf(-fabsf(z0)));
                            o1[j] = fminf(z1, 0.f) - __logf(1.0f + __expf(-fabsf(z1)));
                        }
                        float* lt = LOGF + (size_t)(n / SEQ) * 8 * TP + (NMETA + n % SEQ);
#pragma unroll
                        for (int j = 0; j < 4; ++j) { lt[(size_t)j * TP] = o0[j]; lt[(size_t)(4 + j) * TP] = o1[j]; }
                    }
                }
        }
    }
    __device__ __forceinline__ void operator()(const f32x4 (&acc)[2][2][4][2], const pg8::Unit& u, int wr, int wc, int fr, int fq) const {
        asm volatile("" : "+v"(fr), "+v"(fq));
        part<0>(acc, u, wr, wc, fr, fq); part<1>(acc, u, wr, wc, fr, fq);
    }
};
struct EpiKvUp {
    static constexpr bool PERM = true, AFTER_DRAIN = false;
    const PG8_LAS float* rs; const PG8_LAS int* tag;
    template <int BJ> __device__ __forceinline__ void part(const f32x4 (&acc)[2][2][4][2], const pg8::Unit& u, const PG8_LAS float* rsu, int wr, int wc, int fr, int fq) const {
        KParams kpe = (KParams)__builtin_amdgcn_kernarg_segment_ptr(); asm volatile("" : "+s"(kpe));
        unsigned char* ws = kpe->ws; const float* rope = (const float*)(ws + OFF_ROPE);
        const int cb = 256 * u.pn + 128 * BJ + 32 * wc;
        const int cg64 = cb >> 6, hf = wc & 1, cig = hf * 32 + 8 * fq;
        const bool isk = cg64 < 8, rp = isk && (hf == 0);
        bf16_t* base = (bf16_t*)(ws + (isk ? OFF_KA : OFF_VA)) + (isk ? cg64 : cg64 - 8) * 64 + cig;
#pragma unroll
        for (int ai = 0; ai < 2; ++ai)
#pragma unroll
            for (int m = 0; m < 4; ++m) {
                const int rl = 128 * ai + 64 * wr + 16 * m + fr;
                const int n = 256 * u.pm + rl, t = NMETA + n % SEQ, r = (n / SEQ) * TP + t;
                const float rstd = rsu[rl];
                f32x4 v0 = acc[ai][BJ][m][0] * rstd, v1 = acc[ai][BJ][m][1] * rstd;
                if (rp) rope8(v0, v1, rope, t, fq);
                store8bf((bf16_t*)(ws + (isk ? OFF_KA : OFF_VA)) + (isk ? kimg_off(n / SEQ, cg64, t, cig) : vimg_off(n / SEQ, cg64 - 8, t, cig)), v0, v1);
                asm volatile("" ::: "memory");
            }
    }
    __device__ __forceinline__ void operator()(const f32x4 (&acc)[2][2][4][2], const pg8::Unit& u, int wr, int wc, int fr, int fq) const {
        asm volatile("" : "+v"(fr), "+v"(fq));
        const PG8_LAS float* rsu = (tag[0] == u.pm) ? rs : rs + 256;
        part<0>(acc, u, rsu, wr, wc, fr, fq); part<1>(acc, u, rsu, wr, wc, fr, fq);
    }
};
#ifndef MGB
#define MGB 4
#endif
template <int PASS> struct EpiMerge {
    static constexpr bool PERM = true, AFTER_DRAIN = false;
    __device__ __forceinline__ void operator()(const f32x4 (&acc)[2][2][4][2], const pg8::Unit& u, int wr, int wc, int fr, int fq) const {
        asm volatile("" : "+v"(fr), "+v"(fq));
        KParams kpe = (KParams)__builtin_amdgcn_kernarg_segment_ptr(); asm volatile("" : "+s"(kpe));
        bf16_t* merged = (bf16_t*)(kpe->ws + OFF_MERGED); const bf16_t* gates = (const bf16_t*)kpe->out;
#pragma unroll
        for (int bj = 0; bj < 2; ++bj) {
            const int c = 256 * u.pn + 128 * bj + 32 * wc + 8 * fq;
            const size_t n0 = (size_t)(256 * u.pm + 64 * wr + fr);
#pragma unroll
            for (int i0 = 0; i0 < 8; i0 += MGB) {
                uint4 g[MGB], o[MGB];
#pragma unroll
                for (int i = 0; i < MGB; ++i) g[i] = *(const uint4*)(gates + (n0 + 128 * ((i0 + i) >> 2) + 16 * ((i0 + i) & 3)) * 2048 + PASS * 1024 + c);
                if (PASS == 1) {
#pragma unroll
                    for (int i = 0; i < MGB; ++i) o[i] = *(const uint4*)(merged + (n0 + 128 * ((i0 + i) >> 2) + 16 * ((i0 + i) & 3)) * 1024 + c);
                }
#pragma unroll
                for (int i = 0; i < MGB; ++i) {
                    const int ii = i0 + i;
                    f32x4 v0 = acc[ii >> 2][bj][ii & 3][0], v1 = acc[ii >> 2][bj][ii & 3][1];
                    v0 = v0 * (f32x4){bf2f(g[i].x & 0xffffu), bf2f(g[i].x >> 16), bf2f(g[i].y & 0xffffu), bf2f(g[i].y >> 16)};
                    v1 = v1 * (f32x4){bf2f(g[i].z & 0xffffu), bf2f(g[i].z >> 16), bf2f(g[i].w & 0xffffu), bf2f(g[i].w >> 16)};
                    if (PASS == 1) {
                        v0 = v0 + (f32x4){bf2f(o[i].x & 0xffffu), bf2f(o[i].x >> 16), bf2f(o[i].y & 0xffffu), bf2f(o[i].y >> 16)};
                        v1 = v1 + (f32x4){bf2f(o[i].z & 0xffffu), bf2f(o[i].z >> 16), bf2f(o[i].w & 0xffffu), bf2f(o[i].w >> 16)};
                    }
                    store8bf(merged + (n0 + 128 * (ii >> 2) + 16 * (ii & 3)) * 1024 + c, v0, v1);
                }
                asm volatile("" ::: "memory");
            }
        }
    }
};
struct EpiOutProj {
    static constexpr bool PERM = true, AFTER_DRAIN = false;
    __device__ __forceinline__ void operator()(const f32x4 (&acc)[2][2][4][2], const pg8::Unit& u, int wr, int wc, int fr, int fq) const {
        asm volatile("" : "+v"(fr), "+v"(fq));
        KParams kpe = (KParams)__builtin_amdgcn_kernarg_segment_ptr(); asm volatile("" : "+s"(kpe));
        const float* x = kpe->in[0]; const float* g0 = kpe->in[2]; const float* b0 = kpe->in[3]; float* out = kpe->out;
        const float* stat0 = (const float*)(kpe->ws + OFF_STAT0);
        const int c0 = 256 * u.pn + 32 * wc + 8 * fq;
        f32x4 gg[4], bb[4];
#pragma unroll
        for (int q = 0; q < 4; ++q) { gg[q] = *(const f32x4*)(g0 + c0 + 128 * (q >> 1) + 4 * (q & 1)) * ALPHA; bb[q] = *(const f32x4*)(b0 + c0 + 128 * (q >> 1) + 4 * (q & 1)) * ALPHA; }
#pragma unroll
        for (int rp = 0; rp < 4; ++rp) {
            f32x2 st[2]; f32x4 xv[2][4]; int nn_[2];
#pragma unroll
            for (int mm = 0; mm < 2; ++mm) {
                const int n = 256 * u.pm + 128 * (rp >> 1) + 64 * wr + 16 * ((rp & 1) * 2 + mm) + fr;
                nn_[mm] = n;
                st[mm] = *(const f32x2*)(stat0 + 2 * ((n / SEQ) * TP + NMETA + n % SEQ));
#pragma unroll
                for (int q = 0; q < 4; ++q) xv[mm][q] = *(const f32x4*)(x + (size_t)n * 1024 + c0 + 128 * (q >> 1) + 4 * (q & 1));
            }
#pragma unroll
            for (int mm = 0; mm < 2; ++mm) {
                const float mu = st[mm][0], rstd = st[mm][1];
#pragma unroll
                for (int q = 0; q < 4; ++q)
                    *(f32x4*)(out + (size_t)nn_[mm] * 1024 + c0 + 128 * (q >> 1) + 4 * (q & 1)) = (xv[mm][q] - mu) * rstd * gg[q] + bb[q] + acc[rp >> 1][q >> 1][(rp & 1) * 2 + mm][q & 1];
            }
        }
    }
};
struct EpiMoeDown {
    static constexpr bool PERM = true, AFTER_DRAIN = false;
    const PG8_LAS int* tab;
    __device__ __forceinline__ void operator()(const f32x4 (&acc)[2][2][4][2], const pg8::Unit& u, int wr, int wc, int fr, int fq) const {
        asm volatile("" : "+v"(fr), "+v"(fq));
        KParams kpe = (KParams)__builtin_amdgcn_kernarg_segment_ptr(); asm volatile("" : "+s"(kpe));
        unsigned char* ws = kpe->ws;
        const int* TOKL = (const int*)(ws + OFF_TOKL); const float* GW = (const float*)(ws + OFF_GW); bf16_t* SLOT = (bf16_t*)(ws + OFF_SLOT);
        const int e = u.pn >> 2, cnt = tab[e], pos0 = (u.pm - (tab[64 + e] >> 8)) * 256;
        const int cb = 256 * (u.pn & 3) + 32 * wc + 8 * fq;
        int aid[8]; float gw[8];
#pragma unroll
        for (int i = 0; i < 8; ++i) { const int pos = pos0 + 128 * (i >> 2) + 64 * wr + 16 * (i & 3) + fr; aid[i] = TOKL[e * 32768 + (pos < cnt ? pos : cnt - 1)]; }
#pragma unroll
        for (int i = 0; i < 8; ++i) gw[i] = GW[aid[i]];
#pragma unroll
        for (int ai = 0; ai < 2; ++ai)
#pragma unroll
            for (int m = 0; m < 4; ++m) {
                const int pos = pos0 + 128 * ai + 64 * wr + 16 * m + fr;
                if (pos < cnt) {
                    const float g = gw[ai * 4 + m];
                    bf16_t* dst = SLOT + (size_t)aid[ai * 4 + m] * 1024 + cb;
                    store8bf(dst, acc[ai][0][m][0] * g, acc[ai][0][m][1] * g);
                    store8bf(dst + 128, acc[ai][1][m][0] * g, acc[ai][1][m][1] * g);
                }
            }
    }
};
struct EpiAny {
    static constexpr bool PERM = true, AFTER_DRAIN = false;
    int kind; const PG8_LAS float* rs; const PG8_LAS int* tag;
    __device__ __forceinline__ void operator()(const f32x4 (&acc)[2][2][4][2], const pg8::Unit& u, int wr, int wc, int fr, int fq) const {
        if (kind == 0) { EpiInProj e{}; e(acc, u, wr, wc, fr, fq); }
        else if (kind == 1) { EpiKvUp e{rs, tag}; e(acc, u, wr, wc, fr, fq); }
        else if (kind == 2) { EpiMerge<0> e{}; e(acc, u, wr, wc, fr, fq); }
        else if (kind == 3) { EpiMerge<1> e{}; e(acc, u, wr, wc, fr, fq); }
        else if (kind == 4) { EpiOutProj e{}; e(acc, u, wr, wc, fr, fq); }
        else { EpiMoeDown e{tag}; e(acc, u, wr, wc, fr, fq); }
    }
};

template <int POS> __device__ __forceinline__ unsigned bitmask1(int m) { int r; asm("v_bfe_i32 %0, %1, %2, 1" : "=v"(r) : "v"(m), "n"(POS)); return (unsigned)r; }
typedef short s16x4 __attribute__((ext_vector_type(4)));
__device__ __forceinline__ s16x4 vtr16(const unsigned char* p) {
    return __builtin_bit_cast(s16x4, __builtin_amdgcn_ds_read_tr16_b64_v4i16((__attribute__((address_space(3))) s16x4*)p));
}
constexpr int AT_VP = 192;
constexpr int AT_K = 0, AT_V = 8192, AT_C = 8192 + 64 * AT_VP, AT_BUF = 8192 + 64 * AT_VP + 256;
template <bool FOX>
__device__ void attn_item(unsigned char* ws, int b, int h, int qb, unsigned char* smem) {
    constexpr int mode = 0;
    const bf16_t* Q = (const bf16_t*)(ws + (FOX ? OFF_QF : OFF_QA));
    bf16_t* Y = (bf16_t*)(ws + (FOX ? OFF_YF : OFF_YA));
    const bf16_t* Kg = (const bf16_t*)(ws + (FOX ? OFF_KF : OFF_KA));
    const bf16_t* Vt = (const bf16_t*)(ws + (FOX ? OFF_VF : OFF_VA));
    const float* cum = (const float*)(ws + OFF_CUM);
    const unsigned long long* mask = (const unsigned long long*)(ws + OFF_MASK);
    const int tid = ltid(), lane = tid & 63, wave = __builtin_amdgcn_readfirstlane(tid >> 6), hlf = lane >> 5;
    const int q0w = qb * 256 + wave * 32;
    const int qrow = q0w + (lane & 31);
    const size_t grow = (size_t)b * TP + qrow;
    const bool wave_on = q0w < T;
    bf16x8 qf[4];
#pragma unroll
    for (int ks = 0; ks < 4; ++ks) qf[ks] = *(const bf16x8*)(Q + grow * 512 + h * 64 + ks * 16 + hlf * 8);
    const int nkt = qb * 4 + 4;
    int kt0 = 0;
    if (FOX) {
        const float* knorm = (const float*)(ws + OFF_KNORM) + (size_t)(b * 8 + h) * MW;
        float* red = (float*)(smem + 2 * AT_BUF);
        float qq = 0.f;
#pragma unroll
        for (int ks = 0; ks < 4; ++ks)
#pragma unroll
            for (int e = 0; e < 8; ++e) { const float v = bf2f((unsigned)(unsigned short)qf[ks][e]); qq = fmaf(v, v, qq); }
        qq += __shfl_xor(qq, 32);
#pragma unroll
        for (int o = 1; o < 32; o <<= 1) qq = fmaxf(qq, __shfl_xor(qq, o));
        if (lane == 0) red[wave] = qq;
        __syncthreads();
        if (wave == 0) {
            float qm = red[0];
#pragma unroll
            for (int w = 1; w < 8; ++w) qm = fmaxf(qm, red[w]);
            const float Qn = sqrtf(qm) * 1.0001f;
            const float Kd = fmaxf(fmaxf(knorm[qb * 4], knorm[qb * 4 + 1]), fmaxf(knorm[qb * 4 + 2], knorm[qb * 4 + 3])) * 1.0001f;
            const float cfirst = cum[((size_t)b * TP + qb * 256) * 8 + h];
            bool keep0 = true, keep1 = true;
            if (lane < qb * 4) { const float bnd = Qn * (knorm[lane] * 1.0001f + Kd) + cfirst - cum[((size_t)b * TP + lane * 64 + 63) * 8 + h]; keep0 = !(bnd < -40.0f); }
            if (lane + 64 < qb * 4) { const float bnd = Qn * (knorm[lane + 64] * 1.0001f + Kd) + cfirst - cum[((size_t)b * TP + (lane + 64) * 64 + 63) * 8 + h]; keep1 = !(bnd < -40.0f); }
            const unsigned long long b0 = __ballot(keep0), b1 = __ballot(keep1);
            const int first = b0 ? (int)__builtin_ctzll(b0) : (b1 ? 64 + (int)__builtin_ctzll(b1) : 128);
            if (lane == 0) ((int*)red)[8] = first < qb * 4 ? first : qb * 4;
        }
        __syncthreads();
        kt0 = ((const int*)red)[8];
    }
    const int my_last = qb * 4 + (wave >> 1);
    f32x16 o0, o1;
#pragma unroll
    for (int i = 0; i < 16; ++i) { o0[i] = 0.f; o1[i] = 0.f; }
    float m_run = -1e30f, l_run = 0.f;
    const int skey = tid >> 3, sc = tid & 7;
    const bf16_t* kp = Kg + ((size_t)b * TP + skey) * 512 + h * 64 + sc * 8;
    const bf16_t* vp = Vt + ((size_t)b * TP + skey) * 512 + h * 64 + sc * 8;
    const int kw_off = skey * 128 + ((sc ^ ((skey >> 1) & 7)) * 16);
    const int vw_off = skey * AT_VP + sc * 16;
    uint4 rk = *(const uint4*)(kp + (size_t)kt0 * 64 * 512), rv = *(const uint4*)(vp + (size_t)kt0 * 64 * 512);
    float rc = 0.f;
    if (FOX && tid < 64) rc = cum[((size_t)b * TP + kt0 * 64 + tid) * 8 + h];
    unsigned long long mw = 0ull, mw_next = 0ull;
    if (!FOX) mw_next = mask[grow * MW + 0];
    for (int kt = kt0; kt < nkt; ++kt) {
        unsigned char* sb = smem + (kt & 1) * AT_BUF;
        if (mode != 3) {
        *(uint4*)(sb + AT_K + kw_off) = rk;
        *(uint4*)(sb + AT_V + vw_off) = rv;
        if (FOX && tid < 64) *(float*)(sb + AT_C + tid * 4) = rc;
        }
        mw = mw_next;
        if (mode != 3) __syncthreads();
        if (kt + 1 < nkt) {
            rk = *(const uint4*)(kp + (size_t)(kt + 1) * 64 * 512);
            rv = *(const uint4*)(vp + (size_t)(kt + 1) * 64 * 512);
            if (FOX && tid < 64) rc = cum[((size_t)b * TP + (kt + 1) * 64 + tid) * 8 + h];
            if (!FOX) mw_next = mask[grow * MW + kt + 1];
        }
        if (wave_on && kt <= my_last) {
            const bf16_t* Ks = (const bf16_t*)(sb + AT_K);
            const unsigned char* Vs = sb + AT_V;
            const float* Cs = (const float*)(sb + AT_C);
            f32x16 st[2];
#pragma unroll
            for (int sub = 0; sub < 2; ++sub) {
#pragma unroll
                for (int i = 0; i < 16; ++i) st[sub][i] = 0.f;
                const int krow = sub * 32 + (lane & 31);
                if (mode != 4)
#pragma unroll
                for (int ks = 0; ks < 4; ++ks) {
                    const bf16x8 kf = *(const bf16x8*)(Ks + krow * 64 + (((ks * 2 + hlf) ^ ((krow >> 1) & 7)) * 8));
                    st[sub] = __builtin_amdgcn_mfma_f32_32x32x16_bf16(kf, qf[ks], st[sub], 0, 0, 0);
                }
            }
            const bool diag = (kt == my_last);
            const int kbase = kt * 64 + 4 * hlf;
            float mx = -3.0e38f;
            if (FOX) {
#pragma unroll
                for (int sub = 0; sub < 2; ++sub)
#pragma unroll
                    for (int g = 0; g < 4; ++g) {
                        const f32x4 ck4 = *(const f32x4*)(Cs + sub * 32 + 8 * g + 4 * hlf);
#pragma unroll
                        for (int j = 0; j < 4; ++j) st[sub][g * 4 + j] -= ck4[j];
                    }
                if (diag) {
#pragma unroll
                    for (int sub = 0; sub < 2; ++sub)
#pragma unroll
                        for (int g = 0; g < 4; ++g)
#pragma unroll
                            for (int j = 0; j < 4; ++j) { const int key = kbase + sub * 32 + 8 * g + j; st[sub][g * 4 + j] = (key <= qrow) ? st[sub][g * 4 + j] : -3.0e38f; }
                }
            }
#pragma unroll
            for (int sub = 0; sub < 2; ++sub)
#pragma unroll
                for (int i = 0; i < 16; ++i) mx = fmaxf(mx, st[sub][i]);
            mx = fmaxf(mx, __shfl_xor(mx, 32));
            const float m_new = fmaxf(m_run, mx);
            const float alpha = __builtin_amdgcn_exp2f(m_run - m_new);
            m_run = m_new;
            float ls = 0.f;
            bf16x8 pf[2][2];
            {
                const int mb0 = (int)(unsigned)(mw >> (4 * hlf)), mb1 = (int)(unsigned)(mw >> (32 + 4 * hlf));
                unsigned pw[2][2][4];
#define ATT_PAIR(SUB, S2, J, MB) do { constexpr int r0_ = 8 * (S2) + (J), r1_ = r0_ + 1; \
                    float p0 = st[SUB][r0_], p1 = st[SUB][r1_]; \
                    if (mode != 5) { p0 = __builtin_amdgcn_exp2f(p0 - m_new); p1 = __builtin_amdgcn_exp2f(p1 - m_new); } \
                    if (!FOX && mode != 5) { p0 = __uint_as_float(__float_as_uint(p0) & bitmask1<8 * (r0_ >> 2) + (r0_ & 3)>(MB)); \
                                             p1 = __uint_as_float(__float_as_uint(p1) & bitmask1<8 * (r1_ >> 2) + (r1_ & 3)>(MB)); } \
                    ls += p0 + p1; pw[SUB][S2][(J) >> 1] = pk2(p0, p1); } while (0)
#define ATT_QUAD(SUB, S2, MB) ATT_PAIR(SUB, S2, 0, MB); ATT_PAIR(SUB, S2, 2, MB); ATT_PAIR(SUB, S2, 4, MB); ATT_PAIR(SUB, S2, 6, MB)
                ATT_QUAD(0, 0, mb0); ATT_QUAD(0, 1, mb0); ATT_QUAD(1, 0, mb1); ATT_QUAD(1, 1, mb1);
#undef ATT_QUAD
#undef ATT_PAIR
#pragma unroll
                for (int sub = 0; sub < 2; ++sub)
#pragma unroll
                    for (int s2 = 0; s2 < 2; ++s2) { uint4 t4 = make_uint4(pw[sub][s2][0], pw[sub][s2][1], pw[sub][s2][2], pw[sub][s2][3]); pf[sub][s2] = *(bf16x8*)&t4; }
            }
            l_run = l_run * alpha + ls;
            if (mode == 2) { asm volatile("" :: "v"(pf[0][0]), "v"(pf[0][1]), "v"(pf[1][0]), "v"(pf[1][1])); }
            else {
#pragma unroll
            for (int i = 0; i < 16; ++i) { o0[i] *= alpha; o1[i] *= alpha; }
#pragma unroll
            for (int sub = 0; sub < 2; ++sub)
#pragma unroll
                for (int s2 = 0; s2 < 2; ++s2) {
                    const int key0 = sub * 32 + 16 * s2 + 4 * hlf;
                    const unsigned char* vr = Vs + (key0 + ((lane & 15) >> 2)) * AT_VP + (16 * ((lane >> 4) & 1) + 4 * (lane & 3)) * 2;
                    {
                        const s16x4 a = vtr16(vr), c = vtr16(vr + 8 * AT_VP);
                        const bf16x8 vf = (bf16x8){a[0], a[1], a[2], a[3], c[0], c[1], c[2], c[3]};
                        o0 = __builtin_amdgcn_mfma_f32_32x32x16_bf16(vf, pf[sub][s2], o0, 0, 0, 0);
                    }
                    {
                        const s16x4 a = vtr16(vr + 64), c = vtr16(vr + 64 + 8 * AT_VP);
                        const bf16x8 vf = (bf16x8){a[0], a[1], a[2], a[3], c[0], c[1], c[2], c[3]};
                        o1 = __builtin_amdgcn_mfma_f32_32x32x16_bf16(vf, pf[sub][s2], o1, 0, 0, 0);
                    }
                }
            }
        }
    }
    __syncthreads();
    if (wave_on) {
        const float lt = l_run + __shfl_xor(l_run, 32);
        const float inv = 1.0f / lt;
        if (qrow >= NMETA && qrow < T && mode == 0) {
            bf16_t* yo = Y + ((size_t)b * SEQ + (qrow - NMETA)) * 512 + h * 64;
#pragma unroll
            for (int g = 0; g < 4; ++g) {
                const int d = 8 * g + 4 * hlf;
                store4bf(yo + d, (f32x4){o0[4 * g] * inv, o0[4 * g + 1] * inv, o0[4 * g + 2] * inv, o0[4 * g + 3] * inv});
                store4bf(yo + 32 + d, (f32x4){o1[4 * g] * inv, o1[4 * g + 1] * inv, o1[4 * g + 2] * inv, o1[4 * g + 3] * inv});
            }
        }
    }
}

namespace ab {
using bf16=__hip_bfloat16;
using bf16x8=__attribute__((ext_vector_type(8)))short;
using s16x4=__attribute__((ext_vector_type(4)))short;
using f32x16=__attribute__((ext_vector_type(16)))float;
using u32x4=__attribute__((ext_vector_type(4)))unsigned;
constexpr int BATCH=2,NHEAD=8,SEQ=8448  ,D=64,DM=NHEAD*D;
constexpr int NW=8,QBLK=32,QB=QBLK*NW,KVBLK=64,NQB=SEQ/QB;
constexpr int ATTN_PITCH=DM, ATTN_UNIT_ROWS=QB;
__device__ __forceinline__ int crow(int r,int hi){return (r&3)+8*(r>>2)+4*hi;}
#define SBAR() __builtin_amdgcn_sched_barrier(0)
__device__ __forceinline__ void cmask(f32x16&p0,f32x16&p1,int jb,int qrel,int hi){
  const float NEG=-INFINITY; int kb=64*jb+4*hi;
  #pragma unroll
  for(int r=0;r<16;++r){int kv=kb+(r&3)+8*(r>>2); if(kv>qrel)p0[r]=NEG; if(kv+32>qrel)p1[r]=NEG;}
}

constexpr int NSLOT=3, SLOTB=8192;
constexpr int LDS_K=0, LDS_V=NSLOT*SLOTB, LDS_WS=2*NSLOT*SLOTB, LDS_OST=LDS_WS+NW*64*4, LDS_BYTES=LDS_OST+NW*4096;
constexpr float C2=0.125f*1.4426950408889634f;
__device__ __forceinline__ void glds16(const void*gsrc,unsigned lds_dst){unsigned keep;
  asm volatile("s_mov_b32 %0, m0\n\ts_mov_b32 m0, %2\n\ts_nop 0\n\tglobal_load_lds_dwordx4 %1, off\n\ts_mov_b32 m0, %0":"=&s"(keep):"v"(gsrc),"s"(lds_dst):"memory");}
__device__ __forceinline__ float max3f(float a,float b,float c){float r;asm("v_max3_f32 %0, %1, %2, %3":"=v"(r):"v"(a),"v"(b),"v"(c));return r;}
__device__ __forceinline__ float max2f(float a,float b){float r;asm("v_max_f32_e32 %0, %1, %2":"=v"(r):"v"(a),"v"(b));return r;}
__device__ __forceinline__ float fadd_s(float a,float b){float r;asm("v_add_f32_e32 %0, %1, %2":"=v"(r):"v"(a),"v"(b));return r;}
__device__ __forceinline__ float fsub_s(float a,float b){float r;asm("v_sub_f32_e32 %0, %1, %2":"=v"(r):"v"(a),"v"(b));return r;}
typedef float f32x2_t __attribute__((ext_vector_type(2))); typedef __bf16 bf16x2_t __attribute__((ext_vector_type(2)));
__device__ __forceinline__ unsigned cvtpk_s(float lo,float hi){f32x2_t v={lo,hi};bf16x2_t b=__builtin_convertvector(v,bf16x2_t);return __builtin_bit_cast(unsigned,b);}
#define WAIT_BAR(N) asm volatile("s_waitcnt vmcnt(" #N ") lgkmcnt(0)\n\ts_barrier":::"memory")

__device__ __forceinline__ void qkt(f32x16&p0,f32x16&p1,const char*Kslot,const bf16x8*qr,const f32x16&negm,int r32,int hi){
  const char*kb=Kslot+hi*1024+r32*16;
  #pragma unroll
  for(int d0=0;d0<4;++d0){
    const bf16x8 b0=*reinterpret_cast<const bf16x8*>(kb+d0*2048);
    const bf16x8 b1=*reinterpret_cast<const bf16x8*>(kb+d0*2048+512);
    if(d0==0){p0=__builtin_amdgcn_mfma_f32_32x32x16_bf16(b0,qr[0],negm,0,0,0);p1=__builtin_amdgcn_mfma_f32_32x32x16_bf16(b1,qr[0],negm,0,0,0);}
    else{p0=__builtin_amdgcn_mfma_f32_32x32x16_bf16(b0,qr[d0],p0,0,0,0);p1=__builtin_amdgcn_mfma_f32_32x32x16_bf16(b1,qr[d0],p1,0,0,0);}}
}
typedef __attribute__((address_space(3))) const char* lds_cptr;
typedef short v4i16_t __attribute__((ext_vector_type(4)));
__device__ __forceinline__ void kload8(bf16x8*kf,lds_cptr kp){
  kf[0]=*(const __attribute__((address_space(3))) bf16x8*)(kp);      kf[1]=*(const __attribute__((address_space(3))) bf16x8*)(kp+512);
  kf[2]=*(const __attribute__((address_space(3))) bf16x8*)(kp+2048); kf[3]=*(const __attribute__((address_space(3))) bf16x8*)(kp+2560);
  kf[4]=*(const __attribute__((address_space(3))) bf16x8*)(kp+4096); kf[5]=*(const __attribute__((address_space(3))) bf16x8*)(kp+4608);
  kf[6]=*(const __attribute__((address_space(3))) bf16x8*)(kp+6144); kf[7]=*(const __attribute__((address_space(3))) bf16x8*)(kp+6656);
}
__device__ __forceinline__ void kload2(bf16x8*kf,lds_cptr kp,int j){ kf[2*j]=*(const __attribute__((address_space(3))) bf16x8*)(kp+j*2048); kf[2*j+1]=*(const __attribute__((address_space(3))) bf16x8*)(kp+j*2048+512); }
__device__ __forceinline__ s16x4 vtr(lds_cptr p){ return __builtin_bit_cast(s16x4,__builtin_amdgcn_ds_read_tr16_b64_v4i16((__attribute__((address_space(3))) v4i16_t*)p)); }
__device__ __forceinline__ float rowmax(const f32x16&p0,const f32x16&p1){
  float a=max3f(p0[0],p0[1],p1[0]),b=max3f(p0[2],p0[3],p1[1]);a=max3f(a,p1[2],p1[3]);
  #pragma unroll
  for(int r=4;r<16;r+=4){a=max3f(a,p0[r],p0[r+1]);b=max3f(b,p0[r+2],p0[r+3]);a=max3f(a,p1[r],p1[r+1]);b=max3f(b,p1[r+2],p1[r+3]);}
  const float m=max2f(a,b);
  auto rr=__builtin_amdgcn_permlane32_swap(__float_as_uint(m),__float_as_uint(m),false,false);
  return max2f(__uint_as_float(rr[0]),__uint_as_float(rr[1]));
}
__device__ __forceinline__ void pv(f32x16*o,int vb,bf16x8 pa0,bf16x8 pa1,bf16x8 pa2,bf16x8 pa3){
  #pragma unroll
  for(int d0=0;d0<2;++d0){s16x4 lo[4],hi[4];
    #pragma unroll
    for(int ks=0;ks<4;++ks){
      asm volatile("ds_read_b64_tr_b16 %0,%1 offset:%c2":"=&v"(lo[ks]):"v"(vb),"i"(d0*4096+ks*1024):"memory");
      asm volatile("ds_read_b64_tr_b16 %0,%1 offset:%c2":"=&v"(hi[ks]):"v"(vb),"i"(d0*4096+ks*1024+512):"memory");}
    asm volatile("s_waitcnt lgkmcnt(0)":::"memory");SBAR();
    #define PK(k) (bf16x8){lo[k][0],lo[k][1],lo[k][2],lo[k][3],hi[k][0],hi[k][1],hi[k][2],hi[k][3]}
    o[d0]=__builtin_amdgcn_mfma_f32_32x32x16_bf16(pa0,PK(0),o[d0],0,0,0);
    o[d0]=__builtin_amdgcn_mfma_f32_32x32x16_bf16(pa1,PK(1),o[d0],0,0,0);
    o[d0]=__builtin_amdgcn_mfma_f32_32x32x16_bf16(pa2,PK(2),o[d0],0,0,0);
    o[d0]=__builtin_amdgcn_mfma_f32_32x32x16_bf16(pa3,PK(3),o[d0],0,0,0);
    #undef PK
  }
}

#ifndef ATTN_STORE16
#define ATTN_STORE16(p,v) (*(u32x4*)(p)=(v))
#endif

template<int POS> __device__ __forceinline__ unsigned mbit(int m){int r;asm("v_bfe_i32 %0, %1, %2, 1":"=v"(r):"v"(m),"n"(POS));return (unsigned)r;}
#define AB_M1(P,R,MB) do{ if(!FOXB) P[R]=__uint_as_float(__float_as_uint(P[R])&mbit<8*((R)>>2)+((R)&3)>(MB)); }while(0)
#define AB_MASK16(P,MB) do{AB_M1(P,0,MB);AB_M1(P,1,MB);AB_M1(P,2,MB);AB_M1(P,3,MB);AB_M1(P,4,MB);AB_M1(P,5,MB);AB_M1(P,6,MB);AB_M1(P,7,MB);AB_M1(P,8,MB);AB_M1(P,9,MB);AB_M1(P,10,MB);AB_M1(P,11,MB);AB_M1(P,12,MB);AB_M1(P,13,MB);AB_M1(P,14,MB);AB_M1(P,15,MB);}while(0)
template<int THRL,bool FOXB> __device__ __forceinline__ void attn_unit(int b,int h,int qb,const bf16*Q,const bf16*__restrict__ K,const bf16*__restrict__ V,bf16*O,const unsigned long long*__restrict__ MK,const float*__restrict__ CK,int kt0,char*shm){
  const int tid=ltid(),lane=tid&63,r32=lane&31,hi=lane>>5; const int wid=__builtin_amdgcn_readfirstlane(tid>>6);
  const long rowbase=(long)b*SEQ; const int q0=qb*QB;
  const bf16*Qw=Q+(rowbase+q0+wid*QBLK)*DM+h*D;
  const long tstep=FOXB?(long)KVBLK*DM:4096;
  const bf16*Kh=FOXB?K+(rowbase+(long)kt0*KVBLK)*DM+h*D:K+(long)(b*NHEAD+h)*(SEQ/KVBLK)*4096,*Vh=FOXB?V+(rowbase+(long)kt0*KVBLK)*DM+h*D:V+(long)(b*NHEAD+h)*(SEQ/KVBLK)*4096;
  const unsigned lds0=(unsigned)(uintptr_t)shm;
  float*wsf=(float*)(shm+LDS_WS)+wid*64;
  const bf16*ksrc=FOXB?Kh+(long)lane*DM+wid*8:Kh+(wid*64+lane)*8;
  const bf16*vsrc=FOXB?Vh+(long)(16*(wid&3)+(lane>>2))*DM+(wid>>2)*32+(lane&3)*8:Vh+((wid>>2)*64+16*(wid&3))*32+lane*8;
  const unsigned kdst=lds0+LDS_K+wid*1024, vdst=lds0+LDS_V+wid*1024;
  #define DMA_K(t,slot) glds16(ksrc+(long)(t)*tstep,(unsigned)__builtin_amdgcn_readfirstlane(kdst+(slot)))
  #define DMA_V(t,slot) glds16(vsrc+(long)(t)*tstep,(unsigned)__builtin_amdgcn_readfirstlane(vdst+(slot)))
  const char*Kbase=shm+LDS_K; bf16x8 kf[8];
  const lds_cptr shm3=(lds_cptr)shm; const lds_cptr kp0=shm3+LDS_K+hi*1024+r32*16; const lds_cptr vp0=shm3+LDS_V+((lane>>4)&1)*32+(lane&3)*8+(4*hi+((lane&15)>>2))*64;
  const int NT=(q0+QB)/KVBLK-kt0;
  DMA_K(0,0);DMA_V(0,0);DMA_K(1,SLOTB);
  bf16x8 qr[4];
  #pragma unroll
  for(int d0=0;d0<4;++d0)qr[d0]=*reinterpret_cast<const bf16x8*>(&Qw[(long)r32*DM+d0*16+hi*8]);
  const lds_cptr qp0=shm3+LDS_OST+wid*4096+lane*16;
  #pragma unroll
  for(int d0=0;d0<4;++d0)*(__attribute__((address_space(3))) bf16x8*)(qp0+d0*1024)=qr[d0];
  #define QR(d) (*(const __attribute__((address_space(3))) bf16x8*)(qp0+(d)*1024))
  float mhat=0.f,l_reg=0.f;f32x16 o[2];o[0]=f32x16{};o[1]=f32x16{};f32x16 negm=f32x16{};asm volatile("":"+v"(negm));
  const int qrel=wid*QBLK+r32;
  const unsigned mrow_off=(unsigned)((rowbase+q0+qrel)*(SEQ/64));
  unsigned long long mw_cur=0ull; if(!FOXB) mw_cur=MK[mrow_off];
  float*ckring=(float*)(shm+LDS_BYTES); const unsigned ckoff=(unsigned)((b*NHEAD+h)*SEQ+kt0*KVBLK+lane); float ckreg=0.f;
  if(FOXB&&wid==0){ ckring[lane]=CK[ckoff]; ckring[64+lane]=CK[ckoff+64]; ckreg=CK[ckoff+128]; }
  #define CKBIAS(C0,C1,t) do{ if(FOXB){ const float*cks_=ckring+((t)%3)*64+4*hi; \
      _Pragma("unroll") for(int g_=0;g_<4;++g_){ const f32x4 ca_=*(const f32x4*)(cks_+8*g_), cb_=*(const f32x4*)(cks_+32+8*g_); \
        _Pragma("unroll") for(int j_=0;j_<4;++j_){ C0[4*g_+j_]-=ca_[j_]; C1[4*g_+j_]-=cb_[j_]; } } } }while(0)
  #define CMASK(P0,P1,t) do{int jb_=(t)-(NT-4); if(jb_>=0)cmask(P0,P1,jb_,qrel,hi);}while(0)
  bool resc=false;
  #define START(P0,P1) do{ const float rm=rowmax(P0,P1); resc=false; \
    { const float dl=rm; mhat=fadd_s(mhat,dl); \
      _Pragma("unroll") for(int r=0;r<16;++r){P0[r]=fsub_s(P0[r],dl);P1[r]=fsub_s(P1[r],dl);} \
      _Pragma("unroll") for(int r=0;r<16;++r)negm[r]=-mhat; asm volatile("":"+v"(negm)); } \
    _Pragma("unroll") for(int r=0;r<16;++r)P0[r]=__builtin_amdgcn_exp2f(P0[r]); }while(0)
  #define RESC() do{ if(resc){ asm volatile("s_waitcnt lgkmcnt(0)":::"memory"); \
      _Pragma("unroll") for(int d_=0;d_<2;++d_) _Pragma("unroll") for(int r=0;r<16;++r)o[d_][r]*=wsf[crow(r,hi)]; } }while(0)
  f32x16 pA0,pA1,pB0,pB1;
  int sl_prev=0,sl_cur=0,sl_next=SLOTB;
  #define ROT() do{sl_prev=sl_cur;sl_cur=sl_next;sl_next=(sl_next==(NSLOT-1)*SLOTB)?0:sl_next+SLOTB;}while(0)
  DMA_K(2,2*SLOTB);
  WAIT_BAR(3);
  qkt(pA0,pA1,Kbase,qr,negm,r32,hi);asm volatile("s_nop 15\n\ts_nop 7":"+v"(pA0),"+v"(pA1));CKBIAS(pA0,pA1,0);CMASK(pA0,pA1,0);
  START(pA0,pA1);
  _Pragma("unroll") for(int r=0;r<16;++r)pA1[r]=__builtin_amdgcn_exp2f(pA1[r]);
  WAIT_BAR(0);
  DMA_K(3,0);DMA_V(1,SLOTB);
  ROT();
  kload8(kf,kp0+sl_cur);
  WAIT_BAR(2);
  s16x4 vlo[8],vhi[8]; u32x4 pw0,pw1,pw2,pw3;
  #define PKW(P,B) cvtpk_s(P[B],P[B+1])
  #define PAF(k) __builtin_bit_cast(bf16x8,pw##k)
  #define VFR(i) (bf16x8){vlo[i][0],vlo[i][1],vlo[i][2],vlo[i][3],vhi[i][0],vhi[i][1],vhi[i][2],vhi[i][3]}
  #define PIN(x) asm volatile("":"+v"(x))
  #define MX3(a,b,c) __builtin_fmaxf(__builtin_fmaxf((a),(b)),(c))
  #define GAPA(MK_,MF,A0,A1,A2,A3,W0,W1,PW) do{ MF; MK_; sacc+=A0; sacc+=A1; sacc+=A2; sacc+=A3; PIN(sacc); W0; W1; PIN(PW); SBAR(); }while(0)
  #define MK4(P,R0,R1,R2,R3,MB) do{AB_M1(P,R0,MB);AB_M1(P,R1,MB);AB_M1(P,R2,MB);AB_M1(P,R3,MB);}while(0)
  #define EX(v) __builtin_amdgcn_exp2f(v)
  #define GAPB(MF,X,B) do{ MF; X[B]=EX(X[B]); X[B+1]=EX(X[B+1]); X[B+2]=EX(X[B+2]); X[B+3]=EX(X[B+3]); PIN(X); SBAR(); }while(0)
  #define VRD(i) do{ vlo[i]=vtr(vp_+(((i)>>2)*4096+((i)&3)*1024)); vhi[i]=vtr(vp_+(((i)>>2)*4096+((i)&3)*1024+512)); }while(0)
  #define KRD(G,j) do{ if(G){ kload2(kf,kp0+sl_next,j); SBAR(); } }while(0)
  #define STEP(C0,C1,P0,P1,t,GK,GV,GL) do{ SBAR(); \
    if(FOXB&&wid==0){ ckring[(((t)+1)%3)*64+lane]=ckreg; if((t)+2<NT) ckreg=CK[ckoff+((t)+2)*64]; } \
    const int mb0_=(int)(unsigned)(mw_cur>>(4*hi)), mb1_=(int)(unsigned)(mw_cur>>(32+4*hi)); AB_M1(P0,0,mb0_); AB_M1(P0,1,mb0_); \
    const lds_cptr vp_=vp0+sl_prev; \
    VRD(0); SBAR(); float sacc=(P0[0]+P0[1]); \
    GAPA(MK4(P0,2,3,4,5,mb0_), C0=__builtin_amdgcn_mfma_f32_32x32x16_bf16(kf[0],QR(0),negm,0,0,0), P0[2],P0[3],P0[4],P0[5],     pw0[0]=PKW(P0,0), pw0[1]=PKW(P0,2), pw0); \
    VRD(4); SBAR(); GAPA(MK4(P0,6,7,8,9,mb0_), C1=__builtin_amdgcn_mfma_f32_32x32x16_bf16(kf[1],QR(0),negm,0,0,0), P0[6],P0[7],P0[8],P0[9],     pw0[2]=PKW(P0,4), pw0[3]=PKW(P0,6), pw0); \
    VRD(1); SBAR(); GAPA(MK4(P0,10,11,12,13,mb0_), C0=__builtin_amdgcn_mfma_f32_32x32x16_bf16(kf[2],QR(1),C0,0,0,0),   P0[10],P0[11],P0[12],P0[13], pw1[0]=PKW(P0,8), pw1[1]=PKW(P0,10), pw1); \
    VRD(5); SBAR(); GAPA(do{AB_M1(P0,14,mb0_);AB_M1(P0,15,mb0_);AB_M1(P1,0,mb1_);AB_M1(P1,1,mb1_);}while(0), C1=__builtin_amdgcn_mfma_f32_32x32x16_bf16(kf[3],QR(1),C1,0,0,0),   P0[14],P0[15],P1[0],P1[1],   pw1[2]=PKW(P0,12),pw1[3]=PKW(P0,14), pw1); \
    VRD(2); SBAR(); GAPA(MK4(P1,2,3,4,5,mb1_), C0=__builtin_amdgcn_mfma_f32_32x32x16_bf16(kf[4],QR(2),C0,0,0,0),   P1[2],P1[3],P1[4],P1[5],     pw2[0]=PKW(P1,0), pw2[1]=PKW(P1,2), pw2); \
    VRD(6); SBAR(); GAPA(MK4(P1,6,7,8,9,mb1_), C1=__builtin_amdgcn_mfma_f32_32x32x16_bf16(kf[5],QR(2),C1,0,0,0),   P1[6],P1[7],P1[8],P1[9],     pw2[2]=PKW(P1,4), pw2[3]=PKW(P1,6), pw2); \
    VRD(3); SBAR(); GAPA(MK4(P1,10,11,12,13,mb1_), C0=__builtin_amdgcn_mfma_f32_32x32x16_bf16(kf[6],QR(3),C0,0,0,0),   P1[10],P1[11],P1[12],P1[13], pw3[0]=PKW(P1,8), pw3[1]=PKW(P1,10), pw3); \
    VRD(7); SBAR(); GAPA(do{AB_M1(P1,14,mb1_);AB_M1(P1,15,mb1_);}while(0), C1=__builtin_amdgcn_mfma_f32_32x32x16_bf16(kf[7],QR(3),C1,0,0,0),   P1[14],P1[15],0.f,0.f,       pw3[2]=PKW(P1,12),pw3[3]=PKW(P1,14), pw3); \
    l_reg+=sacc; if(!FOXB) mw_cur=MK[mrow_off+(t)]; \
    if(GK){DMA_K((t)+3,sl_cur);} if(GV){DMA_V((t)+1,sl_next);} \
    CKBIAS(C0,C1,t); CMASK(C0,C1,t); \
    { float a=MX3(C0[0],C0[1],C1[0]),b=MX3(C0[2],C0[3],C1[1]); a=MX3(a,C1[2],C1[3]); \
      _Pragma("unroll") for(int r=4;r<16;r+=4){a=MX3(a,C0[r],C0[r+1]);b=MX3(b,C0[r+2],C0[r+3]);a=MX3(a,C1[r],C1[r+1]);b=MX3(b,C1[r+2],C1[r+3]);} \
      float rm=__builtin_fmaxf(a,b); { auto rr=__builtin_amdgcn_permlane32_swap(__float_as_uint(rm),__float_as_uint(rm),false,false); rm=__builtin_fmaxf(__uint_as_float(rr[0]),__uint_as_float(rr[1])); } \
      resc=false; \
      if(__builtin_expect(__any(rm>(float)THRL),0)){ const float dl=__builtin_fmaxf(rm,0.f); mhat+=dl; \
        _Pragma("unroll") for(int r=0;r<16;++r){C0[r]-=dl;C1[r]-=dl;} \
        _Pragma("unroll") for(int r=0;r<16;++r)negm[r]=-mhat; asm volatile("":"+v"(negm)); \
        const float f=__builtin_amdgcn_exp2f(-dl); l_reg*=f; { int ri_=r32; asm volatile("":"+v"(ri_)); if(hi==0)wsf[ri_]=f; } resc=true; } } \
    SBAR(); \
    GAPB(o[0]=__builtin_amdgcn_mfma_f32_32x32x16_bf16(PAF(0),VFR(0),o[0],0,0,0), C0,0); \
    GAPB(o[1]=__builtin_amdgcn_mfma_f32_32x32x16_bf16(PAF(0),VFR(4),o[1],0,0,0), C0,4); \
    KRD(GL,0); GAPB(o[0]=__builtin_amdgcn_mfma_f32_32x32x16_bf16(PAF(1),VFR(1),o[0],0,0,0), C0,8); \
    KRD(GL,1); GAPB(o[1]=__builtin_amdgcn_mfma_f32_32x32x16_bf16(PAF(1),VFR(5),o[1],0,0,0), C0,12); \
    KRD(GL,2); GAPB(o[0]=__builtin_amdgcn_mfma_f32_32x32x16_bf16(PAF(2),VFR(2),o[0],0,0,0), C1,0); \
    KRD(GL,3); GAPB(o[1]=__builtin_amdgcn_mfma_f32_32x32x16_bf16(PAF(2),VFR(6),o[1],0,0,0), C1,4); \
    GAPB(o[0]=__builtin_amdgcn_mfma_f32_32x32x16_bf16(PAF(3),VFR(3),o[0],0,0,0), C1,8); \
    GAPB(o[1]=__builtin_amdgcn_mfma_f32_32x32x16_bf16(PAF(3),VFR(7),o[1],0,0,0), C1,12); \
    }while(0)
  int t=1;
  #undef CMASK
  #define CMASK(P0,P1,t) do{}while(0)
  for(;t+5<NT;t+=2){
    STEP(pB0,pB1,pA0,pA1,t,true,true,true);     WAIT_BAR(2); RESC(); ROT();
    STEP(pA0,pA1,pB0,pB1,t+1,true,true,true);   WAIT_BAR(2); RESC(); ROT();
  }
  #undef CMASK
  #define CMASK(P0,P1,t) do{int jb_=(t)-(NT-4); if(jb_>=0)cmask(P0,P1,jb_,qrel,hi);}while(0)
  #define ENDW(tt) do{ if((tt)+3<NT){WAIT_BAR(2);} else if((tt)+2<NT){WAIT_BAR(1);} else {WAIT_BAR(0);} }while(0)
  for(;t+1<NT;t+=2){
    STEP(pB0,pB1,pA0,pA1,t,(t+3<NT),(t+1<NT),(t+1<NT));       ENDW(t);   RESC(); ROT();
    STEP(pA0,pA1,pB0,pB1,t+1,(t+4<NT),(t+2<NT),(t+2<NT));     ENDW(t+1); RESC(); ROT();
  }
  STEP(pB0,pB1,pA0,pA1,NT-1,false,false,false); RESC();
  { const int mb0_=(int)(unsigned)(mw_cur>>(4*hi)), mb1_=(int)(unsigned)(mw_cur>>(32+4*hi)); AB_MASK16(pB0,mb0_); AB_MASK16(pB1,mb1_); }
  { float sacc=pB0[0]+pB0[1]; _Pragma("unroll") for(int r=2;r<16;++r)sacc+=pB0[r]; _Pragma("unroll") for(int r=0;r<16;++r)sacc+=pB1[r]; l_reg+=sacc;
    pw0=(u32x4){PKW(pB0,0),PKW(pB0,2),PKW(pB0,4),PKW(pB0,6)};pw1=(u32x4){PKW(pB0,8),PKW(pB0,10),PKW(pB0,12),PKW(pB0,14)};pw2=(u32x4){PKW(pB1,0),PKW(pB1,2),PKW(pB1,4),PKW(pB1,6)};pw3=(u32x4){PKW(pB1,8),PKW(pB1,10),PKW(pB1,12),PKW(pB1,14)};
    SBAR(); { int ln_=lane; asm volatile("":"+v"(ln_)); const int vb0=(int)(lds0+LDS_V)+((ln_>>4)&1)*32+(ln_&3)*8+(4*(ln_>>5)+((ln_&15)>>2))*64;
      pv(o,vb0+sl_cur,PAF(0),PAF(1),PAF(2),PAF(3)); } }
  #undef PKW
  #undef PAF
  #undef VFR
  #undef PIN
  #undef MX3
  #undef GAPA
  #undef MK4
  #undef GAPB
  #undef EX
  #undef VRD
  #undef KRD
  #undef STEP
  #undef ENDW
  {auto rr=__builtin_amdgcn_permlane32_swap(__float_as_uint(l_reg),__float_as_uint(l_reg),false,false);l_reg=__uint_as_float(rr[0])+__uint_as_float(rr[1]);}
  if(hi==0)wsf[32+r32]=l_reg;asm volatile("s_waitcnt lgkmcnt(0)":::"memory");
  float rli[16];
  #pragma unroll
  for(int r=0;r<16;++r)rli[r]=__builtin_amdgcn_rcpf(wsf[32+crow(r,hi)]);
  { bf16*stg=(bf16*)(shm+LDS_OST)+wid*2048;
    #pragma unroll
    for(int r=0;r<16;++r){const int orow=crow(r,hi);
      #pragma unroll
      for(int d0=0;d0<2;++d0)stg[orow*64+d0*32+r32]=__float2bfloat16(o[d0][r]*rli[r]);}
    asm volatile("s_waitcnt lgkmcnt(0)":::"memory");
    #pragma unroll
    for(int i=0;i<4;++i){const int row=i*8+(lane>>3),ch=lane&7; const u32x4 v=*(const u32x4*)(stg+row*64+ch*8); const int trow=q0+wid*QBLK+row;
      if(trow>=16&&trow<8208) ATTN_STORE16(O+((long)b*8192+(trow-16))*DM+h*D+ch*8,v);} }
  asm volatile("s_waitcnt lgkmcnt(0)\n\ts_barrier":::"memory");
  #undef DMA_K
  #undef DMA_V
  #undef CMASK
  #undef START
  #undef RESC
  #undef ROT
  #undef CKBIAS
  #undef QR
}
constexpr int ATTN_LDS_BYTES=LDS_BYTES;
#undef SBAR
#undef WAIT_BAR
}

__device__ __forceinline__ unsigned ordkey16(float s) {
    const _Float16 hf = (_Float16)(s + 0.0f);
    const unsigned bits = (unsigned)__builtin_bit_cast(unsigned short, hf);
    return (bits & 0x8000u) ? (~bits & 0xffffu) : (bits | 0x8000u);
}
template <int CTRL, int ROWMASK> __device__ __forceinline__ int dppi(int v) { return __builtin_amdgcn_update_dpp(0, v, CTRL, ROWMASK, 0xf, true); }
__device__ __forceinline__ int wave_incl_scan(int v) {
    v += dppi<0x111, 0xf>(v);
    v += dppi<0x112, 0xf>(v);
    v += dppi<0x114, 0xf>(v);
    v += dppi<0x118, 0xf>(v);
    v += dppi<0x142, 0xa>(v);
    v += dppi<0x143, 0xc>(v);
    return v;
}
__device__ __forceinline__ void hist_find(const unsigned* hist, int need, int lane, int& bin, int& above) {
    const uint4 c4 = *(const uint4*)(hist + 252 - 4 * lane);
    const int c0 = (int)c4.w, c1 = (int)c4.z, c2 = (int)c4.y, c3 = (int)c4.x;
    const int tot = c0 + c1 + c2 + c3;
    const int incl = wave_incl_scan(tot);
    const unsigned long long bal = __ballot(incl >= need);
    const int L = bal ? (int)__builtin_ctzll(bal) : 63;
    int mybin, myabove;
    {
        int cum = incl - tot;
        if (cum + c0 >= need) { mybin = 255 - 4 * lane; myabove = cum; }
        else { cum += c0;
            if (cum + c1 >= need) { mybin = 254 - 4 * lane; myabove = cum; }
            else { cum += c1;
                if (cum + c2 >= need) { mybin = 253 - 4 * lane; myabove = cum; }
                else { cum += c2; mybin = 252 - 4 * lane; myabove = cum; } } }
    }
    bin = __builtin_amdgcn_readlane(mybin, L); above = __builtin_amdgcn_readlane(myabove, L);
}
__device__ __forceinline__ unsigned fixkey16(float s) {
    const int v = (int)(__float_as_uint(fmaf(s, 2048.0f, 12582912.0f + 32768.0f)) - 0x4B400000u);
    return (unsigned)min(max(v, 1), 65535);
}
__device__ void indexer_item(unsigned char* ws, int b, int qg, unsigned char* smem) {
    const bf16_t* QI = (const bf16_t*)(ws + OFF_QI);
    const bf16_t* KI = (const bf16_t*)(ws + OFF_KI);
    const float* WI = (const float*)(ws + OFF_WI);
    unsigned long long* mask = (unsigned long long*)(ws + OFF_MASK);
    unsigned short* sc = (unsigned short*)smem;
    unsigned* hist_all = (unsigned*)(smem + 8 * SCP * 2);
    const int tid = ltid(), lane = tid & 63, wave = __builtin_amdgcn_readfirstlane(tid >> 6);
    const int t0 = qg * 8;
    const int g = lane >> 4, kc = lane & 15;
    for (int i = tid * 4; i < 8 * HP; i += NTHREADS * 4) *(uint4*)(hist_all + i) = zero4u();
    bf16x8 af[4][2];
#pragma unroll
    for (int mi = 0; mi < 4; ++mi) {
        const int q = (mi >> 1) * 4 + (kc >> 2), hh = (mi & 1) * 4 + (kc & 3);
#pragma unroll
        for (int ks = 0; ks < 2; ++ks) af[mi][ks] = *(const bf16x8*)(QI + ((size_t)b * TP + t0 + q) * 512 + hh * 64 + ks * 32 + g * 8);
    }
    float wq[2][8];
#pragma unroll
    for (int a = 0; a < 2; ++a)
#pragma unroll
        for (int hh = 0; hh < 8; ++hh) wq[a][hh] = WI[((size_t)b * TP + t0 + a * 4 + g) * 8 + hh];
    __syncthreads();
    const int ntile = (t0 + 8 + 15) >> 4;
    const bf16_t* kbase = KI + ((size_t)b * (TP / 16) * 2 * 64 + lane) * 8;
    for (int rep_ = 0; rep_ < IDX_REP_MFMA; ++rep_) {
    constexpr int U = 4;
    const f32x4 z4 = zero4();
    const int nfull = (t0 >= 15) ? ((t0 - 15) >> 4) + 1 : 0;
    unsigned short* scw0 = sc + g * SCP + kc;
    unsigned* hw0 = hist_all + g * HP;
    bf16x8 c0[U], c1[U];
#pragma unroll
    for (int u = 0; u < U; ++u) { const int kt = wave + 8 * u; if (kt < ntile) { const bf16_t* kr = kbase + (size_t)kt * 1024; c0[u] = *(const bf16x8*)kr; c1[u] = *(const bf16x8*)(kr + 512); } }
    for (int base = wave; base < ntile; base += 8 * U) {
        bf16x8 n0[U], n1[U];
#pragma unroll
        for (int u = 0; u < U; ++u) { const int kt = base + 8 * (U + u); n0[u] = c0[u]; n1[u] = c1[u]; if (kt < ntile && !(IDX_PROBE == 3 && rep_ > 0)) { const bf16_t* kr = kbase + (size_t)kt * 1024; n0[u] = *(const bf16x8*)kr; n1[u] = *(const bf16x8*)(kr + 512); } }
#pragma unroll
        for (int u = 0; u < U; ++u) {
            const int kt = base + 8 * u;
            if (kt < ntile) {
                f32x4 acc[4];
#pragma unroll
                for (int mi = 0; mi < 4; ++mi) {
                    acc[mi] = __builtin_amdgcn_mfma_f32_16x16x32_bf16(af[mi][0], c0[u], z4, 0, 0, 0);
                    acc[mi] = __builtin_amdgcn_mfma_f32_16x16x32_bf16(af[mi][1], c1[u], acc[mi], 0, 0, 0);
                }
                float s0 = 0.f, s1 = 0.f;
#pragma unroll
                for (int c = 0; c < 2; ++c)
#pragma unroll
                    for (int j = 0; j < 4; ++j) {
                        s0 = fmaf(wq[0][c * 4 + j], __builtin_amdgcn_fmed3f(acc[c][j], 0.f, 3.0e38f), s0);
                        s1 = fmaf(wq[1][c * 4 + j], __builtin_amdgcn_fmed3f(acc[2 + c][j], 0.f, 3.0e38f), s1);
                    }
                unsigned k0 = fixkey16(s0), k1 = fixkey16(s1);
                if ((IDX_PROBE == 1 || IDX_PROBE == 3) && rep_ > 0) { asm volatile("" :: "v"(k0), "v"(k1)); }
                else if (kt < nfull) {
                    scw0[kt * 16] = (unsigned short)k0; scw0[4 * SCP + kt * 16] = (unsigned short)k1;
                    if (rep_ == 0) { atomicAdd(&hw0[k0 >> 8], 1u); atomicAdd(&hw0[4 * HP + (k1 >> 8)], 1u); }
                } else {
                    const int key = kt * 16 + kc;
                    const bool ok0 = key <= t0 + g, ok1 = key <= t0 + 4 + g;
                    k0 = ok0 ? k0 : 0u; k1 = ok1 ? k1 : 0u;
                    scw0[kt * 16] = (unsigned short)k0; scw0[4 * SCP + kt * 16] = (unsigned short)k1;
                    if (rep_ == 0) { if (ok0) atomicAdd(&hw0[k0 >> 8], 1u); if (ok1) atomicAdd(&hw0[4 * HP + (k1 >> 8)], 1u); }
                }
            }
        }
#pragma unroll
        for (int u = 0; u < U; ++u) { c0[u] = n0[u]; c1[u] = n1[u]; }
    }
    }
    __syncthreads();
    for (int rep2_ = 0; rep2_ < IDX_REP_SEL; ++rep2_)
    {
        const int t = t0 + wave;
        const int n = t + 1;
        const unsigned short* row = sc + wave * SCP;
        unsigned* hist = hist_all + wave * HP;
        unsigned char* mrow = (unsigned char*)(mask + ((size_t)b * TP + t) * MW);
        const int nbytes = ((t >> 8) + 1) * 32;
        const int nit3 = (nbytes + 63) >> 6;
        unsigned Tkey = 0u; int rem = 0;
        if (n > 256) {
            const int nit = (n + 511) >> 9;
            int B1, above1;
            hist_find(hist, 256, lane, B1, above1);
            const int need2 = 256 - above1;
            __threadfence_block();
            *(uint4*)(hist + lane * 4) = zero4u();
            __threadfence_block();
            for (int it = 0; it < nit; ++it) {
                const int e0 = (it * 64 + lane) * 8;
                const uint4 v = *(const uint4*)(row + e0);
                const unsigned ww[4] = {v.x, v.y, v.z, v.w};
#pragma unroll
                for (int e = 0; e < 8; ++e) {
                    const unsigned k = (ww[e >> 1] >> ((e & 1) * 16)) & 0xffffu;
                    if (e0 + e < n && (int)(k >> 8) == B1) atomicAdd(&hist[k & 255u], 1u);
                }
            }
            __threadfence_block();
            int B2, above2;
            hist_find(hist, need2, lane, B2, above2);
            Tkey = ((unsigned)B1 << 8) | (unsigned)B2;
            rem = 256 - above1 - above2;
        }
        for (int it = 0; it < nit3; ++it) {
            const int e0 = (it * 64 + lane) * 8;
            const uint4 v = *(const uint4*)(row + e0);
            const unsigned ww[4] = {v.x, v.y, v.z, v.w};
            unsigned gtb = 0u, eqb = 0u;
#pragma unroll
            for (int e = 0; e < 8; ++e) {
                const unsigned k = (ww[e >> 1] >> ((e & 1) * 16)) & 0xffffu;
                const bool valid = (e0 + e) < n;
                gtb |= (valid && k > Tkey) ? (1u << e) : 0u;
                eqb |= (valid && k == Tkey) ? (1u << e) : 0u;
            }
            if (__ballot(eqb != 0u) != 0ull) {
                const int c = __popc(eqb);
                int incl = c;
#pragma unroll
                for (int d = 1; d < 64; d <<= 1) { const int vv = __shfl_up(incl, d); if (lane >= d) incl += vv; }
                int r = incl - c;
                unsigned tk = 0u;
#pragma unroll
                for (int e = 0; e < 8; ++e) if ((eqb >> e) & 1u) { if (r < rem) tk |= (1u << e); ++r; }
                rem -= __shfl(incl, 63) < rem ? __shfl(incl, 63) : rem;
                gtb |= tk;
            }
            const int bi = it * 64 + lane;
            if (bi < nbytes) mrow[bi] = (unsigned char)gtb;
        }
    }
    __syncthreads();
}

__device__ int fox_prune(unsigned char* ws, int b, int h, int qb, unsigned char* smem) {
    const int tid = ltid(), lane = tid & 63, wave = __builtin_amdgcn_readfirstlane(tid >> 6), hlf = lane >> 5;
    const bf16_t* Q = (const bf16_t*)(ws + OFF_QF);
    const float* cumt = (const float*)(ws + OFF_CUMT) + (size_t)(b * 8 + h) * TP;
    const float* knorm = (const float*)(ws + OFF_KNORM) + (size_t)(b * 8 + h) * MW;
    float* red = (float*)(smem + 90112);
    const size_t grow = (size_t)b * TP + qb * 256 + wave * 32 + (lane & 31);
    float qq = 0.f;
#pragma unroll
    for (int ks = 0; ks < 4; ++ks) {
        const bf16x8 qv = *(const bf16x8*)(Q + grow * 512 + h * 64 + ks * 16 + hlf * 8);
#pragma unroll
        for (int e = 0; e < 8; ++e) { const float v = bf2f((unsigned)(unsigned short)qv[e]); qq = fmaf(v, v, qq); }
    }
    qq += __shfl_xor(qq, 32);
#pragma unroll
    for (int o = 1; o < 32; o <<= 1) qq = fmaxf(qq, __shfl_xor(qq, o));
    if (lane == 0) red[wave] = qq;
    __syncthreads();
    if (wave == 0) {
        float qm = red[0];
#pragma unroll
        for (int w = 1; w < 8; ++w) qm = fmaxf(qm, red[w]);
        const float Qn = sqrtf(qm) * 1.0001f;
        const float Kd = fmaxf(fmaxf(knorm[qb * 4], knorm[qb * 4 + 1]), fmaxf(knorm[qb * 4 + 2], knorm[qb * 4 + 3])) * 1.0001f;
        const float cfirst = cumt[qb * 256];
        bool keep0 = true, keep1 = true;
        if (lane < qb * 4) { const float bnd = Qn * (knorm[lane] * 1.0001f + Kd) + cfirst - cumt[lane * 64 + 63]; keep0 = !(bnd < -40.0f); }
        if (lane + 64 < qb * 4) { const float bnd = Qn * (knorm[lane + 64] * 1.0001f + Kd) + cfirst - cumt[(lane + 64) * 64 + 63]; keep1 = !(bnd < -40.0f); }
        const unsigned long long b0 = __ballot(keep0), b1 = __ballot(keep1);
        const int first = b0 ? (int)__builtin_ctzll(b0) : (b1 ? 64 + (int)__builtin_ctzll(b1) : 128);
        if (lane == 0) ((int*)red)[8] = (first < qb * 4 ? first : qb * 4) & ~1;
    }
    __syncthreads();
    return ((const int*)red)[8];
}

#define LAS __attribute__((address_space(3)))
#define XB_TMO      128
#define XB_XCNT(j)  (256  + 64 * (j))
#define XB_XSUB(j)  (1280 + 64 * (j))
#define XB_XGEN(j)  (2304 + 64 * (j))
#define XB_TOP      3328
#define XB_TOPGEN   3392
#define XCD_BAR_WORDS 3456
#define XB_SPIN_CAP (1u << 18)
__device__ __forceinline__ unsigned xb_ld(unsigned* p)              { return __hip_atomic_load(p, __ATOMIC_RELAXED, __HIP_MEMORY_SCOPE_AGENT); }
__device__ __forceinline__ unsigned xb_add(unsigned* p, unsigned v) { return __hip_atomic_fetch_add(p, v, __ATOMIC_RELAXED, __HIP_MEMORY_SCOPE_AGENT); }
__device__ __forceinline__ unsigned xb_xcc_id() { return (unsigned)__builtin_amdgcn_s_getreg((3 << 11) | 20) & 0xFu; }
#define XB_SPIN(cond, bar) do { unsigned _sp = 0; while (cond) { __builtin_amdgcn_s_sleep(1); \
    if ((++_sp & 255u) == 0u) { if (xb_ld(&(bar)[XB_TMO])) break; if (_sp > XB_SPIN_CAP) { atomicAdd(&(bar)[XB_TMO], 1u); break; } } } } while (0)
struct XcdBarrier { unsigned* bar; unsigned x; volatile LAS unsigned* st; };
__device__ __forceinline__ XcdBarrier xcd_barrier_post(unsigned* bar, volatile LAS unsigned* st) {
    XcdBarrier b; b.bar = bar; b.x = xb_xcc_id(); b.st = st;
    if (threadIdx.x == 0) (void)xb_add(&bar[XB_XCNT(b.x)], 1u);
    return b;
}
__device__ __forceinline__ void xcd_barrier_complete(unsigned* bar, unsigned x, unsigned& nloc, unsigned& nx) {
    const unsigned G = gridDim.x * gridDim.y * gridDim.z;
    unsigned sum, cnt, mine, sp = 0u;
    for (;;) {
        sum = 0u; cnt = 0u; mine = 0u;
#pragma unroll
        for (unsigned j = 0; j < 16; ++j) { const unsigned c = xb_ld(&bar[XB_XCNT(j)]); sum += c; cnt += (c > 0u) ? 1u : 0u; mine = (j == x) ? c : mine; }
        if (sum == G) break;
        __builtin_amdgcn_s_sleep(1);
        if ((++sp & 255u) == 0u) { if (xb_ld(&bar[XB_TMO])) break; if (sp > XB_SPIN_CAP) { atomicAdd(&bar[XB_TMO], 1u); break; } }
    }
    nloc = mine > 0u ? mine : 1u; nx = cnt > 0u ? cnt : 1u;
}
__device__ __forceinline__ void xcd_barrier(const XcdBarrier& b) {
    asm volatile("s_waitcnt vmcnt(0)" ::: "memory");
    __syncthreads();
    if (threadIdx.x == 0) {
        unsigned* bar = b.bar;
        __builtin_amdgcn_s_waitcnt(0);
        unsigned nloc = b.st[0], nx = b.st[1];
        if (nloc == 0u) { xcd_barrier_complete(bar, b.x, nloc, nx); b.st[0] = nloc; b.st[1] = nx; }
        const unsigned old = xb_add(&bar[XB_XSUB(b.x)], 1u);
        const unsigned gen = old / nloc;
        if (old + 1u == (gen + 1u) * nloc) {
            __builtin_amdgcn_fence(__ATOMIC_RELEASE, "agent");
            asm volatile("s_waitcnt vmcnt(0)" ::: "memory");
            const unsigned og = xb_add(&bar[XB_TOP], 1u);
            const unsigned tg = og / nx;
            if (og + 1u == (tg + 1u) * nx) xb_add(&bar[XB_TOPGEN], 1u);
            else XB_SPIN(xb_ld(&bar[XB_TOPGEN]) == tg, bar);
            __builtin_amdgcn_fence(__ATOMIC_ACQUIRE, "agent");
            xb_add(&bar[XB_XGEN(b.x)], 1u);
            asm volatile("s_waitcnt vmcnt(0)" ::: "memory");
        } else {
            XB_SPIN(xb_ld(&bar[XB_XGEN(b.x)]) == gen, bar);
            __builtin_amdgcn_fence(__ATOMIC_ACQUIRE, "agent");
            asm volatile("s_waitcnt vmcnt(0)" ::: "memory");
        }
    }
    __syncthreads();
}

__global__ void __launch_bounds__(NTHREADS, 2) mega(Params p) {
    __shared__ __attribute__((aligned(16))) unsigned char smem[LDS_BYTES];
    volatile LAS unsigned* bst = (volatile LAS unsigned*)(smem + LDS_BYTES - 64);
    if (threadIdx.x < 2) bst[threadIdx.x] = 0u;
    __syncthreads();
    (void)xcd_barrier_post((unsigned*)(p.ws + OFF_CTL) + CW_BAR, bst);

#pragma unroll 1
    for (int step = p.ph_lo; step < p.ph_hi; ++step) {
        if (step > p.ph_lo && !(FUSE89 && REPEAT_PH < 0 && step == 9)) {
            KParams kpb = (KParams)__builtin_amdgcn_kernarg_segment_ptr(); asm volatile("" : "+s"(kpb));
            XcdBarrier gb; gb.bar = (unsigned*)(kpb->ws + OFF_CTL) + CW_BAR; gb.x = xb_xcc_id(); gb.st = (volatile LAS unsigned*)(smem + LDS_BYTES - 64);
            xcd_barrier(gb);
        }
        if (TIME_PH >= 0 && TIME_PH < 100 && blockIdx.x == 0 && threadIdx.x == 0 && (step == TIME_PH || step == TIME_PH + 1)) {
            const unsigned long long tt = wall_clock64(); volatile LAS unsigned* ts = (volatile LAS unsigned*)(smem + LDS_BYTES - 64) + (step == TIME_PH ? 4 : 6);
            ts[0] = (unsigned)tt; ts[1] = (unsigned)(tt >> 32);
        }
        const int ph = (REPEAT_PH >= 0 && step > REPEAT_PH) ? step - 1 : step;
        KParams kp = (KParams)__builtin_amdgcn_kernarg_segment_ptr(); asm volatile("" : "+s"(kp));
        unsigned char* ws = kp->ws;
        const int G = gridDim.x, bid = blockIdx.x;
        unsigned* ctl = (unsigned*)(ws + OFF_CTL);
        const float* rope = (const float*)(ws + OFF_ROPE);
        float* stat0 = (float*)(ws + OFF_STAT0);
        const float* x = kp->in[0];
        if (PH(0) && ph == 0) {
            const int tid = ltid(), lane = tid & 63, wave = __builtin_amdgcn_readfirstlane(tid >> 6); (void)lane; (void)wave;
            {
                bf16_t* HB = (bf16_t*)(ws + OFF_HB); bf16_t* HBM = (bf16_t*)(ws + OFF_HBM);
                const float* g0 = kp->in[2]; const float* b0 = kp->in[3];
                auto ln_rows = [&](const float* src0, bf16_t* dst0, int i0, int stride, int lim, bool meta) {
                    f32x4 v[4][4];
#pragma unroll
                    for (int k = 0; k < 4; ++k) {
                        const int i = (i0 + k * stride < lim) ? i0 + k * stride : i0;
#pragma unroll
                        for (int j = 0; j < 4; ++j) v[k][j] = *(const f32x4*)(src0 + (size_t)i * 1024 + lane * 4 + 256 * j);
                    }
#pragma unroll
                    for (int k = 0; k < 4; ++k) {
                        const int i = (i0 + k * stride < lim) ? i0 + k * stride : i0;
                        float s = 0.f;
#pragma unroll
                        for (int j = 0; j < 4; ++j) s += (v[k][j][0] + v[k][j][1]) + (v[k][j][2] + v[k][j][3]);
                        const float mu = wave_sum(s) * (1.0f / 1024.0f);
                        float q = 0.f;
#pragma unroll
                        for (int j = 0; j < 4; ++j) { const f32x4 d = v[k][j] - mu; q += (d[0] * d[0] + d[1] * d[1]) + (d[2] * d[2] + d[3] * d[3]); }
                        const float rstd = rsqrtf(wave_sum(q) * (1.0f / 1024.0f) + LN_EPS);
#pragma unroll
                        for (int j = 0; j < 4; ++j) {
                            const f32x4 gg = *(const f32x4*)(g0 + lane * 4 + 256 * j), bb = *(const f32x4*)(b0 + lane * 4 + 256 * j);
                            store4bf(dst0 + (size_t)i * 1024 + lane * 4 + 256 * j, (v[k][j] - mu) * rstd * gg + bb);
                        }
                        if (lane == 0 && !meta) { const int r = (i / SEQ) * TP + NMETA + i % SEQ; stat0[2 * r] = mu; stat0[2 * r + 1] = rstd; }
                    }
                };
                for (int i0 = bid * 8 + wave; i0 < NTOK; i0 += G * 8 * 4) ln_rows(x, HB, i0, G * 8, NTOK, false);
                if (bid * 8 + wave < NMETA / 4) ln_rows(kp->in[1], HBM, bid * 8 + wave, NMETA / 4, NMETA, true);
            }
            {
                float* ropew = (float*)(ws + OFF_ROPE);
                for (int i = bid * NTHREADS + tid; i < TP * 8; i += G * NTHREADS) {
                    const int t = i >> 3, k = i & 7;
                    const float invf[8] = {1.0f, 0.1939227432012558f, 0.03760603070259094f, 0.007292664609849453f, 0.0014142135623842478f,
                                           0.00027424818836152554f, 5.3182957344688475e-05f, 1.0313385246263351e-05f};
                    float iv = invf[0];
#pragma unroll
                    for (int kk = 1; kk < 8; ++kk) iv = (k == kk) ? invf[kk] : iv;
                    const float ang = (float)t * iv;
                    ropew[2 * i] = cosf(ang); ropew[2 * i + 1] = sinf(ang);
                }
            }
            {
                bf16_t* wrt = (bf16_t*)(ws + OFF_WRT);
                const float* wrg = kp->in[13]; const float* wre = kp->in[15];
                for (int i = bid * NTHREADS + tid; i < 48 * 1024; i += G * NTHREADS) {
                    const int e = i >> 10, k = i & 1023;
                    const float w = (e < 4) ? wrg[k * 4 + e] : ((e < 36) ? wre[k * 32 + (e - 4)] : 0.f);
                    const unsigned hi = f2bf(w);
                    wrt[i] = (bf16_t)hi; wrt[48 * 1024 + i] = (bf16_t)f2bf(w - bf2f(hi));
                }
            }
            {
                KParams kq = kp;
                unsigned char* wsq = ws;
                constexpr int N_WIN = 16 * 80, N_KV = 4 * 16, N_A = 8 * 16, N_F = 8 * 16, N_O = 16 * 16;
                constexpr int NT = N_WIN + N_KV + N_A + N_F + N_O;
                auto dec = [kq, wsq](int it) -> XTile {
                    XTile x; x.kscale = nullptr; x.winmap = 0; x.s16 = 16;
                    int i = it;
                    if (i < N_WIN) { x.src = kq->in[4]; x.src_ld = 4944; x.dst = (bf16_t*)(wsq + OFF_WIN); x.dst_ld = 1024; x.k0 = (i % 16) * 64; x.j0 = (i / 16) * 64; x.winmap = 1; }
                    else if ((i -= N_WIN) < N_KV) { x.src = kq->in[7]; x.src_ld = 1024; x.dst = (bf16_t*)(wsq + OFF_WKV); x.dst_ld = 256; x.k0 = (i % 4) * 64; x.j0 = (i / 4) * 64; x.kscale = kq->in[6]; }
                    else if ((i -= N_KV) < N_A) { x.src = kq->in[8]; x.src_ld = 1024; x.dst = (bf16_t*)(wsq + OFF_WA); x.dst_ld = 512; x.k0 = (i % 8) * 64; x.j0 = (i / 8) * 64; }
                    else if ((i -= N_A) < N_F) { x.src = kq->in[9]; x.src_ld = 1024; x.dst = (bf16_t*)(wsq + OFF_WF); x.dst_ld = 512; x.k0 = (i % 8) * 64; x.j0 = (i / 8) * 64; }
                    else { i -= N_F; x.src = kq->in[10]; x.src_ld = 1024; x.dst = (bf16_t*)(wsq + OFF_WO); x.dst_ld = 1024; x.k0 = (i % 16) * 64; x.j0 = (i / 16) * 64; }
                    x.rb = x.j0;
                    return x;
                };
                xpose_many(NT, G, bid, dec, (float*)smem);
            }
        }
        if ((PH(1) && ph == 1) || (PH(2) && ph == 2) || (PH(5) && ph == 5) || (PH(6) && ph == 6) || (PH(9) && ph == 9)) {
            {
            }
            float* rs = (float*)(smem + pg8::STAGE_BYTES);
            int* tag = (int*)(smem + pg8::STAGE_BYTES + 2048);
            if (ph == 2) TS_BEGIN(1);
            if (ph == 2) {
                const int tid = ltid();
                const bf16_t* CKV = (const bf16_t*)(ws + OFF_CKV);
                pg8::StaticOrder S; S.init(NTOK, 1024, G, bid);
                pg8::Unit u;
                for (int i = 0; i < 2; ++i) {
                    if (!S.next(i, u)) { if (tid == 0) tag[i] = -1; continue; }
                    if (tid == 0) tag[i] = u.pm;
                    const bf16_t* rp = CKV + (size_t)(u.pm * 256 + (tid >> 1)) * 256 + (tid & 1) * 128;
                    float ss = 0.f;
#pragma unroll
                    for (int c = 0; c < 16; ++c) {
                        const uint4 uu = *(const uint4*)(rp + c * 8);
                        const unsigned ww[4] = {uu.x, uu.y, uu.z, uu.w};
#pragma unroll
                        for (int e = 0; e < 4; ++e) { const float a0 = bf2f(ww[e] & 0xffffu), a1 = bf2f(ww[e] >> 16); ss = fmaf(a0, a0, fmaf(a1, a1, ss)); }
                    }
                    ss += __shfl_xor(ss, 1);
                    if ((tid & 1) == 0) rs[i * 256 + (tid >> 1)] = rsqrtf(ss * (1.0f / 256.0f) + RMS_EPS);
                }
                __syncthreads();
            }
            if (ph == 9) {
                const int tid = ltid();
                if (tid < 32) tag[tid] = (int)ctl[CW_ECNT + tid * ECS];
                __syncthreads();
                if (tid == 0) { int cp = 0, rb = 0; for (int e = 0; e < 32; ++e) { tag[32 + e] = cp; tag[64 + e] = rb; const int nc = (tag[e] + 255) >> 8; cp += nc; rb += nc * 256; } tag[96] = cp; }
                __syncthreads();
            }
            const int njobs = (ph == 5) ? 2 : 1;
#pragma unroll 1
            for (int job = 0; job < njobs; ++job) {
                pg8::Gemm g; int kind;
                if (ph == 1) { g = pg8::Gemm{(const bf16_t*)(ws + OFF_HB), (const bf16_t*)(ws + OFF_WIN), NTOK, NP, 1024}; kind = 0; }
                else if (ph == 2) { g = pg8::Gemm{(const bf16_t*)(ws + OFF_CKV), (const bf16_t*)(ws + OFF_WKV), NTOK, 1024, 256}; kind = 1; }
                else if (ph == 5) { g = (job == 0) ? pg8::Gemm{(const bf16_t*)(ws + OFF_YA), (const bf16_t*)(ws + OFF_WA), NTOK, 1024, 512}
                                                   : pg8::Gemm{(const bf16_t*)(ws + OFF_YF), (const bf16_t*)(ws + OFF_WF), NTOK, 1024, 512}; kind = 2 + job; }
                else if (ph == 6) { g = pg8::Gemm{(const bf16_t*)(ws + OFF_MERGED), (const bf16_t*)(ws + OFF_WO), NTOK, 1024, 1024}; kind = 4; }
                else { g = pg8::Gemm{(const bf16_t*)(ws + OFF_HID), (const bf16_t*)(ws + OFF_WD), HID_ROWS, 32 * 1024, 256}; kind = 5; }
                pg8::StaticOrder S; S.init(g.M, g.N, G, bid);
                if (ph == 9) S.init_moe((const PG8_LAS int*)tag, G, bid, (FUSE89 && REPEAT_PH < 0) ? (const unsigned*)ctl + CW_DONE : nullptr);
                EpiAny E{kind, (const PG8_LAS float*)rs, (const PG8_LAS int*)tag};
                if (ph == 2) { TS_END(1); TS_BEGIN(2); }
                pg8::gemm_phase<EpiAny, pg8::StaticOrder, true, true>((PG8_LAS unsigned char*)smem, g, S, E);
                if (ph == 2) { TS_END(2); TS_BEGIN(3); }
            }
            if (ph == 1) {
                const int tid = ltid(), lane = tid & 63, wave = __builtin_amdgcn_readfirstlane(tid >> 6);
                const int gw = (wave == 0) ? bid : 1 << 20;
                if (gw <= 180) {
                    const bf16_t* HBM = (const bf16_t*)(ws + OFF_HBM); const bf16_t* WIN = (const bf16_t*)(ws + OFF_WIN);
                    const int c0 = (gw < 180) ? gw * 16 : 4928;
                    f32x4 acc = zero4();
                    const bf16_t* ap_ = HBM + (size_t)(lane & 15) * 1024 + (lane >> 4) * 8;
                    const bf16_t* bp_ = WIN + (size_t)(c0 + (lane & 15)) * 1024 + (lane >> 4) * 8;
#pragma unroll 16
                    for (int kk = 0; kk < 32; ++kk) acc = __builtin_amdgcn_mfma_f32_16x16x32_bf16(*(const bf16x8*)(ap_ + kk * 32), *(const bf16x8*)(bp_ + kk * 32), acc, 0, 0, 0);
                    const int cg64 = c0 >> 6, d = (c0 & 63) + (lane & 15);
                    const bool ropeseg = (cg64 < 8 || (cg64 >= 12 && cg64 <= 20)) && ((c0 & 63) == 0);
                    const float* bfg = kp->in[5];
#pragma unroll
                    for (int j = 0; j < 4; ++j) {
                        const int t = (lane >> 4) * 4 + j;
                        float v = acc[j];
                        if (ropeseg) {
                            const float pr = __shfl_xor(v, 8);
                            const float cs = rope[t * 16 + 2 * (d & 7)], sn = rope[t * 16 + 2 * (d & 7) + 1];
                            v = (d & 8) ? (v * cs + pr * sn) : (v * cs - pr * sn);
                        }
#pragma unroll
                        for (int b = 0; b < 2; ++b) {
                            const size_t r = (size_t)b * TP + t;
                            if (cg64 < 8) ((bf16_t*)(ws + OFF_QA))[r * 512 + cg64 * 64 + d] = (bf16_t)f2bf(v * QSCALE);
                            else if (cg64 < 12) { if (b == 0) ((float*)(ws + OFF_MCKV))[t * 256 + (cg64 - 8) * 64 + d] = v; }
                            else if (cg64 < 20) ((bf16_t*)(ws + OFF_QI))[r * 512 + (cg64 - 12) * 64 + d] = (bf16_t)f2bf(v * 0.125f);
                            else if (cg64 == 20) ((bf16_t*)(ws + OFF_KI))[((size_t)((b * (TP / 16) + (t >> 4)) * 2 + (d >> 5)) * 64 + ((d & 31) >> 3) * 16 + (t & 15)) * 8 + (d & 7)] = (bf16_t)f2bf(v);
                            else if (cg64 < 29) ((bf16_t*)(ws + OFF_QF))[r * 512 + (cg64 - 21) * 64 + d] = (bf16_t)f2bf(v * QSCALE);
                            else if (cg64 < 37) ((bf16_t*)(ws + OFF_KF))[r * 512 + (cg64 - 29) * 64 + d] = (bf16_t)f2bf(v);
                            else if (cg64 < 45) ((bf16_t*)(ws + OFF_VF))[r * 512 + (cg64 - 37) * 64 + d] = (bf16_t)f2bf(v);
                            else if (d < 8) ((float*)(ws + OFF_WI))[r * 8 + d] = v * 0.3535533905932738f;
                            else { const float z = v + bfg[d - 8]; ((float*)(ws + OFF_LOGF))[(size_t)(b * 8 + (d - 8)) * TP + t] = fminf(z, 0.f) - __logf(1.0f + __expf(-fabsf(z))); }
                        }
                    }
                }
            }
            if (ph == 2) {
                const int tid = ltid(), lane = tid & 63, wave = __builtin_amdgcn_readfirstlane(tid >> 6);
                const int gw = (wave == 0) ? bid : 1 << 20;
                if (gw < 64) {
                    const float* MC = (const float*)(ws + OFF_MCKV); const bf16_t* WKV = (const bf16_t*)(ws + OFF_WKV);
                    const int c0 = gw * 16;
                    f32x4 acc = zero4(); float ss = 0.f;
                    const float* ap_ = MC + (lane & 15) * 256 + (lane >> 4) * 8;
                    const bf16_t* bp_ = WKV + (size_t)(c0 + (lane & 15)) * 256 + (lane >> 4) * 8;
#pragma unroll
                    for (int kk = 0; kk < 8; ++kk) {
                        const f32x4 a0 = *(const f32x4*)(ap_ + kk * 32), a1 = *(const f32x4*)(ap_ + kk * 32 + 4);
                        uint4 au; au.x = pk2(a0[0], a0[1]); au.y = pk2(a0[2], a0[3]); au.z = pk2(a1[0], a1[1]); au.w = pk2(a1[2], a1[3]);
                        const unsigned aw[4] = {au.x, au.y, au.z, au.w};
#pragma unroll
                        for (int e = 0; e < 4; ++e) { const float x0 = bf2f(aw[e] & 0xffffu), x1 = bf2f(aw[e] >> 16); ss = fmaf(x0, x0, fmaf(x1, x1, ss)); }
                        acc = __builtin_amdgcn_mfma_f32_16x16x32_bf16(*(bf16x8*)&au, *(const bf16x8*)(bp_ + kk * 32), acc, 0, 0, 0);
                    }
                    ss += __shfl_xor(ss, 16); ss += __shfl_xor(ss, 32);
                    const float rstd_row = rsqrtf(ss * (1.0f / 256.0f) + RMS_EPS);
                    const int cg64 = c0 >> 6, d = (c0 & 63) + (lane & 15);
                    const bool ropeseg = (cg64 < 8) && ((c0 & 63) == 0);
#pragma unroll
                    for (int j = 0; j < 4; ++j) {
                        const int t = (lane >> 4) * 4 + j;
                        float v = acc[j] * __shfl(rstd_row, t);
                        if (ropeseg) {
                            const float pr = __shfl_xor(v, 8);
                            const float cs = rope[t * 16 + 2 * (d & 7)], sn = rope[t * 16 + 2 * (d & 7) + 1];
                            v = (d & 8) ? (v * cs + pr * sn) : (v * cs - pr * sn);
                        }
#pragma unroll
                        for (int b = 0; b < 2; ++b) {
                            const size_t r = (size_t)b * TP + t;
                            if (cg64 < 8) ((bf16_t*)(ws + OFF_KA))[kimg_off(b, cg64, t, d)] = (bf16_t)f2bf(v);
                            else ((bf16_t*)(ws + OFF_VA))[vimg_off(b, cg64 - 8, t, d)] = (bf16_t)f2bf(v);
                        }
                    }
                }
            }
            if (ph == 2) { TS_END(3); TS_BEGIN(4); }
            if (ph == 2 && bid >= G - 16) {
                const int tid = ltid(), lane = tid & 63, wave = __builtin_amdgcn_readfirstlane(tid >> 6);
                const int i16 = bid - (G - 16), b = i16 >> 3, h = i16 & 7;
                const float* LOGT = (const float*)(ws + OFF_LOGF) + (size_t)(b * 8 + h) * TP;
                float* CUMT = (float*)(ws + OFF_CUMT) + (size_t)(b * 8 + h) * TP;
                float* seq = (float*)smem;
                double* part = (double*)(smem + 512 * 17 * 4);
                constexpr int CH = 17;
                for (int i = tid; i < 512 * CH; i += NTHREADS) seq[i] = (i < T) ? LOGT[i] : 0.f;
                __syncthreads();
                float lv[CH];
                double sacc = 0.0;
#pragma unroll
                for (int k = 0; k < CH; ++k) lv[k] = seq[tid * CH + k];
#pragma unroll
                for (int k = 0; k < CH; ++k) sacc += (double)lv[k];
                double incl = sacc;
#pragma unroll
                for (int d = 1; d < 64; d <<= 1) { const double v = __shfl_up(incl, d); if (lane >= d) incl += v; }
                if (lane == 63) part[wave] = incl;
                __syncthreads();
                double run = incl - sacc;
                for (int w = 0; w < wave; ++w) run += part[w];
#pragma unroll
                for (int k = 0; k < CH; ++k) { run += (double)lv[k]; seq[tid * CH + k] = (float)(run * 1.4426950408889634); }
                __syncthreads();
                for (int i = tid; i < TP; i += NTHREADS) CUMT[i] = (i < T) ? seq[i] : 0.f;
                __syncthreads();
            }
            if (ph == 2) { TS_END(4); TS_BEGIN(5); }
            if (ph == 2) {
                const int tid = ltid(), lane = tid & 63, wave = __builtin_amdgcn_readfirstlane(tid >> 6);
                const bf16_t* KF = (const bf16_t*)(ws + OFF_KF);
                float* KN = (float*)(ws + OFF_KNORM);
                for (int it = bid * 8 + wave; it < NB * 8 * MW; it += G * 8) {
                    const int kt = it % MW, bh = it / MW, b = bh >> 3, h = bh & 7;
                    const bf16_t* kr = KF + ((size_t)b * TP + kt * 64 + lane) * 512 + h * 64;
                    float ss = 0.f;
#pragma unroll
                    for (int c = 0; c < 8; ++c) {
                        const uint4 u = *(const uint4*)(kr + c * 8);
                        const unsigned ww[4] = {u.x, u.y, u.z, u.w};
#pragma unroll
                        for (int e = 0; e < 4; ++e) { const float a0 = bf2f(ww[e] & 0xffffu), a1 = bf2f(ww[e] >> 16); ss = fmaf(a0, a0, fmaf(a1, a1, ss)); }
                    }
#pragma unroll
                    for (int o = 1; o < 64; o <<= 1) ss = fmaxf(ss, __shfl_xor(ss, o));
                    if (lane == 0) KN[it] = sqrtf(ss);
                }
            }
            if (ph == 2) TS_END(5);
        }
        if (PH(3) && ph == 3) {
            const int tid = ltid(), lane = tid & 63, wave = __builtin_amdgcn_readfirstlane(tid >> 6); (void)lane; (void)wave;
            constexpr int N_FOX = 33 * 16, N_IDX2 = T / 8, N_CV2 = 512;
            int* qslot = (int*)(smem + LDS_BYTES - 16);
            for (;;) {
                __syncthreads();
                if (tid == 0) *qslot = (int)atomicAdd(&ctl[CW_Q3 + step], 1u);
                __syncthreads();
                const int it = *qslot;
                if (it >= N_FOX + N_IDX2 + N_CV2) break;
                if (it >= N_FOX + N_IDX2) {
                    KParams kq = kp; unsigned char* wsq = ws;
                    const int g2 = (it - (N_FOX + N_IDX2)) * 2;
#pragma unroll 1
                    for (int gg = 0; gg < 2; ++gg) xpose_group(g2 + gg, 4096, [kq, wsq](int t_) { return moe_tile(kq, wsq, t_); }, (float*)smem);
                    continue;
                }
                if (it < N_FOX) {
                    const int qb = 32 - it / 16, bh = it % 16;
                    const int kt0 = fox_prune(ws, bh >> 3, bh & 7, qb, smem);
                    ab::attn_unit<16, true>(bh >> 3, bh & 7, qb, (const ab::bf16*)(ws + OFF_QF), (const ab::bf16*)(ws + OFF_KF), (const ab::bf16*)(ws + OFF_VF), (ab::bf16*)(ws + OFF_YF),
                                           nullptr, (const float*)(ws + OFF_CUMT), kt0, (char*)smem);
                }
                else {
                    const int qg = (T / 8 - 1) - (it - N_FOX);
#pragma unroll 1
                    for (int bb = 0; bb < 2; ++bb) indexer_item(ws, bb, qg, smem);
                }
            }
        }
        if (PH(4) && ph == 4) {
            const int tid = ltid(), lane = tid & 63, wave = __builtin_amdgcn_readfirstlane(tid >> 6); (void)lane; (void)wave;
            constexpr int N_DSA = 33 * 16;
            int* qslot = (int*)(smem + LDS_BYTES - 16);
            for (;;) {
                __syncthreads();
                if (tid == 0) *qslot = (int)atomicAdd(&ctl[CW_Q4 + step], 1u);
                __syncthreads();
                const int it = *qslot;
                if (it >= N_DSA + 256) break;
                if (it >= N_DSA) {
                    KParams kq = kp; unsigned char* wsq = ws;
#pragma unroll 1
                    for (int gg = 0; gg < 2; ++gg) xpose_group(1024 + 2 * (it - N_DSA) + gg, 6144, [kq, wsq](int t_) { return moe_tile(kq, wsq, t_); }, (float*)smem);
                    continue;
                }
                const int qb = 32 - it / 16, bh = it % 16;
                ab::attn_unit<8, false>(bh >> 3, bh & 7, qb, (const ab::bf16*)(ws + OFF_QA), (const ab::bf16*)(ws + OFF_KA), (const ab::bf16*)(ws + OFF_VA), (ab::bf16*)(ws + OFF_YA),
                                        (const unsigned long long*)(ws + OFF_MASK), nullptr, 0, (char*)smem);
            }
        }
        if (PH(5) && ph == 5) {
            const int tid = ltid(), lane = tid & 63, wave = __builtin_amdgcn_readfirstlane(tid >> 6); (void)lane; (void)wave;
        }
        if (PH(7) && ph == 7) {
            const int tid = ltid(), lane = tid & 63, wave = __builtin_amdgcn_readfirstlane(tid >> 6);
            constexpr int AP = 264;
            bf16_t* Ahi = (bf16_t*)smem; bf16_t* Alo = Ahi + 64 * AP;
            bf16_t* WL = Alo + 64 * AP;
            float* LG = (float*)(smem + (2 * 64 + 96) * AP * 2);
            const float* g1 = kp->in[11]; const float* b1 = kp->in[12];
            const float* brg = kp->in[14]; const float* bre = kp->in[16];
            const bf16_t* wrt = (const bf16_t*)(ws + OFF_WRT);
            bf16_t* H1B = (bf16_t*)(ws + OFF_H1B);
            int* TOKL = (int*)(ws + OFF_TOKL); float* GW = (float*)(ws + OFF_GW);
            unsigned* lcnt = (unsigned*)(LG + 64 * 49);
            for (int tb = bid; tb < NTOK / 64; tb += G) {
                const int n0 = tb * 64 + wave * 8;
                if (tid < 32) lcnt[tid] = 0u;
                f32x4 v[8][4];
#pragma unroll
                for (int tt = 0; tt < 8; ++tt)
#pragma unroll
                    for (int j = 0; j < 4; ++j) v[tt][j] = *(const f32x4*)(kp->out + (size_t)(n0 + tt) * 1024 + lane * 4 + 256 * j);
#pragma unroll
                for (int tt = 0; tt < 8; ++tt) {
                    float s_ = 0.f;
#pragma unroll
                    for (int j = 0; j < 4; ++j) s_ += (v[tt][j][0] + v[tt][j][1]) + (v[tt][j][2] + v[tt][j][3]);
                    const float mu = wave_sum(s_) * (1.0f / 1024.0f);
                    float q = 0.f;
#pragma unroll
                    for (int j = 0; j < 4; ++j) { const f32x4 d = v[tt][j] - mu; q += (d[0] * d[0] + d[1] * d[1]) + (d[2] * d[2] + d[3] * d[3]); }
                    const float rstd = rsqrtf(wave_sum(q) * (1.0f / 1024.0f) + LN_EPS);
#pragma unroll
                    for (int j = 0; j < 4; ++j) {
                        const f32x4 gg = *(const f32x4*)(g1 + lane * 4 + 256 * j), bb = *(const f32x4*)(b1 + lane * 4 + 256 * j);
                        v[tt][j] = (v[tt][j] - mu) * rstd * gg + bb;
                        store4bf(H1B + (size_t)(n0 + tt) * 1024 + lane * 4 + 256 * j, v[tt][j]);
                    }
                    if (lane == 0) { float* st1 = (float*)(ws + OFF_ST1); st1[2 * (n0 + tt)] = mu; st1[2 * (n0 + tt) + 1] = rstd; }
                }
                f32x4 acc0 = zero4(), acc1 = zero4();
                const int mt = wave & 3, nt0 = (wave < 4) ? 0 : 2;
                const bool two = wave < 4;
#pragma unroll
                for (int j = 0; j < 4; ++j) {
                    const int wrow = tid >> 5, wch = tid & 31;
                    const bf16_t* wsrc = wrt + (size_t)wrow * 1024 + j * 256 + wch * 8;
                    const uint4 w0 = *(const uint4*)(wsrc), w1 = *(const uint4*)(wsrc + 16 * 1024), w2 = *(const uint4*)(wsrc + 32 * 1024),
                                w3 = *(const uint4*)(wsrc + 48 * 1024), w4 = *(const uint4*)(wsrc + 64 * 1024), w5 = *(const uint4*)(wsrc + 80 * 1024);
                    __syncthreads();
#pragma unroll
                    for (int tt = 0; tt < 8; ++tt) {
                        const f32x4 x = v[tt][j];
                        const unsigned h0 = f2bf(x[0]), h1 = f2bf(x[1]), h2 = f2bf(x[2]), h3 = f2bf(x[3]);
                        uint2 hi, lo;
                        hi.x = h0 | (h1 << 16); hi.y = h2 | (h3 << 16);
                        lo.x = pk2(x[0] - bf2f(h0), x[1] - bf2f(h1)); lo.y = pk2(x[2] - bf2f(h2), x[3] - bf2f(h3));
                        *(uint2*)(Ahi + (wave * 8 + tt) * AP + lane * 4) = hi;
                        *(uint2*)(Alo + (wave * 8 + tt) * AP + lane * 4) = lo;
                    }
                    {
                        bf16_t* wd = WL + wrow * AP + wch * 8;
                        *(uint4*)(wd) = w0; *(uint4*)(wd + 16 * AP) = w1; *(uint4*)(wd + 32 * AP) = w2;
                        *(uint4*)(wd + 48 * AP) = w3; *(uint4*)(wd + 64 * AP) = w4; *(uint4*)(wd + 80 * AP) = w5;
                    }
                    __syncthreads();
#pragma unroll 2
                    for (int kk = 0; kk < 8; ++kk) {
                        const int ko = kk * 32 + (lane >> 4) * 8;
                        const bf16x8 ah = *(const bf16x8*)(Ahi + (mt * 16 + (lane & 15)) * AP + ko);
                        const bf16x8 al = *(const bf16x8*)(Alo + (mt * 16 + (lane & 15)) * AP + ko);
                        {
                            const bf16_t* wp = WL + (nt0 * 16 + (lane & 15)) * AP + ko;
                            const bf16x8 bh = *(const bf16x8*)wp, bl = *(const bf16x8*)(wp + 48 * AP);
                            acc0 = __builtin_amdgcn_mfma_f32_16x16x32_bf16(ah, bh, acc0, 0, 0, 0);
                            acc0 = __builtin_amdgcn_mfma_f32_16x16x32_bf16(ah, bl, acc0, 0, 0, 0);
                            acc0 = __builtin_amdgcn_mfma_f32_16x16x32_bf16(al, bh, acc0, 0, 0, 0);
                        }
                        if (two) {
                            const bf16_t* wp = WL + (16 + (lane & 15)) * AP + ko;
                            const bf16x8 bh = *(const bf16x8*)wp, bl = *(const bf16x8*)(wp + 48 * AP);
                            acc1 = __builtin_amdgcn_mfma_f32_16x16x32_bf16(ah, bh, acc1, 0, 0, 0);
                            acc1 = __builtin_amdgcn_mfma_f32_16x16x32_bf16(ah, bl, acc1, 0, 0, 0);
                            acc1 = __builtin_amdgcn_mfma_f32_16x16x32_bf16(al, bh, acc1, 0, 0, 0);
                        }
                    }
                }
#pragma unroll
                for (int i = 0; i < 4; ++i) {
                    LG[(mt * 16 + (lane >> 4) * 4 + i) * 49 + nt0 * 16 + (lane & 15)] = acc0[i];
                    if (two) LG[(mt * 16 + (lane >> 4) * 4 + i) * 49 + 16 + (lane & 15)] = acc1[i];
                }
                __syncthreads();
                int my_e1 = 0, my_e2 = 0; float my_g1 = 0.f, my_g2 = 0.f;
#pragma unroll 2
                for (int tt = 0; tt < 8; ++tt) {
                    float mylg = (lane < 36) ? LG[(wave * 8 + tt) * 49 + lane] : 0.f;
                    mylg += (lane < 4) ? brg[lane] : ((lane < 36) ? bre[lane - 4] : 0.f);
                    float gl[4];
#pragma unroll
                    for (int i = 0; i < 4; ++i) gl[i] = __shfl(mylg, i);
                    int gs = 0; float gm = gl[0];
#pragma unroll
                    for (int i = 1; i < 4; ++i) if (gl[i] > gm) { gm = gl[i]; gs = i; }
                    float den = 0.f;
#pragma unroll
                    for (int i = 0; i < 4; ++i) den += __expf(gl[i] - gm);
                    const float pg = 1.0f / den;
                    float el[8];
#pragma unroll
                    for (int j = 0; j < 8; ++j) el[j] = __shfl(mylg, 4 + gs * 8 + j);
                    int i1 = 0; float l1 = el[0];
#pragma unroll
                    for (int j = 1; j < 8; ++j) if (el[j] > l1) { l1 = el[j]; i1 = j; }
                    int i2 = -1; float l2 = -3.0e38f;
#pragma unroll
                    for (int j = 0; j < 8; ++j) if (j != i1 && el[j] > l2) { l2 = el[j]; i2 = j; }
                    const float w1 = 1.0f / (1.0f + __expf(l2 - l1)), w2 = 1.0f - w1;
                    if (lane == tt) { my_e1 = gs * 8 + i1; my_e2 = gs * 8 + i2; my_g1 = pg * w1; my_g2 = pg * w2; }
                }
                unsigned r1 = 0, r2 = 0;
                if (lane < 8) { r1 = atomicAdd(&lcnt[my_e1], 1u); r2 = atomicAdd(&lcnt[my_e2], 1u); }
                __syncthreads();
                if (tid < 32) { const int t2 = ltid(); const unsigned c = lcnt[t2]; lcnt[32 + t2] = c ? atomicAdd(&ctl[CW_ECNT + t2 * ECS], c) : 0u; }
                __syncthreads();
                if (lane < 8) {
                    const int n = n0 + lane;
                    TOKL[my_e1 * 32768 + lcnt[32 + my_e1] + r1] = n * 2;
                    TOKL[my_e2 * 32768 + lcnt[32 + my_e2] + r2] = n * 2 + 1;
                    GW[n * 2] = my_g1; GW[n * 2 + 1] = my_g2;
                }
                __syncthreads();
            }
        }
        if (PH(8) && ph == 8) {
            const int tid = ltid(), lane = tid & 63, wave = __builtin_amdgcn_readfirstlane(tid >> 6); (void)lane; (void)wave;
            int* ecnt_s = (int*)(smem + LDS_BYTES - 1024);
            if (tid < 32) ecnt_s[tid] = (int)ctl[CW_ECNT + tid * ECS];
            __syncthreads();
            if (tid == 0) { int cp = 0, rb = 0; for (int e = 0; e < 32; ++e) { ecnt_s[32 + e] = cp; ecnt_s[64 + e] = rb; const int nc = (ecnt_s[e] + 255) >> 8; cp += nc; rb += nc * 256; } ecnt_s[96] = cp; }
            __syncthreads();
            const int nchunks = ecnt_s[96];
            const int* TOKL = (const int*)(ws + OFF_TOKL);
            bf16_t* HID = (bf16_t*)(ws + OFF_HID);
            const int NNT = (ph == 8) ? 4 : 8;
            for (int tile = bid; tile < nchunks * NNT; tile += G) {
                const int ch = tile / NNT, nt = tile % NNT;
                int e = 0;
#pragma unroll 1
                for (int k = 1; k < 32; ++k) if (ecnt_s[32 + k] <= ch) e = k;
                const int c_in_e = ch - ecnt_s[32 + e];
                const int cnt = ecnt_s[e];
                const int rowbase = ecnt_s[64 + e] + c_in_e * 256;
                const int pos0 = c_in_e * 256;
                const int rl = (wave >> 1) * 64, c4 = (lane >> 4) * 4;
                if (PH(8) && ph == 8) {
                    const bf16_t* H1B = (const bf16_t*)(ws + OFF_H1B);
                    const bf16_t* WGU = (const bf16_t*)(ws + OFF_WGU) + (size_t)e * 512 * 1024;
                    const bf16_t* ap[4]; const bf16_t* bp[2];
#pragma unroll
                    for (int i = 0; i < 4; ++i) {
                        int pos = pos0 + (tid >> 3) + 64 * i; pos = pos < cnt ? pos : cnt - 1;
                        const int aid = TOKL[e * 32768 + pos];
                        ap[i] = H1B + (size_t)(aid >> 1) * 1024;
                    }
#pragma unroll
                    for (int i = 0; i < 2; ++i) bp[i] = WGU + (size_t)(nt * 128 + (tid >> 3) + 64 * i) * 1024;
                    f32x4 acc[4][4]; zero_acc(acc);
                    gemm_core3(ap, bp, 1024, smem, acc);
                    const int hc0 = (nt * 128 + (wave & 1) * 64) >> 1;
#pragma unroll
                    for (int mi = 0; mi < 4; ++mi) {
                        const int rr = rl + mi * 16 + (lane & 15);
                        bf16_t* dst = HID + (size_t)(rowbase + rr) * 256 + hc0 + c4;
#pragma unroll
                        for (int pr = 0; pr < 2; ++pr) {
                            f32x4 hv;
#pragma unroll
                            for (int j = 0; j < 4; ++j) { const float gte = acc[mi][2 * pr][j], up = acc[mi][2 * pr + 1][j]; hv[j] = gte * sigmoidf_(gte) * up; }
                            if (FUSE89) store4bf_agent(dst + pr * 16, hv); else store4bf(dst + pr * 16, hv);
                        }
                    }
                    if (FUSE89) {
                        asm volatile("s_waitcnt vmcnt(0)" ::: "memory");
                        __syncthreads();
                        if (ltid() == 0) (void)__hip_atomic_fetch_add(&ctl[CW_DONE + ch], 1u, __ATOMIC_RELAXED, __HIP_MEMORY_SCOPE_AGENT);
                    }
                } else {
                    const bf16_t* WD = (const bf16_t*)(ws + OFF_WD) + (size_t)e * 1024 * 256;
                    const float* GW = (const float*)(ws + OFF_GW);
                    bf16_t* SLOT = (bf16_t*)(ws + OFF_SLOT);
                    const bf16_t* ap[4]; const bf16_t* bp[2];
                    dense_ptrs(HID, 256, rowbase, WD, 256, nt * 128, ap, bp);
                    f32x4 acc[4][4]; zero_acc(acc);
                    gemm_core(ap, bp, 256, (bf16_t*)smem, acc);
                    const int cbase = nt * 128 + (wave & 1) * 64;
#pragma unroll
                    for (int mi = 0; mi < 4; ++mi) {
                        const int pos = pos0 + rl + mi * 16 + (lane & 15);
                        if (pos < cnt) {
                            const int aid = TOKL[e * 32768 + pos];
                            const float gw = GW[aid];
                            bf16_t* dst = SLOT + (size_t)aid * 1024 + cbase + c4;
#pragma unroll
                            for (int ni = 0; ni < 4; ++ni) store4bf(dst + ni * 16, acc[mi][ni] * gw);
                        }
                    }
                }
            }
        }
        if (PH(10) && ph == 10) {
            const int tid = ltid(), lane = tid & 63, wave = __builtin_amdgcn_readfirstlane(tid >> 6); (void)tid;
            const bf16_t* SLOT = (const bf16_t*)(ws + OFF_SLOT);
            const float* g2 = kp->in[20]; const float* b2 = kp->in[21];
            const bf16_t* H1B = (const bf16_t*)(ws + OFF_H1B);
            for (int n0 = (bid * 8 + wave) * 4; n0 < NTOK; n0 += G * 8 * 4) {
                f32x4 v[4][4];
#pragma unroll
                for (int rr = 0; rr < 4; ++rr) {
                    const int n = n0 + rr;
#pragma unroll
                    for (int j = 0; j < 4; ++j) {
                        const int c = lane * 4 + 256 * j;
                        const uint2 hb = *(const uint2*)(H1B + (size_t)n * 1024 + c);
                        const f32x4 hv = {bf2f(hb.x & 0xffffu), bf2f(hb.x >> 16), bf2f(hb.y & 0xffffu), bf2f(hb.y >> 16)};
                        const uint2 u0 = *(const uint2*)(SLOT + (size_t)(2 * n) * 1024 + c), u1 = *(const uint2*)(SLOT + (size_t)(2 * n + 1) * 1024 + c);
                        f32x4 f; f[0] = bf2f(u0.x & 0xffffu) + bf2f(u1.x & 0xffffu); f[1] = bf2f(u0.x >> 16) + bf2f(u1.x >> 16);
                        f[2] = bf2f(u0.y & 0xffffu) + bf2f(u1.y & 0xffffu); f[3] = bf2f(u0.y >> 16) + bf2f(u1.y >> 16);
                        v[rr][j] = hv * ALPHA + f;
                    }
                }
#pragma unroll
                for (int rr = 0; rr < 4; ++rr) {
                    float s = 0.f;
#pragma unroll
                    for (int j = 0; j < 4; ++j) s += (v[rr][j][0] + v[rr][j][1]) + (v[rr][j][2] + v[rr][j][3]);
                    const float mu = wave_sum(s) * (1.0f / 1024.0f);
                    float q = 0.f;
#pragma unroll
                    for (int j = 0; j < 4; ++j) { const f32x4 d = v[rr][j] - mu; q += (d[0] * d[0] + d[1] * d[1]) + (d[2] * d[2] + d[3] * d[3]); }
                    const float rstd = rsqrtf(wave_sum(q) * (1.0f / 1024.0f) + LN_EPS);
                    float* row = kp->out + (size_t)(n0 + rr) * 1024;
#pragma unroll
                    for (int j = 0; j < 4; ++j) {
                        const int c = lane * 4 + 256 * j;
                        const f32x4 gg = *(const f32x4*)(g2 + c), bb = *(const f32x4*)(b2 + c);
                        *(f32x4*)(row + c) = (v[rr][j] - mu) * rstd * gg + bb;
                    }
                }
            }
        }
    }
    if (TIME_PH >= 0 && blockIdx.x == (TIME_PH >= 100 ? TIME_BLK : 0)) {
        __syncthreads();
        if (threadIdx.x == 0) {
            volatile LAS unsigned* ts = (volatile LAS unsigned*)(smem + LDS_BYTES - 64);
            const unsigned long long t0 = ((unsigned long long)ts[5] << 32) | ts[4];
            const unsigned long long tnow = wall_clock64();
            const unsigned long long t1 = (TIME_PH == NPHASES - 1) ? tnow : (((unsigned long long)ts[7] << 32) | ts[6]);
            unsigned long long d = t1 - t0; if (d > 100000ull) d = 100000ull;
            while (wall_clock64() - tnow < d) __builtin_amdgcn_s_sleep(8);
        }
    }
}

extern "C" void kernel_launch(void* const* d_in, const int* in_sizes, int n_in, void* d_out, int out_size, void* d_ws, size_t ws_size, hipStream_t stream) {
    static int grid = 0;
    if (grid == 0) {
        int dev = 0, cus = 0, per_cu = 0;
        hipGetDevice(&dev);
        hipDeviceGetAttribute(&cus, hipDeviceAttributeMultiprocessorCount, dev);
        hipOccupancyMaxActiveBlocksPerMultiprocessor(&per_cu, (const void*)mega, NTHREADS, 0);
        if (per_cu < 1) per_cu = 1;
        if (per_cu > 1) per_cu = 1;
        grid = cus * per_cu;
        if (n_in != 22 || ws_size < WS_END) { fprintf(stderr, "kernel_launch: unexpected n_in %d / ws_size %zu (need %zu)\n", n_in, ws_size, (size_t)WS_END); }
    }
    hipMemsetAsync((char*)d_ws + OFF_CTL, 0, 32768, stream);
    Params p{};
    for (int i = 0; i < 22; ++i) p.in[i] = (const float*)d_in[i];
    p.out = (float*)d_out; p.ws = (unsigned char*)d_ws;
#if N_LAUNCH_MODE == 0
    p.ph_lo = 0; p.ph_hi = NPHASES + (REPEAT_PH >= 0 ? 1 : 0) + EXTRA_SYNCS;
    void* args[] = {&p};
    hipError_t e = hipLaunchCooperativeKernel((const void*)mega, dim3(grid), dim3(NTHREADS), args, 0, stream);
    if (e != hipSuccess) fprintf(stderr, "cooperative launch failed: %s (grid %d)\n", hipGetErrorString(e), grid);
#else
    for (int ph = 0; ph < NPHASES; ++ph) {
        p.ph_lo = ph; p.ph_hi = ph + 1;
        hipLaunchKernelGGL(mega, dim3(grid), dim3(NTHREADS), 0, stream, p);
    }
#endif
}
```

```cpp
#include <hip/hip_runtime.h>
#include <hip/hip_cooperative_groups.h>
#include <hip/hip_bf16.h>
#include <stdint.h>
#include <stdio.h>
namespace cg = cooperative_groups;

#ifndef ONLY_PHASE
#define ONLY_PHASE -1
#endif
#ifndef PH_MASK
#define PH_MASK 0x7ff
#endif
#define PH(k) ((ONLY_PHASE < 0 || ONLY_PHASE == (k)) && ((PH_MASK >> (k)) & 1))
#ifndef REPEAT_PH
#define REPEAT_PH -1
#endif
#ifndef IDX_REP_MFMA
#define IDX_REP_MFMA 1
#endif
#ifndef P7_REP
#define P7_REP 1
#endif
#ifndef P10_REP
#define P10_REP 1
#endif
#ifndef ATT_PROBE
#define ATT_PROBE 0
#endif
#ifndef IDX_PROBE
#define IDX_PROBE 0
#endif
#ifndef IDX_REP_SEL
#define IDX_REP_SEL 1
#endif
#ifndef IDX_REP
#define IDX_REP 1
#endif
#ifndef TIME_PH
#define TIME_PH -1
#endif
#ifndef TIME_BLK
#define TIME_BLK 0
#endif
#define TS_STAMP(id, slot) do { if (TIME_PH == 100 + (id) && (TIME_BLK < 0 || blockIdx.x == TIME_BLK) && threadIdx.x == 0) { const unsigned long long tt_ = wall_clock64(); \
    volatile __attribute__((address_space(3))) unsigned* ts_ = (volatile __attribute__((address_space(3))) unsigned*)(smem + LDS_BYTES - 64) + (slot); ts_[0] = (unsigned)tt_; ts_[1] = (unsigned)(tt_ >> 32); } } while (0)
#define TS_ACC_BEGIN(id) TS_STAMP((id) + 100, 8)
#define TS_ACC_END(id) do { if (TIME_PH == 200 + (id) && (TIME_BLK < 0 || blockIdx.x == TIME_BLK) && threadIdx.x == 0) { const unsigned long long tt_ = wall_clock64(); \
    volatile __attribute__((address_space(3))) unsigned* ts_ = (volatile __attribute__((address_space(3))) unsigned*)(smem + LDS_BYTES - 64); \
    const unsigned long long t0_ = ((unsigned long long)ts_[9] << 32) | ts_[8]; unsigned long long a_ = ((unsigned long long)ts_[7] << 32) | ts_[6]; a_ += tt_ - t0_; ts_[6] = (unsigned)a_; ts_[7] = (unsigned)(a_ >> 32); } } while (0)
#define TS_BEGIN(id) TS_STAMP(id, 4)
#define TS_END(id) TS_STAMP(id, 6)
#ifndef QPF
#define QPF 1
#endif
#ifndef P2CONV
#define P2CONV 1
#endif
#ifndef MOEXCD
#define MOEXCD 1
#endif
#ifndef FUSE23
#define FUSE23 1
#endif
#ifndef FUSE34
#define FUSE34 1
#endif
#ifndef FUSE89
#define FUSE89 1
#endif
#ifndef EXTRA_SYNCS
#define EXTRA_SYNCS 0
#endif
#ifndef N_LAUNCH_MODE
#define N_LAUNCH_MODE 0
#endif

typedef unsigned short bf16_t;
typedef short bf16x8 __attribute__((ext_vector_type(8)));
typedef float f32x4 __attribute__((ext_vector_type(4)));
typedef float f32x16 __attribute__((ext_vector_type(16)));

constexpr int NB = 2, SEQ = 8192, DM = 1024, NMETA = 16;
constexpr int T = SEQ + NMETA;
constexpr int TP = 8448;
constexpr int R = NB * TP;
constexpr int NTOK = NB * SEQ;
constexpr int NP = 5120;
constexpr int MW = TP / 64;
constexpr float LN_EPS = 1e-5f, RMS_EPS = 1e-6f;
constexpr float ALPHA = 1.189207115002721f;
constexpr float LOG2E = 1.4426950408889634f;
constexpr float QSCALE = 0.125f * LOG2E;
constexpr int NTHREADS = 512;
constexpr int NPHASES = 11;

constexpr size_t al256(size_t x) { return (x + 255) & ~size_t(255); }
constexpr size_t OFF_CTL = 0;
constexpr size_t OFF_ROPE = 65536;
constexpr size_t OFF_STAT0 = OFF_ROPE + al256((size_t)TP * 16 * 4);
constexpr size_t OFF_WRT = OFF_STAT0 + al256((size_t)R * 8);
constexpr size_t OFF_WIN = OFF_WRT + (size_t)2 * 48 * 1024 * 2;
constexpr size_t OFF_WKV = OFF_WIN + (size_t)NP * 1024 * 2;
constexpr size_t OFF_WA = OFF_WKV + (size_t)1024 * 256 * 2;
constexpr size_t OFF_WF = OFF_WA + (size_t)1024 * 512 * 2;
constexpr size_t OFF_WO = OFF_WF + (size_t)1024 * 512 * 2;
constexpr size_t OFF_HB = OFF_WO + (size_t)1024 * 1024 * 2;
constexpr size_t OFF_HBM = OFF_HB + (size_t)NTOK * 1024 * 2;
constexpr size_t OFF_QI = OFF_HB + (size_t)R * 1024 * 2;
constexpr size_t OFF_QA = OFF_QI + (size_t)R * 512 * 2;
constexpr size_t OFF_QF = OFF_QA + (size_t)R * 512 * 2;
constexpr size_t OFF_KF = OFF_QF + (size_t)R * 512 * 2;
constexpr size_t OFF_VF = OFF_KF + (size_t)R * 512 * 2;
constexpr size_t OFF_KA = OFF_VF + (size_t)R * 512 * 2;
constexpr size_t OFF_VA = OFF_KA + (size_t)R * 512 * 2;
constexpr size_t OFF_KI = OFF_VA + (size_t)R * 512 * 2;
constexpr size_t OFF_WI = OFF_KI + (size_t)R * 64 * 2;
constexpr size_t OFF_LOGF = OFF_WI + (size_t)R * 8 * 4;
constexpr size_t OFF_CUM = OFF_LOGF + (size_t)R * 8 * 4;
constexpr size_t OFF_CUMT = OFF_CUM + (size_t)R * 8 * 4;
constexpr size_t OFF_KNORM = OFF_CUMT + (size_t)R * 8 * 4;
constexpr size_t OFF_CKV = OFF_KNORM + al256((size_t)NB * 8 * MW * 4);
constexpr size_t OFF_MASK = OFF_CKV + (size_t)R * 256 * 2;
constexpr size_t OFF_TOKL = OFF_MASK + (size_t)R * MW * 8;
constexpr size_t OFF_GW = OFF_TOKL + (size_t)32 * 32768 * 4;
constexpr int HID_ROWS = 32768 + 32 * 256;
constexpr size_t OFF_MCKV = OFF_GW + (size_t)NTOK * 2 * 4;
constexpr size_t OFF_ST1 = OFF_MCKV + 16 * 256 * 4;
constexpr size_t OFF_HID = OFF_ST1 + (size_t)NTOK * 2 * 4;
constexpr size_t OFF_YA = OFF_HID + (size_t)HID_ROWS * 256 * 2;
constexpr size_t OFF_YF = OFF_YA + (size_t)NTOK * 512 * 2;
constexpr size_t WS_END = OFF_YF + (size_t)NTOK * 512 * 2;
constexpr size_t OFF_WGU = OFF_HB;
constexpr size_t OFF_WD = OFF_WGU + (size_t)32 * 512 * 1024 * 2;
constexpr size_t OFF_MERGED = OFF_KF;
constexpr size_t OFF_H1B = OFF_YA;
constexpr size_t OFF_SLOT = OFF_QA;
static_assert(OFF_WD + (size_t)32 * 1024 * 256 * 2 <= OFF_QA, "moe weights fit in HB+QI");
static_assert(OFF_MERGED + (size_t)NTOK * 1024 * 2 <= OFF_KA, "merged fits");
static_assert(OFF_H1B + (size_t)NTOK * 1024 * 2 <= WS_END, "h1b fits");
static_assert(OFF_SLOT + (size_t)NTOK * 2 * 1024 * 2 <= OFF_KA, "slot fits");
static_assert(WS_END <= (size_t)256 * 1024 * 1024, "workspace");

constexpr int CW_Q3 = 0, CW_Q4 = 64, CW_ECNT = 128, ECS = 64, CW_DONE = 2304, CW_MQB = 2700, CW_IDXDONE = 2740, CW_P2DONE = 2760, CW_BAR = 4096;

constexpr int SCP = TP + 16;
constexpr int HP = 264;
constexpr int LDS_IDX = 8 * SCP * 2 + 8 * HP * 4;
constexpr int LDS_ROUTER = 36 * 1024 * 4;
constexpr int LDS_GEMM = 2 * (256 * 64 + 128 * 64) * 2 + 1024;
constexpr int LDS_BYTES = 150528;

struct Params {
    const float* in[22];
    float* out;
    unsigned char* ws;
    int ph_lo, ph_hi;
};

typedef const __attribute__((address_space(4))) Params* KParams;
__device__ __forceinline__ f32x4 zero4() { float z = 0.f; asm volatile("" : "+v"(z)); return (f32x4){z, z, z, z}; }
__device__ __forceinline__ uint4 zero4u() { unsigned z = 0u; asm volatile("" : "+v"(z)); return make_uint4(z, z, z, z); }
__device__ __forceinline__ int ltid() { int t = threadIdx.x; asm volatile("" : "+v"(t)); return t; }
__device__ __forceinline__ unsigned f2bf(float f) { unsigned u = __float_as_uint(f); return (u + 0x7fffu + ((u >> 16) & 1u)) >> 16; }
typedef __bf16 bf16x2_t __attribute__((ext_vector_type(2)));
typedef float f32x2 __attribute__((ext_vector_type(2)));
__device__ __forceinline__ unsigned pk2(float lo, float hi) { f32x2 v = {lo, hi}; bf16x2_t b = __builtin_convertvector(v, bf16x2_t); return __builtin_bit_cast(unsigned, b); }
__device__ __forceinline__ float bf2f(unsigned h) { return __uint_as_float(h << 16); }
typedef unsigned u32x2_t __attribute__((ext_vector_type(2)));
typedef unsigned u32x4_t __attribute__((ext_vector_type(4)));
__device__ __forceinline__ uint2 ntload_u2(const void* p) { const u32x2_t v = __builtin_nontemporal_load((const u32x2_t*)p); uint2 r; r.x = v[0]; r.y = v[1]; return r; }
__device__ __forceinline__ uint4 ntload_u4(const void* p) { const u32x4_t v = __builtin_nontemporal_load((const u32x4_t*)p); uint4 r; r.x = v[0]; r.y = v[1]; r.z = v[2]; r.w = v[3]; return r; }
template <int CTRL> __device__ __forceinline__ float dppf(float v) { return __uint_as_float((unsigned)__builtin_amdgcn_update_dpp(0, (int)__float_as_uint(v), CTRL, 0xf, 0xf, true)); }
__device__ __forceinline__ float wave_sum(float v) {
    v += dppf<0xB1>(v);
    v += dppf<0x4E>(v);
    v += dppf<0x124>(v);
    v += dppf<0x128>(v);
    const float a = __uint_as_float((unsigned)__builtin_amdgcn_readlane((int)__float_as_uint(v), 0)), b = __uint_as_float((unsigned)__builtin_amdgcn_readlane((int)__float_as_uint(v), 16));
    const float c = __uint_as_float((unsigned)__builtin_amdgcn_readlane((int)__float_as_uint(v), 32)), d = __uint_as_float((unsigned)__builtin_amdgcn_readlane((int)__float_as_uint(v), 48));
    return (a + b) + (c + d);
}
__device__ __forceinline__ float sigmoidf_(float v) { return 1.0f / (1.0f + __expf(-v)); }

__device__ __forceinline__ int win_oldcol(int n) {
    if (n < 1344) return n;
    if (n < 2880) return n + 8;
    if (n < 4928) return n + 16;
    if (n < 4936) return 1344 + (n - 4928);
    if (n < 4944) return 2888 + (n - 4936);
    return -1;
}

template <class ColMap>
__device__ __forceinline__ void xpose64(const float* __restrict__ src, int src_ld, bf16_t* __restrict__ dst, int dst_ld, int k0, int n0, ColMap cm,
                                        const float* __restrict__ kscale, float* tile) {
    const int tid = ltid();
    {
        const int nn = tid & 63; const int sc = cm(n0 + nn);
#pragma unroll
        for (int i = 0; i < 8; ++i) {
            const int kk = (tid >> 6) + 8 * i;
            float v = 0.f;
            if (sc >= 0) { v = src[(size_t)(k0 + kk) * src_ld + sc]; if (kscale) v *= kscale[k0 + kk]; }
            tile[kk * 65 + nn] = v;
        }
    }
    __syncthreads();
    {
        const int kp = tid & 31;
#pragma unroll
        for (int i = 0; i < 4; ++i) {
            const int nn = (tid >> 5) + 16 * i;
            const unsigned u = pk2(tile[(2 * kp) * 65 + nn], tile[(2 * kp + 1) * 65 + nn]);
            *(unsigned*)(dst + (size_t)(n0 + nn) * dst_ld + k0 + 2 * kp) = u;
        }
    }
    __syncthreads();
}


struct XTile { const float* src; bf16_t* dst; const float* kscale; int src_ld, dst_ld, k0, j0, rb, s16, winmap; };
template <class Decode>
__device__ __forceinline__ void xpose_group(int g4, int ntiles, Decode dec, float* tiles  ) {
    const int tid = ltid();
    const int nn = tid & 63, kr = tid >> 6;
    float v[4][8];
    XTile xt[4];
#pragma unroll
    for (int q = 0; q < 4; ++q) {
        const int it = g4 * 4 + q;
        if (it < ntiles) {
            xt[q] = dec(it);
            const int sc = xt[q].winmap ? win_oldcol(xt[q].j0 + nn) : (xt[q].j0 + nn);
#pragma unroll
            for (int i = 0; i < 8; ++i) {
                const int kk = kr + 8 * i;
                float x = 0.f;
                if (sc >= 0) x = __builtin_nontemporal_load(xt[q].src + (size_t)(xt[q].k0 + kk) * xt[q].src_ld + sc);
                v[q][i] = x;
            }
            if (xt[q].kscale) {
                float ks[8];
#pragma unroll
                for (int i = 0; i < 8; ++i) ks[i] = xt[q].kscale[xt[q].k0 + kr + 8 * i];
#pragma unroll
                for (int i = 0; i < 8; ++i) v[q][i] *= ks[i];
            }
        }
    }
#pragma unroll
    for (int q = 0; q < 4; ++q)
        if (g4 * 4 + q < ntiles) {
#pragma unroll
            for (int i = 0; i < 8; ++i) {
                const int kk = kr + 8 * i;
                tiles[q * 4160 + kk * 65 + nn] = v[q][i];
            }
        }
    __syncthreads();
    {
        const int kp = tid & 31;
#pragma unroll
        for (int q = 0; q < 4; ++q)
            if (g4 * 4 + q < ntiles) {
#pragma unroll
                for (int i = 0; i < 4; ++i) {
                    const int vr = (tid >> 5) + 16 * i;
                    const int row = xt[q].rb + (vr >> 4) * xt[q].s16 + (vr & 15);
                    *(unsigned*)(xt[q].dst + (size_t)row * xt[q].dst_ld + xt[q].k0 + 2 * kp) = pk2(tiles[q * 4160 + (2 * kp) * 65 + vr], tiles[q * 4160 + (2 * kp + 1) * 65 + vr]);
                }
            }
    }
    __syncthreads();
}
template <class Decode>
__device__ __forceinline__ void xpose_many(int ntiles, int G, int bid, Decode dec, float* tiles) {
    for (int g4 = bid; g4 * 4 < ntiles; g4 += G) xpose_group(g4, ntiles, dec, tiles);
}
__device__ __forceinline__ XTile moe_tile(KParams kq, unsigned char* wsq, int it) {
    XTile x; x.kscale = nullptr; x.winmap = 0;
    const int which = it / 2048, rem = it % 2048, e = rem / 64, i = rem % 64;
    if (which < 2) {
        x.src = kq->in[which == 0 ? 17 : 18] + (size_t)e * 1024 * 256; x.src_ld = 256;
        x.dst = (bf16_t*)(wsq + OFF_WGU) + (size_t)e * 512 * 1024; x.dst_ld = 1024;
        x.k0 = (i % 16) * 64; x.j0 = (i / 16) * 64; x.rb = (x.j0 >> 4) * 32 + which * 16; x.s16 = 32;
    } else {
        x.src = kq->in[19] + (size_t)e * 256 * 1024; x.src_ld = 1024;
        x.dst = (bf16_t*)(wsq + OFF_WD) + (size_t)e * 1024 * 256; x.dst_ld = 256;
        x.k0 = (i % 4) * 64; x.j0 = (i / 4) * 64; x.rb = x.j0; x.s16 = 16;
    }
    return x;
}

struct MoeSlab { const float* src; bf16_t* dst; int src_ld, dst_ld, k0, which; };
__device__ __forceinline__ MoeSlab moe_slab(KParams kq, unsigned char* wsq, int s_) {
    MoeSlab m;
    if (s_ < 1024) {
        const int which = s_ >> 9, rem = s_ & 511, e = rem >> 4, kb = rem & 15;
        m.src = kq->in[which == 0 ? 17 : 18] + (size_t)e * 1024 * 256 + (size_t)kb * 64 * 256; m.src_ld = 256;
        m.dst = (bf16_t*)(wsq + OFF_WGU) + (size_t)e * 512 * 1024; m.dst_ld = 1024; m.k0 = kb * 64; m.which = which;
    } else {
        const int d = s_ - 1024, e = d >> 4, i = d & 15, kb = i & 3, nb = i >> 2;
        m.src = kq->in[19] + (size_t)e * 256 * 1024 + (size_t)kb * 64 * 1024 + nb * 256; m.src_ld = 1024;
        m.dst = (bf16_t*)(wsq + OFF_WD) + (size_t)e * 1024 * 256 + (size_t)nb * 256 * 256; m.dst_ld = 256; m.k0 = kb * 64; m.which = -1;
    }
    return m;
}
__device__ __forceinline__ void moe_slab_pair(KParams kq, unsigned char* wsq, int s0, float* T) {
    const int tid = ltid();
    f32x4 r[8];
    MoeSlab m = moe_slab(kq, wsq, s0);
#pragma unroll
    for (int j = 0; j < 8; ++j) { const int f = tid + 512 * j; r[j] = __builtin_nontemporal_load((const f32x4*)(m.src + (size_t)(f >> 6) * m.src_ld + (f & 63) * 4)); }
#pragma unroll 1
    for (int h = 0; h < 2; ++h) {
#pragma unroll
        for (int j = 0; j < 8; ++j) { const int f = tid + 512 * j, k = f >> 6; *(f32x4*)(T + k * 256 + (((f & 63) * 4) ^ (8 * ((k >> 3) & 3)))) = r[j]; }
        __syncthreads();
        const MoeSlab mc = m;
        if (h == 0) {
            m = moe_slab(kq, wsq, s0 + 1);
#pragma unroll
            for (int j = 0; j < 8; ++j) { const int f = tid + 512 * j; r[j] = __builtin_nontemporal_load((const f32x4*)(m.src + (size_t)(f >> 6) * m.src_ld + (f & 63) * 4)); }
        }
#pragma unroll
        for (int j = 0; j < 4; ++j) {
            const int o = tid + 512 * j, c = o & 7, n = o >> 3;
            const float* tp = T + (8 * c) * 256 + (n ^ (8 * (c & 3)));
            uint4 u; u.x = pk2(tp[0], tp[256]); u.y = pk2(tp[512], tp[768]); u.z = pk2(tp[1024], tp[1280]); u.w = pk2(tp[1536], tp[1792]);
            const int row = (mc.which >= 0) ? ((n >> 4) * 32 + mc.which * 16 + (n & 15)) : n;
            *(uint4*)(mc.dst + (size_t)row * mc.dst_ld + mc.k0 + 8 * c) = u;
        }
        __syncthreads();
    }
}

constexpr int GEMM_BUF = 256 * 64 + 128 * 64;
__device__ __forceinline__ void gemm_core(const bf16_t* const (&ap)[4], const bf16_t* const (&bp)[2], int K, bf16_t* sm, f32x4 (&acc)[4][4]) {
    const int tid = ltid(), lane = tid & 63, wave = __builtin_amdgcn_readfirstlane(tid >> 6);
    const int wm = wave >> 1, wn = wave & 1;
    const int swz = ((tid & 7) ^ ((tid >> 4) & 7)) * 8;
    const int woff = (tid >> 3) * 64 + swz;
    uint4 ra[4], rb[2];
#pragma unroll
    for (int i = 0; i < 4; ++i) ra[i] = *(const uint4*)(ap[i]);
#pragma unroll
    for (int i = 0; i < 2; ++i) rb[i] = *(const uint4*)(bp[i]);
#pragma unroll
    for (int i = 0; i < 4; ++i) *(uint4*)(sm + woff + 4096 * i) = ra[i];
#pragma unroll
    for (int i = 0; i < 2; ++i) *(uint4*)(sm + 16384 + woff + 4096 * i) = rb[i];
    __syncthreads();
    const int nk = K >> 6;
    const int rsw = (lane >> 1) & 7;
    for (int kt = 0; kt < nk; ++kt) {
        const int cur = kt & 1;
        if (kt + 1 < nk) {
#pragma unroll
            for (int i = 0; i < 4; ++i) ra[i] = *(const uint4*)(ap[i] + (kt + 1) * 64);
#pragma unroll
            for (int i = 0; i < 2; ++i) rb[i] = *(const uint4*)(bp[i] + (kt + 1) * 64);
        }
        const bf16_t* sa = sm + cur * GEMM_BUF;
        const bf16_t* sb = sa + 16384;
#pragma unroll
        for (int ks = 0; ks < 2; ++ks) {
            const int coff = ((ks * 4 + (lane >> 4)) ^ rsw) * 8;
            bf16x8 af[4], bfr[4];
#pragma unroll
            for (int mi = 0; mi < 4; ++mi) af[mi] = *(const bf16x8*)(sa + (wm * 64 + mi * 16 + (lane & 15)) * 64 + coff);
#pragma unroll
            for (int ni = 0; ni < 4; ++ni) bfr[ni] = *(const bf16x8*)(sb + (wn * 64 + ni * 16 + (lane & 15)) * 64 + coff);
#pragma unroll
            for (int mi = 0; mi < 4; ++mi)
#pragma unroll
                for (int ni = 0; ni < 4; ++ni) acc[mi][ni] = __builtin_amdgcn_mfma_f32_16x16x32_bf16(bfr[ni], af[mi], acc[mi][ni], 0, 0, 0);
        }
        if (kt + 1 < nk) {
            bf16_t* dn = sm + (cur ^ 1) * GEMM_BUF;
#pragma unroll
            for (int i = 0; i < 4; ++i) *(uint4*)(dn + woff + 4096 * i) = ra[i];
#pragma unroll
            for (int i = 0; i < 2; ++i) *(uint4*)(dn + 16384 + woff + 4096 * i) = rb[i];
        }
        __syncthreads();
    }
}
__device__ __forceinline__ void zero_acc(f32x4 (&acc)[4][4]) {
#pragma unroll
    for (int i = 0; i < 4; ++i)
#pragma unroll
        for (int j = 0; j < 4; ++j) acc[i][j] = zero4();
}
__device__ __forceinline__ void gemm_core3(const bf16_t* const (&ap)[4], const bf16_t* const (&bp)[2], int K, unsigned char* smem_, f32x4 (&acc)[4][4]) {
    typedef __attribute__((address_space(3))) unsigned lds_u32;
    const int tid = ltid(), lane = tid & 63, wave = __builtin_amdgcn_readfirstlane(tid >> 6);
    const int wm = wave >> 1, wn = wave & 1;
    const int csrc = ((tid & 7) ^ ((tid >> 4) & 7)) * 8;
    const bf16_t* sm = (const bf16_t*)smem_;
    const int nk = K >> 6;
    const int rsw = (lane >> 1) & 7;
#define GC3_ISSUE(kt_, st_) do { \
        _Pragma("unroll") for (int i = 0; i < 4; ++i) __builtin_amdgcn_global_load_lds((const unsigned*)(ap[i] + (kt_) * 64 + csrc), (lds_u32*)(smem_ + ((st_) * GEMM_BUF + (64 * i + 8 * wave) * 64) * 2), 16, 0, 0); \
        _Pragma("unroll") for (int i = 0; i < 2; ++i) __builtin_amdgcn_global_load_lds((const unsigned*)(bp[i] + (kt_) * 64 + csrc), (lds_u32*)(smem_ + ((st_) * GEMM_BUF + 16384 + (64 * i + 8 * wave) * 64) * 2), 16, 0, 0); } while (0)
    GC3_ISSUE(0, 0);
    if (nk > 1) GC3_ISSUE(1, 1);
    int st = 0;
    for (int kt = 0; kt < nk; ++kt) {
        if (kt + 1 < nk) asm volatile("s_waitcnt vmcnt(6)" ::: "memory"); else asm volatile("s_waitcnt vmcnt(0)" ::: "memory");
        __builtin_amdgcn_s_barrier(); asm volatile("" ::: "memory");
        if (kt + 2 < nk) { const int s2 = (st >= 1) ? st - 1 : 2; GC3_ISSUE(kt + 2, s2); }
        const bf16_t* sa = sm + st * GEMM_BUF;
        const bf16_t* sb = sa + 16384;
        bf16x8 af[2][4], bfr[2][4];
#pragma unroll
        for (int ks = 0; ks < 2; ++ks) {
            const int coff = ((ks * 4 + (lane >> 4)) ^ rsw) * 8;
#pragma unroll
            for (int mi = 0; mi < 4; ++mi) af[ks][mi] = *(const bf16x8*)(sa + (wm * 64 + mi * 16 + (lane & 15)) * 64 + coff);
#pragma unroll
            for (int ni = 0; ni < 4; ++ni) bfr[ks][ni] = *(const bf16x8*)(sb + (wn * 64 + ni * 16 + (lane & 15)) * 64 + coff);
        }
#pragma unroll
        for (int ks = 0; ks < 2; ++ks)
#pragma unroll
            for (int mi = 0; mi < 4; ++mi)
#pragma unroll
                for (int ni = 0; ni < 4; ++ni) acc[mi][ni] = __builtin_amdgcn_mfma_f32_16x16x32_bf16(bfr[ks][ni], af[ks][mi], acc[mi][ni], 0, 0, 0);
        st = (st == 2) ? 0 : st + 1;
    }
    __syncthreads();
#undef GC3_ISSUE
}
__device__ __forceinline__ void dense_ptrs(const bf16_t* A, int lda, int row0, const bf16_t* Bt, int ldb, int col0, const bf16_t* (&ap)[4], const bf16_t* (&bp)[2]) {
    const int tid = ltid();
#pragma unroll
    for (int i = 0; i < 4; ++i) ap[i] = A + (size_t)(row0 + (tid >> 3) + 64 * i) * lda + (tid & 7) * 8;
#pragma unroll
    for (int i = 0; i < 2; ++i) bp[i] = Bt + (size_t)(col0 + (tid >> 3) + 64 * i) * ldb + (tid & 7) * 8;
}

__device__ __forceinline__ void rope_tile(f32x4& v, const float* __restrict__ rope, int t, int lane) {
    const int ib = ((lane >> 4) & 1) * 4;
    const float* rp = rope + (size_t)t * 16 + ib * 2;
#pragma unroll
    for (int j = 0; j < 4; ++j) {
        const float x = v[j];
        const float pr = __shfl_xor(x, 32);
        const float c = rp[2 * j], s = rp[2 * j + 1];
        v[j] = (lane < 32) ? (x * c - pr * s) : (x * c + pr * s);
    }
}
__device__ __forceinline__ void store4bf(bf16_t* dst, const f32x4& v) {
    uint2 u; u.x = pk2(v[0], v[1]); u.y = pk2(v[2], v[3]);
    *(uint2*)dst = u;
}
__device__ __forceinline__ void store4bf_agent(bf16_t* dst, const f32x4& v) {
    const unsigned long long u = (unsigned long long)pk2(v[0], v[1]) | ((unsigned long long)pk2(v[2], v[3]) << 32);
    __hip_atomic_store((unsigned long long*)dst, u, __ATOMIC_RELAXED, __HIP_MEMORY_SCOPE_AGENT);
}

namespace pg8 {
#define PG8_LAS __attribute__((address_space(3)))
constexpr int BM = 256, BK = 64, HALF = 128, HTB = HALF * BK * 2  , STAGE_BYTES = 8 * HTB, NXCD = 8, WGM = 8;

__host__ __device__ __forceinline__ int lds_byte(int r, int c) { const int st = (r >> 4) * 2 + (c >> 5), rr = r & 15, cc = c & 31, ob = rr * 64 + cc * 2; return st * 1024 + (ob ^ (((ob >> 9) & 1) << 5)); }
__host__ __device__ __forceinline__ void stage_rc(int b, int& R, int& C) { const int st = b / 1024, sb = b % 1024, swz = sb ^ (((sb >> 9) & 1) << 5); R = (st >> 1) * 16 + swz / 64; C = (st & 1) * 32 + (swz % 64) / 2; }
__host__ __device__ __forceinline__ int perm32(int rho) { const int n = rho >> 4, i = rho & 15; return 8 * (i >> 2) + 4 * n + (i & 3); }

struct Unit { int pm, pn; };
struct Gemm { const bf16_t* A; const bf16_t* Bt; int M, N, K; };

struct StaticOrder {
    int nM, nN, nwg, G, c;
    const PG8_LAS int* tab;
    __host__ __device__ void init(int M, int N, int G_, int c_) { nM = M / BM; nN = N / BM; nwg = nM * nN; G = G_; c = c_; tab = nullptr; dep = nullptr; }
    const unsigned* dep;
    __device__ __forceinline__ void init_moe(const PG8_LAS int* tab_, int G_, int c_, const unsigned* dep_) { nM = nN = nwg = 0; G = G_; c = c_; tab = tab_; dep = dep_; }
    __device__ __forceinline__ bool next(int i, Unit& u) const {
        if (tab) {
            const int n9 = tab[96] * 4, rem = n9 % G, nlight = G - rem, r = (c - rem + G) % G;
            int L = r;
            if (i > 0) { if (r >= nlight) return false; L = G + (i - 1) * nlight + r; }
            if (L >= n9) return false;
            const int ch = L >> 2; int e = 0;
#pragma unroll 1
            for (int k = 1; k < 32; ++k) if (tab[32 + k] <= ch) e = k;
            u.pm = (tab[64 + e] >> 8) + (ch - tab[32 + e]); u.pn = e * 4 + (L & 3); return true;
        }
        const long L = (long)i * G + c; if (L >= nwg) return false;
        int wgid = (int)L; { const int q = nwg / NXCD, r = nwg % NXCD, xcd = wgid % NXCD, off = wgid / NXCD; wgid = (xcd < r ? xcd * (q + 1) : r * (q + 1) + (xcd - r) * q) + off; }
        const int nig = WGM * nN, gid = wgid / nig, fm = gid * WGM, gsz = (nM - fm) < WGM ? (nM - fm) : WGM;
        u.pm = fm + ((wgid % nig) % gsz); u.pn = (wgid % nig) / gsz; return true;
    }
    __device__ __forceinline__ void a_ready(const Unit& u) const {
        if (tab && dep) {
            if ((threadIdx.x & 63) == 0) { unsigned sp = 0; while (__hip_atomic_load(dep + u.pm, __ATOMIC_RELAXED, __HIP_MEMORY_SCOPE_AGENT) < 4u && ++sp < (1u << 22)) __builtin_amdgcn_s_sleep(2); }
            asm volatile("" ::: "memory");
        }
    }
    __device__ __forceinline__ void done(const Unit&) const {}
};

template <class Epi, class Sched, bool ALIGN_EPI = false, bool SP2 = false>
__device__ __forceinline__ void gemm_phase(PG8_LAS unsigned char* lds, const Gemm g, const Sched& S, const Epi& E) {
    const int tid = ltid(), wid = __builtin_amdgcn_readfirstlane(tid >> 6), lane = tid & 63, wr = wid >> 2, wc = wid & 3, fr = lane & 15, fq = lane >> 4;
    const int K = g.K, nt = K / BK;
    unsigned voffA[2], voffB[2];
#pragma unroll
    for (int i = 0; i < 2; ++i) { int R, C; stage_rc(tid * 16 + i * 8192, R, C); const int Rb = Epi::PERM ? ((R & ~31) + perm32(R & 31)) : R;
        voffA[i] = (unsigned)(R * K + C) * 2u; voffB[i] = (unsigned)(Rb * K + C) * 2u; }
    const size_t kstep = (size_t)(BK * 2);
    const size_t hstep = (size_t)HALF * K * 2;
    const size_t tstep = 2 * hstep;
    const unsigned ldsw = (unsigned)wid * 1024u;
    const int aoff = lds_byte(wr * 64 + fr, fq * 8), boff = lds_byte(wc * 32 + fr, fq * 8);
#define PG8_SA(b, h) (((b) * 2 + (h)) * HTB)
#define PG8_SB(b, h) ((4 + (b) * 2 + (h)) * HTB)
#define PG8_STAGE(bufoff, gbase, voff) do { _Pragma("unroll") for (int _i = 0; _i < 2; ++_i) \
        __builtin_amdgcn_global_load_lds((const unsigned*)((const char*)(gbase) + (voff)[_i]), (PG8_LAS unsigned*)(lds + (bufoff) + ldsw + _i * 8192), 16, 0, 0); } while (0)
#define PG8_LDA(dst, b, h) do { _Pragma("unroll") for (int m = 0; m < 4; ++m) _Pragma("unroll") for (int k = 0; k < 2; ++k) dst[m][k] = *(const PG8_LAS bf16x8*)(lds + PG8_SA(b, h) + aoff + m * 2048 + k * 1024); } while (0)
#define PG8_LDB(dst, b, h) do { _Pragma("unroll") for (int n = 0; n < 2; ++n) _Pragma("unroll") for (int k = 0; k < 2; ++k) dst[n][k] = *(const PG8_LAS bf16x8*)(lds + PG8_SB(b, h) + boff + n * 2048 + k * 1024); } while (0)
#define PG8_MMA(ai, bj, At, Bt) do { __builtin_amdgcn_s_setprio(1); _Pragma("unroll") for (int m = 0; m < 4; ++m) _Pragma("unroll") for (int n = 0; n < 2; ++n) _Pragma("unroll") for (int k = 0; k < 2; ++k) \
        acc[ai][bj][m][n] = __builtin_amdgcn_mfma_f32_16x16x32_bf16(Bt[n][k], At[m][k], acc[ai][bj][m][n], 0, 0, 0); __builtin_amdgcn_s_setprio(0); } while (0)
#define PG8_WAIT_V(n) asm volatile("s_waitcnt vmcnt(" #n ")" ::: "memory")
#define PG8_WAIT_L(n) asm volatile("s_waitcnt lgkmcnt(" #n ")" ::: "memory")
#define PG8_BAR __builtin_amdgcn_s_barrier()
#define PG8_SCHED __builtin_amdgcn_sched_barrier(0)
    Unit cur, nxt; int ui = 0;
    if (!S.next(0, cur)) return;
    f32x4 acc[2][2][4][2];
#pragma unroll
    for (int a = 0; a < 2; ++a)
#pragma unroll
        for (int b = 0; b < 2; ++b)
#pragma unroll
            for (int m = 0; m < 4; ++m)
#pragma unroll
                for (int n = 0; n < 2; ++n) acc[a][b][m][n] = zero4();
    bf16x8 At[4][2], B0[2][2], B1[2][2];
    const char* cA = (const char*)g.A + (size_t)cur.pm * tstep; const char* cB = (const char*)g.Bt + (size_t)cur.pn * tstep;
    S.a_ready(cur);
    if constexpr (SP2) {
        PG8_STAGE(PG8_SB(0, 0), cB, voffB); PG8_STAGE(PG8_SB(0, 1), cB + hstep, voffB); PG8_STAGE(PG8_SA(0, 0), cA, voffA); PG8_STAGE(PG8_SA(0, 1), cA + hstep, voffA);
        if (wr == 1) PG8_BAR;
        PG8_WAIT_V(2); PG8_BAR;
        PG8_STAGE(PG8_SB(1, 0), cB + kstep, voffB); PG8_STAGE(PG8_SA(1, 0), cA + kstep, voffA); PG8_STAGE(PG8_SB(1, 1), cB + hstep + kstep, voffB);
        PG8_WAIT_V(6); PG8_BAR;
    } else {
        PG8_STAGE(PG8_SB(0, 0), cB, voffB); PG8_STAGE(PG8_SA(0, 0), cA, voffA); PG8_STAGE(PG8_SB(0, 1), cB + hstep, voffB); PG8_STAGE(PG8_SA(0, 1), cA + hstep, voffA);
        if (wr == 1) PG8_BAR;
        PG8_WAIT_V(4); PG8_BAR;
        PG8_STAGE(PG8_SB(1, 0), cB + kstep, voffB); PG8_STAGE(PG8_SA(1, 0), cA + kstep, voffA); PG8_STAGE(PG8_SB(1, 1), cB + hstep + kstep, voffB);
        PG8_WAIT_V(6); PG8_BAR;
    }
    for (;;) {
        const bool has_next = S.next(ui + 1, nxt);
        const char* nA = has_next ? (const char*)g.A + (size_t)nxt.pm * tstep : cA; const char* nB = has_next ? (const char*)g.Bt + (size_t)nxt.pn * tstep : cB;
        for (int t = 0; t < nt; t += 2) {
            const bool last = (t == nt - 2);
            const char* a1 = cA + (size_t)(t + 1) * kstep;
            const char* a2 = last ? nA : cA + (size_t)(t + 2) * kstep; const char* b2 = last ? nB : cB + (size_t)(t + 2) * kstep;
            const char* a3 = a2 + kstep; const char* b3 = b2 + kstep;
            if (last && has_next) S.a_ready(nxt);
            if constexpr (SP2) {
            PG8_LDB(B0, 0, 0); PG8_LDB(B1, 0, 1); PG8_SCHED; PG8_LDA(At, 0, 0); PG8_STAGE(PG8_SA(1, 1), a1 + hstep, voffA);
            PG8_WAIT_V(8); PG8_WAIT_L(0); PG8_BAR; PG8_MMA(0, 0, At, B0); PG8_MMA(0, 1, At, B1); PG8_BAR; PG8_SCHED;
            PG8_LDA(At, 0, 1); PG8_STAGE(PG8_SB(0, 0), b2, voffB); PG8_STAGE(PG8_SB(0, 1), b2 + hstep, voffB); PG8_STAGE(PG8_SA(0, 0), a2, voffA);
            PG8_WAIT_V(8); PG8_WAIT_L(0); PG8_BAR; PG8_MMA(1, 0, At, B0); PG8_MMA(1, 1, At, B1); PG8_BAR; PG8_SCHED;
            PG8_LDB(B0, 1, 0); PG8_LDB(B1, 1, 1); PG8_SCHED; PG8_LDA(At, 1, 0); PG8_STAGE(PG8_SA(0, 1), a2 + hstep, voffA);
            PG8_WAIT_V(8); PG8_WAIT_L(0); PG8_BAR; PG8_MMA(0, 0, At, B0); PG8_MMA(0, 1, At, B1); PG8_BAR; PG8_SCHED;
            PG8_LDA(At, 1, 1); PG8_STAGE(PG8_SB(1, 0), b3, voffB); PG8_STAGE(PG8_SB(1, 1), b3 + hstep, voffB); PG8_STAGE(PG8_SA(1, 0), a3, voffA);
            PG8_WAIT_V(8); PG8_WAIT_L(0); PG8_BAR; PG8_MMA(1, 0, At, B0); PG8_MMA(1, 1, At, B1); PG8_BAR; PG8_SCHED;
            } else {
            PG8_LDB(B0, 0, 0); PG8_SCHED; PG8_LDA(At, 0, 0); PG8_STAGE(PG8_SA(1, 1), a1 + hstep, voffA);
            PG8_WAIT_L(8); PG8_BAR; PG8_WAIT_L(0); PG8_MMA(0, 0, At, B0); PG8_BAR; PG8_SCHED;
            PG8_LDB(B1, 0, 1); PG8_STAGE(PG8_SB(0, 0), b2, voffB);
            PG8_BAR; PG8_WAIT_L(0); PG8_MMA(0, 1, At, B1); PG8_BAR;
            PG8_LDA(At, 0, 1); PG8_STAGE(PG8_SA(0, 0), a2, voffA);
            PG8_BAR; PG8_WAIT_L(0); PG8_MMA(1, 0, At, B0); PG8_BAR; PG8_SCHED;
            PG8_STAGE(PG8_SB(0, 1), b2 + hstep, voffB);
            PG8_WAIT_V(6); PG8_BAR; PG8_MMA(1, 1, At, B1); PG8_BAR;
            PG8_LDB(B0, 1, 0); PG8_SCHED; PG8_LDA(At, 1, 0); PG8_STAGE(PG8_SA(0, 1), a2 + hstep, voffA);
            PG8_WAIT_L(8); PG8_BAR; PG8_WAIT_L(0); PG8_MMA(0, 0, At, B0); PG8_BAR; PG8_SCHED;
            PG8_LDB(B1, 1, 1); PG8_STAGE(PG8_SB(1, 0), b3, voffB);
            PG8_BAR; PG8_WAIT_L(0); PG8_MMA(0, 1, At, B1); PG8_BAR;
            PG8_LDA(At, 1, 1); PG8_STAGE(PG8_SA(1, 0), a3, voffA);
            PG8_BAR; PG8_WAIT_L(0); PG8_MMA(1, 0, At, B0); PG8_BAR; PG8_SCHED;
            PG8_STAGE(PG8_SB(1, 1), b3 + hstep, voffB);
            PG8_WAIT_V(6); PG8_BAR; PG8_MMA(1, 1, At, B1); PG8_BAR;
            }
        }
        if constexpr (ALIGN_EPI) { if (wr == 0) PG8_BAR; }
        if constexpr (!Epi::AFTER_DRAIN) { E(acc, cur, wr, wc, fr, fq); S.done(cur); }
        if (!has_next) break;
#pragma unroll
        for (int a = 0; a < 2; ++a)
#pragma unroll
            for (int b = 0; b < 2; ++b)
#pragma unroll
                for (int m = 0; m < 4; ++m)
#pragma unroll
                    for (int n = 0; n < 2; ++n) acc[a][b][m][n] = zero4();
        cur = nxt; cA = nA; cB = nB; ++ui;
        if constexpr (ALIGN_EPI) { if (wr == 1) PG8_BAR; }
    }
    PG8_WAIT_V(0);
    if constexpr (!ALIGN_EPI) { if (wr == 0) PG8_BAR; }
    PG8_BAR;
    if constexpr (Epi::AFTER_DRAIN) { E.fused(acc, cur, wr, wc, fr, fq, lds, wid, lane); S.done(cur); }
#undef PG8_SA
#undef PG8_SB
#undef PG8_STAGE
#undef PG8_LDA
#undef PG8_LDB
#undef PG8_MMA
#undef PG8_WAIT_V
#undef PG8_WAIT_L
#undef PG8_BAR
#undef PG8_SCHED
}
}

__device__ __forceinline__ int opaque(int v) { asm volatile("" : "+s"(v)); return v; }
__device__ __forceinline__ size_t kimg_off(int b, int h, int t, int d) { return ((((size_t)(b * 8 + h) * MW + (t >> 6)) * 8 + (d >> 3)) * 64 + (t & 63)) * 8 + (d & 7); }
__device__ __forceinline__ size_t vimg_off(int b, int h, int t, int d) { return ((((size_t)(b * 8 + h) * MW + (t >> 6)) * 2 + (d >> 5)) * 64 + (t & 63)) * 32 + (d & 31); }
__device__ __forceinline__ void store8bf(bf16_t* dst, const f32x4& a, const f32x4& b) {
    uint4 w; w.x = pk2(a[0], a[1]); w.y = pk2(a[2], a[3]); w.z = pk2(b[0], b[1]); w.w = pk2(b[2], b[3]);
    *(uint4*)dst = w;
}
__device__ __forceinline__ void store8bf_nt(bf16_t* dst, const f32x4& a, const f32x4& b) {
    u32x4_t w; w[0] = pk2(a[0], a[1]); w[1] = pk2(a[2], a[3]); w[2] = pk2(b[0], b[1]); w[3] = pk2(b[2], b[3]);
    __builtin_nontemporal_store(w, (u32x4_t*)dst);
}
__device__ __forceinline__ float xor16(float x, int lane16row) {
    const auto r = __builtin_amdgcn_permlane16_swap(__float_as_uint(x), __float_as_uint(x), false, false);
    return __uint_as_float((lane16row & 1) ? r[0] : r[1]);
}
__device__ __forceinline__ void rope8(f32x4& v0, f32x4& v1, const float* __restrict__ rope, int t, int fq) {
    const float* rp = rope + (size_t)t * 16;
#pragma unroll
    for (int j = 0; j < 4; ++j) {
        { const float x = v0[j]; const float pr = xor16(x, fq); const float c = rp[2 * j], sn = rp[2 * j + 1];
          v0[j] = (fq == 0) ? (x * c - pr * sn) : ((fq == 1) ? (x * c + pr * sn) : x); }
        { const float x = v1[j]; const float pr = xor16(x, fq); const float c = rp[2 * (4 + j)], sn = rp[2 * (4 + j) + 1];
          v1[j] = (fq == 0) ? (x * c - pr * sn) : ((fq == 1) ? (x * c + pr * sn) : x); }
    }
}
__device__ __forceinline__ void rope8r(f32x4& v0, f32x4& v1, const f32x4 (&rt)[4], int fq) {
#pragma unroll
    for (int j = 0; j < 4; ++j) {
        { const float x = v0[j]; const float pr = xor16(x, fq); const float c = rt[j >> 1][2 * (j & 1)], sn = rt[j >> 1][2 * (j & 1) + 1];
          v0[j] = (fq == 0) ? (x * c - pr * sn) : ((fq == 1) ? (x * c + pr * sn) : x); }
        { const float x = v1[j]; const float pr = xor16(x, fq); const float c = rt[2 + (j >> 1)][2 * (j & 1)], sn = rt[2 + (j >> 1)][2 * (j & 1) + 1];
          v1[j] = (fq == 0) ? (x * c - pr * sn) : ((fq == 1) ? (x * c + pr * sn) : x); }
    }
}
struct EpiInProj {
    static constexpr bool PERM = true, AFTER_DRAIN = false;
    template <int BJ> __device__ __forceinline__ void part(const f32x4 (&acc)[2][2][4][2], const pg8::Unit& u, int wr, int wc, int fr, int fq) const {
        KParams kpe = (KParams)__builtin_amdgcn_kernarg_segment_ptr(); asm volatile("" : "+s"(kpe));
        unsigned char* ws = kpe->ws; const float* rope = (const float*)(ws + OFF_ROPE);
        const int cb = 256 * u.pn + 128 * BJ + 32 * wc;
        const int cg64 = cb >> 6, hf = wc & 1;
        const int cig = hf * 32 + 8 * fq;
        if (cg64 >= 78) return;
        if (cg64 < 45) {
            size_t off; int pitch = 512, hd = 0; float scl = 1.0f; bool rp = false;
            if (cg64 < 8) { off = OFF_QA; hd = cg64; scl = QSCALE; rp = true; }
            else if (cg64 < 12) { off = OFF_CKV; pitch = 256; hd = cg64 - 8; }
            else if (cg64 < 20) { off = OFF_QI; hd = cg64 - 12; scl = 0.125f; rp = true; }
            else if (cg64 == 20) { off = OFF_KI; pitch = 64; rp = true; }
            else if (cg64 < 29) { off = OFF_QF; hd = cg64 - 21; scl = QSCALE; }
            else if (cg64 < 37) { off = OFF_KF; hd = cg64 - 29; }
            else { off = OFF_VF; hd = cg64 - 37; }
            bf16_t* base = (bf16_t*)(ws + off) + hd * 64 + cig;
            rp = rp && (hf == 0);
#pragma unroll
            for (int ai = 0; ai < 2; ++ai) {
                f32x4 rt[2][4];
#pragma unroll
                for (int m = 0; m < 4; ++m) {
                    const int n = 256 * u.pm + 128 * ai + 64 * wr + 16 * m + fr;
                    const int b = n / SEQ, t = NMETA + n % SEQ, r = b * TP + t;
                    f32x4 v0 = acc[ai][BJ][m][0], v1 = acc[ai][BJ][m][1];
                    if (rp && (m & 1) == 0) {
#pragma unroll
                        for (int mm = 0; mm < 2; ++mm)
#pragma unroll
                            for (int q = 0; q < 4; ++q) rt[mm][q] = *(const f32x4*)(rope + (size_t)(t + 16 * mm) * 16 + 4 * q);
                    }
                    if (rp) rope8r(v0, v1, rt[m & 1], fq);
                    if (cg64 == 20) {
                        store8bf((bf16_t*)(ws + OFF_KI) + ((size_t)((b * (TP / 16) + (t >> 4)) * 2 + hf) * 64 + fq * 16 + (t & 15)) * 8, v0, v1);
                    } else
                    store8bf(base + (size_t)((cg64 >= 8 && cg64 < 12) ? n : r) * pitch, v0 * scl, v1 * scl);
                    asm volatile("" ::: "memory");
                }
            }
        } else if (cg64 < 77) {
            bf16_t* gates = (bf16_t*)kpe->out + (cg64 - 45) * 64 + cig;
#pragma unroll
            for (int ai = 0; ai < 2; ++ai)
#pragma unroll
                for (int m = 0; m < 4; ++m) {
                    const int n = 256 * u.pm + 128 * ai + 64 * wr + 16 * m + fr;
                    {
                        f32x4 v0 = acc[ai][BJ][m][0], v1 = acc[ai][BJ][m][1];
#pragma unroll
                        for (int j = 0; j < 4; ++j) { v0[j] = sigmoidf_(v0[j]); v1[j] = sigmoidf_(v1[j]); }
                        store8bf_nt(gates + (size_t)n * 2048, v0, v1);
                    }
                }
        } else if (hf == 0 && fq < 2) {
            float* WIo = (float*)(ws + OFF_WI); float* LOGF = (float*)(ws + OFF_LOGF); const float* bfg = kpe->in[5];
#pragma unroll
            for (int ai = 0; ai < 2; ++ai)
#pragma unroll
                for (int m = 0; m < 4; ++m) {
                    const int n = 256 * u.pm + 128 * ai + 64 * wr + 16 * m + fr;
                    const int r = (n / SEQ) * TP + NMETA + n % SEQ;
                    const f32x4 v0 = acc[ai][BJ][m][0], v1 = acc[ai][BJ][m][1];
                    if (fq == 0) {
                        *(f32x4*)(WIo + (size_t)r * 8) = v0 * 0.3535533905932738f; *(f32x4*)(WIo + (size_t)r * 8 + 4) = v1 * 0.3535533905932738f;
                    } else {
                        f32x4 o0, o1;
#pragma unroll
                        for (int j = 0; j < 4; ++j) {
                            const float z0 = v0[j] + bfg[j], z1 = v1[j] + bfg[4 + j];
                            o0[j] = fminf(z0, 0.f) - __logf(1.0f + __expf(-fabsf(z0)));
                            o1[j] = fminf(z1, 0.f) - __logf(1.0f + __expf(-fabsf(z1)));
                        }
                        float* lt = LOGF + (size_t)(n / SEQ) * 8 * TP + (NMETA + n % SEQ);
#pragma unroll
                        for (int j = 0; j < 4; ++j) { lt[(size_t)j * TP] = o0[j]; lt[(size_t)(4 + j) * TP] = o1[j]; }
                    }
                }
        }
    }
    __device__ __forceinline__ void operator()(const f32x4 (&acc)[2][2][4][2], const pg8::Unit& u, int wr, int wc, int fr, int fq) const {
        asm volatile("" : "+v"(fr), "+v"(fq));
        part<0>(acc, u, wr, wc, fr, fq); part<1>(acc, u, wr, wc, fr, fq);
    }
};
struct EpiKvUp {
    static constexpr bool PERM = true, AFTER_DRAIN = false;
    const PG8_LAS float* rs; const PG8_LAS int* tag;
    template <int BJ> __device__ __forceinline__ void part(const f32x4 (&acc)[2][2][4][2], const pg8::Unit& u, const PG8_LAS float* rsu, int wr, int wc, int fr, int fq) const {
        KParams kpe = (KParams)__builtin_amdgcn_kernarg_segment_ptr(); asm volatile("" : "+s"(kpe));
        unsigned char* ws = kpe->ws; const float* rope = (const float*)(ws + OFF_ROPE);
        const int cb = 256 * u.pn + 128 * BJ + 32 * wc;
        const int cg64 = cb >> 6, hf = wc & 1, cig = hf * 32 + 8 * fq;
        const bool isk = cg64 < 8, rp = isk && (hf == 0);
        bf16_t* base = (bf16_t*)(ws + (isk ? OFF_KA : OFF_VA)) + (isk ? cg64 : cg64 - 8) * 64 + cig;
#pragma unroll
        for (int ai = 0; ai < 2; ++ai)
#pragma unroll
            for (int m = 0; m < 4; ++m) {
                const int rl = 128 * ai + 64 * wr + 16 * m + fr;
                const int n = 256 * u.pm + rl, t = NMETA + n % SEQ, r = (n / SEQ) * TP + t;
                const float rstd = rsu[rl];
                f32x4 v0 = acc[ai][BJ][m][0] * rstd, v1 = acc[ai][BJ][m][1] * rstd;
                if (rp) rope8(v0, v1, rope, t, fq);
                store8bf((bf16_t*)(ws + (isk ? OFF_KA : OFF_VA)) + (isk ? kimg_off(n / SEQ, cg64, t, cig) : vimg_off(n / SEQ, cg64 - 8, t, cig)), v0, v1);
                asm volatile("" ::: "memory");
            }
    }
    __device__ __forceinline__ void operator()(const f32x4 (&acc)[2][2][4][2], const pg8::Unit& u, int wr, int wc, int fr, int fq) const {
        asm volatile("" : "+v"(fr), "+v"(fq));
        const PG8_LAS float* rsu = (tag[0] == u.pm) ? rs : rs + 256;
        part<0>(acc, u, rsu, wr, wc, fr, fq); part<1>(acc, u, rsu, wr, wc, fr, fq);
    }
};
#ifndef MGB
#define MGB 4
#endif
template <int PASS> struct EpiMerge {
    static constexpr bool PERM = true, AFTER_DRAIN = false;
    __device__ __forceinline__ void operator()(const f32x4 (&acc)[2][2][4][2], const pg8::Unit& u, int wr, int wc, int fr, int fq) const {
        asm volatile("" : "+v"(fr), "+v"(fq));
        KParams kpe = (KParams)__builtin_amdgcn_kernarg_segment_ptr(); asm volatile("" : "+s"(kpe));
        bf16_t* merged = (bf16_t*)(kpe->ws + OFF_MERGED); const bf16_t* gates = (const bf16_t*)kpe->out;
#pragma unroll
        for (int bj = 0; bj < 2; ++bj) {
            const int c = 256 * u.pn + 128 * bj + 32 * wc + 8 * fq;
            const size_t n0 = (size_t)(256 * u.pm + 64 * wr + fr);
#pragma unroll
            for (int i0 = 0; i0 < 8; i0 += MGB) {
                uint4 g[MGB], o[MGB];
#pragma unroll
                for (int i = 0; i < MGB; ++i) g[i] = ntload_u4(gates + (n0 + 128 * ((i0 + i) >> 2) + 16 * ((i0 + i) & 3)) * 2048 + PASS * 1024 + c);
                if (PASS == 1) {
#pragma unroll
                    for (int i = 0; i < MGB; ++i) o[i] = *(const uint4*)(merged + (n0 + 128 * ((i0 + i) >> 2) + 16 * ((i0 + i) & 3)) * 1024 + c);
                }
#pragma unroll
                for (int i = 0; i < MGB; ++i) {
                    const int ii = i0 + i;
                    f32x4 v0 = acc[ii >> 2][bj][ii & 3][0], v1 = acc[ii >> 2][bj][ii & 3][1];
                    v0 = v0 * (f32x4){bf2f(g[i].x & 0xffffu), bf2f(g[i].x >> 16), bf2f(g[i].y & 0xffffu), bf2f(g[i].y >> 16)};
                    v1 = v1 * (f32x4){bf2f(g[i].z & 0xffffu), bf2f(g[i].z >> 16), bf2f(g[i].w & 0xffffu), bf2f(g[i].w >> 16)};
                    if (PASS == 1) {
                        v0 = v0 + (f32x4){bf2f(o[i].x & 0xffffu), bf2f(o[i].x >> 16), bf2f(o[i].y & 0xffffu), bf2f(o[i].y >> 16)};
                        v1 = v1 + (f32x4){bf2f(o[i].z & 0xffffu), bf2f(o[i].z >> 16), bf2f(o[i].w & 0xffffu), bf2f(o[i].w >> 16)};
                    }
                    store8bf(merged + (n0 + 128 * (ii >> 2) + 16 * (ii & 3)) * 1024 + c, v0, v1);
                }
                asm volatile("" ::: "memory");
            }
        }
    }
};
struct EpiOutProj {
    static constexpr bool PERM = true, AFTER_DRAIN = false;
    __device__ __forceinline__ void operator()(const f32x4 (&acc)[2][2][4][2], const pg8::Unit& u, int wr, int wc, int fr, int fq) const {
        asm volatile("" : "+v"(fr), "+v"(fq));
        KParams kpe = (KParams)__builtin_amdgcn_kernarg_segment_ptr(); asm volatile("" : "+s"(kpe));
        const float* x = kpe->in[0]; const float* g0 = kpe->in[2]; const float* b0 = kpe->in[3]; float* out = kpe->out;
        const float* stat0 = (const float*)(kpe->ws + OFF_STAT0);
        const int c0 = 256 * u.pn + 32 * wc + 8 * fq;
        f32x4 gg[4], bb[4];
#pragma unroll
        for (int q = 0; q < 4; ++q) { gg[q] = *(const f32x4*)(g0 + c0 + 128 * (q >> 1) + 4 * (q & 1)) * ALPHA; bb[q] = *(const f32x4*)(b0 + c0 + 128 * (q >> 1) + 4 * (q & 1)) * ALPHA; }
#pragma unroll
        for (int rp = 0; rp < 4; ++rp) {
            f32x2 st[2]; f32x4 xv[2][4]; int nn_[2];
#pragma unroll
            for (int mm = 0; mm < 2; ++mm) {
                const int n = 256 * u.pm + 128 * (rp >> 1) + 64 * wr + 16 * ((rp & 1) * 2 + mm) + fr;
                nn_[mm] = n;
                st[mm] = *(const f32x2*)(stat0 + 2 * ((n / SEQ) * TP + NMETA + n % SEQ));
#pragma unroll
                for (int q = 0; q < 4; ++q) xv[mm][q] = __builtin_nontemporal_load((const f32x4*)(x + (size_t)n * 1024 + c0 + 128 * (q >> 1) + 4 * (q & 1)));
            }
#pragma unroll
            for (int mm = 0; mm < 2; ++mm) {
                const float mu = st[mm][0], rstd = st[mm][1];
#pragma unroll
                for (int q = 0; q < 4; ++q)
                    *(f32x4*)(out + (size_t)nn_[mm] * 1024 + c0 + 128 * (q >> 1) + 4 * (q & 1)) = (xv[mm][q] - mu) * rstd * gg[q] + bb[q] + acc[rp >> 1][q >> 1][(rp & 1) * 2 + mm][q & 1];
            }
        }
    }
};
struct EpiMoeDown {
    static constexpr bool PERM = true, AFTER_DRAIN = false;
    const PG8_LAS int* tab;
    __device__ __forceinline__ void operator()(const f32x4 (&acc)[2][2][4][2], const pg8::Unit& u, int wr, int wc, int fr, int fq) const {
        asm volatile("" : "+v"(fr), "+v"(fq));
        KParams kpe = (KParams)__builtin_amdgcn_kernarg_segment_ptr(); asm volatile("" : "+s"(kpe));
        unsigned char* ws = kpe->ws;
        const int* TOKL = (const int*)(ws + OFF_TOKL); const float* GW = (const float*)(ws + OFF_GW); bf16_t* SLOT = (bf16_t*)(ws + OFF_SLOT);
        const int e = u.pn >> 2, cnt = tab[e], pos0 = (u.pm - (tab[64 + e] >> 8)) * 256;
        const int cb = 256 * (u.pn & 3) + 32 * wc + 8 * fq;
        int aid[8]; float gw[8];
#pragma unroll
        for (int i = 0; i < 8; ++i) { const int pos = pos0 + 128 * (i >> 2) + 64 * wr + 16 * (i & 3) + fr; aid[i] = TOKL[e * 32768 + (pos < cnt ? pos : cnt - 1)]; }
#pragma unroll
        for (int i = 0; i < 8; ++i) gw[i] = GW[aid[i]];
#pragma unroll
        for (int ai = 0; ai < 2; ++ai)
#pragma unroll
            for (int m = 0; m < 4; ++m) {
                const int pos = pos0 + 128 * ai + 64 * wr + 16 * m + fr;
                if (pos < cnt) {
                    const float g = gw[ai * 4 + m];
                    bf16_t* dst = SLOT + (size_t)aid[ai * 4 + m] * 1024 + cb;
                    store8bf(dst, acc[ai][0][m][0] * g, acc[ai][0][m][1] * g);
                    store8bf(dst + 128, acc[ai][1][m][0] * g, acc[ai][1][m][1] * g);
                }
            }
    }
};
struct EpiAny {
    static constexpr bool PERM = true, AFTER_DRAIN = false;
    int kind; const PG8_LAS float* rs; const PG8_LAS int* tag;
    __device__ __forceinline__ void operator()(const f32x4 (&acc)[2][2][4][2], const pg8::Unit& u, int wr, int wc, int fr, int fq) const {
        if (kind == 0) { EpiInProj e{}; e(acc, u, wr, wc, fr, fq); }
        else if (kind == 1) { EpiKvUp e{rs, tag}; e(acc, u, wr, wc, fr, fq); }
        else if (kind == 2) { EpiMerge<0> e{}; e(acc, u, wr, wc, fr, fq); }
        else if (kind == 3) { EpiMerge<1> e{}; e(acc, u, wr, wc, fr, fq); }
        else if (kind == 4) { EpiOutProj e{}; e(acc, u, wr, wc, fr, fq); }
        else { EpiMoeDown e{tag}; e(acc, u, wr, wc, fr, fq); }
    }
};

template <int POS> __device__ __forceinline__ unsigned bitmask1(int m) { int r; asm("v_bfe_i32 %0, %1, %2, 1" : "=v"(r) : "v"(m), "n"(POS)); return (unsigned)r; }
typedef short s16x4 __attribute__((ext_vector_type(4)));
__device__ __forceinline__ s16x4 vtr16(const unsigned char* p) {
    return __builtin_bit_cast(s16x4, __builtin_amdgcn_ds_read_tr16_b64_v4i16((__attribute__((address_space(3))) s16x4*)p));
}
constexpr int AT_VP = 192;
constexpr int AT_K = 0, AT_V = 8192, AT_C = 8192 + 64 * AT_VP, AT_BUF = 8192 + 64 * AT_VP + 256;
template <bool FOX>
__device__ void attn_item(unsigned char* ws, int b, int h, int qb, unsigned char* smem) {
    constexpr int mode = 0;
    const bf16_t* Q = (const bf16_t*)(ws + (FOX ? OFF_QF : OFF_QA));
    bf16_t* Y = (bf16_t*)(ws + (FOX ? OFF_YF : OFF_YA));
    const bf16_t* Kg = (const bf16_t*)(ws + (FOX ? OFF_KF : OFF_KA));
    const bf16_t* Vt = (const bf16_t*)(ws + (FOX ? OFF_VF : OFF_VA));
    const float* cum = (const float*)(ws + OFF_CUM);
    const unsigned long long* mask = (const unsigned long long*)(ws + OFF_MASK);
    const int tid = ltid(), lane = tid & 63, wave = __builtin_amdgcn_readfirstlane(tid >> 6), hlf = lane >> 5;
    const int q0w = qb * 256 + wave * 32;
    const int qrow = q0w + (lane & 31);
    const size_t grow = (size_t)b * TP + qrow;
    const bool wave_on = q0w < T;
    bf16x8 qf[4];
#pragma unroll
    for (int ks = 0; ks < 4; ++ks) qf[ks] = *(const bf16x8*)(Q + grow * 512 + h * 64 + ks * 16 + hlf * 8);
    const int nkt = qb * 4 + 4;
    int kt0 = 0;
    if (FOX) {
        const float* knorm = (const float*)(ws + OFF_KNORM) + (size_t)(b * 8 + h) * MW;
        float* red = (float*)(smem + 2 * AT_BUF);
        float qq = 0.f;
#pragma unroll
        for (int ks = 0; ks < 4; ++ks)
#pragma unroll
            for (int e = 0; e < 8; ++e) { const float v = bf2f((unsigned)(unsigned short)qf[ks][e]); qq = fmaf(v, v, qq); }
        qq += __shfl_xor(qq, 32);
#pragma unroll
        for (int o = 1; o < 32; o <<= 1) qq = fmaxf(qq, __shfl_xor(qq, o));
        if (lane == 0) red[wave] = qq;
        __syncthreads();
        if (wave == 0) {
            float qm = red[0];
#pragma unroll
            for (int w = 1; w < 8; ++w) qm = fmaxf(qm, red[w]);
            const float Qn = sqrtf(qm) * 1.0001f;
            const float Kd = fmaxf(fmaxf(knorm[qb * 4], knorm[qb * 4 + 1]), fmaxf(knorm[qb * 4 + 2], knorm[qb * 4 + 3])) * 1.0001f;
            const float cfirst = cum[((size_t)b * TP + qb * 256) * 8 + h];
            bool keep0 = true, keep1 = true;
            if (lane < qb * 4) { const float bnd = Qn * (knorm[lane] * 1.0001f + Kd) + cfirst - cum[((size_t)b * TP + lane * 64 + 63) * 8 + h]; keep0 = !(bnd < -40.0f); }
            if (lane + 64 < qb * 4) { const float bnd = Qn * (knorm[lane + 64] * 1.0001f + Kd) + cfirst - cum[((size_t)b * TP + (lane + 64) * 64 + 63) * 8 + h]; keep1 = !(bnd < -40.0f); }
            const unsigned long long b0 = __ballot(keep0), b1 = __ballot(keep1);
            const int first = b0 ? (int)__builtin_ctzll(b0) : (b1 ? 64 + (int)__builtin_ctzll(b1) : 128);
            if (lane == 0) ((int*)red)[8] = first < qb * 4 ? first : qb * 4;
        }
        __syncthreads();
        kt0 = ((const int*)red)[8];
    }
    const int my_last = qb * 4 + (wave >> 1);
    f32x16 o0, o1;
#pragma unroll
    for (int i = 0; i < 16; ++i) { o0[i] = 0.f; o1[i] = 0.f; }
    float m_run = -1e30f, l_run = 0.f;
    const int skey = tid >> 3, sc = tid & 7;
    const bf16_t* kp = Kg + ((size_t)b * TP + skey) * 512 + h * 64 + sc * 8;
    const bf16_t* vp = Vt + ((size_t)b * TP + skey) * 512 + h * 64 + sc * 8;
    const int kw_off = skey * 128 + ((sc ^ ((skey >> 1) & 7)) * 16);
    const int vw_off = skey * AT_VP + sc * 16;
    uint4 rk = *(const uint4*)(kp + (size_t)kt0 * 64 * 512), rv = *(const uint4*)(vp + (size_t)kt0 * 64 * 512);
    float rc = 0.f;
    if (FOX && tid < 64) rc = cum[((size_t)b * TP + kt0 * 64 + tid) * 8 + h];
    unsigned long long mw = 0ull, mw_next = 0ull;
    if (!FOX) mw_next = mask[grow * MW + 0];
    for (int kt = kt0; kt < nkt; ++kt) {
        unsigned char* sb = smem + (kt & 1) * AT_BUF;
        if (mode != 3) {
        *(uint4*)(sb + AT_K + kw_off) = rk;
        *(uint4*)(sb + AT_V + vw_off) = rv;
        if (FOX && tid < 64) *(float*)(sb + AT_C + tid * 4) = rc;
        }
        mw = mw_next;
        if (mode != 3) __syncthreads();
        if (kt + 1 < nkt) {
            rk = *(const uint4*)(kp + (size_t)(kt + 1) * 64 * 512);
            rv = *(const uint4*)(vp + (size_t)(kt + 1) * 64 * 512);
            if (FOX && tid < 64) rc = cum[((size_t)b * TP + (kt + 1) * 64 + tid) * 8 + h];
            if (!FOX) mw_next = mask[grow * MW + kt + 1];
        }
        if (wave_on && kt <= my_last) {
            const bf16_t* Ks = (const bf16_t*)(sb + AT_K);
            const unsigned char* Vs = sb + AT_V;
            const float* Cs = (const float*)(sb + AT_C);
            f32x16 st[2];
#pragma unroll
            for (int sub = 0; sub < 2; ++sub) {
#pragma unroll
                for (int i = 0; i < 16; ++i) st[sub][i] = 0.f;
                const int krow = sub * 32 + (lane & 31);
                if (mode != 4)
#pragma unroll
                for (int ks = 0; ks < 4; ++ks) {
                    const bf16x8 kf = *(const bf16x8*)(Ks + krow * 64 + (((ks * 2 + hlf) ^ ((krow >> 1) & 7)) * 8));
                    st[sub] = __builtin_amdgcn_mfma_f32_32x32x16_bf16(kf, qf[ks], st[sub], 0, 0, 0);
                }
            }
            const bool diag = (kt == my_last);
            const int kbase = kt * 64 + 4 * hlf;
            float mx = -3.0e38f;
            if (FOX) {
#pragma unroll
                for (int sub = 0; sub < 2; ++sub)
#pragma unroll
                    for (int g = 0; g < 4; ++g) {
                        const f32x4 ck4 = *(const f32x4*)(Cs + sub * 32 + 8 * g + 4 * hlf);
#pragma unroll
                        for (int j = 0; j < 4; ++j) st[sub][g * 4 + j] -= ck4[j];
                    }
                if (diag) {
#pragma unroll
                    for (int sub = 0; sub < 2; ++sub)
#pragma unroll
                        for (int g = 0; g < 4; ++g)
#pragma unroll
                            for (int j = 0; j < 4; ++j) { const int key = kbase + sub * 32 + 8 * g + j; st[sub][g * 4 + j] = (key <= qrow) ? st[sub][g * 4 + j] : -3.0e38f; }
                }
            }
#pragma unroll
            for (int sub = 0; sub < 2; ++sub)
#pragma unroll
                for (int i = 0; i < 16; ++i) mx = fmaxf(mx, st[sub][i]);
            mx = fmaxf(mx, __shfl_xor(mx, 32));
            const float m_new = fmaxf(m_run, mx);
            const float alpha = __builtin_amdgcn_exp2f(m_run - m_new);
            m_run = m_new;
            float ls = 0.f;
            bf16x8 pf[2][2];
            {
                const int mb0 = (int)(unsigned)(mw >> (4 * hlf)), mb1 = (int)(unsigned)(mw >> (32 + 4 * hlf));
                unsigned pw[2][2][4];
#define ATT_PAIR(SUB, S2, J, MB) do { constexpr int r0_ = 8 * (S2) + (J), r1_ = r0_ + 1; \
                    float p0 = st[SUB][r0_], p1 = st[SUB][r1_]; \
                    if (mode != 5) { p0 = __builtin_amdgcn_exp2f(p0 - m_new); p1 = __builtin_amdgcn_exp2f(p1 - m_new); } \
                    if (!FOX && mode != 5) { p0 = __uint_as_float(__float_as_uint(p0) & bitmask1<8 * (r0_ >> 2) + (r0_ & 3)>(MB)); \
                                             p1 = __uint_as_float(__float_as_uint(p1) & bitmask1<8 * (r1_ >> 2) + (r1_ & 3)>(MB)); } \
                    ls += p0 + p1; pw[SUB][S2][(J) >> 1] = pk2(p0, p1); } while (0)
#define ATT_QUAD(SUB, S2, MB) ATT_PAIR(SUB, S2, 0, MB); ATT_PAIR(SUB, S2, 2, MB); ATT_PAIR(SUB, S2, 4, MB); ATT_PAIR(SUB, S2, 6, MB)
                ATT_QUAD(0, 0, mb0); ATT_QUAD(0, 1, mb0); ATT_QUAD(1, 0, mb1); ATT_QUAD(1, 1, mb1);
#undef ATT_QUAD
#undef ATT_PAIR
#pragma unroll
                for (int sub = 0; sub < 2; ++sub)
#pragma unroll
                    for (int s2 = 0; s2 < 2; ++s2) { uint4 t4 = make_uint4(pw[sub][s2][0], pw[sub][s2][1], pw[sub][s2][2], pw[sub][s2][3]); pf[sub][s2] = *(bf16x8*)&t4; }
            }
            l_run = l_run * alpha + ls;
            if (mode == 2) { asm volatile("" :: "v"(pf[0][0]), "v"(pf[0][1]), "v"(pf[1][0]), "v"(pf[1][1])); }
            else {
#pragma unroll
            for (int i = 0; i < 16; ++i) { o0[i] *= alpha; o1[i] *= alpha; }
#pragma unroll
            for (int sub = 0; sub < 2; ++sub)
#pragma unroll
                for (int s2 = 0; s2 < 2; ++s2) {
                    const int key0 = sub * 32 + 16 * s2 + 4 * hlf;
                    const unsigned char* vr = Vs + (key0 + ((lane & 15) >> 2)) * AT_VP + (16 * ((lane >> 4) & 1) + 4 * (lane & 3)) * 2;
                    {
                        const s16x4 a = vtr16(vr), c = vtr16(vr + 8 * AT_VP);
                        const bf16x8 vf = (bf16x8){a[0], a[1], a[2], a[3], c[0], c[1], c[2], c[3]};
                        o0 = __builtin_amdgcn_mfma_f32_32x32x16_bf16(vf, pf[sub][s2], o0, 0, 0, 0);
                    }
                    {
                        const s16x4 a = vtr16(vr + 64), c = vtr16(vr + 64 + 8 * AT_VP);
                        const bf16x8 vf = (bf16x8){a[0], a[1], a[2], a[3], c[0], c[1], c[2], c[3]};
                        o1 = __builtin_amdgcn_mfma_f32_32x32x16_bf16(vf, pf[sub][s2], o1, 0, 0, 0);
                    }
                }
            }
        }
    }
    __syncthreads();
    if (wave_on) {
        const float lt = l_run + __shfl_xor(l_run, 32);
        const float inv = 1.0f / lt;
        if (qrow >= NMETA && qrow < T && mode == 0) {
            bf16_t* yo = Y + ((size_t)b * SEQ + (qrow - NMETA)) * 512 + h * 64;
#pragma unroll
            for (int g = 0; g < 4; ++g) {
                const int d = 8 * g + 4 * hlf;
                store4bf(yo + d, (f32x4){o0[4 * g] * inv, o0[4 * g + 1] * inv, o0[4 * g + 2] * inv, o0[4 * g + 3] * inv});
                store4bf(yo + 32 + d, (f32x4){o1[4 * g] * inv, o1[4 * g + 1] * inv, o1[4 * g + 2] * inv, o1[4 * g + 3] * inv});
            }
        }
    }
}

namespace ab {
using bf16=__hip_bfloat16;
using bf16x8=__attribute__((ext_vector_type(8)))short;
using s16x4=__attribute__((ext_vector_type(4)))short;
using f32x16=__attribute__((ext_vector_type(16)))float;
using u32x4=__attribute__((ext_vector_type(4)))unsigned;
constexpr int BATCH=2,NHEAD=8,SEQ=8448  ,D=64,DM=NHEAD*D;
constexpr int NW=8,QBLK=32,QB=QBLK*NW,KVBLK=64,NQB=SEQ/QB;
constexpr int ATTN_PITCH=DM, ATTN_UNIT_ROWS=QB;
__device__ __forceinline__ int crow(int r,int hi){return (r&3)+8*(r>>2)+4*hi;}
#define SBAR() __builtin_amdgcn_sched_barrier(0)
__device__ __forceinline__ void cmask(f32x16&p0,f32x16&p1,int jb,int qrel,int hi){
  const float NEG=-INFINITY; int kb=64*jb+4*hi;
  #pragma unroll
  for(int r=0;r<16;++r){int kv=kb+(r&3)+8*(r>>2); if(kv>qrel)p0[r]=NEG; if(kv+32>qrel)p1[r]=NEG;}
}

constexpr int NSLOT=3, SLOTB=8192;
constexpr int LDS_K=0, LDS_V=NSLOT*SLOTB, LDS_WS=2*NSLOT*SLOTB, LDS_OST=LDS_WS+NW*64*4, LDS_BYTES=LDS_OST+NW*4096;
constexpr float C2=0.125f*1.4426950408889634f;
__device__ __forceinline__ void glds16(const void*gsrc,unsigned lds_dst){unsigned keep;
  asm volatile("s_mov_b32 %0, m0\n\ts_mov_b32 m0, %2\n\ts_nop 0\n\tglobal_load_lds_dwordx4 %1, off\n\ts_mov_b32 m0, %0":"=&s"(keep):"v"(gsrc),"s"(lds_dst):"memory");}
__device__ __forceinline__ float max3f(float a,float b,float c){float r;asm("v_max3_f32 %0, %1, %2, %3":"=v"(r):"v"(a),"v"(b),"v"(c));return r;}
__device__ __forceinline__ float max2f(float a,float b){float r;asm("v_max_f32_e32 %0, %1, %2":"=v"(r):"v"(a),"v"(b));return r;}
__device__ __forceinline__ float fadd_s(float a,float b){float r;asm("v_add_f32_e32 %0, %1, %2":"=v"(r):"v"(a),"v"(b));return r;}
__device__ __forceinline__ float fsub_s(float a,float b){float r;asm("v_sub_f32_e32 %0, %1, %2":"=v"(r):"v"(a),"v"(b));return r;}
typedef float f32x2_t __attribute__((ext_vector_type(2))); typedef __bf16 bf16x2_t __attribute__((ext_vector_type(2)));
__device__ __forceinline__ unsigned cvtpk_s(float lo,float hi){f32x2_t v={lo,hi};bf16x2_t b=__builtin_convertvector(v,bf16x2_t);return __builtin_bit_cast(unsigned,b);}
#define WAIT_BAR(N) asm volatile("s_waitcnt vmcnt(" #N ") lgkmcnt(0)\n\ts_barrier":::"memory")

__device__ __forceinline__ void qkt(f32x16&p0,f32x16&p1,const char*Kslot,const bf16x8*qr,const f32x16&negm,int r32,int hi){
  const char*kb=Kslot+hi*1024+r32*16;
  #pragma unroll
  for(int d0=0;d0<4;++d0){
    const bf16x8 b0=*reinterpret_cast<const bf16x8*>(kb+d0*2048);
    const bf16x8 b1=*reinterpret_cast<const bf16x8*>(kb+d0*2048+512);
    if(d0==0){p0=__builtin_amdgcn_mfma_f32_32x32x16_bf16(b0,qr[0],negm,0,0,0);p1=__builtin_amdgcn_mfma_f32_32x32x16_bf16(b1,qr[0],negm,0,0,0);}
    else{p0=__builtin_amdgcn_mfma_f32_32x32x16_bf16(b0,qr[d0],p0,0,0,0);p1=__builtin_amdgcn_mfma_f32_32x32x16_bf16(b1,qr[d0],p1,0,0,0);}}
}
typedef __attribute__((address_space(3))) const char* lds_cptr;
typedef short v4i16_t __attribute__((ext_vector_type(4)));
__device__ __forceinline__ void kload8(bf16x8*kf,lds_cptr kp){
  kf[0]=*(const __attribute__((address_space(3))) bf16x8*)(kp);      kf[1]=*(const __attribute__((address_space(3))) bf16x8*)(kp+512);
  kf[2]=*(const __attribute__((address_space(3))) bf16x8*)(kp+2048); kf[3]=*(const __attribute__((address_space(3))) bf16x8*)(kp+2560);
  kf[4]=*(const __attribute__((address_space(3))) bf16x8*)(kp+4096); kf[5]=*(const __attribute__((address_space(3))) bf16x8*)(kp+4608);
  kf[6]=*(const __attribute__((address_space(3))) bf16x8*)(kp+6144); kf[7]=*(const __attribute__((address_space(3))) bf16x8*)(kp+6656);
}
__device__ __forceinline__ void kload2(bf16x8*kf,lds_cptr kp,int j){ kf[2*j]=*(const __attribute__((address_space(3))) bf16x8*)(kp+j*2048); kf[2*j+1]=*(const __attribute__((address_space(3))) bf16x8*)(kp+j*2048+512); }
__device__ __forceinline__ s16x4 vtr(lds_cptr p){ return __builtin_bit_cast(s16x4,__builtin_amdgcn_ds_read_tr16_b64_v4i16((__attribute__((address_space(3))) v4i16_t*)p)); }
__device__ __forceinline__ float rowmax(const f32x16&p0,const f32x16&p1){
  float a=max3f(p0[0],p0[1],p1[0]),b=max3f(p0[2],p0[3],p1[1]);a=max3f(a,p1[2],p1[3]);
  #pragma unroll
  for(int r=4;r<16;r+=4){a=max3f(a,p0[r],p0[r+1]);b=max3f(b,p0[r+2],p0[r+3]);a=max3f(a,p1[r],p1[r+1]);b=max3f(b,p1[r+2],p1[r+3]);}
  const float m=max2f(a,b);
  auto rr=__builtin_amdgcn_permlane32_swap(__float_as_uint(m),__float_as_uint(m),false,false);
  return max2f(__uint_as_float(rr[0]),__uint_as_float(rr[1]));
}
__device__ __forceinline__ void pv(f32x16*o,int vb,bf16x8 pa0,bf16x8 pa1,bf16x8 pa2,bf16x8 pa3){
  #pragma unroll
  for(int d0=0;d0<2;++d0){s16x4 lo[4],hi[4];
    #pragma unroll
    for(int ks=0;ks<4;++ks){
      asm volatile("ds_read_b64_tr_b16 %0,%1 offset:%c2":"=&v"(lo[ks]):"v"(vb),"i"(d0*4096+ks*1024):"memory");
      asm volatile("ds_read_b64_tr_b16 %0,%1 offset:%c2":"=&v"(hi[ks]):"v"(vb),"i"(d0*4096+ks*1024+512):"memory");}
    asm volatile("s_waitcnt lgkmcnt(0)":::"memory");SBAR();
    #define PK(k) (bf16x8){lo[k][0],lo[k][1],lo[k][2],lo[k][3],hi[k][0],hi[k][1],hi[k][2],hi[k][3]}
    o[d0]=__builtin_amdgcn_mfma_f32_32x32x16_bf16(pa0,PK(0),o[d0],0,0,0);
    o[d0]=__builtin_amdgcn_mfma_f32_32x32x16_bf16(pa1,PK(1),o[d0],0,0,0);
    o[d0]=__builtin_amdgcn_mfma_f32_32x32x16_bf16(pa2,PK(2),o[d0],0,0,0);
    o[d0]=__builtin_amdgcn_mfma_f32_32x32x16_bf16(pa3,PK(3),o[d0],0,0,0);
    #undef PK
  }
}

#ifndef ATTN_STORE16
#define ATTN_STORE16(p,v) (*(u32x4*)(p)=(v))
#endif

template<int POS> __device__ __forceinline__ unsigned mbit(int m){int r;asm("v_bfe_i32 %0, %1, %2, 1":"=v"(r):"v"(m),"n"(POS));return (unsigned)r;}
#define AB_M1(P,R,MB) do{ if(!FOXB) P[R]=__uint_as_float(__float_as_uint(P[R])&mbit<8*((R)>>2)+((R)&3)>(MB)); }while(0)
#define AB_MASK16(P,MB) do{AB_M1(P,0,MB);AB_M1(P,1,MB);AB_M1(P,2,MB);AB_M1(P,3,MB);AB_M1(P,4,MB);AB_M1(P,5,MB);AB_M1(P,6,MB);AB_M1(P,7,MB);AB_M1(P,8,MB);AB_M1(P,9,MB);AB_M1(P,10,MB);AB_M1(P,11,MB);AB_M1(P,12,MB);AB_M1(P,13,MB);AB_M1(P,14,MB);AB_M1(P,15,MB);}while(0)
template<int THRL,bool FOXB> __device__ __forceinline__ void attn_unit(int b,int h,int qb,const bf16*Q,const bf16*__restrict__ K,const bf16*__restrict__ V,bf16*O,const unsigned long long*__restrict__ MK,const float*__restrict__ CK,int kt0,char*shm){
  const int tid=ltid(),lane=tid&63,r32=lane&31,hi=lane>>5; const int wid=__builtin_amdgcn_readfirstlane(tid>>6);
  const long rowbase=(long)b*SEQ; const int q0=qb*QB;
  const bf16*Qw=Q+(rowbase+q0+wid*QBLK)*DM+h*D;
  const long tstep=FOXB?(long)KVBLK*DM:4096;
  const bf16*Kh=FOXB?K+(rowbase+(long)kt0*KVBLK)*DM+h*D:K+(long)(b*NHEAD+h)*(SEQ/KVBLK)*4096,*Vh=FOXB?V+(rowbase+(long)kt0*KVBLK)*DM+h*D:V+(long)(b*NHEAD+h)*(SEQ/KVBLK)*4096;
  const unsigned lds0=(unsigned)(uintptr_t)shm;
  float*wsf=(float*)(shm+LDS_WS)+wid*64;
  const bf16*ksrc=FOXB?Kh+(long)lane*DM+wid*8:Kh+(wid*64+lane)*8;
  const bf16*vsrc=FOXB?Vh+(long)(16*(wid&3)+(lane>>2))*DM+(wid>>2)*32+(lane&3)*8:Vh+((wid>>2)*64+16*(wid&3))*32+lane*8;
  const unsigned kdst=lds0+LDS_K+wid*1024, vdst=lds0+LDS_V+wid*1024;
  #define DMA_K(t,slot) glds16(ksrc+(long)(t)*tstep,(unsigned)__builtin_amdgcn_readfirstlane(kdst+(slot)))
  #define DMA_V(t,slot) glds16(vsrc+(long)(t)*tstep,(unsigned)__builtin_amdgcn_readfirstlane(vdst+(slot)))
  const char*Kbase=shm+LDS_K; bf16x8 kf[8];
  const lds_cptr shm3=(lds_cptr)shm; const lds_cptr kp0=shm3+LDS_K+hi*1024+r32*16; const lds_cptr vp0=shm3+LDS_V+((lane>>4)&1)*32+(lane&3)*8+(4*hi+((lane&15)>>2))*64;
  const int NT=(q0+QB)/KVBLK-kt0;
  DMA_K(0,0);DMA_V(0,0);DMA_K(1,SLOTB);
  bf16x8 qr[4];
  #pragma unroll
  for(int d0=0;d0<4;++d0)qr[d0]=*reinterpret_cast<const bf16x8*>(&Qw[(long)r32*DM+d0*16+hi*8]);
  const lds_cptr qp0=shm3+LDS_OST+wid*4096+lane*16;
  #pragma unroll
  for(int d0=0;d0<4;++d0)*(__attribute__((address_space(3))) bf16x8*)(qp0+d0*1024)=qr[d0];
  #define QR(d) (*(const __attribute__((address_space(3))) bf16x8*)(qp0+(d)*1024))
  float mhat=0.f,l_reg=0.f;f32x16 o[2];o[0]=f32x16{};o[1]=f32x16{};f32x16 negm=f32x16{};asm volatile("":"+v"(negm));
  const int qrel=wid*QBLK+r32;
  const unsigned mrow_off=(unsigned)((rowbase+q0+qrel)*(SEQ/64));
  unsigned long long mw_cur=0ull; if(!FOXB) mw_cur=MK[mrow_off];
  float*ckring=(float*)(shm+LDS_BYTES); const unsigned ckoff=(unsigned)((b*NHEAD+h)*SEQ+kt0*KVBLK+lane); float ckreg=0.f;
  if(FOXB&&wid==0){ ckring[lane]=CK[ckoff]; ckring[64+lane]=CK[ckoff+64]; ckreg=CK[ckoff+128]; }
  #define CKBIAS(C0,C1,t) do{ if(FOXB){ const float*cks_=ckring+((t)%3)*64+4*hi; \
      _Pragma("unroll") for(int g_=0;g_<4;++g_){ const f32x4 ca_=*(const f32x4*)(cks_+8*g_), cb_=*(const f32x4*)(cks_+32+8*g_); \
        _Pragma("unroll") for(int j_=0;j_<4;++j_){ C0[4*g_+j_]-=ca_[j_]; C1[4*g_+j_]-=cb_[j_]; } } } }while(0)
  #define CMASK(P0,P1,t) do{int jb_=(t)-(NT-4); if(jb_>=0)cmask(P0,P1,jb_,qrel,hi);}while(0)
  bool resc=false;
  #define START(P0,P1) do{ const float rm=rowmax(P0,P1); resc=false; \
    { const float dl=rm; mhat=fadd_s(mhat,dl); \
      _Pragma("unroll") for(int r=0;r<16;++r){P0[r]=fsub_s(P0[r],dl);P1[r]=fsub_s(P1[r],dl);} \
      _Pragma("unroll") for(int r=0;r<16;++r)negm[r]=-mhat; asm volatile("":"+v"(negm)); } \
    _Pragma("unroll") for(int r=0;r<16;++r)P0[r]=__builtin_amdgcn_exp2f(P0[r]); }while(0)
  #define RESC() do{ if(resc){ asm volatile("s_waitcnt lgkmcnt(0)":::"memory"); \
      _Pragma("unroll") for(int d_=0;d_<2;++d_) _Pragma("unroll") for(int r=0;r<16;++r)o[d_][r]*=wsf[crow(r,hi)]; } }while(0)
  f32x16 pA0,pA1,pB0,pB1;
  int sl_prev=0,sl_cur=0,sl_next=SLOTB;
  #define ROT() do{sl_prev=sl_cur;sl_cur=sl_next;sl_next=(sl_next==(NSLOT-1)*SLOTB)?0:sl_next+SLOTB;}while(0)
  DMA_K(2,2*SLOTB);
  WAIT_BAR(3);
  qkt(pA0,pA1,Kbase,qr,negm,r32,hi);asm volatile("s_nop 15\n\ts_nop 7":"+v"(pA0),"+v"(pA1));CKBIAS(pA0,pA1,0);CMASK(pA0,pA1,0);
  START(pA0,pA1);
  _Pragma("unroll") for(int r=0;r<16;++r)pA1[r]=__builtin_amdgcn_exp2f(pA1[r]);
  WAIT_BAR(0);
  DMA_K(3,0);DMA_V(1,SLOTB);
  ROT();
  kload8(kf,kp0+sl_cur);
  WAIT_BAR(2);
  s16x4 vlo[8],vhi[8]; u32x4 pw0,pw1,pw2,pw3;
  #define PKW(P,B) cvtpk_s(P[B],P[B+1])
  #define PAF(k) __builtin_bit_cast(bf16x8,pw##k)
  #define VFR(i) (bf16x8){vlo[i][0],vlo[i][1],vlo[i][2],vlo[i][3],vhi[i][0],vhi[i][1],vhi[i][2],vhi[i][3]}
  #define PIN(x) asm volatile("":"+v"(x))
  #define MX3(a,b,c) __builtin_fmaxf(__builtin_fmaxf((a),(b)),(c))
  #define GAPA(MK_,MF,A0,A1,A2,A3,W0,W1,PW) do{ MF; MK_; sacc+=A0; sacc+=A1; sacc+=A2; sacc+=A3; PIN(sacc); W0; W1; PIN(PW); SBAR(); }while(0)
  #define MK4(P,R0,R1,R2,R3,MB) do{AB_M1(P,R0,MB);AB_M1(P,R1,MB);AB_M1(P,R2,MB);AB_M1(P,R3,MB);}while(0)
  #define EX(v) __builtin_amdgcn_exp2f(v)
  #define GAPB(MF,X,B) do{ MF; X[B]=EX(X[B]); X[B+1]=EX(X[B+1]); X[B+2]=EX(X[B+2]); X[B+3]=EX(X[B+3]); PIN(X); SBAR(); }while(0)
  #define VRD(i) do{ vlo[i]=vtr(vp_+(((i)>>2)*4096+((i)&3)*1024)); vhi[i]=vtr(vp_+(((i)>>2)*4096+((i)&3)*1024+512)); }while(0)
  #define KRD(G,j) do{ if(G){ kload2(kf,kp0+sl_next,j); SBAR(); } }while(0)
  #define STEP(C0,C1,P0,P1,t,GK,GV,GL) do{ SBAR(); \
    if(FOXB&&wid==0){ ckring[(((t)+1)%3)*64+lane]=ckreg; if((t)+2<NT) ckreg=CK[ckoff+((t)+2)*64]; } \
    const int mb0_=(int)(unsigned)(mw_cur>>(4*hi)), mb1_=(int)(unsigned)(mw_cur>>(32+4*hi)); AB_M1(P0,0,mb0_); AB_M1(P0,1,mb0_); \
    const lds_cptr vp_=vp0+sl_prev; \
    VRD(0); SBAR(); float sacc=(P0[0]+P0[1]); \
    GAPA(MK4(P0,2,3,4,5,mb0_), C0=__builtin_amdgcn_mfma_f32_32x32x16_bf16(kf[0],QR(0),negm,0,0,0), P0[2],P0[3],P0[4],P0[5],     pw0[0]=PKW(P0,0), pw0[1]=PKW(P0,2), pw0); \
    VRD(4); SBAR(); GAPA(MK4(P0,6,7,8,9,mb0_), C1=__builtin_amdgcn_mfma_f32_32x32x16_bf16(kf[1],QR(0),negm,0,0,0), P0[6],P0[7],P0[8],P0[9],     pw0[2]=PKW(P0,4), pw0[3]=PKW(P0,6), pw0); \
    VRD(1); SBAR(); GAPA(MK4(P0,10,11,12,13,mb0_), C0=__builtin_amdgcn_mfma_f32_32x32x16_bf16(kf[2],QR(1),C0,0,0,0),   P0[10],P0[11],P0[12],P0[13], pw1[0]=PKW(P0,8), pw1[1]=PKW(P0,10), pw1); \
    VRD(5); SBAR(); GAPA(do{AB_M1(P0,14,mb0_);AB_M1(P0,15,mb0_);AB_M1(P1,0,mb1_);AB_M1(P1,1,mb1_);}while(0), C1=__builtin_amdgcn_mfma_f32_32x32x16_bf16(kf[3],QR(1),C1,0,0,0),   P0[14],P0[15],P1[0],P1[1],   pw1[2]=PKW(P0,12),pw1[3]=PKW(P0,14), pw1); \
    VRD(2); SBAR(); GAPA(MK4(P1,2,3,4,5,mb1_), C0=__builtin_amdgcn_mfma_f32_32x32x16_bf16(kf[4],QR(2),C0,0,0,0),   P1[2],P1[3],P1[4],P1[5],     pw2[0]=PKW(P1,0), pw2[1]=PKW(P1,2), pw2); \
    VRD(6); SBAR(); GAPA(MK4(P1,6,7,8,9,mb1_), C1=__builtin_amdgcn_mfma_f32_32x32x16_bf16(kf[5],QR(2),C1,0,0,0),   P1[6],P1[7],P1[8],P1[9],     pw2[2]=PKW(P1,4), pw2[3]=PKW(P1,6), pw2); \
    VRD(3); SBAR(); GAPA(MK4(P1,10,11,12,13,mb1_), C0=__builtin_amdgcn_mfma_f32_32x32x16_bf16(kf[6],QR(3),C0,0,0,0),   P1[10],P1[11],P1[12],P1[13], pw3[0]=PKW(P1,8), pw3[1]=PKW(P1,10), pw3); \
    VRD(7); SBAR(); GAPA(do{AB_M1(P1,14,mb1_);AB_M1(P1,15,mb1_);}while(0), C1=__builtin_amdgcn_mfma_f32_32x32x16_bf16(kf[7],QR(3),C1,0,0,0),   P1[14],P1[15],0.f,0.f,       pw3[2]=PKW(P1,12),pw3[3]=PKW(P1,14), pw3); \
    l_reg+=sacc; if(!FOXB) mw_cur=MK[mrow_off+(t)]; \
    if(GK){DMA_K((t)+3,sl_cur);} if(GV){DMA_V((t)+1,sl_next);} \
    CKBIAS(C0,C1,t); CMASK(C0,C1,t); \
    { float a=MX3(C0[0],C0[1],C1[0]),b=MX3(C0[2],C0[3],C1[1]); a=MX3(a,C1[2],C1[3]); \
      _Pragma("unroll") for(int r=4;r<16;r+=4){a=MX3(a,C0[r],C0[r+1]);b=MX3(b,C0[r+2],C0[r+3]);a=MX3(a,C1[r],C1[r+1]);b=MX3(b,C1[r+2],C1[r+3]);} \
      float rm=__builtin_fmaxf(a,b); { auto rr=__builtin_amdgcn_permlane32_swap(__float_as_uint(rm),__float_as_uint(rm),false,false); rm=__builtin_fmaxf(__uint_as_float(rr[0]),__uint_as_float(rr[1])); } \
      resc=false; \
      if(__builtin_expect(__any(rm>(float)THRL),0)){ const float dl=__builtin_fmaxf(rm,0.f); mhat+=dl; \
        _Pragma("unroll") for(int r=0;r<16;++r){C0[r]-=dl;C1[r]-=dl;} \
        _Pragma("unroll") for(int r=0;r<16;++r)negm[r]=-mhat; asm volatile("":"+v"(negm)); \
        const float f=__builtin_amdgcn_exp2f(-dl); l_reg*=f; { int ri_=r32; asm volatile("":"+v"(ri_)); if(hi==0)wsf[ri_]=f; } resc=true; } } \
    SBAR(); \
    GAPB(o[0]=__builtin_amdgcn_mfma_f32_32x32x16_bf16(PAF(0),VFR(0),o[0],0,0,0), C0,0); \
    GAPB(o[1]=__builtin_amdgcn_mfma_f32_32x32x16_bf16(PAF(0),VFR(4),o[1],0,0,0), C0,4); \
    KRD(GL,0); GAPB(o[0]=__builtin_amdgcn_mfma_f32_32x32x16_bf16(PAF(1),VFR(1),o[0],0,0,0), C0,8); \
    KRD(GL,1); GAPB(o[1]=__builtin_amdgcn_mfma_f32_32x32x16_bf16(PAF(1),VFR(5),o[1],0,0,0), C0,12); \
    KRD(GL,2); GAPB(o[0]=__builtin_amdgcn_mfma_f32_32x32x16_bf16(PAF(2),VFR(2),o[0],0,0,0), C1,0); \
    KRD(GL,3); GAPB(o[1]=__builtin_amdgcn_mfma_f32_32x32x16_bf16(PAF(2),VFR(6),o[1],0,0,0), C1,4); \
    GAPB(o[0]=__builtin_amdgcn_mfma_f32_32x32x16_bf16(PAF(3),VFR(3),o[0],0,0,0), C1,8); \
    GAPB(o[1]=__builtin_amdgcn_mfma_f32_32x32x16_bf16(PAF(3),VFR(7),o[1],0,0,0), C1,12); \
    }while(0)
  int t=1;
  #undef CMASK
  #define CMASK(P0,P1,t) do{}while(0)
  for(;t+5<NT;t+=2){
    STEP(pB0,pB1,pA0,pA1,t,true,true,true);     WAIT_BAR(2); RESC(); ROT();
    STEP(pA0,pA1,pB0,pB1,t+1,true,true,true);   WAIT_BAR(2); RESC(); ROT();
  }
  #undef CMASK
  #define CMASK(P0,P1,t) do{int jb_=(t)-(NT-4); if(jb_>=0)cmask(P0,P1,jb_,qrel,hi);}while(0)
  #define ENDW(tt) do{ if((tt)+3<NT){WAIT_BAR(2);} else if((tt)+2<NT){WAIT_BAR(1);} else {WAIT_BAR(0);} }while(0)
  for(;t+1<NT;t+=2){
    STEP(pB0,pB1,pA0,pA1,t,(t+3<NT),(t+1<NT),(t+1<NT));       ENDW(t);   RESC(); ROT();
    STEP(pA0,pA1,pB0,pB1,t+1,(t+4<NT),(t+2<NT),(t+2<NT));     ENDW(t+1); RESC(); ROT();
  }
  STEP(pB0,pB1,pA0,pA1,NT-1,false,false,false); RESC();
  { const int mb0_=(int)(unsigned)(mw_cur>>(4*hi)), mb1_=(int)(unsigned)(mw_cur>>(32+4*hi)); AB_MASK16(pB0,mb0_); AB_MASK16(pB1,mb1_); }
  { float sacc=pB0[0]+pB0[1]; _Pragma("unroll") for(int r=2;r<16;++r)sacc+=pB0[r]; _Pragma("unroll") for(int r=0;r<16;++r)sacc+=pB1[r]; l_reg+=sacc;
    pw0=(u32x4){PKW(pB0,0),PKW(pB0,2),PKW(pB0,4),PKW(pB0,6)};pw1=(u32x4){PKW(pB0,8),PKW(pB0,10),PKW(pB0,12),PKW(pB0,14)};pw2=(u32x4){PKW(pB1,0),PKW(pB1,2),PKW(pB1,4),PKW(pB1,6)};pw3=(u32x4){PKW(pB1,8),PKW(pB1,10),PKW(pB1,12),PKW(pB1,14)};
    SBAR(); { int ln_=lane; asm volatile("":"+v"(ln_)); const int vb0=(int)(lds0+LDS_V)+((ln_>>4)&1)*32+(ln_&3)*8+(4*(ln_>>5)+((ln_&15)>>2))*64;
      pv(o,vb0+sl_cur,PAF(0),PAF(1),PAF(2),PAF(3)); } }
  #undef PKW
  #undef PAF
  #undef VFR
  #undef PIN
  #undef MX3
  #undef GAPA
  #undef MK4
  #undef GAPB
  #undef EX
  #undef VRD
  #undef KRD
  #undef STEP
  #undef ENDW
  {auto rr=__builtin_amdgcn_permlane32_swap(__float_as_uint(l_reg),__float_as_uint(l_reg),false,false);l_reg=__uint_as_float(rr[0])+__uint_as_float(rr[1]);}
  if(hi==0)wsf[32+r32]=l_reg;asm volatile("s_waitcnt lgkmcnt(0)":::"memory");
  float rli[16];
  #pragma unroll
  for(int r=0;r<16;++r)rli[r]=__builtin_amdgcn_rcpf(wsf[32+crow(r,hi)]);
  { bf16*stg=(bf16*)(shm+LDS_OST)+wid*2048;
    #pragma unroll
    for(int r=0;r<16;++r){const int orow=crow(r,hi);
      #pragma unroll
      for(int d0=0;d0<2;++d0)stg[orow*64+d0*32+r32]=__float2bfloat16(o[d0][r]*rli[r]);}
    asm volatile("s_waitcnt lgkmcnt(0)":::"memory");
    #pragma unroll
    for(int i=0;i<4;++i){const int row=i*8+(lane>>3),ch=lane&7; const u32x4 v=*(const u32x4*)(stg+row*64+ch*8); const int trow=q0+wid*QBLK+row;
      if(trow>=16&&trow<8208) ATTN_STORE16(O+((long)b*8192+(trow-16))*DM+h*D+ch*8,v);} }
  asm volatile("s_waitcnt lgkmcnt(0)\n\ts_barrier":::"memory");
  #undef DMA_K
  #undef DMA_V
  #undef CMASK
  #undef START
  #undef RESC
  #undef ROT
  #undef CKBIAS
  #undef QR
}
constexpr int ATTN_LDS_BYTES=LDS_BYTES;
#undef SBAR
#undef WAIT_BAR
}

__device__ __forceinline__ unsigned ordkey16(float s) {
    const _Float16 hf = (_Float16)(s + 0.0f);
    const unsigned bits = (unsigned)__builtin_bit_cast(unsigned short, hf);
    return (bits & 0x8000u) ? (~bits & 0xffffu) : (bits | 0x8000u);
}
template <int CTRL, int ROWMASK> __device__ __forceinline__ int dppi(int v) { return __builtin_amdgcn_update_dpp(0, v, CTRL, ROWMASK, 0xf, true); }
__device__ __forceinline__ int wave_incl_scan(int v) {
    v += dppi<0x111, 0xf>(v);
    v += dppi<0x112, 0xf>(v);
    v += dppi<0x114, 0xf>(v);
    v += dppi<0x118, 0xf>(v);
    v += dppi<0x142, 0xa>(v);
    v += dppi<0x143, 0xc>(v);
    return v;
}
__device__ __forceinline__ void hist_find(const unsigned* hist, int need, int lane, int& bin, int& above, int& at) {
    const uint4 c4 = *(const uint4*)(hist + 252 - 4 * lane);
    const int c0 = (int)c4.w, c1 = (int)c4.z, c2 = (int)c4.y, c3 = (int)c4.x;
    const int tot = c0 + c1 + c2 + c3;
    const int incl = wave_incl_scan(tot);
    const unsigned long long bal = __ballot(incl >= need);
    const int L = bal ? (int)__builtin_ctzll(bal) : 63;
    int mybin, myabove, myat;
    {
        int cum = incl - tot;
        if (cum + c0 >= need) { mybin = 255 - 4 * lane; myabove = cum; myat = c0; }
        else { cum += c0;
            if (cum + c1 >= need) { mybin = 254 - 4 * lane; myabove = cum; myat = c1; }
            else { cum += c1;
                if (cum + c2 >= need) { mybin = 253 - 4 * lane; myabove = cum; myat = c2; }
                else { cum += c2; mybin = 252 - 4 * lane; myabove = cum; myat = c3; } } }
    }
    bin = __builtin_amdgcn_readlane(mybin, L); above = __builtin_amdgcn_readlane(myabove, L); at = __builtin_amdgcn_readlane(myat, L);
}
__device__ __forceinline__ unsigned fixkey16(float s) {
    const int v = (int)(__float_as_uint(fmaf(s, 2048.0f, 12582912.0f + 32768.0f)) - 0x4B400000u);
    return (unsigned)min(max(v, 1), 65535);
}
static __device__ __forceinline__ void indexer_item(unsigned char* ws, int b, int qg, unsigned char* smem) {
    const bf16_t* QI = (const bf16_t*)(ws + OFF_QI);
    const bf16_t* KI = (const bf16_t*)(ws + OFF_KI);
    const float* WI = (const float*)(ws + OFF_WI);
    unsigned long long* mask = (unsigned long long*)(ws + OFF_MASK);
    unsigned short* sc = (unsigned short*)smem;
    unsigned* hist_all = (unsigned*)(smem + 8 * SCP * 2);
    const int tid = ltid(), lane = tid & 63, wave = __builtin_amdgcn_readfirstlane(tid >> 6);
    const int t0 = qg * 8;
    const int g = lane >> 4, kc = lane & 15;
    for (int i = tid * 4; i < 8 * HP; i += NTHREADS * 4) *(uint4*)(hist_all + i) = zero4u();
    bf16x8 af[4][2];
#pragma unroll
    for (int mi = 0; mi < 4; ++mi) {
        const int q = (mi >> 1) * 4 + (kc >> 2), hh = (mi & 1) * 4 + (kc & 3);
#pragma unroll
        for (int ks = 0; ks < 2; ++ks) af[mi][ks] = *(const bf16x8*)(QI + ((size_t)b * TP + t0 + q) * 512 + hh * 64 + ks * 32 + g * 8);
    }
    float wq[2][8];
#pragma unroll
    for (int a = 0; a < 2; ++a)
#pragma unroll
        for (int hh = 0; hh < 8; ++hh) wq[a][hh] = WI[((size_t)b * TP + t0 + a * 4 + g) * 8 + hh];
    __syncthreads();
    const int ntile = (t0 + 8 + 15) >> 4;
    const bf16_t* kbase = KI + ((size_t)b * (TP / 16) * 2 * 64 + lane) * 8;
    for (int rep_ = 0; rep_ < IDX_REP_MFMA; ++rep_) {
    constexpr int U = 4;
    const f32x4 z4 = zero4();
    const int nfull = (t0 >= 15) ? ((t0 - 15) >> 4) + 1 : 0;
    unsigned short* scw0 = sc + g * SCP + kc;
    unsigned* hw0 = hist_all + g * HP;
    bf16x8 c0[U], c1[U];
#pragma unroll
    for (int u = 0; u < U; ++u) { const int kt = wave + 8 * u; if (kt < ntile) { const bf16_t* kr = kbase + (size_t)kt * 1024; c0[u] = *(const bf16x8*)kr; c1[u] = *(const bf16x8*)(kr + 512); } }
    for (int base = wave; base < ntile; base += 8 * U) {
        bf16x8 n0[U], n1[U];
#pragma unroll
        for (int u = 0; u < U; ++u) { const int kt = base + 8 * (U + u); n0[u] = c0[u]; n1[u] = c1[u]; if (kt < ntile && !(IDX_PROBE == 3 && rep_ > 0)) { const bf16_t* kr = kbase + (size_t)kt * 1024; n0[u] = *(const bf16x8*)kr; n1[u] = *(const bf16x8*)(kr + 512); } }
#pragma unroll
        for (int u = 0; u < U; ++u) {
            const int kt = base + 8 * u;
            if (kt < ntile) {
                f32x4 acc[4];
#pragma unroll
                for (int mi = 0; mi < 4; ++mi) {
                    acc[mi] = __builtin_amdgcn_mfma_f32_16x16x32_bf16(af[mi][0], c0[u], z4, 0, 0, 0);
                    acc[mi] = __builtin_amdgcn_mfma_f32_16x16x32_bf16(af[mi][1], c1[u], acc[mi], 0, 0, 0);
                }
                float s0 = 0.f, s1 = 0.f;
#pragma unroll
                for (int c = 0; c < 2; ++c)
#pragma unroll
                    for (int j = 0; j < 4; ++j) {
                        s0 = fmaf(wq[0][c * 4 + j], __builtin_amdgcn_fmed3f(acc[c][j], 0.f, 3.0e38f), s0);
                        s1 = fmaf(wq[1][c * 4 + j], __builtin_amdgcn_fmed3f(acc[2 + c][j], 0.f, 3.0e38f), s1);
                    }
                unsigned k0 = fixkey16(s0), k1 = fixkey16(s1);
                if ((IDX_PROBE == 1 || IDX_PROBE == 3) && rep_ > 0) { asm volatile("" :: "v"(k0), "v"(k1)); }
                else if (kt < nfull) {
                    scw0[kt * 16] = (unsigned short)k0; scw0[4 * SCP + kt * 16] = (unsigned short)k1;
                    if (rep_ == 0) { atomicAdd(&hw0[k0 >> 8], 1u); atomicAdd(&hw0[4 * HP + (k1 >> 8)], 1u); }
                } else {
                    const int key = kt * 16 + kc;
                    const bool ok0 = key <= t0 + g, ok1 = key <= t0 + 4 + g;
                    k0 = ok0 ? k0 : 0u; k1 = ok1 ? k1 : 0u;
                    scw0[kt * 16] = (unsigned short)k0; scw0[4 * SCP + kt * 16] = (unsigned short)k1;
                    if (rep_ == 0) { if (ok0) atomicAdd(&hw0[k0 >> 8], 1u); if (ok1) atomicAdd(&hw0[4 * HP + (k1 >> 8)], 1u); }
                }
            }
        }
#pragma unroll
        for (int u = 0; u < U; ++u) { c0[u] = n0[u]; c1[u] = n1[u]; }
    }
    }
    __syncthreads();
    TS_ACC_BEGIN(4);
    for (int rep2_ = 0; rep2_ < IDX_REP_SEL; ++rep2_)
    {
        const int t = t0 + wave;
        const int n = t + 1;
        const unsigned short* row = sc + wave * SCP;
        unsigned* hist = hist_all + wave * HP;
        unsigned char* mrow = (unsigned char*)(mask + ((size_t)b * TP + t) * MW);
        const int nbytes = ((t >> 8) + 1) * 32;
        const int nit3 = (nbytes + 63) >> 6;
        unsigned Tkey = 0u; int rem = 0;
        const int nfull = n >> 9;
        bool simple = false;
        if (n > 256) {
            const int nit = (n + 511) >> 9;
            int B1, above1, at1;
            hist_find(hist, 256, lane, B1, above1, at1);
            const int need2 = 256 - above1;
            __threadfence_block();
            *(uint4*)(hist + lane * 4) = zero4u();
            __threadfence_block();
            uint4 vpre = *(const uint4*)(row + lane * 8);
            for (int it = 0; it < nfull; ++it) {
                const uint4 v = vpre;
                vpre = *(const uint4*)(row + ((it + 1) * 64 + lane) * 8);
                const unsigned ww[4] = {v.x, v.y, v.z, v.w};
#pragma unroll
                for (int e = 0; e < 8; ++e) {
                    const unsigned k = (ww[e >> 1] >> ((e & 1) * 16)) & 0xffffu;
                    atomicAdd(&hist[k & 255u], ((int)(k >> 8) == B1) ? 1u : 0u);
                }
            }
            for (int it = nfull; it < nit; ++it) {
                const int e0 = (it * 64 + lane) * 8;
                const uint4 v = *(const uint4*)(row + e0);
                const unsigned ww[4] = {v.x, v.y, v.z, v.w};
#pragma unroll
                for (int e = 0; e < 8; ++e) {
                    const unsigned k = (ww[e >> 1] >> ((e & 1) * 16)) & 0xffffu;
                    if (e0 + e < n && (int)(k >> 8) == B1) atomicAdd(&hist[k & 255u], 1u);
                }
            }
            __threadfence_block();
            int B2, above2, atT;
            hist_find(hist, need2, lane, B2, above2, atT);
            Tkey = ((unsigned)B1 << 8) | (unsigned)B2;
            rem = 256 - above1 - above2;
            simple = (rem == atT);
        }
        uint4 vnx = *(const uint4*)(row + lane * 8);
        for (int it = 0; it < nit3; ++it) {
            const uint4 v = vnx;
            vnx = *(const uint4*)(row + ((it + 1) * 64 + lane) * 8);
            if (it < nfull && (simple || rem == 0)) {
                const unsigned Tc = simple ? Tkey - 1u : Tkey;
                const unsigned ww[4] = {v.x, v.y, v.z, v.w};
                unsigned gtb = 0u;
#pragma unroll
                for (int e = 0; e < 8; ++e) {
                    const unsigned k = (ww[e >> 1] >> ((e & 1) * 16)) & 0xffffu;
                    gtb |= (k > Tc) ? (1u << e) : 0u;
                }
                __hip_atomic_store(&mrow[it * 64 + lane], (unsigned char)gtb, __ATOMIC_RELAXED, __HIP_MEMORY_SCOPE_AGENT);
                continue;
            }
            const int e0 = (it * 64 + lane) * 8;
            const unsigned ww[4] = {v.x, v.y, v.z, v.w};
            unsigned gtb = 0u, eqb = 0u;
#pragma unroll
            for (int e = 0; e < 8; ++e) {
                const unsigned k = (ww[e >> 1] >> ((e & 1) * 16)) & 0xffffu;
                const bool valid = (e0 + e) < n;
                gtb |= (valid && k > Tkey) ? (1u << e) : 0u;
                eqb |= (valid && k == Tkey) ? (1u << e) : 0u;
            }
            if (__ballot(eqb != 0u) != 0ull) {
                const int c = __popc(eqb);
                int incl = c;
#pragma unroll
                for (int d = 1; d < 64; d <<= 1) { const int vv = __shfl_up(incl, d); if (lane >= d) incl += vv; }
                int r = incl - c;
                unsigned tk = 0u;
#pragma unroll
                for (int e = 0; e < 8; ++e) if ((eqb >> e) & 1u) { if (r < rem) tk |= (1u << e); ++r; }
                rem -= __shfl(incl, 63) < rem ? __shfl(incl, 63) : rem;
                gtb |= tk;
            }
            const int bi = it * 64 + lane;
            if (bi < nbytes) __hip_atomic_store(&mrow[bi], (unsigned char)gtb, __ATOMIC_RELAXED, __HIP_MEMORY_SCOPE_AGENT);
        }
    }
    __syncthreads();
    TS_ACC_END(4);
}

static __device__ __forceinline__ int fox_prune(unsigned char* ws, int b, int h, int qb, unsigned char* smem) {
    const int tid = ltid(), lane = tid & 63, wave = __builtin_amdgcn_readfirstlane(tid >> 6), hlf = lane >> 5;
    const bf16_t* Q = (const bf16_t*)(ws + OFF_QF);
    const float* cumt = (const float*)(ws + OFF_CUMT) + (size_t)(b * 8 + h) * TP;
    const float* knorm = (const float*)(ws + OFF_KNORM) + (size_t)(b * 8 + h) * MW;
    float* red = (float*)(smem + 90112);
    const size_t grow = (size_t)b * TP + qb * 256 + wave * 32 + (lane & 31);
    float kn0 = 0.f, kn1 = 0.f, ce0 = 0.f, ce1 = 0.f, kd0 = 0.f, cfirst = 0.f;
    if (wave == 0) {
        if (lane < qb * 4) { kn0 = knorm[lane]; ce0 = cumt[lane * 64 + 63]; }
        if (lane + 64 < qb * 4) { kn1 = knorm[lane + 64]; ce1 = cumt[(lane + 64) * 64 + 63]; }
        kd0 = knorm[qb * 4 + (lane & 3)]; cfirst = cumt[qb * 256];
    }
    float qq = 0.f;
#pragma unroll
    for (int ks = 0; ks < 4; ++ks) {
        const bf16x8 qv = *(const bf16x8*)(Q + grow * 512 + h * 64 + ks * 16 + hlf * 8);
#pragma unroll
        for (int e = 0; e < 8; ++e) { const float v = bf2f((unsigned)(unsigned short)qv[e]); qq = fmaf(v, v, qq); }
    }
    qq += __shfl_xor(qq, 32);
#pragma unroll
    for (int o = 1; o < 32; o <<= 1) qq = fmaxf(qq, __shfl_xor(qq, o));
    if (lane == 0) red[wave] = qq;
    __syncthreads();
    if (wave == 0) {
        float qm = red[0];
#pragma unroll
        for (int w = 1; w < 8; ++w) qm = fmaxf(qm, red[w]);
        const float Qn = sqrtf(qm) * 1.0001f;
        const float Kd = fmaxf(fmaxf(__shfl(kd0, 0), __shfl(kd0, 1)), fmaxf(__shfl(kd0, 2), __shfl(kd0, 3))) * 1.0001f;
        bool keep0 = true, keep1 = true;
        if (lane < qb * 4) { const float bnd = Qn * (kn0 * 1.0001f + Kd) + cfirst - ce0; keep0 = !(bnd < -40.0f); }
        if (lane + 64 < qb * 4) { const float bnd = Qn * (kn1 * 1.0001f + Kd) + cfirst - ce1; keep1 = !(bnd < -40.0f); }
        const unsigned long long b0 = __ballot(keep0), b1 = __ballot(keep1);
        const int first = b0 ? (int)__builtin_ctzll(b0) : (b1 ? 64 + (int)__builtin_ctzll(b1) : 128);
        if (lane == 0) ((int*)red)[8] = (first < qb * 4 ? first : qb * 4) & ~1;
    }
    __syncthreads();
    return ((const int*)red)[8];
}

#define LAS __attribute__((address_space(3)))
#define XB_TMO      128
#define XB_XCNT(j)  (256  + 64 * (j))
#define XB_XSUB(j)  (1280 + 64 * (j))
#define XB_XGEN(j)  (2304 + 64 * (j))
#define XB_TOP      3328
#define XB_TOPGEN   3392
#define XCD_BAR_WORDS 3456
#define XB_SPIN_CAP (1u << 18)
__device__ __forceinline__ unsigned xb_ld(unsigned* p)              { return __hip_atomic_load(p, __ATOMIC_RELAXED, __HIP_MEMORY_SCOPE_AGENT); }
__device__ __forceinline__ unsigned xb_add(unsigned* p, unsigned v) { return __hip_atomic_fetch_add(p, v, __ATOMIC_RELAXED, __HIP_MEMORY_SCOPE_AGENT); }
__device__ __forceinline__ unsigned xb_xcc_id() { return (unsigned)__builtin_amdgcn_s_getreg((3 << 11) | 20) & 0xFu; }
#define XB_SPIN(cond, bar) do { unsigned _sp = 0; while (cond) { __builtin_amdgcn_s_sleep(1); \
    if ((++_sp & 255u) == 0u) { if (xb_ld(&(bar)[XB_TMO])) break; if (_sp > XB_SPIN_CAP) { atomicAdd(&(bar)[XB_TMO], 1u); break; } } } } while (0)
struct XcdBarrier { unsigned* bar; unsigned x; volatile LAS unsigned* st; };
__device__ __forceinline__ XcdBarrier xcd_barrier_post(unsigned* bar, volatile LAS unsigned* st) {
    XcdBarrier b; b.bar = bar; b.x = xb_xcc_id(); b.st = st;
    if (threadIdx.x == 0) (void)xb_add(&bar[XB_XCNT(b.x)], 1u);
    return b;
}
__device__ __forceinline__ void xcd_barrier_complete(unsigned* bar, unsigned x, unsigned& nloc, unsigned& nx) {
    const unsigned G = gridDim.x * gridDim.y * gridDim.z;
    unsigned sum, cnt, mine, sp = 0u;
    for (;;) {
        sum = 0u; cnt = 0u; mine = 0u;
#pragma unroll
        for (unsigned j = 0; j < 16; ++j) { const unsigned c = xb_ld(&bar[XB_XCNT(j)]); sum += c; cnt += (c > 0u) ? 1u : 0u; mine = (j == x) ? c : mine; }
        if (sum == G) break;
        __builtin_amdgcn_s_sleep(1);
        if ((++sp & 255u) == 0u) { if (xb_ld(&bar[XB_TMO])) break; if (sp > XB_SPIN_CAP) { atomicAdd(&bar[XB_TMO], 1u); break; } }
    }
    nloc = mine > 0u ? mine : 1u; nx = cnt > 0u ? cnt : 1u;
}
__device__ __forceinline__ void xcd_barrier(const XcdBarrier& b) {
    asm volatile("s_waitcnt vmcnt(0)" ::: "memory");
    __syncthreads();
    if (threadIdx.x == 0) {
        unsigned* bar = b.bar;
        __builtin_amdgcn_s_waitcnt(0);
        unsigned nloc = b.st[0], nx = b.st[1];
        if (nloc == 0u) { xcd_barrier_complete(bar, b.x, nloc, nx); b.st[0] = nloc; b.st[1] = nx; }
        const unsigned old = xb_add(&bar[XB_XSUB(b.x)], 1u);
        const unsigned gen = old / nloc;
        if (old + 1u == (gen + 1u) * nloc) {
            __builtin_amdgcn_fence(__ATOMIC_RELEASE, "agent");
            asm volatile("s_waitcnt vmcnt(0)" ::: "memory");
            const unsigned og = xb_add(&bar[XB_TOP], 1u);
            const unsigned tg = og / nx;
            if (og + 1u == (tg + 1u) * nx) xb_add(&bar[XB_TOPGEN], 1u);
            else XB_SPIN(xb_ld(&bar[XB_TOPGEN]) == tg, bar);
            __builtin_amdgcn_fence(__ATOMIC_ACQUIRE, "agent");
            xb_add(&bar[XB_XGEN(b.x)], 1u);
            asm volatile("s_waitcnt vmcnt(0)" ::: "memory");
        } else {
            XB_SPIN(xb_ld(&bar[XB_XGEN(b.x)]) == gen, bar);
            __builtin_amdgcn_fence(__ATOMIC_ACQUIRE, "agent");
            asm volatile("s_waitcnt vmcnt(0)" ::: "memory");
        }
    }
    __syncthreads();
}

__global__ void __launch_bounds__(NTHREADS, 2) mega(Params p) {
    __shared__ __attribute__((aligned(16))) unsigned char smem[LDS_BYTES];
    volatile LAS unsigned* bst = (volatile LAS unsigned*)(smem + LDS_BYTES - 64);
    if (threadIdx.x < 2) bst[threadIdx.x] = 0u;
    if (TIME_PH >= 200 && threadIdx.x >= 4 && threadIdx.x < 10) bst[threadIdx.x] = 0u;
    __syncthreads();
    (void)xcd_barrier_post((unsigned*)(p.ws + OFF_CTL) + CW_BAR, bst);

#pragma unroll 1
    for (int step = p.ph_lo; step < p.ph_hi; ++step) {
        if (step > p.ph_lo && !(FUSE89 && REPEAT_PH < 0 && step == 9) && !(FUSE34 && REPEAT_PH < 0 && step == 4) && !(FUSE23 && REPEAT_PH < 0 && step == 3)) {
            KParams kpb = (KParams)__builtin_amdgcn_kernarg_segment_ptr(); asm volatile("" : "+s"(kpb));
            XcdBarrier gb; gb.bar = (unsigned*)(kpb->ws + OFF_CTL) + CW_BAR; gb.x = xb_xcc_id(); gb.st = (volatile LAS unsigned*)(smem + LDS_BYTES - 64);
            xcd_barrier(gb);
        }
        if (TIME_PH >= 0 && TIME_PH < 100 && blockIdx.x == 0 && threadIdx.x == 0 && (step == TIME_PH || step == TIME_PH + 1)) {
            const unsigned long long tt = wall_clock64(); volatile LAS unsigned* ts = (volatile LAS unsigned*)(smem + LDS_BYTES - 64) + (step == TIME_PH ? 4 : 6);
            ts[0] = (unsigned)tt; ts[1] = (unsigned)(tt >> 32);
        }
        const int ph = (REPEAT_PH >= 0 && step > REPEAT_PH) ? step - 1 : step;
        KParams kp = (KParams)__builtin_amdgcn_kernarg_segment_ptr(); asm volatile("" : "+s"(kp));
        unsigned char* ws = kp->ws;
        const int G = gridDim.x, bid = blockIdx.x;
        unsigned* ctl = (unsigned*)(ws + OFF_CTL);
        const float* rope = (const float*)(ws + OFF_ROPE);
        float* stat0 = (float*)(ws + OFF_STAT0);
        const float* x = kp->in[0];
        if (PH(0) && ph == 0) {
            const int tid = ltid(), lane = tid & 63, wave = __builtin_amdgcn_readfirstlane(tid >> 6); (void)lane; (void)wave;
            {
                bf16_t* HB = (bf16_t*)(ws + OFF_HB); bf16_t* HBM = (bf16_t*)(ws + OFF_HBM);
                const float* g0 = kp->in[2]; const float* b0 = kp->in[3];
                f32x4 gg0[4], bb0[4];
#pragma unroll
                for (int j = 0; j < 4; ++j) { gg0[j] = *(const f32x4*)(g0 + lane * 4 + 256 * j); bb0[j] = *(const f32x4*)(b0 + lane * 4 + 256 * j); }
                auto ln_rows = [&](const float* src0, bf16_t* dst0, int i0, int stride, int lim, bool meta) {
                    f32x4 v[4][4];
#pragma unroll
                    for (int k = 0; k < 4; ++k) {
                        const int i = (i0 + k * stride < lim) ? i0 + k * stride : i0;
#pragma unroll
                        for (int j = 0; j < 4; ++j) v[k][j] = __builtin_nontemporal_load((const f32x4*)(src0 + (size_t)i * 1024 + lane * 4 + 256 * j));
                    }
#pragma unroll
                    for (int k = 0; k < 4; ++k) {
                        const int i = (i0 + k * stride < lim) ? i0 + k * stride : i0;
                        float s = 0.f;
#pragma unroll
                        for (int j = 0; j < 4; ++j) s += (v[k][j][0] + v[k][j][1]) + (v[k][j][2] + v[k][j][3]);
                        const float mu = wave_sum(s) * (1.0f / 1024.0f);
                        float q = 0.f;
#pragma unroll
                        for (int j = 0; j < 4; ++j) { const f32x4 d = v[k][j] - mu; q += (d[0] * d[0] + d[1] * d[1]) + (d[2] * d[2] + d[3] * d[3]); }
                        const float rstd = rsqrtf(wave_sum(q) * (1.0f / 1024.0f) + LN_EPS);
#pragma unroll
                        for (int j = 0; j < 4; ++j) {
                            store4bf(dst0 + (size_t)i * 1024 + lane * 4 + 256 * j, (v[k][j] - mu) * rstd * gg0[j] + bb0[j]);
                        }
                        if (lane == 0 && !meta) { const int r = (i / SEQ) * TP + NMETA + i % SEQ; stat0[2 * r] = mu; stat0[2 * r + 1] = rstd; }
                    }
                };
                for (int i0 = bid * 8 + wave; i0 < NTOK; i0 += G * 8 * 4) ln_rows(x, HB, i0, G * 8, NTOK, false);
                if (bid * 8 + wave < NMETA / 4) ln_rows(kp->in[1], HBM, bid * 8 + wave, NMETA / 4, NMETA, true);
            }
            {
                float* ropew = (float*)(ws + OFF_ROPE);
                for (int i = bid * NTHREADS + tid; i < TP * 8; i += G * NTHREADS) {
                    const int t = i >> 3, k = i & 7;
                    const float invf[8] = {1.0f, 0.1939227432012558f, 0.03760603070259094f, 0.007292664609849453f, 0.0014142135623842478f,
                                           0.00027424818836152554f, 5.3182957344688475e-05f, 1.0313385246263351e-05f};
                    float iv = invf[0];
#pragma unroll
                    for (int kk = 1; kk < 8; ++kk) iv = (k == kk) ? invf[kk] : iv;
                    const float ang = (float)t * iv;
                    ropew[2 * i] = cosf(ang); ropew[2 * i + 1] = sinf(ang);
                }
            }
            {
                bf16_t* wrt = (bf16_t*)(ws + OFF_WRT);
                const float* wrg = kp->in[13]; const float* wre = kp->in[15];
                for (int i = bid * NTHREADS + tid; i < 48 * 1024; i += G * NTHREADS) {
                    const int e = i >> 10, k = i & 1023;
                    const float w = (e < 4) ? wrg[k * 4 + e] : ((e < 36) ? wre[k * 32 + (e - 4)] : 0.f);
                    const unsigned hi = f2bf(w);
                    wrt[i] = (bf16_t)hi; wrt[48 * 1024 + i] = (bf16_t)f2bf(w - bf2f(hi));
                }
            }
            {
                KParams kq = kp;
                unsigned char* wsq = ws;
                constexpr int N_WIN = 16 * 80, N_KV = 4 * 16, N_A = 8 * 16, N_F = 8 * 16, N_O = 16 * 16;
                constexpr int NT = N_WIN + N_KV + N_A + N_F + N_O;
                auto dec = [kq, wsq](int it) -> XTile {
                    XTile x; x.kscale = nullptr; x.winmap = 0; x.s16 = 16;
                    int i = it;
                    if (i < N_WIN) { x.src = kq->in[4]; x.src_ld = 4944; x.dst = (bf16_t*)(wsq + OFF_WIN); x.dst_ld = 1024; x.k0 = (i % 16) * 64; x.j0 = (i / 16) * 64; x.winmap = 1; }
                    else if ((i -= N_WIN) < N_KV) { x.src = kq->in[7]; x.src_ld = 1024; x.dst = (bf16_t*)(wsq + OFF_WKV); x.dst_ld = 256; x.k0 = (i % 4) * 64; x.j0 = (i / 4) * 64; x.kscale = kq->in[6]; }
                    else if ((i -= N_KV) < N_A) { x.src = kq->in[8]; x.src_ld = 1024; x.dst = (bf16_t*)(wsq + OFF_WA); x.dst_ld = 512; x.k0 = (i % 8) * 64; x.j0 = (i / 8) * 64; }
                    else if ((i -= N_A) < N_F) { x.src = kq->in[9]; x.src_ld = 1024; x.dst = (bf16_t*)(wsq + OFF_WF); x.dst_ld = 512; x.k0 = (i % 8) * 64; x.j0 = (i / 8) * 64; }
                    else { i -= N_F; x.src = kq->in[10]; x.src_ld = 1024; x.dst = (bf16_t*)(wsq + OFF_WO); x.dst_ld = 1024; x.k0 = (i % 16) * 64; x.j0 = (i / 16) * 64; }
                    x.rb = x.j0;
                    return x;
                };
                xpose_many(NT, G, bid, dec, (float*)smem);
            }
        }
        if ((PH(1) && ph == 1) || (PH(2) && ph == 2) || (PH(5) && ph == 5) || (PH(6) && ph == 6) || (PH(9) && ph == 9)) {
            {
            }
            float* rs = (float*)(smem + pg8::STAGE_BYTES);
            int* tag = (int*)(smem + pg8::STAGE_BYTES + 2048);
            if (ph == 2) TS_BEGIN(1);
            if (ph == 2) {
                const int tid = ltid();
                const bf16_t* CKV = (const bf16_t*)(ws + OFF_CKV);
                pg8::StaticOrder S; S.init(NTOK, 1024, G, bid);
                pg8::Unit u;
                for (int i = 0; i < 2; ++i) {
                    if (!S.next(i, u)) { if (tid == 0) tag[i] = -1; continue; }
                    if (tid == 0) tag[i] = u.pm;
                    const bf16_t* rp = CKV + (size_t)(u.pm * 256 + (tid >> 1)) * 256 + (tid & 1) * 128;
                    float ss = 0.f;
#pragma unroll
                    for (int c = 0; c < 16; ++c) {
                        const uint4 uu = *(const uint4*)(rp + c * 8);
                        const unsigned ww[4] = {uu.x, uu.y, uu.z, uu.w};
#pragma unroll
                        for (int e = 0; e < 4; ++e) { const float a0 = bf2f(ww[e] & 0xffffu), a1 = bf2f(ww[e] >> 16); ss = fmaf(a0, a0, fmaf(a1, a1, ss)); }
                    }
                    ss += __shfl_xor(ss, 1);
                    if ((tid & 1) == 0) rs[i * 256 + (tid >> 1)] = rsqrtf(ss * (1.0f / 256.0f) + RMS_EPS);
                }
                __syncthreads();
            }
            if (ph == 9) {
                const int tid = ltid();
                if (tid < 32) tag[tid] = (int)ctl[CW_ECNT + tid * ECS];
                __syncthreads();
                if (tid == 0) { int cp = 0, rb = 0; for (int e = 0; e < 32; ++e) { tag[32 + e] = cp; tag[64 + e] = rb; const int nc = (tag[e] + 255) >> 8; cp += nc; rb += nc * 256; } tag[96] = cp; }
                __syncthreads();
            }
            const int njobs = (ph == 5) ? 2 : 1;
#pragma unroll 1
            for (int job = 0; job < njobs; ++job) {
                pg8::Gemm g; int kind;
                if (ph == 1) { g = pg8::Gemm{(const bf16_t*)(ws + OFF_HB), (const bf16_t*)(ws + OFF_WIN), NTOK, NP, 1024}; kind = 0; }
                else if (ph == 2) { g = pg8::Gemm{(const bf16_t*)(ws + OFF_CKV), (const bf16_t*)(ws + OFF_WKV), NTOK, 1024, 256}; kind = 1; }
                else if (ph == 5) { g = (job == 0) ? pg8::Gemm{(const bf16_t*)(ws + OFF_YA), (const bf16_t*)(ws + OFF_WA), NTOK, 1024, 512}
                                                   : pg8::Gemm{(const bf16_t*)(ws + OFF_YF), (const bf16_t*)(ws + OFF_WF), NTOK, 1024, 512}; kind = 2 + job; }
                else if (ph == 6) { g = pg8::Gemm{(const bf16_t*)(ws + OFF_MERGED), (const bf16_t*)(ws + OFF_WO), NTOK, 1024, 1024}; kind = 4; }
                else { g = pg8::Gemm{(const bf16_t*)(ws + OFF_HID), (const bf16_t*)(ws + OFF_WD), HID_ROWS, 32 * 1024, 256}; kind = 5; }
                pg8::StaticOrder S; S.init(g.M, g.N, G, bid);
                if (ph == 9) S.init_moe((const PG8_LAS int*)tag, G, (MOEXCD && G == 256) ? ((8 * (bid & 7) + (bid >> 5)) * 4 + ((bid >> 3) & 3)) : bid, (FUSE89 && REPEAT_PH < 0) ? (const unsigned*)ctl + CW_DONE : nullptr);
                EpiAny E{kind, (const PG8_LAS float*)rs, (const PG8_LAS int*)tag};
                if (ph == 2) { TS_END(1); TS_BEGIN(2); }
                pg8::gemm_phase<EpiAny, pg8::StaticOrder, true, true>((PG8_LAS unsigned char*)smem, g, S, E);
                if (ph == 2) { TS_END(2); TS_BEGIN(3); }
            }
            if (ph == 1) {
                const int tid = ltid(), lane = tid & 63, wave = __builtin_amdgcn_readfirstlane(tid >> 6);
                const int gw = (wave == 0) ? bid : 1 << 20;
                if (gw <= 180) {
                    const bf16_t* HBM = (const bf16_t*)(ws + OFF_HBM); const bf16_t* WIN = (const bf16_t*)(ws + OFF_WIN);
                    const int c0 = (gw < 180) ? gw * 16 : 4928;
                    f32x4 acc = zero4();
                    const bf16_t* ap_ = HBM + (size_t)(lane & 15) * 1024 + (lane >> 4) * 8;
                    const bf16_t* bp_ = WIN + (size_t)(c0 + (lane & 15)) * 1024 + (lane >> 4) * 8;
#pragma unroll 1
                    for (int k8 = 0; k8 < 4; ++k8) {
                        bf16x8 fa[8], fb[8];
#pragma unroll
                        for (int q = 0; q < 8; ++q) { fa[q] = *(const bf16x8*)(ap_ + (k8 * 8 + q) * 32); fb[q] = *(const bf16x8*)(bp_ + (k8 * 8 + q) * 32); }
#pragma unroll
                        for (int q = 0; q < 8; ++q) acc = __builtin_amdgcn_mfma_f32_16x16x32_bf16(fa[q], fb[q], acc, 0, 0, 0);
                    }
                    const int cg64 = c0 >> 6, d = (c0 & 63) + (lane & 15);
                    const bool ropeseg = (cg64 < 8 || (cg64 >= 12 && cg64 <= 20)) && ((c0 & 63) == 0);
                    const float* bfg = kp->in[5];
#pragma unroll
                    for (int j = 0; j < 4; ++j) {
                        const int t = (lane >> 4) * 4 + j;
                        float v = acc[j];
                        if (ropeseg) {
                            const float pr = __shfl_xor(v, 8);
                            const float cs = rope[t * 16 + 2 * (d & 7)], sn = rope[t * 16 + 2 * (d & 7) + 1];
                            v = (d & 8) ? (v * cs + pr * sn) : (v * cs - pr * sn);
                        }
#pragma unroll
                        for (int b = 0; b < 2; ++b) {
                            const size_t r = (size_t)b * TP + t;
                            if (cg64 < 8) ((bf16_t*)(ws + OFF_QA))[r * 512 + cg64 * 64 + d] = (bf16_t)f2bf(v * QSCALE);
                            else if (cg64 < 12) { if (b == 0) ((float*)(ws + OFF_MCKV))[t * 256 + (cg64 - 8) * 64 + d] = v; }
                            else if (cg64 < 20) ((bf16_t*)(ws + OFF_QI))[r * 512 + (cg64 - 12) * 64 + d] = (bf16_t)f2bf(v * 0.125f);
                            else if (cg64 == 20) ((bf16_t*)(ws + OFF_KI))[((size_t)((b * (TP / 16) + (t >> 4)) * 2 + (d >> 5)) * 64 + ((d & 31) >> 3) * 16 + (t & 15)) * 8 + (d & 7)] = (bf16_t)f2bf(v);
                            else if (cg64 < 29) ((bf16_t*)(ws + OFF_QF))[r * 512 + (cg64 - 21) * 64 + d] = (bf16_t)f2bf(v * QSCALE);
                            else if (cg64 < 37) ((bf16_t*)(ws + OFF_KF))[r * 512 + (cg64 - 29) * 64 + d] = (bf16_t)f2bf(v);
                            else if (cg64 < 45) ((bf16_t*)(ws + OFF_VF))[r * 512 + (cg64 - 37) * 64 + d] = (bf16_t)f2bf(v);
                            else if (d < 8) ((float*)(ws + OFF_WI))[r * 8 + d] = v * 0.3535533905932738f;
                            else { const float z = v + bfg[d - 8]; ((float*)(ws + OFF_LOGF))[(size_t)(b * 8 + (d - 8)) * TP + t] = fminf(z, 0.f) - __logf(1.0f + __expf(-fabsf(z))); }
                        }
                    }
                }
            }
            if (ph == 2) {
                const int tid = ltid(), lane = tid & 63, wave = __builtin_amdgcn_readfirstlane(tid >> 6);
                const int gw = (wave == 0) ? bid : 1 << 20;
                if (gw < 64) {
                    const float* MC = (const float*)(ws + OFF_MCKV); const bf16_t* WKV = (const bf16_t*)(ws + OFF_WKV);
                    const int c0 = gw * 16;
                    f32x4 acc = zero4(); float ss = 0.f;
                    const float* ap_ = MC + (lane & 15) * 256 + (lane >> 4) * 8;
                    const bf16_t* bp_ = WKV + (size_t)(c0 + (lane & 15)) * 256 + (lane >> 4) * 8;
                    f32x4 a0s[8], a1s[8]; bf16x8 bs[8];
#pragma unroll
                    for (int kk = 0; kk < 8; ++kk) { a0s[kk] = *(const f32x4*)(ap_ + kk * 32); a1s[kk] = *(const f32x4*)(ap_ + kk * 32 + 4); bs[kk] = *(const bf16x8*)(bp_ + kk * 32); }
#pragma unroll
                    for (int kk = 0; kk < 8; ++kk) {
                        const f32x4 a0 = a0s[kk], a1 = a1s[kk];
                        uint4 au; au.x = pk2(a0[0], a0[1]); au.y = pk2(a0[2], a0[3]); au.z = pk2(a1[0], a1[1]); au.w = pk2(a1[2], a1[3]);
                        const unsigned aw[4] = {au.x, au.y, au.z, au.w};
#pragma unroll
                        for (int e = 0; e < 4; ++e) { const float x0 = bf2f(aw[e] & 0xffffu), x1 = bf2f(aw[e] >> 16); ss = fmaf(x0, x0, fmaf(x1, x1, ss)); }
                        acc = __builtin_amdgcn_mfma_f32_16x16x32_bf16(*(bf16x8*)&au, bs[kk], acc, 0, 0, 0);
                    }
                    ss += __shfl_xor(ss, 16); ss += __shfl_xor(ss, 32);
                    const float rstd_row = rsqrtf(ss * (1.0f / 256.0f) + RMS_EPS);
                    const int cg64 = c0 >> 6, d = (c0 & 63) + (lane & 15);
                    const bool ropeseg = (cg64 < 8) && ((c0 & 63) == 0);
#pragma unroll
                    for (int j = 0; j < 4; ++j) {
                        const int t = (lane >> 4) * 4 + j;
                        float v = acc[j] * __shfl(rstd_row, t);
                        if (ropeseg) {
                            const float pr = __shfl_xor(v, 8);
                            const float cs = rope[t * 16 + 2 * (d & 7)], sn = rope[t * 16 + 2 * (d & 7) + 1];
                            v = (d & 8) ? (v * cs + pr * sn) : (v * cs - pr * sn);
                        }
#pragma unroll
                        for (int b = 0; b < 2; ++b) {
                            const size_t r = (size_t)b * TP + t;
                            if (cg64 < 8) ((bf16_t*)(ws + OFF_KA))[kimg_off(b, cg64, t, d)] = (bf16_t)f2bf(v);
                            else ((bf16_t*)(ws + OFF_VA))[vimg_off(b, cg64 - 8, t, d)] = (bf16_t)f2bf(v);
                        }
                    }
                }
            }
            if (ph == 2) { TS_END(3); TS_BEGIN(4); }
            if (ph == 2 && bid >= G - 16) {
                const int tid = ltid(), lane = tid & 63, wave = __builtin_amdgcn_readfirstlane(tid >> 6);
                const int i16 = bid - (G - 16), b = i16 >> 3, h = i16 & 7;
                const float* LOGT = (const float*)(ws + OFF_LOGF) + (size_t)(b * 8 + h) * TP;
                float* CUMT = (float*)(ws + OFF_CUMT) + (size_t)(b * 8 + h) * TP;
                float* seq = (float*)smem;
                double* part = (double*)(smem + 512 * 17 * 4);
                constexpr int CH = 17;
                for (int i = tid; i < 512 * CH; i += NTHREADS) seq[i] = (i < T) ? LOGT[i] : 0.f;
                __syncthreads();
                float lv[CH];
                double sacc = 0.0;
#pragma unroll
                for (int k = 0; k < CH; ++k) lv[k] = seq[tid * CH + k];
#pragma unroll
                for (int k = 0; k < CH; ++k) sacc += (double)lv[k];
                double incl = sacc;
#pragma unroll
                for (int d = 1; d < 64; d <<= 1) { const double v = __shfl_up(incl, d); if (lane >= d) incl += v; }
                if (lane == 63) part[wave] = incl;
                __syncthreads();
                double run = incl - sacc;
                for (int w = 0; w < wave; ++w) run += part[w];
#pragma unroll
                for (int k = 0; k < CH; ++k) { run += (double)lv[k]; seq[tid * CH + k] = (float)(run * 1.4426950408889634); }
                __syncthreads();
                for (int i = tid; i < TP; i += NTHREADS) CUMT[i] = (i < T) ? seq[i] : 0.f;
                __syncthreads();
            }
            if (ph == 2) { TS_END(4); TS_BEGIN(5); }
            if (ph == 2) {
                const int tid = ltid(), lane = tid & 63, wave = __builtin_amdgcn_readfirstlane(tid >> 6);
                const bf16_t* KF = (const bf16_t*)(ws + OFF_KF);
                float* KN = (float*)(ws + OFF_KNORM);
                for (int it = bid * 8 + wave; it < NB * 8 * MW; it += G * 8) {
                    const int kt = it % MW, bh = it / MW, b = bh >> 3, h = bh & 7;
                    const bf16_t* kr = KF + ((size_t)b * TP + kt * 64 + lane) * 512 + h * 64;
                    float ss = 0.f;
#pragma unroll
                    for (int c = 0; c < 8; ++c) {
                        const uint4 u = *(const uint4*)(kr + c * 8);
                        const unsigned ww[4] = {u.x, u.y, u.z, u.w};
#pragma unroll
                        for (int e = 0; e < 4; ++e) { const float a0 = bf2f(ww[e] & 0xffffu), a1 = bf2f(ww[e] >> 16); ss = fmaf(a0, a0, fmaf(a1, a1, ss)); }
                    }
#pragma unroll
                    for (int o = 1; o < 64; o <<= 1) ss = fmaxf(ss, __shfl_xor(ss, o));
                    if (lane == 0) KN[it] = sqrtf(ss);
                }
            }
            if (ph == 2 && P2CONV && bid < G - 16) moe_slab_pair(kp, ws, 2 * bid, (float*)smem);
            if (ph == 2 && FUSE23 && REPEAT_PH < 0) {
                asm volatile("s_waitcnt vmcnt(0)" ::: "memory");
                __syncthreads();
                if (ltid() == 0) { __threadfence(); (void)__hip_atomic_fetch_add(&ctl[CW_P2DONE], 1u, __ATOMIC_RELAXED, __HIP_MEMORY_SCOPE_AGENT); }
            }
            if (ph == 2) TS_END(5);
        }
        if (PH(3) && ph == 3) {
            const int tid = ltid(), lane = tid & 63, wave = __builtin_amdgcn_readfirstlane(tid >> 6); (void)lane; (void)wave;
            constexpr int N_FOX = 33 * 16, N_IDX2 = T / 8;
            const int cv0 = P2CONV ? 2 * (G - 16) : 0, N_CV2 = (1024 - cv0) / 2;
            int* qslot = (int*)(smem + LDS_BYTES - 16);
            if (tid == 0) qslot[1] = -1;
            for (;;) {
                __syncthreads();
                if (tid == 0) { const int nx = qslot[1]; qslot[1] = -1; *qslot = (nx >= 0) ? nx : (int)atomicAdd(&ctl[CW_Q3 + step], 1u); }
                __syncthreads();
                int it = *qslot;
                if (it >= N_FOX + N_IDX2 + N_CV2) break;
                if (FUSE23 && REPEAT_PH < 0) { constexpr int NI1 = 256; if (it < NI1) it = N_FOX + it; else if (it < NI1 + N_FOX) it -= NI1; }
                if (it >= N_FOX + N_IDX2) {
                    KParams kq = kp; unsigned char* wsq = ws;
                    const int g2 = cv0 + (it - (N_FOX + N_IDX2)) * 2;
                    int pf = -1;
#pragma unroll 1
                    TS_ACC_BEGIN(1);
                    if (QPF && tid == 0) pf = (int)atomicAdd(&ctl[CW_Q3 + step], 1u);
                    moe_slab_pair(kq, wsq, g2, (float*)smem);
                    TS_ACC_END(1);
                    if (QPF && tid == 0) qslot[1] = pf;
                    continue;
                }
                if (it < N_FOX) {
                    const int qb = 32 - it / 16, bh = it % 16;
                    if (FUSE23 && REPEAT_PH < 0) {
                        if (tid == 0) { unsigned sp = 0; while (__hip_atomic_load(&ctl[CW_P2DONE], __ATOMIC_RELAXED, __HIP_MEMORY_SCOPE_AGENT) < (unsigned)G && ++sp < (1u << 22)) __builtin_amdgcn_s_sleep(2);
                                        __builtin_amdgcn_fence(__ATOMIC_ACQUIRE, "agent"); }
                        __syncthreads();
                    }
                    TS_ACC_BEGIN(2);
                    const int kt0 = fox_prune(ws, bh >> 3, bh & 7, qb, smem);
                    ab::attn_unit<16, true>(bh >> 3, bh & 7, qb, (const ab::bf16*)(ws + OFF_QF), (const ab::bf16*)(ws + OFF_KF), (const ab::bf16*)(ws + OFF_VF), (ab::bf16*)(ws + OFF_YF),
                                           nullptr, (const float*)(ws + OFF_CUMT), kt0, (char*)smem);
                    TS_ACC_END(2);
                }
                else {
                    const int qg = (T / 8 - 1) - (it - N_FOX);
                    int pf = -1;
#pragma unroll 1
                    TS_ACC_BEGIN(3);
                    for (int bb = 0; bb < 2; ++bb) {
                        if (QPF && bb == 1 && tid == 0) pf = (int)atomicAdd(&ctl[CW_Q3 + step], 1u);
                        indexer_item(ws, bb, qg, smem);
                    }
                    if (FUSE34) {
                        asm volatile("s_waitcnt vmcnt(0)" ::: "memory");
                        __syncthreads();
                        if (tid == 0) { (void)__hip_atomic_fetch_add(&ctl[CW_MQB + (qg >> 5)], 1u, __ATOMIC_RELAXED, __HIP_MEMORY_SCOPE_AGENT); (void)__hip_atomic_fetch_add(&ctl[CW_IDXDONE], 1u, __ATOMIC_RELAXED, __HIP_MEMORY_SCOPE_AGENT); }
                    }
                    TS_ACC_END(3);
                    if (QPF && tid == 0) qslot[1] = pf;
                }
            }
        }
        if (PH(4) && ph == 4) {
            const int tid = ltid(), lane = tid & 63, wave = __builtin_amdgcn_readfirstlane(tid >> 6); (void)lane; (void)wave;
            constexpr int N_DSA = 33 * 16;
            int* qslot = (int*)(smem + LDS_BYTES - 16);
            for (;;) {
                __syncthreads();
                if (tid == 0) *qslot = (int)atomicAdd(&ctl[CW_Q4 + step], 1u);
                __syncthreads();
                const int it = *qslot;
                if (it >= N_DSA + 256) break;
                if (it >= N_DSA) {
                    KParams kq = kp; unsigned char* wsq = ws;
                    if (FUSE34 && REPEAT_PH < 0) {
                        if (tid == 0) { unsigned sp = 0; while (__hip_atomic_load(&ctl[CW_IDXDONE], __ATOMIC_RELAXED, __HIP_MEMORY_SCOPE_AGENT) < (unsigned)(T / 8) && ++sp < (1u << 22)) __builtin_amdgcn_s_sleep(2); }
                        __syncthreads();
                    }
                    moe_slab_pair(kq, wsq, 1024 + 2 * (it - N_DSA), (float*)smem);
                    continue;
                }
                const int qb = 32 - it / 16, bh = it % 16;
                if (FUSE34 && REPEAT_PH < 0) {
                    if (tid == 0) {
                        const unsigned need = (unsigned)((T / 8 - 32 * qb) < 32 ? (T / 8 - 32 * qb) : 32);
                        unsigned sp = 0; while ((__hip_atomic_load(&ctl[CW_MQB + qb], __ATOMIC_RELAXED, __HIP_MEMORY_SCOPE_AGENT) < need || (FUSE23 && __hip_atomic_load(&ctl[CW_P2DONE], __ATOMIC_RELAXED, __HIP_MEMORY_SCOPE_AGENT) < (unsigned)G)) && ++sp < (1u << 22)) __builtin_amdgcn_s_sleep(2);
                        __builtin_amdgcn_fence(__ATOMIC_ACQUIRE, "agent");
                    }
                    __syncthreads();
                }
                ab::attn_unit<16, false>(bh >> 3, bh & 7, qb, (const ab::bf16*)(ws + OFF_QA), (const ab::bf16*)(ws + OFF_KA), (const ab::bf16*)(ws + OFF_VA), (ab::bf16*)(ws + OFF_YA),
                                        (const unsigned long long*)(ws + OFF_MASK), nullptr, 0, (char*)smem);
            }
        }
        if (PH(5) && ph == 5) {
            const int tid = ltid(), lane = tid & 63, wave = __builtin_amdgcn_readfirstlane(tid >> 6); (void)lane; (void)wave;
        }
        if (PH(7) && ph == 7) {
            const int tid = ltid(), lane = tid & 63, wave = __builtin_amdgcn_readfirstlane(tid >> 6);
            constexpr int AP = 264;
            bf16_t* Ahi = (bf16_t*)smem; bf16_t* Alo = Ahi + 64 * AP;
            bf16_t* WL = Alo + 64 * AP;
            float* LG = (float*)(smem + (2 * 64 + 96) * AP * 2);
            const float* g1 = kp->in[11]; const float* b1 = kp->in[12];
            const float* brg = kp->in[14]; const float* bre = kp->in[16];
            const bf16_t* wrt = (const bf16_t*)(ws + OFF_WRT);
            bf16_t* H1B = (bf16_t*)(ws + OFF_H1B);
            int* TOKL = (int*)(ws + OFF_TOKL); float* GW = (float*)(ws + OFF_GW);
            unsigned* lcnt = (unsigned*)(LG + 64 * 49);
            for (int tb = bid; tb < NTOK / 64; tb += G) {
                const int n0 = tb * 64 + wave * 8;
                if (tid < 32) lcnt[tid] = 0u;
                f32x4 v[8][4];
#pragma unroll
                for (int tt = 0; tt < 8; ++tt)
#pragma unroll
                    for (int j = 0; j < 4; ++j) v[tt][j] = __builtin_nontemporal_load((const f32x4*)(kp->out + (size_t)(n0 + tt) * 1024 + lane * 4 + 256 * j));
                f32x4 gg1[4], bb1[4];
#pragma unroll
                for (int j = 0; j < 4; ++j) { gg1[j] = *(const f32x4*)(g1 + lane * 4 + 256 * j); bb1[j] = *(const f32x4*)(b1 + lane * 4 + 256 * j); }
#pragma unroll
                for (int tt = 0; tt < 8; ++tt) {
                    float s_ = 0.f;
#pragma unroll
                    for (int j = 0; j < 4; ++j) s_ += (v[tt][j][0] + v[tt][j][1]) + (v[tt][j][2] + v[tt][j][3]);
                    const float mu = wave_sum(s_) * (1.0f / 1024.0f);
                    float q = 0.f;
#pragma unroll
                    for (int j = 0; j < 4; ++j) { const f32x4 d = v[tt][j] - mu; q += (d[0] * d[0] + d[1] * d[1]) + (d[2] * d[2] + d[3] * d[3]); }
                    const float rstd = rsqrtf(wave_sum(q) * (1.0f / 1024.0f) + LN_EPS);
#pragma unroll
                    for (int j = 0; j < 4; ++j) {
                        v[tt][j] = (v[tt][j] - mu) * rstd * gg1[j] + bb1[j];
                        store4bf(H1B + (size_t)(n0 + tt) * 1024 + lane * 4 + 256 * j, v[tt][j]);
                    }
                    if (lane == 0) { float* st1 = (float*)(ws + OFF_ST1); st1[2 * (n0 + tt)] = mu; st1[2 * (n0 + tt) + 1] = rstd; }
                }
                f32x4 acc0 = zero4(), acc1 = zero4();
                const int mt = wave & 3, nt0 = (wave < 4) ? 0 : 2;
                const bool two = wave < 4;
#pragma unroll
                for (int j = 0; j < 4; ++j) {
                    const int wrow = tid >> 5, wch = tid & 31;
                    const bf16_t* wsrc = wrt + (size_t)wrow * 1024 + j * 256 + wch * 8;
                    const uint4 w0 = *(const uint4*)(wsrc), w1 = *(const uint4*)(wsrc + 16 * 1024), w2 = *(const uint4*)(wsrc + 32 * 1024),
                                w3 = *(const uint4*)(wsrc + 48 * 1024), w4 = *(const uint4*)(wsrc + 64 * 1024), w5 = *(const uint4*)(wsrc + 80 * 1024);
                    __syncthreads();
#pragma unroll
                    for (int tt = 0; tt < 8; ++tt) {
                        const f32x4 x = v[tt][j];
                        float x0 = x[0], x1 = x[1], x2 = x[2], x3 = x[3];
                        asm volatile("" : "+v"(x0), "+v"(x1), "+v"(x2), "+v"(x3));
                        uint2 hi, lo;
                        hi.x = pk2(x0, x1); hi.y = pk2(x2, x3);
                        lo.x = pk2(x0 - __uint_as_float(hi.x << 16), x1 - __uint_as_float(hi.x & 0xffff0000u));
                        lo.y = pk2(x2 - __uint_as_float(hi.y << 16), x3 - __uint_as_float(hi.y & 0xffff0000u));
                        *(uint2*)(Ahi + (wave * 8 + tt) * AP + lane * 4) = hi;
                        *(uint2*)(Alo + (wave * 8 + tt) * AP + lane * 4) = lo;
                    }
                    {
                        bf16_t* wd = WL + wrow * AP + wch * 8;
                        *(uint4*)(wd) = w0; *(uint4*)(wd + 16 * AP) = w1; *(uint4*)(wd + 32 * AP) = w2;
                        *(uint4*)(wd + 48 * AP) = w3; *(uint4*)(wd + 64 * AP) = w4; *(uint4*)(wd + 80 * AP) = w5;
                    }
                    __syncthreads();
#pragma unroll 4
                    for (int kk = 0; kk < 8; ++kk) {
                        const int ko = kk * 32 + (lane >> 4) * 8;
                        const bf16x8 ah = *(const bf16x8*)(Ahi + (mt * 16 + (lane & 15)) * AP + ko);
                        const bf16x8 al = *(const bf16x8*)(Alo + (mt * 16 + (lane & 15)) * AP + ko);
                        {
                            const bf16_t* wp = WL + (nt0 * 16 + (lane & 15)) * AP + ko;
                            const bf16x8 bh = *(const bf16x8*)wp, bl = *(const bf16x8*)(wp + 48 * AP);
                            acc0 = __builtin_amdgcn_mfma_f32_16x16x32_bf16(ah, bh, acc0, 0, 0, 0);
                            acc0 = __builtin_amdgcn_mfma_f32_16x16x32_bf16(ah, bl, acc0, 0, 0, 0);
                            acc0 = __builtin_amdgcn_mfma_f32_16x16x32_bf16(al, bh, acc0, 0, 0, 0);
                        }
                        if (two) {
                            const bf16_t* wp = WL + (16 + (lane & 15)) * AP + ko;
                            const bf16x8 bh = *(const bf16x8*)wp, bl = *(const bf16x8*)(wp + 48 * AP);
                            acc1 = __builtin_amdgcn_mfma_f32_16x16x32_bf16(ah, bh, acc1, 0, 0, 0);
                            acc1 = __builtin_amdgcn_mfma_f32_16x16x32_bf16(ah, bl, acc1, 0, 0, 0);
                            acc1 = __builtin_amdgcn_mfma_f32_16x16x32_bf16(al, bh, acc1, 0, 0, 0);
                        }
                    }
                }
#pragma unroll
                for (int i = 0; i < 4; ++i) {
                    LG[(mt * 16 + (lane >> 4) * 4 + i) * 49 + nt0 * 16 + (lane & 15)] = acc0[i];
                    if (two) LG[(mt * 16 + (lane >> 4) * 4 + i) * 49 + 16 + (lane & 15)] = acc1[i];
                }
                __syncthreads();
                int my_e1 = 0, my_e2 = 0; float my_g1 = 0.f, my_g2 = 0.f;
                if (lane < 8) {
                    const float* lg = LG + (wave * 8 + lane) * 49;
                    float gl[4];
#pragma unroll
                    for (int i = 0; i < 4; ++i) gl[i] = lg[i] + brg[i];
                    int gs = 0; float gm = gl[0];
#pragma unroll
                    for (int i = 1; i < 4; ++i) if (gl[i] > gm) { gm = gl[i]; gs = i; }
                    float den = 0.f;
#pragma unroll
                    for (int i = 0; i < 4; ++i) den += __expf(gl[i] - gm);
                    const float pg = 1.0f / den;
                    float el[8];
#pragma unroll
                    for (int j = 0; j < 8; ++j) el[j] = lg[4 + gs * 8 + j] + bre[gs * 8 + j];
                    int i1 = 0; float l1 = el[0];
#pragma unroll
                    for (int j = 1; j < 8; ++j) if (el[j] > l1) { l1 = el[j]; i1 = j; }
                    int i2 = -1; float l2 = -3.0e38f;
#pragma unroll
                    for (int j = 0; j < 8; ++j) if (j != i1 && el[j] > l2) { l2 = el[j]; i2 = j; }
                    const float w1 = 1.0f / (1.0f + __expf(l2 - l1)), w2 = 1.0f - w1;
                    my_e1 = gs * 8 + i1; my_e2 = gs * 8 + i2; my_g1 = pg * w1; my_g2 = pg * w2;
                }
                unsigned r1 = 0, r2 = 0;
                if (lane < 8) { r1 = atomicAdd(&lcnt[my_e1], 1u); r2 = atomicAdd(&lcnt[my_e2], 1u); }
                __syncthreads();
                if (tid < 32) { const int t2 = ltid(); const unsigned c = lcnt[t2]; lcnt[32 + t2] = c ? atomicAdd(&ctl[CW_ECNT + t2 * ECS], c) : 0u; }
                __syncthreads();
                if (lane < 8) {
                    const int n = n0 + lane;
                    TOKL[my_e1 * 32768 + lcnt[32 + my_e1] + r1] = n * 2;
                    TOKL[my_e2 * 32768 + lcnt[32 + my_e2] + r2] = n * 2 + 1;
                    GW[n * 2] = my_g1; GW[n * 2 + 1] = my_g2;
                }
                __syncthreads();
            }
        }
        if (PH(8) && ph == 8) {
            const int tid = ltid(), lane = tid & 63, wave = __builtin_amdgcn_readfirstlane(tid >> 6); (void)lane; (void)wave;
            int* ecnt_s = (int*)(smem + LDS_BYTES - 1024);
            if (tid < 32) ecnt_s[tid] = (int)ctl[CW_ECNT + tid * ECS];
            __syncthreads();
            if (tid == 0) { int cp = 0, rb = 0; for (int e = 0; e < 32; ++e) { ecnt_s[32 + e] = cp; ecnt_s[64 + e] = rb; const int nc = (ecnt_s[e] + 255) >> 8; cp += nc; rb += nc * 256; } ecnt_s[96] = cp; }
            __syncthreads();
            const int nchunks = ecnt_s[96];
            const int* TOKL = (const int*)(ws + OFF_TOKL);
            bf16_t* HID = (bf16_t*)(ws + OFF_HID);
            const int NNT = (ph == 8) ? 4 : 8;
            const int obid = (MOEXCD && G == 256) ? ((8 * (bid & 7) + (bid >> 5)) * 4 + ((bid >> 3) & 3)) : bid;
            for (int tile = obid; tile < nchunks * NNT; tile += G) {
                const int ch = tile / NNT, nt = tile % NNT;
                int e = 0;
#pragma unroll 1
                for (int k = 1; k < 32; ++k) if (ecnt_s[32 + k] <= ch) e = k;
                const int c_in_e = ch - ecnt_s[32 + e];
                const int cnt = ecnt_s[e];
                const int rowbase = ecnt_s[64 + e] + c_in_e * 256;
                const int pos0 = c_in_e * 256;
                const int rl = (wave >> 1) * 64, c4 = (lane >> 4) * 4;
                if (PH(8) && ph == 8) {
                    const bf16_t* H1B = (const bf16_t*)(ws + OFF_H1B);
                    const bf16_t* WGU = (const bf16_t*)(ws + OFF_WGU) + (size_t)e * 512 * 1024;
                    const bf16_t* ap[4]; const bf16_t* bp[2];
#pragma unroll
                    for (int i = 0; i < 4; ++i) {
                        int pos = pos0 + (tid >> 3) + 64 * i; pos = pos < cnt ? pos : cnt - 1;
                        const int aid = TOKL[e * 32768 + pos];
                        ap[i] = H1B + (size_t)(aid >> 1) * 1024;
                    }
#pragma unroll
                    for (int i = 0; i < 2; ++i) bp[i] = WGU + (size_t)(nt * 128 + (tid >> 3) + 64 * i) * 1024;
                    f32x4 acc[4][4]; zero_acc(acc);
                    gemm_core3(ap, bp, 1024, smem, acc);
                    const int hc0 = (nt * 128 + (wave & 1) * 64) >> 1;
#pragma unroll
                    for (int mi = 0; mi < 4; ++mi) {
                        const int rr = rl + mi * 16 + (lane & 15);
                        bf16_t* dst = HID + (size_t)(rowbase + rr) * 256 + hc0 + c4;
#pragma unroll
                        for (int pr = 0; pr < 2; ++pr) {
                            f32x4 hv;
#pragma unroll
                            for (int j = 0; j < 4; ++j) { const float gte = acc[mi][2 * pr][j], up = acc[mi][2 * pr + 1][j]; hv[j] = gte * sigmoidf_(gte) * up; }
                            if (FUSE89) store4bf_agent(dst + pr * 16, hv); else store4bf(dst + pr * 16, hv);
                        }
                    }
                    if (FUSE89) {
                        asm volatile("s_waitcnt vmcnt(0)" ::: "memory");
                        __syncthreads();
                        if (ltid() == 0) (void)__hip_atomic_fetch_add(&ctl[CW_DONE + ch], 1u, __ATOMIC_RELAXED, __HIP_MEMORY_SCOPE_AGENT);
                    }
                } else {
                    const bf16_t* WD = (const bf16_t*)(ws + OFF_WD) + (size_t)e * 1024 * 256;
                    const float* GW = (const float*)(ws + OFF_GW);
                    bf16_t* SLOT = (bf16_t*)(ws + OFF_SLOT);
                    const bf16_t* ap[4]; const bf16_t* bp[2];
                    dense_ptrs(HID, 256, rowbase, WD, 256, nt * 128, ap, bp);
                    f32x4 acc[4][4]; zero_acc(acc);
                    gemm_core(ap, bp, 256, (bf16_t*)smem, acc);
                    const int cbase = nt * 128 + (wave & 1) * 64;
#pragma unroll
                    for (int mi = 0; mi < 4; ++mi) {
                        const int pos = pos0 + rl + mi * 16 + (lane & 15);
                        if (pos < cnt) {
                            const int aid = TOKL[e * 32768 + pos];
                            const float gw = GW[aid];
                            bf16_t* dst = SLOT + (size_t)aid * 1024 + cbase + c4;
#pragma unroll
                            for (int ni = 0; ni < 4; ++ni) store4bf(dst + ni * 16, acc[mi][ni] * gw);
                        }
                    }
                }
            }
        }
        if (PH(10) && ph == 10) {
            const int tid = ltid(), lane = tid & 63, wave = __builtin_amdgcn_readfirstlane(tid >> 6); (void)tid;
            const bf16_t* SLOT = (const bf16_t*)(ws + OFF_SLOT);
            const float* g2 = kp->in[20]; const float* b2 = kp->in[21];
            const bf16_t* H1B = (const bf16_t*)(ws + OFF_H1B);
            f32x4 gg2[4], bb2[4];
#pragma unroll
            for (int j = 0; j < 4; ++j) { gg2[j] = *(const f32x4*)(g2 + lane * 4 + 256 * j); bb2[j] = *(const f32x4*)(b2 + lane * 4 + 256 * j); }
            for (int n0 = (bid * 8 + wave) * 4; n0 < NTOK; n0 += G * 8 * 4) {
                f32x4 v[4][4];
#pragma unroll
                for (int rr = 0; rr < 4; ++rr) {
                    const int n = n0 + rr;
#pragma unroll
                    for (int j = 0; j < 4; ++j) {
                        const int c = lane * 4 + 256 * j;
                        const uint2 hb = ntload_u2(H1B + (size_t)n * 1024 + c);
                        const f32x4 hv = {bf2f(hb.x & 0xffffu), bf2f(hb.x >> 16), bf2f(hb.y & 0xffffu), bf2f(hb.y >> 16)};
                        const uint2 u0 = ntload_u2(SLOT + (size_t)(2 * n) * 1024 + c), u1 = ntload_u2(SLOT + (size_t)(2 * n + 1) * 1024 + c);
                        f32x4 f; f[0] = bf2f(u0.x & 0xffffu) + bf2f(u1.x & 0xffffu); f[1] = bf2f(u0.x >> 16) + bf2f(u1.x >> 16);
                        f[2] = bf2f(u0.y & 0xffffu) + bf2f(u1.y & 0xffffu); f[3] = bf2f(u0.y >> 16) + bf2f(u1.y >> 16);
                        v[rr][j] = hv * ALPHA + f;
                    }
                }
#pragma unroll
                for (int rr = 0; rr < 4; ++rr) {
                    float s = 0.f;
#pragma unroll
                    for (int j = 0; j < 4; ++j) s += (v[rr][j][0] + v[rr][j][1]) + (v[rr][j][2] + v[rr][j][3]);
                    const float mu = wave_sum(s) * (1.0f / 1024.0f);
                    float q = 0.f;
#pragma unroll
                    for (int j = 0; j < 4; ++j) { const f32x4 d = v[rr][j] - mu; q += (d[0] * d[0] + d[1] * d[1]) + (d[2] * d[2] + d[3] * d[3]); }
                    const float rstd = rsqrtf(wave_sum(q) * (1.0f / 1024.0f) + LN_EPS);
                    float* row = kp->out + (size_t)(n0 + rr) * 1024;
#pragma unroll
                    for (int j = 0; j < 4; ++j) {
                        const int c = lane * 4 + 256 * j;
                        __builtin_nontemporal_store((v[rr][j] - mu) * rstd * gg2[j] + bb2[j], (f32x4*)(row + c));
                    }
                }
            }
        }
    }
    if (TIME_PH >= 200 && TIME_BLK < 0) {
        volatile LAS unsigned* ts = (volatile LAS unsigned*)(smem + LDS_BYTES - 64);
        KParams kpt = (KParams)__builtin_amdgcn_kernarg_segment_ptr();
        unsigned* ctlt = (unsigned*)(kpt->ws + OFF_CTL);
        if (threadIdx.x == 0) atomicAdd(&ctlt[CW_DONE + 300], ts[6]);
        XcdBarrier gb; gb.bar = ctlt + CW_BAR; gb.x = xb_xcc_id(); gb.st = (volatile LAS unsigned*)(smem + LDS_BYTES - 64);
        xcd_barrier(gb);
        if (blockIdx.x == 0 && threadIdx.x == 0) {
            const unsigned long long d = __hip_atomic_load(&ctlt[CW_DONE + 300], __ATOMIC_RELAXED, __HIP_MEMORY_SCOPE_AGENT) / gridDim.x;
            const unsigned long long tnow = wall_clock64();
            while (wall_clock64() - tnow < d) __builtin_amdgcn_s_sleep(8);
        }
    } else
    if (TIME_PH >= 0 && blockIdx.x == (TIME_PH >= 100 ? TIME_BLK : 0)) {
        __syncthreads();
        if (threadIdx.x == 0) {
            volatile LAS unsigned* ts = (volatile LAS unsigned*)(smem + LDS_BYTES - 64);
            const unsigned long long t0 = ((unsigned long long)ts[5] << 32) | ts[4];
            const unsigned long long tnow = wall_clock64();
            const unsigned long long t1 = (TIME_PH == NPHASES - 1) ? tnow : (((unsigned long long)ts[7] << 32) | ts[6]);
            unsigned long long d = t1 - t0; if (d > 100000ull) d = 100000ull;
            while (wall_clock64() - tnow < d) __builtin_amdgcn_s_sleep(8);
        }
    }
}

extern "C" void kernel_launch(void* const* d_in, const int* in_sizes, int n_in, void* d_out, int out_size, void* d_ws, size_t ws_size, hipStream_t stream) {
    static int grid = 0;
    if (grid == 0) {
        int dev = 0, cus = 0, per_cu = 0;
        hipGetDevice(&dev);
        hipDeviceGetAttribute(&cus, hipDeviceAttributeMultiprocessorCount, dev);
        hipOccupancyMaxActiveBlocksPerMultiprocessor(&per_cu, (const void*)mega, NTHREADS, 0);
        if (per_cu < 1) per_cu = 1;
        if (per_cu > 1) per_cu = 1;
        grid = cus * per_cu;
        if (n_in != 22 || ws_size < WS_END) { fprintf(stderr, "kernel_launch: unexpected n_in %d / ws_size %zu (need %zu)\n", n_in, ws_size, (size_t)WS_END); }
    }
    hipMemsetAsync((char*)d_ws + OFF_CTL, 0, 32768, stream);
    Params p{};
    for (int i = 0; i < 22; ++i) p.in[i] = (const float*)d_in[i];
    p.out = (float*)d_out; p.ws = (unsigned char*)d_ws;
#if N_LAUNCH_MODE == 0
    p.ph_lo = 0; p.ph_hi = NPHASES + (REPEAT_PH >= 0 ? 1 : 0) + EXTRA_SYNCS;
    void* args[] = {&p};
    hipError_t e = hipLaunchCooperativeKernel((const void*)mega, dim3(grid), dim3(NTHREADS), args, 0, stream);
    if (e != hipSuccess) fprintf(stderr, "cooperative launch failed: %s (grid %d)\n", hipGetErrorString(e), grid);
#else
    for (int ph = 0; ph < NPHASES; ++ph) {
        p.ph_lo = ph; p.ph_hi = ph + 1;
        hipLaunchKernelGGL(mega, dim3(grid), dim3(NTHREADS), 0, stream, p);
    }
#endif
}
```
